# Optimizing an MI355X kernel written in HIP

```python
import math
import jax
import jax.numpy as jnp
from jax import lax
import numpy as np


D_MODEL = 1024
BATCH = 8
SEQ = 4096
DEPTH = 2

GRID_W = 64
CTX_LEN = 256
EPS = 1e-6
ROPE_BASE = 10000.0

BR_WIDTH = D_MODEL // 2
A_DK = 128
A_DV = 128
A_HEADS = BR_WIDTH // A_DK
A_WIDTH = A_HEADS * A_DV
A_CONV = 5
A_CHUNK = 64
B_HD = 64
B_Q_HEADS = BR_WIDTH // B_HD
B_KV_HEADS = B_Q_HEADS // 4
B_WIDTH = B_Q_HEADS * B_HD
WINDOW = 128
B_BLOCK = 128
C_HD = 128
C_HEADS = BR_WIDTH // C_HD
C_WIDTH = C_HEADS * C_HD
C_CHUNK = 64
N_BRANCH = 3

SPLIT_SIZES = (3 * A_WIDTH, A_WIDTH, 2 * A_HEADS, 2 * A_HEADS,
               B_Q_HEADS * B_HD, 2 * B_KV_HEADS * B_HD, B_WIDTH,
               3 * C_WIDTH, C_WIDTH, N_BRANCH * D_MODEL)
SPLIT_POINTS = tuple(int(v) for v in np.cumsum(SPLIT_SIZES)[:-1])
IN_WIDTH = int(sum(SPLIT_SIZES))

kernel_name = 'hybrid_delta_window_retention_dit'


def rms_norm(x, w):
    xf = x.astype(jnp.float32)
    y = xf * lax.rsqrt(jnp.mean(xf * xf, axis=-1, keepdims=True) + EPS)
    return (y * w.astype(jnp.float32)).astype(x.dtype)


def l2_normalize(x):
    xf = x.astype(jnp.float32)
    return xf * lax.rsqrt(jnp.sum(xf * xf, axis=-1, keepdims=True) + EPS)


def to_heads(x, h):
    b, t, _ = x.shape
    return x.reshape(b, t, h, -1).transpose(0, 2, 1, 3)


def from_heads(x):
    b, h, t, d = x.shape
    return x.transpose(0, 2, 1, 3).reshape(b, t, h * d)


def flip_t(a):
    return jnp.flip(a, axis=2)


def rope_angles(pos, n_freq):
    inv = ROPE_BASE ** (-jnp.arange(n_freq, dtype=jnp.float32) / n_freq)
    return pos[:, None] * inv[None, :]


def apply_rot(x, ang):
    x1, x2 = jnp.split(x, 2, axis=-1)
    cos = jnp.cos(ang).astype(x.dtype)
    sin = jnp.sin(ang).astype(x.dtype)
    return jnp.concatenate([x1 * cos - x2 * sin, x1 * sin + x2 * cos], axis=-1)


def apply_axial(x, ang_r, ang_c):
    half = x.shape[-1] // 2
    return jnp.concatenate([apply_rot(x[..., :half], ang_r), apply_rot(x[..., half:], ang_c)], axis=-1)


def short_conv(x, w):
    k = w.shape[0]
    p = k // 2
    return lax.conv_general_dilated(x, w[:, None, :].astype(x.dtype), window_strides=(1,),
                                    padding=[(p, p)], dimension_numbers=('NWC', 'WIO', 'NWC'),
                                    feature_group_count=x.shape[-1])


def gated_delta_chunk(q, k, v, g, beta, s0):
    b, h, t, dk = q.shape
    dv = v.shape[-1]
    c = A_CHUNK
    n = t // c
    q = q.reshape(b, h, n, c, dk)
    k = k.reshape(b, h, n, c, dk)
    v = v.reshape(b, h, n, c, dv)
    g = jnp.cumsum(g.reshape(b, h, n, c), axis=-1)
    beta = beta.reshape(b, h, n, c)
    incl = jnp.tril(jnp.ones((c, c), dtype=bool))
    strict = jnp.tril(jnp.ones((c, c), dtype=bool), -1)
    decay = jnp.exp(jnp.where(incl, g[..., :, None] - g[..., None, :], -jnp.inf))
    kb = k * beta[..., None]
    lmat = jnp.where(strict, jnp.einsum('bhnid,bhnjd->bhnij', kb, k) * decay, 0.0)
    eye = jnp.eye(c, dtype=jnp.float32)
    tinv = lax.linalg.triangular_solve(lmat + eye, jnp.broadcast_to(eye, lmat.shape),
                                       left_side=True, lower=True)
    u = jnp.einsum('bhnij,bhnjd->bhnid', tinv, v * beta[..., None])
    w = jnp.einsum('bhnij,bhnjd->bhnid', tinv, kb * jnp.exp(g)[..., None])
    qk = jnp.einsum('bhnid,bhnjd->bhnij', q, k) * decay
    q_dec = q * jnp.exp(g)[..., None]
    g_last = g[..., -1]
    k_tail = k * jnp.exp(g_last[..., None] - g)[..., None]

    def step(state, inp):
        u_n, w_n, qk_n, qd_n, kt_n, gl_n = inp
        v_new = u_n - jnp.einsum('bhcd,bhde->bhce', w_n, state)
        o_n = jnp.einsum('bhcd,bhde->bhce', qd_n, state) + jnp.einsum('bhij,bhje->bhie', qk_n, v_new)
        state = state * jnp.exp(gl_n)[..., None, None] + jnp.einsum('bhcd,bhce->bhde', kt_n, v_new)
        return state, o_n

    mv = lambda a: jnp.moveaxis(a, 2, 0)
    s_fin, o = lax.scan(step, s0, (mv(u), mv(w), mv(qk), mv(q_dec), mv(k_tail), mv(g_last)))
    return jnp.moveaxis(o, 0, 2).reshape(b, h, t, dv), s_fin


def delta_prep(qkv, b_raw, a_raw, conv_w, a_log, dt_bias):
    qkv = jax.nn.silu(short_conv(qkv, conv_w))
    q, k, v = jnp.split(qkv, 3, axis=-1)
    q = l2_normalize(to_heads(q, A_HEADS)) * (A_DK ** -0.5)
    k = l2_normalize(to_heads(k, A_HEADS))
    v = to_heads(v, A_HEADS).astype(jnp.float32)
    beta = jax.nn.sigmoid(b_raw.astype(jnp.float32)).transpose(0, 2, 1)
    g = -jnp.exp(a_log.astype(jnp.float32))[None, :, None] * jax.nn.softplus(
        (a_raw.astype(jnp.float32) + dt_bias.astype(jnp.float32)).transpose(0, 2, 1))
    return q, k, v, beta, g


def bidir_delta(q, k, v, beta, g, s0_f, s0_b):
    h = A_HEADS
    o_f, s_f = gated_delta_chunk(q, k, v, g[:, :h], beta[:, :h], s0_f)
    o_b, s_b = gated_delta_chunk(flip_t(q), flip_t(k), flip_t(v), flip_t(g[:, h:]), flip_t(beta[:, h:]), s0_b)
    return o_f + flip_t(o_b), s_f, s_b


def gated_head_rmsnorm(o, z, w):
    o = o * lax.rsqrt(jnp.mean(o * o, axis=-1, keepdims=True) + EPS) * w.astype(jnp.float32)
    return (from_heads(o) * jax.nn.silu(z.astype(jnp.float32))).astype(z.dtype)


def window_attention(q, k, v, k_ctx, v_ctx, sink):
    b, t, hq, dh = q.shape
    hkv = k.shape[2]
    grp = hq // hkv
    blk = B_BLOCK
    nb = t // blk
    l = k_ctx.shape[1]
    scale = dh ** -0.5
    qb = q.reshape(b, nb, blk, hkv, grp, dh)
    pad = ((0, 0), (blk, blk), (0, 0), (0, 0))
    kp = jnp.pad(k, pad).reshape(b, nb + 2, blk, hkv, dh)
    vp = jnp.pad(v, pad).reshape(b, nb + 2, blk, hkv, dh)
    kw = jnp.concatenate([kp[:, :-2], kp[:, 1:-1], kp[:, 2:]], axis=2)
    vw = jnp.concatenate([vp[:, :-2], vp[:, 1:-1], vp[:, 2:]], axis=2)
    s_win = jnp.einsum('bnqhgd,bnkhd->bnhgqk', qb, kw).astype(jnp.float32) * scale
    s_ctx = jnp.einsum('bnqhgd,blhd->bnhgql', qb, k_ctx).astype(jnp.float32) * scale
    rel = jnp.arange(3 * blk)[None, :] - blk - jnp.arange(blk)[:, None]
    kpos = jnp.arange(nb)[:, None] * blk - blk + jnp.arange(3 * blk)[None, :]
    valid = (jnp.abs(rel) <= WINDOW)[None] & ((kpos >= 0) & (kpos < t))[:, None, :]
    s_win = jnp.where(valid[None, :, None, None], s_win, -jnp.inf)
    sink_s = jnp.broadcast_to(sink.astype(jnp.float32).reshape(1, 1, hkv, grp, 1, 1), s_win.shape[:-1] + (1,))
    p = jax.nn.softmax(jnp.concatenate([sink_s, s_ctx, s_win], axis=-1), axis=-1)
    p_ctx = p[..., 1:1 + l].astype(v.dtype)
    p_win = p[..., 1 + l:].astype(v.dtype)
    o = (jnp.einsum('bnhgql,blhd->bnqhgd', p_ctx, v_ctx)
         + jnp.einsum('bnhgqk,bnkhd->bnqhgd', p_win, vw))
    return o.reshape(b, t, hq * dh)


def context_attention(q, k, v, sink):
    b, l, hq, dh = q.shape
    hkv = k.shape[2]
    grp = hq // hkv
    qg = q.reshape(b, l, hkv, grp, dh)
    s = jnp.einsum('bqhgd,bkhd->bhgqk', qg, k).astype(jnp.float32) * (dh ** -0.5)
    sink_s = jnp.broadcast_to(sink.astype(jnp.float32).reshape(1, hkv, grp, 1, 1), s.shape[:-1] + (1,))
    p = jax.nn.softmax(jnp.concatenate([sink_s, s], axis=-1), axis=-1)[..., 1:]
    o = jnp.einsum('bhgqk,bkhd->bqhgd', p.astype(v.dtype), v)
    return o.reshape(b, l, hq * dh)


def retention_chunk(q, k, v, log_gamma, s0):
    b, h, t, dk = q.shape
    dv = v.shape[-1]
    c = C_CHUNK
    n = t // c
    q = q.reshape(b, h, n, c, dk)
    k = k.reshape(b, h, n, c, dk)
    v = v.reshape(b, h, n, c, dv)
    idx = jnp.arange(c, dtype=jnp.float32)
    lg = log_gamma.astype(jnp.float32)[:, None]
    incl = jnp.tril(jnp.ones((c, c), dtype=bool))
    dmask = jnp.exp(jnp.where(incl, (idx[:, None] - idx[None, :]) * lg[:, :, None], -jnp.inf))
    o_inner = jnp.einsum('bhnij,bhnje->bhnie',
                         jnp.einsum('bhnid,bhnjd->bhnij', q, k) * dmask[None, :, None], v)
    q_dec = q * jnp.exp((idx + 1.0) * lg)[None, :, None, :, None]
    k_dec = k * jnp.exp((c - 1.0 - idx) * lg)[None, :, None, :, None]
    chunk_dec = jnp.exp(c * lg)[None, :, :, None]

    def step(state, inp):
        qd_n, kd_n, v_n = inp
        o_n = jnp.einsum('bhcd,bhde->bhce', qd_n, state)
        state = state * chunk_dec + jnp.einsum('bhcd,bhce->bhde', kd_n, v_n)
        return state, o_n

    mv = lambda a: jnp.moveaxis(a, 2, 0)
    s_fin, o_cross = lax.scan(step, s0, (mv(q_dec), mv(k_dec), mv(v)))
    o = o_inner + jnp.moveaxis(o_cross, 0, 2)
    return o.reshape(b, h, t, dv), s_fin


def retention_prep(qkv, ang):
    q, k, v = jnp.split(qkv, 3, axis=-1)
    q = to_heads(q, C_HEADS).astype(jnp.float32)
    k = to_heads(k, C_HEADS).astype(jnp.float32) * (C_HD ** -0.5)
    v = to_heads(v, C_HEADS).astype(jnp.float32)
    if ang is not None:
        q = apply_rot(q, ang)
        k = apply_rot(k, ang)
    return q, k, v


def bidir_retention(q, k, v, log_gamma, s0_f, s0_b):
    h = C_HEADS
    o_f, s_f = retention_chunk(q, k, v, log_gamma[:h], s0_f)
    o_b, s_b = retention_chunk(flip_t(q), flip_t(k), flip_t(v), log_gamma[h:], s0_b)
    return o_f + flip_t(o_b), s_f, s_b


def retention_out(o, z, w):
    mu = jnp.mean(o, axis=-1, keepdims=True)
    var = jnp.mean(jnp.square(o - mu), axis=-1, keepdims=True)
    o = from_heads((o - mu) * lax.rsqrt(var + EPS)) * w.astype(jnp.float32)
    return (o * jax.nn.silu(z.astype(jnp.float32))).astype(z.dtype)


def merge_branches(y_a, y_b, y_c, logits, w_br, w_o):
    g_a, g_b, g_c = jnp.split(jax.nn.sigmoid(logits), 3, axis=-1)
    merged = g_a * (y_a @ w_br[0]) + g_b * (y_b @ w_br[1]) + g_c * (y_c @ w_br[2])
    return merged @ w_o


def setup_inputs(seed: int = 0) -> dict:
    key = jax.random.key(seed)
    ks = jax.random.split(key, 18)
    f32 = jnp.float32

    def nrm(k, shape, s):
        return jax.random.normal(k, shape, f32) * s

    x = nrm(ks[0], (BATCH, SEQ, D_MODEL), 1.0)
    c = nrm(ks[1], (BATCH, D_MODEL), 1.0)
    ctx = nrm(ks[2], (BATCH, CTX_LEN, D_MODEL), 1.0)
    c_ctx = nrm(ks[3], (D_MODEL,), 1.0)
    w_ada = nrm(ks[4], (DEPTH, D_MODEL, 3 * D_MODEL), 0.5 * D_MODEL ** -0.5)
    b_ada = nrm(ks[5], (DEPTH, 3 * D_MODEL), 0.02)
    norm_w = 1.0 + nrm(ks[6], (DEPTH, D_MODEL), 0.02)
    w_in = nrm(ks[7], (DEPTH, D_MODEL, IN_WIDTH), D_MODEL ** -0.5)
    a_conv_w = nrm(ks[8], (DEPTH, A_CONV, 3 * A_WIDTH), A_CONV ** -0.5)
    a_log = jnp.log(jax.random.uniform(ks[9], (DEPTH, 2 * A_HEADS), f32, 1.0, 16.0))
    dt = jnp.exp(jax.random.uniform(ks[10], (DEPTH, 2 * A_HEADS), f32, math.log(1e-3), math.log(1e-1)))
    a_dt_bias = dt + jnp.log(-jnp.expm1(-dt))
    a_norm_w = 1.0 + nrm(ks[11], (DEPTH, A_DV), 0.02)
    b_sink = nrm(ks[12], (DEPTH, B_Q_HEADS), 0.5)
    gam = 1.0 - 2.0 ** (-5.0 - np.arange(C_HEADS, dtype=np.float32))
    base = jnp.asarray(np.log(gam) - np.log1p(-gam), f32)
    c_decay = jnp.tile(base, 2)[None, :] + nrm(ks[13], (DEPTH, 2 * C_HEADS), 0.1)
    c_norm_w = 1.0 + nrm(ks[14], (DEPTH, C_WIDTH), 0.02)
    w_branch = nrm(ks[15], (DEPTH, N_BRANCH, BR_WIDTH, D_MODEL), BR_WIDTH ** -0.5)
    w_out = nrm(ks[16], (DEPTH, D_MODEL, D_MODEL), D_MODEL ** -0.5)
    final_norm_w = 1.0 + nrm(ks[17], (D_MODEL,), 0.02)
    return {'x': x, 'c': c, 'ctx': ctx, 'c_ctx': c_ctx, 'w_ada': w_ada, 'b_ada': b_ada,
            'norm_w': norm_w, 'w_in': w_in, 'a_conv_w': a_conv_w, 'a_log': a_log,
            'a_dt_bias': a_dt_bias, 'a_norm_w': a_norm_w, 'b_sink': b_sink, 'c_decay': c_decay,
            'c_norm_w': c_norm_w, 'w_branch': w_branch, 'w_out': w_out, 'final_norm_w': final_norm_w}


def reference(x, c, ctx, c_ctx, w_ada, b_ada, norm_w, w_in, a_conv_w, a_log, a_dt_bias, a_norm_w,
              b_sink, c_decay, c_norm_w, w_branch, w_out, final_norm_w):
    b, t, d = x.shape
    l = ctx.shape[1]
    rows_n = t // GRID_W
    rows = jnp.repeat(jnp.arange(rows_n, dtype=jnp.float32), GRID_W)
    cols = jnp.tile(jnp.arange(GRID_W, dtype=jnp.float32), rows_n)
    n_ax = B_HD // 4
    ang_r = rope_angles(rows, n_ax)[:, None, :]
    ang_c = rope_angles(cols, n_ax)[:, None, :]
    ang_ret = rope_angles(jnp.arange(t, dtype=jnp.float32), C_HD // 2)
    zeros_a = jnp.zeros((b, A_HEADS, A_DK, A_DV), jnp.float32)
    zeros_c = jnp.zeros((b, C_HEADS, C_HD, C_HD), jnp.float32)

    for layer in range(DEPTH):
        mod = jax.nn.silu(c) @ w_ada[layer] + b_ada[layer]
        shift, scale, gate = [m[:, None, :] for m in jnp.split(mod, 3, axis=-1)]
        mod_c = jax.nn.silu(c_ctx) @ w_ada[layer] + b_ada[layer]
        shift_c, scale_c, gate_c = jnp.split(mod_c, 3, axis=-1)
        h = rms_norm(x, norm_w[layer]) * (1.0 + scale) + shift
        hc = rms_norm(ctx, norm_w[layer]) * (1.0 + scale_c) + shift_c
        (a_qkv, a_z, a_beta, a_alpha, b_q, b_kv, b_z, c_qkv, c_z, merge) = jnp.split(
            h @ w_in[layer], SPLIT_POINTS, axis=-1)
        (a_qkv_c, a_z_c, a_beta_c, a_alpha_c, b_q_c, b_kv_c, b_z_c, c_qkv_c, c_z_c, merge_c) = jnp.split(
            hc @ w_in[layer], SPLIT_POINTS, axis=-1)

        qa, ka, va, beta_a, g_a = delta_prep(a_qkv, a_beta, a_alpha, a_conv_w[layer], a_log[layer], a_dt_bias[layer])
        qa_c, ka_c, va_c, beta_ac, g_ac = delta_prep(a_qkv_c, a_beta_c, a_alpha_c, a_conv_w[layer],
                                                     a_log[layer], a_dt_bias[layer])
        o_ac, s_af, s_ab = bidir_delta(qa_c, ka_c, va_c, beta_ac, g_ac, zeros_a, zeros_a)
        o_a, _, _ = bidir_delta(qa, ka, va, beta_a, g_a, s_af, s_ab)
        y_a = gated_head_rmsnorm(o_a, a_z, a_norm_w[layer]).astype(x.dtype)

        q_b = apply_axial(b_q.reshape(b, t, B_Q_HEADS, B_HD), ang_r, ang_c)
        k_b, v_b = jnp.split(b_kv.reshape(b, t, 2 * B_KV_HEADS, B_HD), 2, axis=2)
        k_b = apply_axial(k_b, ang_r, ang_c)
        q_bc = b_q_c.reshape(b, l, B_Q_HEADS, B_HD)
        k_bc, v_bc = jnp.split(b_kv_c.reshape(b, l, 2 * B_KV_HEADS, B_HD), 2, axis=2)
        y_b = (window_attention(q_b, k_b, v_b, k_bc, v_bc, b_sink[layer]) * jax.nn.silu(b_z)).astype(x.dtype)

        log_gamma = jax.nn.log_sigmoid(c_decay[layer].astype(jnp.float32))
        q_c, k_c, v_c = retention_prep(c_qkv, ang_ret)
        q_cc, k_cc, v_cc = retention_prep(c_qkv_c, None)
        o_cc, s_cf, s_cb = bidir_retention(q_cc, k_cc, v_cc, log_gamma, zeros_c, zeros_c)
        o_c, _, _ = bidir_retention(q_c, k_c, v_c, log_gamma, s_cf, s_cb)
        y_c = retention_out(o_c, c_z, c_norm_w[layer]).astype(x.dtype)

        out = merge_branches(y_a, y_b, y_c, merge, w_branch[layer], w_out[layer])
        x_new = x + gate * out

        if layer < DEPTH - 1:
            y_ac = gated_head_rmsnorm(o_ac, a_z_c, a_norm_w[layer]).astype(ctx.dtype)
            y_bc = (context_attention(q_bc, k_bc, v_bc, b_sink[layer]) * jax.nn.silu(b_z_c)).astype(ctx.dtype)
            y_cc = retention_out(o_cc, c_z_c, c_norm_w[layer]).astype(ctx.dtype)
            out_c = merge_branches(y_ac, y_bc, y_cc, merge_c, w_branch[layer], w_out[layer])
            ctx = ctx + gate_c * out_c
        x = x_new

    return rms_norm(x, final_norm_w)
```

```cpp
#ifndef CPU_EMU
#include <hip/hip_runtime.h>
#include <hip/hip_cooperative_groups.h>
#include <cstdio>
#include <cstdint>
namespace cg = cooperative_groups;
#define DEVI __device__ __forceinline__
#define HD __host__ __device__ __forceinline__
#define CFENCE() asm volatile("" ::: "memory")
#else
#define CFENCE() do {} while (0)
#include <cstring>
#include <cmath>
#include <cstdio>
#include <cstdint>
#include <cstddef>
#define DEVI inline
#define HD inline
#endif

#ifndef NB
#define NB 8
#endif
#ifndef SEQ
#define SEQ 4096
#endif
#ifndef CTXL
#define CTXL 256
#endif
constexpr int DM = 1024, INW = 8464, GRIDW = 64;
constexpr int ML = NB * SEQ, MC = NB * CTXL, MT = ML + MC;
constexpr int N1 = 3840;
constexpr int NZ = 1536;
constexpr int NMG = 3072;
constexpr float EPSF = 1e-6f;
constexpr int NLAYER = 2;
static_assert(MT % 256 == 0 && ML % 256 == 0, "row tiles");

typedef unsigned short bf16_t;
struct alignas(16) U4 { unsigned x, y, z, w; };

constexpr size_t MiB = 1u << 20;
constexpr size_t al1(size_t x) { return (x + MiB - 1) & ~(MiB - 1); }
constexpr size_t WS_CTL = 0;
constexpr size_t WS_MOD = 256 * 1024;
constexpr size_t WS_W1 = 1 * MiB;
constexpr size_t WS_WZ = WS_W1 + al1((size_t)2 * N1 * DM * 2);
constexpr size_t WS_WM = WS_WZ + al1((size_t)2 * NZ * DM * 2);
constexpr size_t WS_WB = WS_WM + al1((size_t)2 * NMG * DM * 2);
constexpr size_t WS_WO = WS_WB + al1((size_t)2 * 3 * DM * 512 * 2);
constexpr size_t WS_G = WS_WO + al1((size_t)2 * DM * DM * 2);
constexpr size_t WS_BETA = WS_G + al1((size_t)MT * 8 * 4);
constexpr size_t WS_CTX1 = WS_BETA + al1((size_t)MT * 8 * 4);
constexpr size_t WS_XN = WS_CTX1 + al1((size_t)MC * DM * 4);
constexpr size_t WS_AQKV = WS_XN + al1((size_t)MT * DM * 2);
constexpr size_t WS_CQKV = WS_AQKV + al1((size_t)MT * 1536 * 2);
constexpr size_t WS_BQ = WS_CQKV + al1((size_t)MT * 1536 * 2);
constexpr size_t WS_BKV = WS_BQ + al1((size_t)MT * 512 * 2);
constexpr size_t WS_PA = WS_BKV + al1((size_t)MT * 256 * 2);
constexpr size_t WS_PC = WS_PA + al1((size_t)MT * 512 * 2);
constexpr size_t WS_END = WS_PC + al1((size_t)MT * 512 * 2);
static_assert(WS_CQKV + (size_t)MT * NMG * 2 <= WS_END, "L overlay");
static_assert(WS_END <= (size_t)512 * MiB, "workspace");

struct Params {
    const float *x, *c, *ctx, *c_ctx, *w_ada, *b_ada, *norm_w, *w_in, *a_conv_w, *a_log, *a_dt_bias, *a_norm_w, *b_sink, *c_decay, *c_norm_w, *w_branch, *w_out, *final_norm_w;
    float* out; unsigned char* ws;
    int ph_lo, ph_hi;
};

#ifdef CPU_EMU
inline float u2f(unsigned u) { float f; memcpy(&f, &u, 4); return f; }
inline unsigned f2u(float f) { unsigned u; memcpy(&u, &f, 4); return u; }
#else
DEVI float u2f(unsigned u) { return __uint_as_float(u); }
DEVI unsigned f2u(float f) { return __float_as_uint(f); }
#endif
DEVI float bf2f(bf16_t h) { return u2f((unsigned)h << 16); }
DEVI bf16_t f2bf(float f) { unsigned u = f2u(f); return (bf16_t)((u + 0x7fffu + ((u >> 16) & 1u)) >> 16); }
DEVI unsigned pk2(float lo, float hi) { return (unsigned)f2bf(lo) | ((unsigned)f2bf(hi) << 16); }
DEVI float lo16(unsigned w) { return u2f(w << 16); }
DEVI float hi16(unsigned w) { return u2f(w & 0xffff0000u); }
DEVI float sigmoidf_(float x) { return 1.0f / (1.0f + expf(-x)); }
DEVI float siluf_(float x) { return x / (1.0f + expf(-x)); }
DEVI float softplusf_(float x) { return x > 20.f ? x : log1pf(expf(x)); }
DEVI void unpack8(const U4& w, float* v) { v[0] = lo16(w.x); v[1] = hi16(w.x); v[2] = lo16(w.y); v[3] = hi16(w.y); v[4] = lo16(w.z); v[5] = hi16(w.z); v[6] = lo16(w.w); v[7] = hi16(w.w); }
DEVI U4 pack8(const float* v) { U4 w; w.x = pk2(v[0], v[1]); w.y = pk2(v[2], v[3]); w.z = pk2(v[4], v[5]); w.w = pk2(v[6], v[7]); return w; }

struct Ctx { int tid, bid, nblk; };
struct TI { long id, n; };
DEVI TI thread_info(const Ctx& c) {
#ifdef CPU_EMU
    return TI{0, 1};
#else
    const int wave = c.tid >> 6, lane = c.tid & 63;
    return TI{((long)wave * c.nblk + c.bid) * 64 + lane, (long)c.nblk * 512};
#endif
}

struct Views {
    float* MOD; bf16_t *W1, *WZ, *WM, *WB, *WO; float *G, *BETA, *CTX1; bf16_t *XN, *AQKV, *CQKV, *BQ, *BKV, *PA, *PC, *Y, *Z, *L, *MRG;
};
DEVI Views make_views(unsigned char* ws) {
    Views v;
    v.MOD = (float*)(ws + WS_MOD); v.W1 = (bf16_t*)(ws + WS_W1); v.WZ = (bf16_t*)(ws + WS_WZ); v.WM = (bf16_t*)(ws + WS_WM); v.WB = (bf16_t*)(ws + WS_WB); v.WO = (bf16_t*)(ws + WS_WO);
    v.G = (float*)(ws + WS_G); v.BETA = (float*)(ws + WS_BETA); v.CTX1 = (float*)(ws + WS_CTX1);
    v.XN = (bf16_t*)(ws + WS_XN); v.AQKV = (bf16_t*)(ws + WS_AQKV); v.CQKV = (bf16_t*)(ws + WS_CQKV); v.BQ = (bf16_t*)(ws + WS_BQ); v.BKV = (bf16_t*)(ws + WS_BKV);
    v.PA = (bf16_t*)(ws + WS_PA); v.PC = (bf16_t*)(ws + WS_PC); v.Y = v.AQKV; v.Z = v.CQKV; v.L = v.CQKV; v.MRG = v.XN;
    return v;
}

HD int map_g1(int n) { return n < 1536 ? n : (n < 2048 ? 2064 + (n - 1536) : (n < 2304 ? 2576 + (n - 2048) : 3344 + (n - 2304))); }
HD int map_z(int n) { return n < 512 ? 1536 + n : (n < 1024 ? 2832 + (n - 512) : 4880 + (n - 1024)); }

DEVI void phase_prep(const Ctx& cx, const Params& p) {
    const Views v = make_views(p.ws); const TI ti = thread_info(cx);
    const long n1 = (long)2 * N1 * DM, nz = (long)2 * NZ * DM, nm = (long)2 * NMG * DM, nb = (long)2 * 3 * DM * 512, no = (long)2 * DM * DM;
    const long tot = n1 + nz + nm + nb + no;
    for (long i = ti.id; i < tot; i += ti.n) {
        long r = i;
        if (r < n1) { const int l = (int)(r / ((long)N1 * DM)), rem = (int)(r % ((long)N1 * DM)), n = rem / DM, k = rem % DM; v.W1[r] = f2bf(p.w_in[((size_t)l * DM + k) * INW + map_g1(n)]); continue; } r -= n1;
        if (r < nz) { const int l = (int)(r / ((long)NZ * DM)), rem = (int)(r % ((long)NZ * DM)), n = rem / DM, k = rem % DM; v.WZ[r] = f2bf(p.w_in[((size_t)l * DM + k) * INW + map_z(n)]); continue; } r -= nz;
        if (r < nm) { const int l = (int)(r / ((long)NMG * DM)), rem = (int)(r % ((long)NMG * DM)), n = rem / DM, k = rem % DM; v.WM[r] = f2bf(p.w_in[((size_t)l * DM + k) * INW + 5392 + n]); continue; } r -= nm;
        if (r < nb) { const int lb = (int)(r / ((long)DM * 512)), rem = (int)(r % ((long)DM * 512)), n = rem / 512, k = rem % 512; v.WB[r] = f2bf(p.w_branch[((size_t)lb * 512 + k) * DM + n]); continue; } r -= nb;
        { const int l = (int)(r / ((long)DM * DM)), rem = (int)(r % ((long)DM * DM)), n = rem / DM, k = rem % DM; v.WO[r] = f2bf(p.w_out[((size_t)l * DM + k) * DM + n]); }
    }
    const long nmod = (long)NLAYER * (NB + 1) * 3072;
    for (long i = ti.id; i < nmod; i += ti.n) {
        const int l = (int)(i / ((NB + 1) * 3072)), rem = (int)(i % ((NB + 1) * 3072)), b = rem / 3072, n = rem % 3072;
        const float* cv = b < NB ? p.c + (size_t)b * DM : p.c_ctx;
        const float* w = p.w_ada + (size_t)l * DM * 3072 + n;
        float acc = 0.f;
        for (int k = 0; k < DM; ++k) acc += siluf_(cv[k]) * w[(size_t)k * 3072];
        v.MOD[i] = acc + p.b_ada[l * 3072 + n];
    }
}

DEVI const float* xrow_in(const Params& p, const Views& v, int layer, int m) {
    if (layer == 0) return m < ML ? p.x + (size_t)m * DM : p.ctx + (size_t)(m - ML) * DM;
    return m < ML ? p.out + (size_t)m * DM : v.CTX1 + (size_t)(m - ML) * DM;
}
DEVI void phase_norm(const Ctx& cx, const Params& p, int layer) {
    const Views v = make_views(p.ws); const TI ti = thread_info(cx);
    for (long m = ti.id; m < MT; m += ti.n) {
        const float* xr = xrow_in(p, v, layer, (int)m);
        const int b = m < ML ? (int)(m / SEQ) : NB;
        const float* mod = v.MOD + ((size_t)layer * (NB + 1) + b) * 3072;
        const float* nw = p.norm_w + layer * DM;
        float ss = 0.f;
        for (int k = 0; k < DM; ++k) ss += xr[k] * xr[k];
        const float r = 1.0f / sqrtf(ss * (1.0f / DM) + EPSF);
        float a[16];
#pragma unroll
        for (int j = 0; j < 16; ++j) a[j] = 0.f;
        const float* wab = p.w_in + (size_t)layer * DM * INW + 2048;
        for (int k = 0; k < DM; ++k) {
            const float hv = xr[k] * r * nw[k] * (1.0f + mod[1024 + k]) + mod[k];
            v.XN[(size_t)m * DM + k] = f2bf(hv);
            const float* wr_ = wab + (size_t)k * INW;
#pragma unroll
            for (int j = 0; j < 16; ++j) a[j] += hv * wr_[j];
        }
#pragma unroll
        for (int h = 0; h < 8; ++h) {
            v.BETA[(size_t)m * 8 + h] = sigmoidf_(a[h]);
            v.G[(size_t)m * 8 + h] = -expf(p.a_log[layer * 8 + h]) * softplusf_(a[8 + h] + p.a_dt_bias[layer * 8 + h]);
        }
    }
}

DEVI void phase_conv(const Ctx& cx, const Params& p, int layer) {
    const Views v = make_views(p.ws); const TI ti = thread_info(cx);
    const float* cw = p.a_conv_w + (size_t)layer * 5 * 1536;
    for (long it = ti.id; it < (long)2 * NB * 1536; it += ti.n) {
        const int s = (int)(it / 1536), c = (int)(it % 1536);
        const int len = s < NB ? SEQ : CTXL; const size_t m0 = s < NB ? (size_t)s * SEQ : (size_t)ML + (size_t)(s - NB) * CTXL;
        bf16_t* col = v.AQKV + m0 * 1536 + c;
        const float w0 = cw[c], w1 = cw[1536 + c], w2 = cw[2 * 1536 + c], w3 = cw[3 * 1536 + c], w4 = cw[4 * 1536 + c];
        float xm2 = 0.f, xm1 = 0.f, x0 = bf2f(col[0]), x1 = bf2f(col[1536]);
        for (int t = 0; t < len; ++t) {
            const float x2 = (t + 2 < len) ? bf2f(col[(size_t)(t + 2) * 1536]) : 0.f;
            const float y = w0 * xm2 + w1 * xm1 + w2 * x0 + w3 * x1 + w4 * x2;
            col[(size_t)t * 1536] = f2bf(siluf_(y));
            xm2 = xm1; xm1 = x0; x0 = x1; x1 = x2;
        }
    }
}

DEVI void phase_prep2(const Ctx& cx, const Params& p, int layer) {
    const Views v = make_views(p.ws); const TI ti = thread_info(cx);
    for (long it = ti.id; it < (long)MT * 8; it += ti.n) {
        const long m = it >> 3; const int wh = (int)(it & 7), which = wh >> 2, h = wh & 3;
        bf16_t* ptr = v.AQKV + (size_t)m * 1536 + which * 512 + h * 128;
        float ss = 0.f;
        for (int d = 0; d < 128; ++d) { const float f = bf2f(ptr[d]); ss += f * f; }
        const float sc = (1.0f / sqrtf(ss + EPSF)) * (which == 0 ? 0.08838834764831845f : 1.0f);
        for (int d = 0; d < 128; ++d) ptr[d] = f2bf(bf2f(ptr[d]) * sc);
    }
    for (long it = ti.id; it < (long)ML * 10; it += ti.n) {
        const long m = it / 10; const int hh = (int)(it % 10);
        const int t = (int)(m % SEQ); const float rowp = (float)(t / GRIDW), colp = (float)(t % GRIDW);
        bf16_t* ptr = hh < 8 ? v.BQ + (size_t)m * 512 + hh * 64 : v.BKV + (size_t)m * 256 + (hh - 8) * 64;
        for (int half = 0; half < 2; ++half) {
            const float pos = half == 0 ? rowp : colp;
            for (int i = 0; i < 16; ++i) {
                const float inv = powf(10000.0f, -(float)i / 16.0f);
                const float ang = pos * inv; const float cs = cosf(ang), sn = sinf(ang);
                const float x1 = bf2f(ptr[half * 32 + i]), x2 = bf2f(ptr[half * 32 + 16 + i]);
                ptr[half * 32 + i] = f2bf(x1 * cs - x2 * sn); ptr[half * 32 + 16 + i] = f2bf(x1 * sn + x2 * cs);
            }
        }
    }
    for (long it = ti.id; it < (long)MT * 8; it += ti.n) {
        const long m = it >> 3; const int wh = (int)(it & 7), which = wh >> 2, h = wh & 3;
        bf16_t* ptr = v.CQKV + (size_t)m * 1536 + which * 512 + h * 128;
        const float sc = which == 1 ? 0.08838834764831845f : 1.0f;
        if (m < ML) {
            const float pos = (float)(m % SEQ);
            for (int i = 0; i < 64; ++i) {
                const float inv = powf(10000.0f, -(float)i / 64.0f);
                const float ang = pos * inv; const float cs = cosf(ang), sn = sinf(ang);
                const float x1 = bf2f(ptr[i]) * sc, x2 = bf2f(ptr[64 + i]) * sc;
                ptr[i] = f2bf(x1 * cs - x2 * sn); ptr[64 + i] = f2bf(x1 * sn + x2 * cs);
            }
        } else if (which == 1) {
            for (int d = 0; d < 128; ++d) ptr[d] = f2bf(bf2f(ptr[d]) * sc);
        }
    }
}

template <int MIX> DEVI void scan_item(const Params& p, const Views& v, int layer, int item) {
    const int j = item & 127, h = (item >> 7) & 3, b = item >> 9;
    const bf16_t* QKV = MIX == 0 ? v.AQKV : v.CQKV; bf16_t* PARK = MIX == 0 ? v.PA : v.PC;
    float S[128];
    for (int dir = 0; dir < 2; ++dir) {
#pragma unroll
        for (int d = 0; d < 128; ++d) S[d] = 0.f;
        const float gam = MIX == 1 ? sigmoidf_(p.c_decay[layer * 8 + dir * 4 + h]) : 0.f;
        for (int seg = 0; seg < 2; ++seg) {
            const int len = seg == 0 ? CTXL : SEQ; const size_t m0 = seg == 0 ? (size_t)ML + (size_t)b * CTXL : (size_t)b * SEQ;
            for (int i = 0; i < len; ++i) {
                const int t = dir == 0 ? i : len - 1 - i; const size_t m = m0 + t;
                const bf16_t* row = QKV + m * 1536 + h * 128;
                const float vj = bf2f(row[1024 + j]);
                float o = 0.f;
                if (MIX == 0) {
                    const float a = expf(v.G[m * 8 + dir * 4 + h]), be = v.BETA[m * 8 + dir * 4 + h];
                    float dot = 0.f;
#pragma unroll
                    for (int c8 = 0; c8 < 16; ++c8) { float kk[8]; unpack8(*(const U4*)(row + 512 + c8 * 8), kk);
#pragma unroll
                        for (int e = 0; e < 8; ++e) dot += S[c8 * 8 + e] * kk[e];
                        if ((c8 & 3) == 3) CFENCE(); }
                    const float vn = be * (vj - a * dot);
#pragma unroll
                    for (int c8 = 0; c8 < 16; ++c8) { float kk[8], qq[8]; unpack8(*(const U4*)(row + 512 + c8 * 8), kk); unpack8(*(const U4*)(row + c8 * 8), qq);
#pragma unroll
                        for (int e = 0; e < 8; ++e) { const float s = a * S[c8 * 8 + e] + kk[e] * vn; S[c8 * 8 + e] = s; o += s * qq[e]; }
                        if ((c8 & 3) == 3) CFENCE(); }
                } else {
#pragma unroll
                    for (int c8 = 0; c8 < 16; ++c8) { float kk[8], qq[8]; unpack8(*(const U4*)(row + 512 + c8 * 8), kk); unpack8(*(const U4*)(row + c8 * 8), qq);
#pragma unroll
                        for (int e = 0; e < 8; ++e) { const float s = gam * S[c8 * 8 + e] + kk[e] * vj; S[c8 * 8 + e] = s; o += s * qq[e]; }
                        if ((c8 & 3) == 3) CFENCE(); }
                }
                bf16_t* pp = PARK + m * 512 + h * 128 + j;
                *pp = f2bf(dir == 0 ? o : bf2f(*pp) + o);
            }
        }
    }
}

DEVI void attn_item(const Params& p, const Views& v, int layer, long m, int hq) {
    const int hk = hq >> 2;
    bf16_t* qp = v.BQ + (size_t)m * 512 + hq * 64;
    float q[64], acc[64];
#pragma unroll
    for (int c8 = 0; c8 < 8; ++c8) unpack8(*(const U4*)(qp + c8 * 8), q + c8 * 8);
#pragma unroll
    for (int d = 0; d < 64; ++d) acc[d] = 0.f;
    float mrun = p.b_sink[layer * 8 + hq], lrun = 1.0f;
    const int b = m < ML ? (int)(m / SEQ) : (int)((m - ML) / CTXL);
    const int t = m < ML ? (int)(m % SEQ) : 0;
    const int lo = t - 128 < 0 ? 0 : t - 128, hi = t + 128 > SEQ - 1 ? SEQ - 1 : t + 128;
    const int nwin = m < ML ? hi - lo + 1 : 0;
    for (int i = 0; i < CTXL + nwin; ++i) {
        const size_t kr = i < CTXL ? (size_t)ML + (size_t)b * CTXL + i : (size_t)b * SEQ + lo + (i - CTXL);
        const bf16_t* kp = v.BKV + kr * 256 + hk * 64;
        float s = 0.f;
#pragma unroll
        for (int c8 = 0; c8 < 8; ++c8) { float kk[8]; unpack8(*(const U4*)(kp + c8 * 8), kk);
#pragma unroll
            for (int e = 0; e < 8; ++e) s += q[c8 * 8 + e] * kk[e]; }
        CFENCE();
        s *= 0.125f;
        float pw;
        if (s > mrun) { const float f = expf(mrun - s); lrun *= f;
#pragma unroll
            for (int d = 0; d < 64; ++d) acc[d] *= f;
            mrun = s; pw = 1.0f; }
        else pw = expf(s - mrun);
        lrun += pw;
#pragma unroll
        for (int c8 = 0; c8 < 8; ++c8) { float vv[8]; unpack8(*(const U4*)(kp + 128 + c8 * 8), vv);
#pragma unroll
            for (int e = 0; e < 8; ++e) acc[c8 * 8 + e] += pw * vv[e]; }
        CFENCE();
    }
    const float il = 1.0f / lrun;
#pragma unroll
    for (int c8 = 0; c8 < 8; ++c8) { float o8[8];
#pragma unroll
        for (int e = 0; e < 8; ++e) o8[e] = acc[c8 * 8 + e] * il;
        *(U4*)(qp + c8 * 8) = pack8(o8); }
}
DEVI void phase_mix(const Ctx& cx, const Params& p, int layer) {
    const Views v = make_views(p.ws); const TI ti = thread_info(cx);
    const long nscan = (long)NB * 4 * 128;
    for (long it = ti.id; it < 2 * nscan; it += ti.n) { if (it < nscan) scan_item<0>(p, v, layer, (int)it); else scan_item<1>(p, v, layer, (int)(it - nscan)); }
    const long mrows = layer == 0 ? MT : ML;
    for (long it = ti.n - 1 - ti.id; it < mrows * 8; it += ti.n) attn_item(p, v, layer, it >> 3, (int)(it & 7));
}

DEVI void phase_y(const Ctx& cx, const Params& p, int layer) {
    const Views v = make_views(p.ws); const TI ti = thread_info(cx);
    const long mrows = layer == 0 ? MT : ML;
    for (long it = ti.id; it < mrows * 12; it += ti.n) {
        const long m = it / 12; const int r = (int)(it % 12), mix = r >> 2, h = r & 3;
        const bf16_t* zp = v.Z + (size_t)m * 1536 + mix * 512 + h * 128;
        bf16_t* yp = v.Y + ((size_t)mix * MT + m) * 512 + h * 128;
        if (mix == 0) {
            const bf16_t* op = v.PA + (size_t)m * 512 + h * 128; float ss = 0.f;
            for (int d = 0; d < 128; ++d) { const float f = bf2f(op[d]); ss += f * f; }
            const float rs = 1.0f / sqrtf(ss * (1.0f / 128.0f) + EPSF);
            for (int d = 0; d < 128; ++d) yp[d] = f2bf(bf2f(op[d]) * rs * p.a_norm_w[layer * 128 + d] * siluf_(bf2f(zp[d])));
        } else if (mix == 1) {
            const bf16_t* op = v.BQ + (size_t)m * 512 + h * 128;
            for (int d = 0; d < 128; ++d) yp[d] = f2bf(bf2f(op[d]) * siluf_(bf2f(zp[d])));
        } else {
            const bf16_t* op = v.PC + (size_t)m * 512 + h * 128; float s = 0.f;
            for (int d = 0; d < 128; ++d) s += bf2f(op[d]);
            const float mu = s * (1.0f / 128.0f); float q = 0.f;
            for (int d = 0; d < 128; ++d) { const float f = bf2f(op[d]) - mu; q += f * f; }
            const float rs = 1.0f / sqrtf(q * (1.0f / 128.0f) + EPSF);
            for (int d = 0; d < 128; ++d) yp[d] = f2bf((bf2f(op[d]) - mu) * rs * p.c_norm_w[layer * 512 + h * 128 + d] * siluf_(bf2f(zp[d])));
        }
    }
}

DEVI void phase_final(const Ctx& cx, const Params& p) {
    const TI ti = thread_info(cx);
    for (long m = ti.id; m < ML; m += ti.n) {
        float* xr = p.out + (size_t)m * DM; float ss = 0.f;
        for (int k = 0; k < DM; ++k) ss += xr[k] * xr[k];
        const float r = 1.0f / sqrtf(ss * (1.0f / DM) + EPSF);
        for (int k = 0; k < DM; ++k) xr[k] = xr[k] * r * p.final_norm_w[k];
    }
}

struct StG1 { bf16_t *AQKV, *BQ, *BKV, *CQKV;
    DEVI void st8(int row, int col, const float* a) const {
        bf16_t* dst = col < 1536 ? AQKV + (size_t)row * 1536 + col : (col < 2048 ? BQ + (size_t)row * 512 + (col - 1536) : (col < 2304 ? BKV + (size_t)row * 256 + (col - 2048) : CQKV + (size_t)row * 1536 + (col - 2304)));
        *(U4*)dst = pack8(a); } };
struct StPlain { bf16_t* O; int ld;
    DEVI void st8(int row, int col, const float* a) const { *(U4*)(O + (size_t)row * ld + col) = pack8(a); } };
struct StMerge { const bf16_t* L; bf16_t* MRG; int br;
    DEVI void st8(int row, int col, const float* a) const {
        float lg[8], o[8]; unpack8(*(const U4*)(L + (size_t)row * NMG + br * 1024 + col), lg);
        if (br) unpack8(*(const U4*)(MRG + (size_t)row * DM + col), o); else { for (int e = 0; e < 8; ++e) o[e] = 0.f; }
        for (int e = 0; e < 8; ++e) o[e] += sigmoidf_(lg[e]) * a[e];
        *(U4*)(MRG + (size_t)row * DM + col) = pack8(o); } };
struct StResid { const float *xlat, *xctx; float *olat, *octx; const float* mod;
    DEVI void st4(int row, int col, const float* a) const {
        const float* xi = row < ML ? xlat + (size_t)row * DM + col : xctx + (size_t)(row - ML) * DM + col;
        float* xo = row < ML ? olat + (size_t)row * DM + col : octx + (size_t)(row - ML) * DM + col;
        const int b = row < ML ? row / SEQ : NB; const float* g = mod + (size_t)b * 3072 + 2048 + col;
        for (int e = 0; e < 4; ++e) xo[e] = xi[e] + g[e] * a[e]; } };

#ifndef CPU_EMU
namespace pg8 {
#define PG8_LAS __attribute__((address_space(3)))
typedef short bf16x8 __attribute__((ext_vector_type(8)));
typedef float f32x4 __attribute__((ext_vector_type(4)));
typedef unsigned u32x4 __attribute__((ext_vector_type(4)));
constexpr int BM = 256, BK = 64, HALF = 128, HTB = HALF * BK * 2, STAGE_BYTES = 8 * HTB, NXCD = 8, WGM = 8;
__host__ __device__ __forceinline__ int lds_byte(int r, int c) { const int st = (r >> 4) * 2 + (c >> 5), rr = r & 15, cc = c & 31, ob = rr * 64 + cc * 2; return st * 1024 + (ob ^ (((ob >> 9) & 1) << 5)); }
__host__ __device__ __forceinline__ void stage_rc(int b, int& R, int& C) { const int st = b / 1024, sb = b % 1024, swz = sb ^ (((sb >> 9) & 1) << 5); R = (st >> 1) * 16 + swz / 64; C = (st & 1) * 32 + (swz % 64) / 2; }
__host__ __device__ __forceinline__ int perm32(int rho) { const int n = rho >> 4, i = rho & 15; return 8 * (i >> 2) + 4 * n + (i & 3); }
struct Unit { int pm, pn; };
struct Gemm { const bf16_t* A; const bf16_t* Bt; int M, N, K; };
struct StaticOrder {
    int nM, nN, nwg, G, c;
    __host__ __device__ void init(int M, int N, int G_, int c_) { nM = M / BM; nN = N / BM; nwg = nM * nN; G = G_; c = c_; }
    __host__ __device__ bool next(int i, Unit& u) const {
        const long L = (long)i * G + c; if (L >= nwg) return false;
        int wgid = (int)L; { const int q = nwg / NXCD, r = nwg % NXCD, xcd = wgid % NXCD, off = wgid / NXCD; wgid = (xcd < r ? xcd * (q + 1) : r * (q + 1) + (xcd - r) * q) + off; }
        const int nig = WGM * nN, gid = wgid / nig, fm = gid * WGM, gsz = (nM - fm) < WGM ? (nM - fm) : WGM;
        u.pm = fm + ((wgid % nig) % gsz); u.pn = (wgid % nig) / gsz; return true;
    }
    __device__ __forceinline__ void a_ready(const Unit&) const {}
    __device__ __forceinline__ void done(const Unit&) const {}
};
template <class F> struct Epi8 {
    static constexpr bool PERM = true, AFTER_DRAIN = false; F f;
    __device__ __forceinline__ void operator()(const f32x4 (&acc)[2][2][4][2], const Unit& u, int wr, int wc, int fr, int fq) const {
        const int row0 = u.pm * BM + wr * 64 + fr, col0 = u.pn * BM + wc * 32 + 8 * fq;
#pragma unroll
        for (int ai = 0; ai < 2; ++ai)
#pragma unroll
            for (int m = 0; m < 4; ++m)
#pragma unroll
                for (int bj = 0; bj < 2; ++bj) { const f32x4 v0 = acc[ai][bj][m][0], v1 = acc[ai][bj][m][1];
                    const float a[8] = {v0[0], v0[1], v0[2], v0[3], v1[0], v1[1], v1[2], v1[3]};
                    f.st8(row0 + ai * HALF + m * 16, col0 + bj * HALF, a); }
    }
};
template <class F> struct Epi4 {
    static constexpr bool PERM = false, AFTER_DRAIN = false; F f;
    __device__ __forceinline__ void operator()(const f32x4 (&acc)[2][2][4][2], const Unit& u, int wr, int wc, int fr, int fq) const {
        const int row0 = u.pm * BM + wr * 64 + fr, col0 = u.pn * BM + wc * 32 + 4 * fq;
#pragma unroll
        for (int ai = 0; ai < 2; ++ai)
#pragma unroll
            for (int m = 0; m < 4; ++m)
#pragma unroll
                for (int bj = 0; bj < 2; ++bj)
#pragma unroll
                    for (int n = 0; n < 2; ++n) { const f32x4 v0 = acc[ai][bj][m][n]; const float a[4] = {v0[0], v0[1], v0[2], v0[3]};
                        f.st4(row0 + ai * HALF + m * 16, col0 + bj * HALF + n * 16, a); }
    }
};

template <class Epi, class Sched, bool ALIGN_EPI = false, bool SP2 = false>
__device__ __forceinline__ void gemm_phase(PG8_LAS unsigned char* lds, const int tid, const Gemm g, const Sched& S, const Epi& E) {
    const int wid = __builtin_amdgcn_readfirstlane(tid >> 6), lane = tid & 63, wr = wid >> 2, wc = wid & 3, fr = lane & 15, fq = lane >> 4;
    const int K = g.K, nt = K / BK;
    unsigned voffA[2], voffB[2];
#pragma unroll
    for (int i = 0; i < 2; ++i) { int R, C; stage_rc(tid * 16 + i * 8192, R, C); const int Rb = Epi::PERM ? ((R & ~31) + perm32(R & 31)) : R;
        voffA[i] = (unsigned)(R * K + C) * 2u; voffB[i] = (unsigned)(Rb * K + C) * 2u; }
    const size_t kstep = (size_t)(BK * 2);
    const size_t hstep = (size_t)HALF * K * 2;
    const size_t tstep = 2 * hstep;
    const unsigned ldsw = (unsigned)wid * 1024u;
    const int aoff = lds_byte(wr * 64 + fr, fq * 8), boff = lds_byte(wc * 32 + fr, fq * 8);
#define PG8_SA(b, h) (((b) * 2 + (h)) * HTB)
#define PG8_SB(b, h) ((4 + (b) * 2 + (h)) * HTB)
#define PG8_STAGE(bufoff, gbase, voff) do { _Pragma("unroll") for (int _i = 0; _i < 2; ++_i) \
        __builtin_amdgcn_global_load_lds((const unsigned*)((const char*)(gbase) + (voff)[_i]), (PG8_LAS unsigned*)(lds + (bufoff) + ldsw + _i * 8192), 16, 0, 0); } while (0)
#define PG8_LDA(dst, b, h) do { _Pragma("unroll") for (int m = 0; m < 4; ++m) _Pragma("unroll") for (int k = 0; k < 2; ++k) dst[m][k] = *(const PG8_LAS bf16x8*)(lds + PG8_SA(b, h) + aoff + m * 2048 + k * 1024); } while (0)
#define PG8_LDB(dst, b, h) do { _Pragma("unroll") for (int n = 0; n < 2; ++n) _Pragma("unroll") for (int k = 0; k < 2; ++k) dst[n][k] = *(const PG8_LAS bf16x8*)(lds + PG8_SB(b, h) + boff + n * 2048 + k * 1024); } while (0)
#define PG8_MMA(ai, bj, At, Bt) do { __builtin_amdgcn_s_setprio(1); _Pragma("unroll") for (int m = 0; m < 4; ++m) _Pragma("unroll") for (int n = 0; n < 2; ++n) _Pragma("unroll") for (int k = 0; k < 2; ++k) \
        acc[ai][bj][m][n] = __builtin_amdgcn_mfma_f32_16x16x32_bf16(Bt[n][k], At[m][k], acc[ai][bj][m][n], 0, 0, 0); __builtin_amdgcn_s_setprio(0); } while (0)
#define PG8_WAIT_V(n) asm volatile("s_waitcnt vmcnt(" #n ")" ::: "memory")
#define PG8_WAIT_L(n) asm volatile("s_waitcnt lgkmcnt(" #n ")" ::: "memory")
#define PG8_BAR __builtin_amdgcn_s_barrier()
#define PG8_SCHED __builtin_amdgcn_sched_barrier(0)
    Unit cur, nxt; int ui = 0;
    if (!S.next(0, cur)) return;
    f32x4 acc[2][2][4][2];
#pragma unroll
    for (int a = 0; a < 2; ++a)
#pragma unroll
        for (int b = 0; b < 2; ++b)
#pragma unroll
            for (int m = 0; m < 4; ++m)
#pragma unroll
                for (int n = 0; n < 2; ++n) acc[a][b][m][n] = (f32x4){0.f, 0.f, 0.f, 0.f};
    bf16x8 At[4][2], B0[2][2], B1[2][2];
    const char* cA = (const char*)g.A + (size_t)cur.pm * tstep; const char* cB = (const char*)g.Bt + (size_t)cur.pn * tstep;
    S.a_ready(cur);
    if constexpr (SP2) {
        PG8_STAGE(PG8_SB(0, 0), cB, voffB); PG8_STAGE(PG8_SB(0, 1), cB + hstep, voffB); PG8_STAGE(PG8_SA(0, 0), cA, voffA); PG8_STAGE(PG8_SA(0, 1), cA + hstep, voffA);
        if (wr == 1) PG8_BAR;
        PG8_WAIT_V(2); PG8_BAR;
        PG8_STAGE(PG8_SB(1, 0), cB + kstep, voffB); PG8_STAGE(PG8_SA(1, 0), cA + kstep, voffA); PG8_STAGE(PG8_SB(1, 1), cB + hstep + kstep, voffB);
        PG8_WAIT_V(6); PG8_BAR;
    } else {
        PG8_STAGE(PG8_SB(0, 0), cB, voffB); PG8_STAGE(PG8_SA(0, 0), cA, voffA); PG8_STAGE(PG8_SB(0, 1), cB + hstep, voffB); PG8_STAGE(PG8_SA(0, 1), cA + hstep, voffA);
        if (wr == 1) PG8_BAR;
        PG8_WAIT_V(4); PG8_BAR;
        PG8_STAGE(PG8_SB(1, 0), cB + kstep, voffB); PG8_STAGE(PG8_SA(1, 0), cA + kstep, voffA); PG8_STAGE(PG8_SB(1, 1), cB + hstep + kstep, voffB);
        PG8_WAIT_V(6); PG8_BAR;
    }
    for (;;) {
        const bool has_next = S.next(ui + 1, nxt);
        const char* nA = has_next ? (const char*)g.A + (size_t)nxt.pm * tstep : cA; const char* nB = has_next ? (const char*)g.Bt + (size_t)nxt.pn * tstep : cB;
        for (int t = 0; t < nt; t += 2) {
            const bool last = (t == nt - 2);
            const char* a1 = cA + (size_t)(t + 1) * kstep;
            const char* a2 = last ? nA : cA + (size_t)(t + 2) * kstep; const char* b2 = last ? nB : cB + (size_t)(t + 2) * kstep;
            const char* a3 = a2 + kstep; const char* b3 = b2 + kstep;
            if (last && has_next) S.a_ready(nxt);
            if constexpr (SP2) {
            PG8_LDB(B0, 0, 0); PG8_LDB(B1, 0, 1); PG8_SCHED; PG8_LDA(At, 0, 0); PG8_STAGE(PG8_SA(1, 1), a1 + hstep, voffA);
            PG8_WAIT_V(8); PG8_WAIT_L(0); PG8_BAR; PG8_MMA(0, 0, At, B0); PG8_MMA(0, 1, At, B1); PG8_BAR; PG8_SCHED;
            PG8_LDA(At, 0, 1); PG8_STAGE(PG8_SB(0, 0), b2, voffB); PG8_STAGE(PG8_SB(0, 1), b2 + hstep, voffB); PG8_STAGE(PG8_SA(0, 0), a2, voffA);
            PG8_WAIT_V(8); PG8_WAIT_L(0); PG8_BAR; PG8_MMA(1, 0, At, B0); PG8_MMA(1, 1, At, B1); PG8_BAR; PG8_SCHED;
            PG8_LDB(B0, 1, 0); PG8_LDB(B1, 1, 1); PG8_SCHED; PG8_LDA(At, 1, 0); PG8_STAGE(PG8_SA(0, 1), a2 + hstep, voffA);
            PG8_WAIT_V(8); PG8_WAIT_L(0); PG8_BAR; PG8_MMA(0, 0, At, B0); PG8_MMA(0, 1, At, B1); PG8_BAR; PG8_SCHED;
            PG8_LDA(At, 1, 1); PG8_STAGE(PG8_SB(1, 0), b3, voffB); PG8_STAGE(PG8_SB(1, 1), b3 + hstep, voffB); PG8_STAGE(PG8_SA(1, 0), a3, voffA);
            PG8_WAIT_V(8); PG8_WAIT_L(0); PG8_BAR; PG8_MMA(1, 0, At, B0); PG8_MMA(1, 1, At, B1); PG8_BAR; PG8_SCHED;
            } else {
            PG8_LDB(B0, 0, 0); PG8_SCHED; PG8_LDA(At, 0, 0); PG8_STAGE(PG8_SA(1, 1), a1 + hstep, voffA);
            PG8_WAIT_L(8); PG8_BAR; PG8_WAIT_L(0); PG8_MMA(0, 0, At, B0); PG8_BAR; PG8_SCHED;
            PG8_LDB(B1, 0, 1); PG8_STAGE(PG8_SB(0, 0), b2, voffB);
            PG8_BAR; PG8_WAIT_L(0); PG8_MMA(0, 1, At, B1); PG8_BAR;
            PG8_LDA(At, 0, 1); PG8_STAGE(PG8_SA(0, 0), a2, voffA);
            PG8_BAR; PG8_WAIT_L(0); PG8_MMA(1, 0, At, B0); PG8_BAR; PG8_SCHED;
            PG8_STAGE(PG8_SB(0, 1), b2 + hstep, voffB);
            PG8_WAIT_V(6); PG8_BAR; PG8_MMA(1, 1, At, B1); PG8_BAR;
            PG8_LDB(B0, 1, 0); PG8_SCHED; PG8_LDA(At, 1, 0); PG8_STAGE(PG8_SA(0, 1), a2 + hstep, voffA);
            PG8_WAIT_L(8); PG8_BAR; PG8_WAIT_L(0); PG8_MMA(0, 0, At, B0); PG8_BAR; PG8_SCHED;
            PG8_LDB(B1, 1, 1); PG8_STAGE(PG8_SB(1, 0), b3, voffB);
            PG8_BAR; PG8_WAIT_L(0); PG8_MMA(0, 1, At, B1); PG8_BAR;
            PG8_LDA(At, 1, 1); PG8_STAGE(PG8_SA(1, 0), a3, voffA);
            PG8_BAR; PG8_WAIT_L(0); PG8_MMA(1, 0, At, B0); PG8_BAR; PG8_SCHED;
            PG8_STAGE(PG8_SB(1, 1), b3 + hstep, voffB);
            PG8_WAIT_V(6); PG8_BAR; PG8_MMA(1, 1, At, B1); PG8_BAR;
            }
        }
        if constexpr (ALIGN_EPI) { if (wr == 0) PG8_BAR; }
        if constexpr (!Epi::AFTER_DRAIN) { E(acc, cur, wr, wc, fr, fq); S.done(cur); }
        if (!has_next) break;
#pragma unroll
        for (int a = 0; a < 2; ++a)
#pragma unroll
            for (int b = 0; b < 2; ++b)
#pragma unroll
                for (int m = 0; m < 4; ++m)
#pragma unroll
                    for (int n = 0; n < 2; ++n) acc[a][b][m][n] = (f32x4){0.f, 0.f, 0.f, 0.f};
        cur = nxt; cA = nA; cB = nB; ++ui;
        if constexpr (ALIGN_EPI) { if (wr == 1) PG8_BAR; }
    }
    PG8_WAIT_V(0);
    if constexpr (!ALIGN_EPI) { if (wr == 0) PG8_BAR; }
    PG8_BAR;
#undef PG8_SA
#undef PG8_SB
#undef PG8_STAGE
#undef PG8_LDA
#undef PG8_LDB
#undef PG8_MMA
#undef PG8_WAIT_V
#undef PG8_WAIT_L
#undef PG8_BAR
#undef PG8_SCHED
}
}

template <class F> __device__ __forceinline__ void run_gemm8(PG8_LAS unsigned char* lds, const Ctx& cx, const bf16_t* A, const bf16_t* Bt, int M, int N, int K, const F& f) {
    pg8::Gemm g{A, Bt, M, N, K}; pg8::StaticOrder S; S.init(M, N, cx.nblk, cx.bid);
    pg8::Epi8<F> E{f};
    pg8::gemm_phase<pg8::Epi8<F>, pg8::StaticOrder, true, true>(lds, cx.tid, g, S, E);
}
template <class F> __device__ __forceinline__ void run_gemm4(PG8_LAS unsigned char* lds, const Ctx& cx, const bf16_t* A, const bf16_t* Bt, int M, int N, int K, const F& f) {
    pg8::Gemm g{A, Bt, M, N, K}; pg8::StaticOrder S; S.init(M, N, cx.nblk, cx.bid);
    pg8::Epi4<F> E{f};
    pg8::gemm_phase<pg8::Epi4<F>, pg8::StaticOrder, true, true>(lds, cx.tid, g, S, E);
}
#define LDSARG PG8_LAS unsigned char* lds,
#define LDSPASS lds, cx,
#else
template <class F> void run_gemm8(const Ctx&, const bf16_t* A, const bf16_t* Bt, int M, int N, int K, const F& f) {
#pragma omp parallel for schedule(dynamic, 8)
    for (int r = 0; r < M; ++r) for (int c0 = 0; c0 < N; c0 += 8) { float a[8];
        for (int e = 0; e < 8; ++e) { float s = 0.f; const bf16_t* ar = A + (size_t)r * K; const bf16_t* br = Bt + (size_t)(c0 + e) * K; for (int k = 0; k < K; ++k) s += bf2f(ar[k]) * bf2f(br[k]); a[e] = s; }
        f.st8(r, c0, a); }
}
template <class F> void run_gemm4(const Ctx&, const bf16_t* A, const bf16_t* Bt, int M, int N, int K, const F& f) {
#pragma omp parallel for schedule(dynamic, 8)
    for (int r = 0; r < M; ++r) for (int c0 = 0; c0 < N; c0 += 4) { float a[4];
        for (int e = 0; e < 4; ++e) { float s = 0.f; const bf16_t* ar = A + (size_t)r * K; const bf16_t* br = Bt + (size_t)(c0 + e) * K; for (int k = 0; k < K; ++k) s += bf2f(ar[k]) * bf2f(br[k]); a[e] = s; }
        f.st4(r, c0, a); }
}
#define LDSARG
#define LDSPASS cx,
#endif

constexpr int NPHASE = 2 + 12 * NLAYER;
template <int PH> DEVI void run_phase_t(LDSARG const Ctx& cx, const Params& p) {
    const Views v = make_views(p.ws);
    if constexpr (PH == 0) { phase_prep(cx, p); }
    else if constexpr (PH == NPHASE - 1) { phase_final(cx, p); }
    else {
        constexpr int layer = (PH - 1) / 12, s = (PH - 1) % 12;
        constexpr int mrows = layer == NLAYER - 1 ? ML : MT;
        if constexpr (s == 0) phase_norm(cx, p, layer);
        else if constexpr (s == 1) run_gemm8(LDSPASS v.XN, v.W1 + (size_t)layer * N1 * DM, MT, N1, DM, StG1{v.AQKV, v.BQ, v.BKV, v.CQKV});
        else if constexpr (s == 2) phase_conv(cx, p, layer);
        else if constexpr (s == 3) phase_prep2(cx, p, layer);
        else if constexpr (s == 4) phase_mix(cx, p, layer);
        else if constexpr (s == 5) run_gemm8(LDSPASS v.XN, v.WZ + (size_t)layer * NZ * DM, mrows, NZ, DM, StPlain{v.Z, NZ});
        else if constexpr (s == 6) phase_y(cx, p, layer);
        else if constexpr (s == 7) run_gemm8(LDSPASS v.XN, v.WM + (size_t)layer * NMG * DM, mrows, NMG, DM, StPlain{v.L, NMG});
        else if constexpr (s >= 8 && s <= 10) { constexpr int br = s - 8;
            run_gemm8(LDSPASS v.Y + (size_t)br * MT * 512, v.WB + ((size_t)layer * 3 + br) * DM * 512, mrows, DM, 512, StMerge{v.L, v.MRG, br}); }
        else run_gemm4(LDSPASS v.MRG, v.WO + (size_t)layer * DM * DM, mrows, DM, DM,
                       StResid{layer == 0 ? p.x : p.out, layer == 0 ? p.ctx : v.CTX1, p.out, v.CTX1, v.MOD + (size_t)layer * (NB + 1) * 3072});
    }
}
#define MK_PHASE_LIST(X) X(0) X(1) X(2) X(3) X(4) X(5) X(6) X(7) X(8) X(9) X(10) X(11) X(12) X(13) X(14) X(15) X(16) X(17) X(18) X(19) X(20) X(21) X(22) X(23) X(24) X(25)
static_assert(NPHASE == 26, "phase list");
#ifdef CPU_EMU
inline void run_phase(const Ctx& cx, const Params& p, int ph) {
    switch (ph) {
#define X(k) case k: run_phase_t<k>(cx, p); break;
        MK_PHASE_LIST(X)
#undef X
    }
}
#endif

#ifndef CPU_EMU
constexpr int LDS_BYTES = 147456;
__global__ void __launch_bounds__(512, 2) mk_fwd(Params p) {
    extern __shared__ __attribute__((aligned(16))) unsigned char lds_raw[];
    PG8_LAS unsigned char* lds = (PG8_LAS unsigned char*)lds_raw;
    cg::grid_group grid = cg::this_grid();
    const int ph_lo = p.ph_lo, ph_hi = p.ph_hi;
#define X(k) if (ph_lo <= k && k < ph_hi) { \
        const Params* q = (const Params*)__builtin_amdgcn_kernarg_segment_ptr(); asm volatile("" : "+s"(q) :: "memory"); \
        Ctx cx; cx.tid = (int)threadIdx.x; cx.bid = (int)blockIdx.x; cx.nblk = (int)gridDim.x; \
        asm volatile("" : "+v"(cx.tid)); asm volatile("" : "+s"(cx.bid), "+s"(cx.nblk)); \
        run_phase_t<k>(lds, cx, *q); \
        if (k + 1 < ph_hi) grid.sync(); }
    MK_PHASE_LIST(X)
#undef X
}

#ifndef MK_SINGLE
#define MK_SINGLE 0
#endif
extern "C" void kernel_launch(void* const* d_in, const int* in_sizes, int n_in, void* d_out, int out_size, void* d_ws, size_t ws_size, hipStream_t stream) {
    static int grid = 0;
    if (grid == 0) {
        if (n_in != 18 || in_sizes[0] != ML * DM || out_size != ML * DM || ws_size < WS_END) { fprintf(stderr, "kernel_launch: unexpected shapes (n_in %d, in0 %d, out %d, ws %zu < %zu)\n", n_in, n_in > 0 ? in_sizes[0] : -1, out_size, ws_size, (size_t)WS_END); grid = -1; return; }
        int dev = 0, cus = 0, per_cu = 0;
        if (hipGetDevice(&dev) != hipSuccess || hipDeviceGetAttribute(&cus, hipDeviceAttributeMultiprocessorCount, dev) != hipSuccess) { grid = -1; return; }
        if (hipFuncSetAttribute((const void*)mk_fwd, hipFuncAttributeMaxDynamicSharedMemorySize, LDS_BYTES) != hipSuccess) { fprintf(stderr, "kernel_launch: hipFuncSetAttribute failed\n"); grid = -1; return; }
        if (hipOccupancyMaxActiveBlocksPerMultiprocessor(&per_cu, (const void*)mk_fwd, 512, LDS_BYTES) != hipSuccess || per_cu < 1) { fprintf(stderr, "kernel_launch: occupancy query says %d\n", per_cu); (void)hipGetLastError(); grid = -1; return; }
        grid = cus;
    }
    if (grid < 0) return;
    Params p{};
    const float** pp = (const float**)&p;
    for (int i = 0; i < 18; ++i) pp[i] = (const float*)d_in[i];
    p.out = (float*)d_out; p.ws = (unsigned char*)d_ws;
#if MK_SINGLE
    p.ph_lo = 0; p.ph_hi = NPHASE;
    { void* args[] = {&p}; hipError_t e = hipLaunchCooperativeKernel((const void*)mk_fwd, dim3(grid), dim3(512), args, LDS_BYTES, stream);
      if (e != hipSuccess) fprintf(stderr, "cooperative launch failed: %s\n", hipGetErrorString(e)); }
#else
    for (int ph = 0; ph < NPHASE; ++ph) {
        p.ph_lo = ph; p.ph_hi = ph + 1;
        void* args[] = {&p}; hipError_t e = hipLaunchCooperativeKernel((const void*)mk_fwd, dim3(grid), dim3(512), args, LDS_BYTES, stream);
        if (e != hipSuccess) { fprintf(stderr, "cooperative launch %d failed: %s\n", ph, hipGetErrorString(e)); break; }
    }
#endif
}
#endif
```

```cpp
#ifndef CPU_EMU
#include <hip/hip_runtime.h>
#include <hip/hip_cooperative_groups.h>
#include <cstdio>
#include <cstdint>
namespace cg = cooperative_groups;
#define DEVI __device__ __forceinline__
#define HD __host__ __device__ __forceinline__
#define CFENCE() asm volatile("" ::: "memory")
#else
#define CFENCE() do {} while (0)
#include <cstring>
#include <cmath>
#include <cstdio>
#include <cstdint>
#include <cstddef>
#define DEVI inline
#define HD inline
#endif

#ifndef NB
#define NB 8
#endif
#ifndef SEQ
#define SEQ 4096
#endif
#ifndef CTXL
#define CTXL 256
#endif
constexpr int DM = 1024, INW = 8464, GRIDW = 64;
constexpr int ML = NB * SEQ, MC = NB * CTXL, MT = ML + MC;
constexpr int N1 = 3840;
constexpr int NZ = 1536;
constexpr int NMG = 3072;
constexpr float EPSF = 1e-6f;
constexpr int NLAYER = 2;
static_assert(MT % 256 == 0 && ML % 256 == 0, "row tiles");

typedef unsigned short bf16_t;
struct alignas(16) U4 { unsigned x, y, z, w; };

constexpr size_t MiB = 1u << 20;
constexpr size_t al1(size_t x) { return (x + MiB - 1) & ~(MiB - 1); }
constexpr size_t WS_CTL = 0;
constexpr size_t WS_MOD = 256 * 1024;
constexpr size_t WS_W1 = 1 * MiB;
constexpr size_t WS_WZ = WS_W1 + al1((size_t)2 * N1 * DM * 2);
constexpr size_t WS_WM = WS_WZ + al1((size_t)2 * NZ * DM * 2);
constexpr size_t WS_WB = WS_WM + al1((size_t)2 * NMG * DM * 2);
constexpr size_t WS_WO = WS_WB + al1((size_t)2 * 3 * DM * 512 * 2);
constexpr size_t WS_G = WS_WO + al1((size_t)2 * DM * DM * 2);
constexpr size_t WS_BETA = WS_G + al1((size_t)MT * 8 * 4);
constexpr size_t WS_CTX1 = WS_BETA + al1((size_t)MT * 8 * 4);
constexpr size_t WS_XN = WS_CTX1 + al1((size_t)MC * DM * 4);
constexpr size_t WS_AQKV = WS_XN + al1((size_t)MT * DM * 2);
constexpr size_t WS_CQKV = WS_AQKV + al1((size_t)MT * 1536 * 2);
constexpr size_t WS_BQ = WS_CQKV + al1((size_t)MT * 1536 * 2);
constexpr size_t WS_BKV = WS_BQ + al1((size_t)MT * 512 * 2);
constexpr size_t WS_PA = WS_BKV + al1((size_t)MT * 256 * 2);
constexpr size_t WS_PC = WS_PA + al1((size_t)MT * 512 * 2);
constexpr size_t WS_END = WS_PC + al1((size_t)MT * 512 * 2);
static_assert(WS_CQKV + (size_t)MT * NMG * 2 <= WS_END, "L overlay");
static_assert(WS_END <= (size_t)512 * MiB, "workspace");

struct Params {
    const float *x, *c, *ctx, *c_ctx, *w_ada, *b_ada, *norm_w, *w_in, *a_conv_w, *a_log, *a_dt_bias, *a_norm_w, *b_sink, *c_decay, *c_norm_w, *w_branch, *w_out, *final_norm_w;
    float* out; unsigned char* ws;
    int ph_lo, ph_hi;
};

#ifdef CPU_EMU
inline float u2f(unsigned u) { float f; memcpy(&f, &u, 4); return f; }
inline unsigned f2u(float f) { unsigned u; memcpy(&u, &f, 4); return u; }
#else
DEVI float u2f(unsigned u) { return __uint_as_float(u); }
DEVI unsigned f2u(float f) { return __float_as_uint(f); }
#endif
DEVI float bf2f(bf16_t h) { return u2f((unsigned)h << 16); }
DEVI bf16_t f2bf(float f) { unsigned u = f2u(f); return (bf16_t)((u + 0x7fffu + ((u >> 16) & 1u)) >> 16); }
DEVI unsigned pk2(float lo, float hi) { return (unsigned)f2bf(lo) | ((unsigned)f2bf(hi) << 16); }
DEVI float lo16(unsigned w) { return u2f(w << 16); }
DEVI float hi16(unsigned w) { return u2f(w & 0xffff0000u); }
DEVI float sigmoidf_(float x) { return 1.0f / (1.0f + expf(-x)); }
DEVI float siluf_(float x) { return x / (1.0f + expf(-x)); }
DEVI float softplusf_(float x) { return x > 20.f ? x : log1pf(expf(x)); }
DEVI void unpack8(const U4& w, float* v) { v[0] = lo16(w.x); v[1] = hi16(w.x); v[2] = lo16(w.y); v[3] = hi16(w.y); v[4] = lo16(w.z); v[5] = hi16(w.z); v[6] = lo16(w.w); v[7] = hi16(w.w); }
DEVI U4 pack8(const float* v) { U4 w; w.x = pk2(v[0], v[1]); w.y = pk2(v[2], v[3]); w.z = pk2(v[4], v[5]); w.w = pk2(v[6], v[7]); return w; }

struct Ctx { int tid, bid, nblk; };
struct TI { long id, n; };
DEVI TI thread_info(const Ctx& c) {
#ifdef CPU_EMU
    return TI{0, 1};
#else
    const int wave = c.tid >> 6, lane = c.tid & 63;
    return TI{((long)wave * c.nblk + c.bid) * 64 + lane, (long)c.nblk * 512};
#endif
}

struct Views {
    float* MOD; bf16_t *W1, *WZ, *WM, *WB, *WO; float *G, *BETA, *CTX1; bf16_t *XN, *AQKV, *CQKV, *BQ, *BKV, *PA, *PC, *Y, *Z, *L, *MRG;
};
DEVI Views make_views(unsigned char* ws) {
    Views v;
    v.MOD = (float*)(ws + WS_MOD); v.W1 = (bf16_t*)(ws + WS_W1); v.WZ = (bf16_t*)(ws + WS_WZ); v.WM = (bf16_t*)(ws + WS_WM); v.WB = (bf16_t*)(ws + WS_WB); v.WO = (bf16_t*)(ws + WS_WO);
    v.G = (float*)(ws + WS_G); v.BETA = (float*)(ws + WS_BETA); v.CTX1 = (float*)(ws + WS_CTX1);
    v.XN = (bf16_t*)(ws + WS_XN); v.AQKV = (bf16_t*)(ws + WS_AQKV); v.CQKV = (bf16_t*)(ws + WS_CQKV); v.BQ = (bf16_t*)(ws + WS_BQ); v.BKV = (bf16_t*)(ws + WS_BKV);
    v.PA = (bf16_t*)(ws + WS_PA); v.PC = (bf16_t*)(ws + WS_PC); v.Y = v.AQKV; v.Z = v.CQKV; v.L = v.CQKV; v.MRG = v.XN;
    return v;
}

HD int map_g1(int n) { return n < 1536 ? n : (n < 2048 ? 2064 + (n - 1536) : (n < 2304 ? 2576 + (n - 2048) : 3344 + (n - 2304))); }
HD int map_z(int n) { return n < 512 ? 1536 + n : (n < 1024 ? 2832 + (n - 512) : 4880 + (n - 1024)); }

DEVI void phase_prep(const Ctx& cx, const Params& p) {
    const Views v = make_views(p.ws); const TI ti = thread_info(cx);
    const long n1 = (long)2 * N1 * DM, nz = (long)2 * NZ * DM, nm = (long)2 * NMG * DM, nb = (long)2 * 3 * DM * 512, no = (long)2 * DM * DM;
    const long tot = n1 + nz + nm + nb + no;
    for (long i = ti.id; i < tot; i += ti.n) {
        long r = i;
        if (r < n1) { const int l = (int)(r / ((long)N1 * DM)), rem = (int)(r % ((long)N1 * DM)), n = rem / DM, k = rem % DM; v.W1[r] = f2bf(p.w_in[((size_t)l * DM + k) * INW + map_g1(n)]); continue; } r -= n1;
        if (r < nz) { const int l = (int)(r / ((long)NZ * DM)), rem = (int)(r % ((long)NZ * DM)), n = rem / DM, k = rem % DM; v.WZ[r] = f2bf(p.w_in[((size_t)l * DM + k) * INW + map_z(n)]); continue; } r -= nz;
        if (r < nm) { const int l = (int)(r / ((long)NMG * DM)), rem = (int)(r % ((long)NMG * DM)), n = rem / DM, k = rem % DM; v.WM[r] = f2bf(p.w_in[((size_t)l * DM + k) * INW + 5392 + n]); continue; } r -= nm;
        if (r < nb) { const int lb = (int)(r / ((long)DM * 512)), rem = (int)(r % ((long)DM * 512)), n = rem / 512, k = rem % 512; v.WB[r] = f2bf(p.w_branch[((size_t)lb * 512 + k) * DM + n]); continue; } r -= nb;
        { const int l = (int)(r / ((long)DM * DM)), rem = (int)(r % ((long)DM * DM)), n = rem / DM, k = rem % DM; v.WO[r] = f2bf(p.w_out[((size_t)l * DM + k) * DM + n]); }
    }
    const long nmod = (long)NLAYER * (NB + 1) * 3072;
    for (long i = ti.id; i < nmod; i += ti.n) {
        const int l = (int)(i / ((NB + 1) * 3072)), rem = (int)(i % ((NB + 1) * 3072)), b = rem / 3072, n = rem % 3072;
        const float* cv = b < NB ? p.c + (size_t)b * DM : p.c_ctx;
        const float* w = p.w_ada + (size_t)l * DM * 3072 + n;
        float acc = 0.f;
        for (int k = 0; k < DM; ++k) acc += siluf_(cv[k]) * w[(size_t)k * 3072];
        v.MOD[i] = acc + p.b_ada[l * 3072 + n];
    }
}

DEVI const float* xrow_in(const Params& p, const Views& v, int layer, int m) {
    if (layer == 0) return m < ML ? p.x + (size_t)m * DM : p.ctx + (size_t)(m - ML) * DM;
    return m < ML ? p.out + (size_t)m * DM : v.CTX1 + (size_t)(m - ML) * DM;
}
DEVI void phase_norm(const Ctx& cx, const Params& p, int layer) {
    const Views v = make_views(p.ws); const TI ti = thread_info(cx);
    for (long m = ti.id; m < MT; m += ti.n) {
        const float* xr = xrow_in(p, v, layer, (int)m);
        const int b = m < ML ? (int)(m / SEQ) : NB;
        const float* mod = v.MOD + ((size_t)layer * (NB + 1) + b) * 3072;
        const float* nw = p.norm_w + layer * DM;
        float ss = 0.f;
        for (int k = 0; k < DM; ++k) ss += xr[k] * xr[k];
        const float r = 1.0f / sqrtf(ss * (1.0f / DM) + EPSF);
        float a[16];
#pragma unroll
        for (int j = 0; j < 16; ++j) a[j] = 0.f;
        const float* wab = p.w_in + (size_t)layer * DM * INW + 2048;
        for (int k = 0; k < DM; ++k) {
            const float hv = xr[k] * r * nw[k] * (1.0f + mod[1024 + k]) + mod[k];
            v.XN[(size_t)m * DM + k] = f2bf(hv);
            const float* wr_ = wab + (size_t)k * INW;
#pragma unroll
            for (int j = 0; j < 16; ++j) a[j] += hv * wr_[j];
        }
#pragma unroll
        for (int h = 0; h < 8; ++h) {
            v.BETA[(size_t)m * 8 + h] = sigmoidf_(a[h]);
            v.G[(size_t)m * 8 + h] = -expf(p.a_log[layer * 8 + h]) * softplusf_(a[8 + h] + p.a_dt_bias[layer * 8 + h]);
        }
    }
}

DEVI void phase_conv(const Ctx& cx, const Params& p, int layer) {
    const Views v = make_views(p.ws); const TI ti = thread_info(cx);
    const float* cw = p.a_conv_w + (size_t)layer * 5 * 1536;
    for (long it = ti.id; it < (long)2 * NB * 1536; it += ti.n) {
        const int s = (int)(it / 1536), c = (int)(it % 1536);
        const int len = s < NB ? SEQ : CTXL; const size_t m0 = s < NB ? (size_t)s * SEQ : (size_t)ML + (size_t)(s - NB) * CTXL;
        bf16_t* col = v.AQKV + m0 * 1536 + c;
        const float w0 = cw[c], w1 = cw[1536 + c], w2 = cw[2 * 1536 + c], w3 = cw[3 * 1536 + c], w4 = cw[4 * 1536 + c];
        float xm2 = 0.f, xm1 = 0.f, x0 = bf2f(col[0]), x1 = bf2f(col[1536]);
        for (int t = 0; t < len; ++t) {
            const float x2 = (t + 2 < len) ? bf2f(col[(size_t)(t + 2) * 1536]) : 0.f;
            const float y = w0 * xm2 + w1 * xm1 + w2 * x0 + w3 * x1 + w4 * x2;
            col[(size_t)t * 1536] = f2bf(siluf_(y));
            xm2 = xm1; xm1 = x0; x0 = x1; x1 = x2;
        }
    }
}

DEVI void phase_prep2(const Ctx& cx, const Params& p, int layer) {
    const Views v = make_views(p.ws); const TI ti = thread_info(cx);
    for (long it = ti.id; it < (long)MT * 8; it += ti.n) {
        const long m = it >> 3; const int wh = (int)(it & 7), which = wh >> 2, h = wh & 3;
        bf16_t* ptr = v.AQKV + (size_t)m * 1536 + which * 512 + h * 128;
        float ss = 0.f;
        for (int d = 0; d < 128; ++d) { const float f = bf2f(ptr[d]); ss += f * f; }
        const float sc = (1.0f / sqrtf(ss + EPSF)) * (which == 0 ? 0.08838834764831845f : 1.0f);
        for (int d = 0; d < 128; ++d) ptr[d] = f2bf(bf2f(ptr[d]) * sc);
    }
    for (long it = ti.id; it < (long)ML * 10; it += ti.n) {
        const long m = it / 10; const int hh = (int)(it % 10);
        const int t = (int)(m % SEQ); const float rowp = (float)(t / GRIDW), colp = (float)(t % GRIDW);
        bf16_t* ptr = hh < 8 ? v.BQ + (size_t)m * 512 + hh * 64 : v.BKV + (size_t)m * 256 + (hh - 8) * 64;
        for (int half = 0; half < 2; ++half) {
            const float pos = half == 0 ? rowp : colp;
            for (int i = 0; i < 16; ++i) {
                const float inv = powf(10000.0f, -(float)i / 16.0f);
                const float ang = pos * inv; const float cs = cosf(ang), sn = sinf(ang);
                const float x1 = bf2f(ptr[half * 32 + i]), x2 = bf2f(ptr[half * 32 + 16 + i]);
                ptr[half * 32 + i] = f2bf(x1 * cs - x2 * sn); ptr[half * 32 + 16 + i] = f2bf(x1 * sn + x2 * cs);
            }
        }
    }
    for (long it = ti.id; it < (long)MT * 8; it += ti.n) {
        const long m = it >> 3; const int wh = (int)(it & 7), which = wh >> 2, h = wh & 3;
        bf16_t* ptr = v.CQKV + (size_t)m * 1536 + which * 512 + h * 128;
        const float sc = which == 1 ? 0.08838834764831845f : 1.0f;
        if (m < ML) {
            const float pos = (float)(m % SEQ);
            for (int i = 0; i < 64; ++i) {
                const float inv = powf(10000.0f, -(float)i / 64.0f);
                const float ang = pos * inv; const float cs = cosf(ang), sn = sinf(ang);
                const float x1 = bf2f(ptr[i]) * sc, x2 = bf2f(ptr[64 + i]) * sc;
                ptr[i] = f2bf(x1 * cs - x2 * sn); ptr[64 + i] = f2bf(x1 * sn + x2 * cs);
            }
        } else if (which == 1) {
            for (int d = 0; d < 128; ++d) ptr[d] = f2bf(bf2f(ptr[d]) * sc);
        }
    }
}

template <int MIX> DEVI void scan_item(const Params& p, const Views& v, int layer, int item) {
    const int j = item & 127, h = (item >> 7) & 3, b = item >> 9;
    const bf16_t* QKV = MIX == 0 ? v.AQKV : v.CQKV; bf16_t* PARK = MIX == 0 ? v.PA : v.PC;
    float S[128];
    for (int dir = 0; dir < 2; ++dir) {
#pragma unroll
        for (int d = 0; d < 128; ++d) S[d] = 0.f;
        const float gam = MIX == 1 ? sigmoidf_(p.c_decay[layer * 8 + dir * 4 + h]) : 0.f;
        for (int seg = 0; seg < 2; ++seg) {
            const int len = seg == 0 ? CTXL : SEQ; const size_t m0 = seg == 0 ? (size_t)ML + (size_t)b * CTXL : (size_t)b * SEQ;
            for (int i = 0; i < len; ++i) {
                const int t = dir == 0 ? i : len - 1 - i; const size_t m = m0 + t;
                const bf16_t* row = QKV + m * 1536 + h * 128;
                const float vj = bf2f(row[1024 + j]);
                float o = 0.f;
                if (MIX == 0) {
                    const float a = expf(v.G[m * 8 + dir * 4 + h]), be = v.BETA[m * 8 + dir * 4 + h];
                    float dot = 0.f;
#pragma unroll
                    for (int c8 = 0; c8 < 16; ++c8) { float kk[8]; unpack8(*(const U4*)(row + 512 + c8 * 8), kk);
#pragma unroll
                        for (int e = 0; e < 8; ++e) dot += S[c8 * 8 + e] * kk[e];
                        if ((c8 & 3) == 3) CFENCE(); }
                    const float vn = be * (vj - a * dot);
#pragma unroll
                    for (int c8 = 0; c8 < 16; ++c8) { float kk[8], qq[8]; unpack8(*(const U4*)(row + 512 + c8 * 8), kk); unpack8(*(const U4*)(row + c8 * 8), qq);
#pragma unroll
                        for (int e = 0; e < 8; ++e) { const float s = a * S[c8 * 8 + e] + kk[e] * vn; S[c8 * 8 + e] = s; o += s * qq[e]; }
                        if ((c8 & 3) == 3) CFENCE(); }
                } else {
#pragma unroll
                    for (int c8 = 0; c8 < 16; ++c8) { float kk[8], qq[8]; unpack8(*(const U4*)(row + 512 + c8 * 8), kk); unpack8(*(const U4*)(row + c8 * 8), qq);
#pragma unroll
                        for (int e = 0; e < 8; ++e) { const float s = gam * S[c8 * 8 + e] + kk[e] * vj; S[c8 * 8 + e] = s; o += s * qq[e]; }
                        if ((c8 & 3) == 3) CFENCE(); }
                }
                bf16_t* pp = PARK + m * 512 + h * 128 + j;
                *pp = f2bf(dir == 0 ? o : bf2f(*pp) + o);
            }
        }
    }
}

DEVI void attn_item(const Params& p, const Views& v, int layer, long m, int hq) {
    const int hk = hq >> 2;
    bf16_t* qp = v.BQ + (size_t)m * 512 + hq * 64;
    float q[64], acc[64];
#pragma unroll
    for (int c8 = 0; c8 < 8; ++c8) unpack8(*(const U4*)(qp + c8 * 8), q + c8 * 8);
#pragma unroll
    for (int d = 0; d < 64; ++d) acc[d] = 0.f;
    float mrun = p.b_sink[layer * 8 + hq], lrun = 1.0f;
    const int b = m < ML ? (int)(m / SEQ) : (int)((m - ML) / CTXL);
    const int t = m < ML ? (int)(m % SEQ) : 0;
    const int lo = t - 128 < 0 ? 0 : t - 128, hi = t + 128 > SEQ - 1 ? SEQ - 1 : t + 128;
    const int nwin = m < ML ? hi - lo + 1 : 0;
    for (int i = 0; i < CTXL + nwin; ++i) {
        const size_t kr = i < CTXL ? (size_t)ML + (size_t)b * CTXL + i : (size_t)b * SEQ + lo + (i - CTXL);
        const bf16_t* kp = v.BKV + kr * 256 + hk * 64;
        float s = 0.f;
#pragma unroll
        for (int c8 = 0; c8 < 8; ++c8) { float kk[8]; unpack8(*(const U4*)(kp + c8 * 8), kk);
#pragma unroll
            for (int e = 0; e < 8; ++e) s += q[c8 * 8 + e] * kk[e]; }
        CFENCE();
        s *= 0.125f;
        float pw;
        if (s > mrun) { const float f = expf(mrun - s); lrun *= f;
#pragma unroll
            for (int d = 0; d < 64; ++d) acc[d] *= f;
            mrun = s; pw = 1.0f; }
        else pw = expf(s - mrun);
        lrun += pw;
#pragma unroll
        for (int c8 = 0; c8 < 8; ++c8) { float vv[8]; unpack8(*(const U4*)(kp + 128 + c8 * 8), vv);
#pragma unroll
            for (int e = 0; e < 8; ++e) acc[c8 * 8 + e] += pw * vv[e]; }
        CFENCE();
    }
    const float il = 1.0f / lrun;
#pragma unroll
    for (int c8 = 0; c8 < 8; ++c8) { float o8[8];
#pragma unroll
        for (int e = 0; e < 8; ++e) o8[e] = acc[c8 * 8 + e] * il;
        *(U4*)(qp + c8 * 8) = pack8(o8); }
}
DEVI void phase_mix(const Ctx& cx, const Params& p, int layer) {
    const Views v = make_views(p.ws); const TI ti = thread_info(cx);
    const long nscan = (long)NB * 4 * 128;
    for (long it = ti.id; it < 2 * nscan; it += ti.n) { if (it < nscan) scan_item<0>(p, v, layer, (int)it); else scan_item<1>(p, v, layer, (int)(it - nscan)); }
    const long mrows = layer == 0 ? MT : ML;
    for (long it = ti.n - 1 - ti.id; it < mrows * 8; it += ti.n) attn_item(p, v, layer, it >> 3, (int)(it & 7));
}

DEVI void phase_y(const Ctx& cx, const Params& p, int layer) {
    const Views v = make_views(p.ws); const TI ti = thread_info(cx);
    const long mrows = layer == 0 ? MT : ML;
    for (long it = ti.id; it < mrows * 12; it += ti.n) {
        const long m = it / 12; const int r = (int)(it % 12), mix = r >> 2, h = r & 3;
        const bf16_t* zp = v.Z + (size_t)m * 1536 + mix * 512 + h * 128;
        bf16_t* yp = v.Y + ((size_t)mix * MT + m) * 512 + h * 128;
        if (mix == 0) {
            const bf16_t* op = v.PA + (size_t)m * 512 + h * 128; float ss = 0.f;
            for (int d = 0; d < 128; ++d) { const float f = bf2f(op[d]); ss += f * f; }
            const float rs = 1.0f / sqrtf(ss * (1.0f / 128.0f) + EPSF);
            for (int d = 0; d < 128; ++d) yp[d] = f2bf(bf2f(op[d]) * rs * p.a_norm_w[layer * 128 + d] * siluf_(bf2f(zp[d])));
        } else if (mix == 1) {
            const bf16_t* op = v.BQ + (size_t)m * 512 + h * 128;
            for (int d = 0; d < 128; ++d) yp[d] = f2bf(bf2f(op[d]) * siluf_(bf2f(zp[d])));
        } else {
            const bf16_t* op = v.PC + (size_t)m * 512 + h * 128; float s = 0.f;
            for (int d = 0; d < 128; ++d) s += bf2f(op[d]);
            const float mu = s * (1.0f / 128.0f); float q = 0.f;
            for (int d = 0; d < 128; ++d) { const float f = bf2f(op[d]) - mu; q += f * f; }
            const float rs = 1.0f / sqrtf(q * (1.0f / 128.0f) + EPSF);
            for (int d = 0; d < 128; ++d) yp[d] = f2bf((bf2f(op[d]) - mu) * rs * p.c_norm_w[layer * 512 + h * 128 + d] * siluf_(bf2f(zp[d])));
        }
    }
}

DEVI void phase_final(const Ctx& cx, const Params& p) {
    const TI ti = thread_info(cx);
    for (long m = ti.id; m < ML; m += ti.n) {
        float* xr = p.out + (size_t)m * DM; float ss = 0.f;
        for (int k = 0; k < DM; ++k) ss += xr[k] * xr[k];
        const float r = 1.0f / sqrtf(ss * (1.0f / DM) + EPSF);
        for (int k = 0; k < DM; ++k) xr[k] = xr[k] * r * p.final_norm_w[k];
    }
}

struct StG1 { bf16_t *AQKV, *BQ, *BKV, *CQKV;
    DEVI void st8(int row, int col, const float* a) const {
        bf16_t* dst = col < 1536 ? AQKV + (size_t)row * 1536 + col : (col < 2048 ? BQ + (size_t)row * 512 + (col - 1536) : (col < 2304 ? BKV + (size_t)row * 256 + (col - 2048) : CQKV + (size_t)row * 1536 + (col - 2304)));
        *(U4*)dst = pack8(a); } };
struct StPlain { bf16_t* O; int ld;
    DEVI void st8(int row, int col, const float* a) const { *(U4*)(O + (size_t)row * ld + col) = pack8(a); } };
struct StMerge { const bf16_t* L; bf16_t* MRG; int br;
    DEVI void st8(int row, int col, const float* a) const {
        float lg[8], o[8]; unpack8(*(const U4*)(L + (size_t)row * NMG + br * 1024 + col), lg);
        if (br) unpack8(*(const U4*)(MRG + (size_t)row * DM + col), o); else { for (int e = 0; e < 8; ++e) o[e] = 0.f; }
        for (int e = 0; e < 8; ++e) o[e] += sigmoidf_(lg[e]) * a[e];
        *(U4*)(MRG + (size_t)row * DM + col) = pack8(o); } };
struct StResid { const float *xlat, *xctx; float *olat, *octx; const float* mod;
    DEVI void st4(int row, int col, const float* a) const {
        const float* xi = row < ML ? xlat + (size_t)row * DM + col : xctx + (size_t)(row - ML) * DM + col;
        float* xo = row < ML ? olat + (size_t)row * DM + col : octx + (size_t)(row - ML) * DM + col;
        const int b = row < ML ? row / SEQ : NB; const float* g = mod + (size_t)b * 3072 + 2048 + col;
        for (int e = 0; e < 4; ++e) xo[e] = xi[e] + g[e] * a[e]; } };

#ifndef CPU_EMU
namespace pg8 {
#define PG8_LAS __attribute__((address_space(3)))
typedef short bf16x8 __attribute__((ext_vector_type(8)));
typedef float f32x4 __attribute__((ext_vector_type(4)));
typedef unsigned u32x4 __attribute__((ext_vector_type(4)));
constexpr int BM = 256, BK = 64, HALF = 128, HTB = HALF * BK * 2, STAGE_BYTES = 8 * HTB, NXCD = 8, WGM = 8;
__host__ __device__ __forceinline__ int lds_byte(int r, int c) { const int st = (r >> 4) * 2 + (c >> 5), rr = r & 15, cc = c & 31, ob = rr * 64 + cc * 2; return st * 1024 + (ob ^ (((ob >> 9) & 1) << 5)); }
__host__ __device__ __forceinline__ void stage_rc(int b, int& R, int& C) { const int st = b / 1024, sb = b % 1024, swz = sb ^ (((sb >> 9) & 1) << 5); R = (st >> 1) * 16 + swz / 64; C = (st & 1) * 32 + (swz % 64) / 2; }
__host__ __device__ __forceinline__ int perm32(int rho) { const int n = rho >> 4, i = rho & 15; return 8 * (i >> 2) + 4 * n + (i & 3); }
struct Unit { int pm, pn; };
struct Gemm { const bf16_t* A; const bf16_t* Bt; int M, N, K; };
struct StaticOrder {
    int nM, nN, nwg, G, c;
    __host__ __device__ void init(int M, int N, int G_, int c_) { nM = M / BM; nN = N / BM; nwg = nM * nN; G = G_; c = c_; }
    __host__ __device__ bool next(int i, Unit& u) const {
        const long L = (long)i * G + c; if (L >= nwg) return false;
        int wgid = (int)L; { const int q = nwg / NXCD, r = nwg % NXCD, xcd = wgid % NXCD, off = wgid / NXCD; wgid = (xcd < r ? xcd * (q + 1) : r * (q + 1) + (xcd - r) * q) + off; }
        const int nig = WGM * nN, gid = wgid / nig, fm = gid * WGM, gsz = (nM - fm) < WGM ? (nM - fm) : WGM;
        u.pm = fm + ((wgid % nig) % gsz); u.pn = (wgid % nig) / gsz; return true;
    }
    __device__ __forceinline__ void a_ready(const Unit&) const {}
    __device__ __forceinline__ void done(const Unit&) const {}
};
template <class F> struct Epi8 {
    static constexpr bool PERM = true, AFTER_DRAIN = false; F f;
    __device__ __forceinline__ void operator()(const f32x4 (&acc)[2][2][4][2], const Unit& u, int wr, int wc, int fr, int fq) const {
        const int row0 = u.pm * BM + wr * 64 + fr, col0 = u.pn * BM + wc * 32 + 8 * fq;
#pragma unroll
        for (int ai = 0; ai < 2; ++ai)
#pragma unroll
            for (int m = 0; m < 4; ++m)
#pragma unroll
                for (int bj = 0; bj < 2; ++bj) { const f32x4 v0 = acc[ai][bj][m][0], v1 = acc[ai][bj][m][1];
                    const float a[8] = {v0[0], v0[1], v0[2], v0[3], v1[0], v1[1], v1[2], v1[3]};
                    f.st8(row0 + ai * HALF + m * 16, col0 + bj * HALF, a); }
    }
};
template <class F> struct Epi4 {
    static constexpr bool PERM = false, AFTER_DRAIN = false; F f;
    __device__ __forceinline__ void operator()(const f32x4 (&acc)[2][2][4][2], const Unit& u, int wr, int wc, int fr, int fq) const {
        const int row0 = u.pm * BM + wr * 64 + fr, col0 = u.pn * BM + wc * 32 + 4 * fq;
#pragma unroll
        for (int ai = 0; ai < 2; ++ai)
#pragma unroll
            for (int m = 0; m < 4; ++m)
#pragma unroll
                for (int bj = 0; bj < 2; ++bj)
#pragma unroll
                    for (int n = 0; n < 2; ++n) { const f32x4 v0 = acc[ai][bj][m][n]; const float a[4] = {v0[0], v0[1], v0[2], v0[3]};
                        f.st4(row0 + ai * HALF + m * 16, col0 + bj * HALF + n * 16, a); }
    }
};

template <class Epi, class Sched, bool ALIGN_EPI = false, bool SP2 = false>
__device__ __forceinline__ void gemm_phase(PG8_LAS unsigned char* lds, const int tid, const Gemm g, const Sched& S, const Epi& E) {
    const int wid = __builtin_amdgcn_readfirstlane(tid >> 6), lane = tid & 63, wr = wid >> 2, wc = wid & 3, fr = lane & 15, fq = lane >> 4;
    const int K = g.K, nt = K / BK;
    unsigned voffA[2], voffB[2];
#pragma unroll
    for (int i = 0; i < 2; ++i) { int R, C; stage_rc(tid * 16 + i * 8192, R, C); const int Rb = Epi::PERM ? ((R & ~31) + perm32(R & 31)) : R;
        voffA[i] = (unsigned)(R * K + C) * 2u; voffB[i] = (unsigned)(Rb * K + C) * 2u; }
    const size_t kstep = (size_t)(BK * 2);
    const size_t hstep = (size_t)HALF * K * 2;
    const size_t tstep = 2 * hstep;
    const unsigned ldsw = (unsigned)wid * 1024u;
    const int aoff = lds_byte(wr * 64 + fr, fq * 8), boff = lds_byte(wc * 32 + fr, fq * 8);
#define PG8_SA(b, h) (((b) * 2 + (h)) * HTB)
#define PG8_SB(b, h) ((4 + (b) * 2 + (h)) * HTB)
#define PG8_STAGE(bufoff, gbase, voff) do { _Pragma("unroll") for (int _i = 0; _i < 2; ++_i) \
        __builtin_amdgcn_global_load_lds((const unsigned*)((const char*)(gbase) + (voff)[_i]), (PG8_LAS unsigned*)(lds + (bufoff) + ldsw + _i * 8192), 16, 0, 0); } while (0)
#define PG8_LDA(dst, b, h) do { _Pragma("unroll") for (int m = 0; m < 4; ++m) _Pragma("unroll") for (int k = 0; k < 2; ++k) dst[m][k] = *(const PG8_LAS bf16x8*)(lds + PG8_SA(b, h) + aoff + m * 2048 + k * 1024); } while (0)
#define PG8_LDB(dst, b, h) do { _Pragma("unroll") for (int n = 0; n < 2; ++n) _Pragma("unroll") for (int k = 0; k < 2; ++k) dst[n][k] = *(const PG8_LAS bf16x8*)(lds + PG8_SB(b, h) + boff + n * 2048 + k * 1024); } while (0)
#define PG8_MMA(ai, bj, At, Bt) do { __builtin_amdgcn_s_setprio(1); _Pragma("unroll") for (int m = 0; m < 4; ++m) _Pragma("unroll") for (int n = 0; n < 2; ++n) _Pragma("unroll") for (int k = 0; k < 2; ++k) \
        acc[ai][bj][m][n] = __builtin_amdgcn_mfma_f32_16x16x32_bf16(Bt[n][k], At[m][k], acc[ai][bj][m][n], 0, 0, 0); __builtin_amdgcn_s_setprio(0); } while (0)
#define PG8_WAIT_V(n) asm volatile("s_waitcnt vmcnt(" #n ")" ::: "memory")
#define PG8_WAIT_L(n) asm volatile("s_waitcnt lgkmcnt(" #n ")" ::: "memory")
#define PG8_BAR __builtin_amdgcn_s_barrier()
#define PG8_SCHED __builtin_amdgcn_sched_barrier(0)
    Unit cur, nxt; int ui = 0;
    if (!S.next(0, cur)) return;
    f32x4 acc[2][2][4][2];
#pragma unroll
    for (int a = 0; a < 2; ++a)
#pragma unroll
        for (int b = 0; b < 2; ++b)
#pragma unroll
            for (int m = 0; m < 4; ++m)
#pragma unroll
                for (int n = 0; n < 2; ++n) acc[a][b][m][n] = (f32x4){0.f, 0.f, 0.f, 0.f};
    bf16x8 At[4][2], B0[2][2], B1[2][2];
    const char* cA = (const char*)g.A + (size_t)cur.pm * tstep; const char* cB = (const char*)g.Bt + (size_t)cur.pn * tstep;
    S.a_ready(cur);
    if constexpr (SP2) {
        PG8_STAGE(PG8_SB(0, 0), cB, voffB); PG8_STAGE(PG8_SB(0, 1), cB + hstep, voffB); PG8_STAGE(PG8_SA(0, 0), cA, voffA); PG8_STAGE(PG8_SA(0, 1), cA + hstep, voffA);
        if (wr == 1) PG8_BAR;
        PG8_WAIT_V(2); PG8_BAR;
        PG8_STAGE(PG8_SB(1, 0), cB + kstep, voffB); PG8_STAGE(PG8_SA(1, 0), cA + kstep, voffA); PG8_STAGE(PG8_SB(1, 1), cB + hstep + kstep, voffB);
        PG8_WAIT_V(6); PG8_BAR;
    } else {
        PG8_STAGE(PG8_SB(0, 0), cB, voffB); PG8_STAGE(PG8_SA(0, 0), cA, voffA); PG8_STAGE(PG8_SB(0, 1), cB + hstep, voffB); PG8_STAGE(PG8_SA(0, 1), cA + hstep, voffA);
        if (wr == 1) PG8_BAR;
        PG8_WAIT_V(4); PG8_BAR;
        PG8_STAGE(PG8_SB(1, 0), cB + kstep, voffB); PG8_STAGE(PG8_SA(1, 0), cA + kstep, voffA); PG8_STAGE(PG8_SB(1, 1), cB + hstep + kstep, voffB);
        PG8_WAIT_V(6); PG8_BAR;
    }
    for (;;) {
        const bool has_next = S.next(ui + 1, nxt);
        const char* nA = has_next ? (const char*)g.A + (size_t)nxt.pm * tstep : cA; const char* nB = has_next ? (const char*)g.Bt + (size_t)nxt.pn * tstep : cB;
        for (int t = 0; t < nt; t += 2) {
            const bool last = (t == nt - 2);
            const char* a1 = cA + (size_t)(t + 1) * kstep;
            const char* a2 = last ? nA : cA + (size_t)(t + 2) * kstep; const char* b2 = last ? nB : cB + (size_t)(t + 2) * kstep;
            const char* a3 = a2 + kstep; const char* b3 = b2 + kstep;
            if (last && has_next) S.a_ready(nxt);
            if constexpr (SP2) {
            PG8_LDB(B0, 0, 0); PG8_LDB(B1, 0, 1); PG8_SCHED; PG8_LDA(At, 0, 0); PG8_STAGE(PG8_SA(1, 1), a1 + hstep, voffA);
            PG8_WAIT_V(8); PG8_WAIT_L(0); PG8_BAR; PG8_MMA(0, 0, At, B0); PG8_MMA(0, 1, At, B1); PG8_BAR; PG8_SCHED;
            PG8_LDA(At, 0, 1); PG8_STAGE(PG8_SB(0, 0), b2, voffB); PG8_STAGE(PG8_SB(0, 1), b2 + hstep, voffB); PG8_STAGE(PG8_SA(0, 0), a2, voffA);
            PG8_WAIT_V(8); PG8_WAIT_L(0); PG8_BAR; PG8_MMA(1, 0, At, B0); PG8_MMA(1, 1, At, B1); PG8_BAR; PG8_SCHED;
            PG8_LDB(B0, 1, 0); PG8_LDB(B1, 1, 1); PG8_SCHED; PG8_LDA(At, 1, 0); PG8_STAGE(PG8_SA(0, 1), a2 + hstep, voffA);
            PG8_WAIT_V(8); PG8_WAIT_L(0); PG8_BAR; PG8_MMA(0, 0, At, B0); PG8_MMA(0, 1, At, B1); PG8_BAR; PG8_SCHED;
            PG8_LDA(At, 1, 1); PG8_STAGE(PG8_SB(1, 0), b3, voffB); PG8_STAGE(PG8_SB(1, 1), b3 + hstep, voffB); PG8_STAGE(PG8_SA(1, 0), a3, voffA);
            PG8_WAIT_V(8); PG8_WAIT_L(0); PG8_BAR; PG8_MMA(1, 0, At, B0); PG8_MMA(1, 1, At, B1); PG8_BAR; PG8_SCHED;
            } else {
            PG8_LDB(B0, 0, 0); PG8_SCHED; PG8_LDA(At, 0, 0); PG8_STAGE(PG8_SA(1, 1), a1 + hstep, voffA);
            PG8_WAIT_L(8); PG8_BAR; PG8_WAIT_L(0); PG8_MMA(0, 0, At, B0); PG8_BAR; PG8_SCHED;
            PG8_LDB(B1, 0, 1); PG8_STAGE(PG8_SB(0, 0), b2, voffB);
            PG8_BAR; PG8_WAIT_L(0); PG8_MMA(0, 1, At, B1); PG8_BAR;
            PG8_LDA(At, 0, 1); PG8_STAGE(PG8_SA(0, 0), a2, voffA);
            PG8_BAR; PG8_WAIT_L(0); PG8_MMA(1, 0, At, B0); PG8_BAR; PG8_SCHED;
            PG8_STAGE(PG8_SB(0, 1), b2 + hstep, voffB);
            PG8_WAIT_V(6); PG8_BAR; PG8_MMA(1, 1, At, B1); PG8_BAR;
            PG8_LDB(B0, 1, 0); PG8_SCHED; PG8_LDA(At, 1, 0); PG8_STAGE(PG8_SA(0, 1), a2 + hstep, voffA);
            PG8_WAIT_L(8); PG8_BAR; PG8_WAIT_L(0); PG8_MMA(0, 0, At, B0); PG8_BAR; PG8_SCHED;
            PG8_LDB(B1, 1, 1); PG8_STAGE(PG8_SB(1, 0), b3, voffB);
            PG8_BAR; PG8_WAIT_L(0); PG8_MMA(0, 1, At, B1); PG8_BAR;
            PG8_LDA(At, 1, 1); PG8_STAGE(PG8_SA(1, 0), a3, voffA);
            PG8_BAR; PG8_WAIT_L(0); PG8_MMA(1, 0, At, B0); PG8_BAR; PG8_SCHED;
            PG8_STAGE(PG8_SB(1, 1), b3 + hstep, voffB);
            PG8_WAIT_V(6); PG8_BAR; PG8_MMA(1, 1, At, B1); PG8_BAR;
            }
        }
        if constexpr (ALIGN_EPI) { if (wr == 0) PG8_BAR; }
        if constexpr (!Epi::AFTER_DRAIN) { E(acc, cur, wr, wc, fr, fq); S.done(cur); }
        if (!has_next) break;
#pragma unroll
        for (int a = 0; a < 2; ++a)
#pragma unroll
            for (int b = 0; b < 2; ++b)
#pragma unroll
                for (int m = 0; m < 4; ++m)
#pragma unroll
                    for (int n = 0; n < 2; ++n) acc[a][b][m][n] = (f32x4){0.f, 0.f, 0.f, 0.f};
        cur = nxt; cA = nA; cB = nB; ++ui;
        if constexpr (ALIGN_EPI) { if (wr == 1) PG8_BAR; }
    }
    PG8_WAIT_V(0);
    if constexpr (!ALIGN_EPI) { if (wr == 0) PG8_BAR; }
    PG8_BAR;
#undef PG8_SA
#undef PG8_SB
#undef PG8_STAGE
#undef PG8_LDA
#undef PG8_LDB
#undef PG8_MMA
#undef PG8_WAIT_V
#undef PG8_WAIT_L
#undef PG8_BAR
#undef PG8_SCHED
}
}

template <class F> __device__ __forceinline__ void run_gemm8(PG8_LAS unsigned char* lds, const Ctx& cx, const bf16_t* A, const bf16_t* Bt, int M, int N, int K, const F& f) {
    pg8::Gemm g{A, Bt, M, N, K}; pg8::StaticOrder S; S.init(M, N, cx.nblk, cx.bid);
    pg8::Epi8<F> E{f};
    pg8::gemm_phase<pg8::Epi8<F>, pg8::StaticOrder, true, true>(lds, cx.tid, g, S, E);
}
template <class F> __device__ __forceinline__ void run_gemm4(PG8_LAS unsigned char* lds, const Ctx& cx, const bf16_t* A, const bf16_t* Bt, int M, int N, int K, const F& f) {
    pg8::Gemm g{A, Bt, M, N, K}; pg8::StaticOrder S; S.init(M, N, cx.nblk, cx.bid);
    pg8::Epi4<F> E{f};
    pg8::gemm_phase<pg8::Epi4<F>, pg8::StaticOrder, true, true>(lds, cx.tid, g, S, E);
}
#define LDSARG PG8_LAS unsigned char* lds,
#define LDSPASS lds, cx,
#else
template <class F> void run_gemm8(const Ctx&, const bf16_t* A, const bf16_t* Bt, int M, int N, int K, const F& f) {
#pragma omp parallel for schedule(dynamic, 8)
    for (int r = 0; r < M; ++r) for (int c0 = 0; c0 < N; c0 += 8) { float a[8];
        for (int e = 0; e < 8; ++e) { float s = 0.f; const bf16_t* ar = A + (size_t)r * K; const bf16_t* br = Bt + (size_t)(c0 + e) * K; for (int k = 0; k < K; ++k) s += bf2f(ar[k]) * bf2f(br[k]); a[e] = s; }
        f.st8(r, c0, a); }
}
template <class F> void run_gemm4(const Ctx&, const bf16_t* A, const bf16_t* Bt, int M, int N, int K, const F& f) {
#pragma omp parallel for schedule(dynamic, 8)
    for (int r = 0; r < M; ++r) for (int c0 = 0; c0 < N; c0 += 4) { float a[4];
        for (int e = 0; e < 4; ++e) { float s = 0.f; const bf16_t* ar = A + (size_t)r * K; const bf16_t* br = Bt + (size_t)(c0 + e) * K; for (int k = 0; k < K; ++k) s += bf2f(ar[k]) * bf2f(br[k]); a[e] = s; }
        f.st4(r, c0, a); }
}
#define LDSARG
#define LDSPASS cx,
#endif

constexpr int NPHASE = 2 + 12 * NLAYER;
template <int PH> DEVI void run_phase_t(LDSARG const Ctx& cx, const Params& p) {
    const Views v = make_views(p.ws);
    if constexpr (PH == 0) { phase_prep(cx, p); }
    else if constexpr (PH == NPHASE - 1) { phase_final(cx, p); }
    else {
        constexpr int layer = (PH - 1) / 12, s = (PH - 1) % 12;
        constexpr int mrows = layer == NLAYER - 1 ? ML : MT;
        if constexpr (s == 0) phase_norm(cx, p, layer);
        else if constexpr (s == 1) run_gemm8(LDSPASS v.XN, v.W1 + (size_t)layer * N1 * DM, MT, N1, DM, StG1{v.AQKV, v.BQ, v.BKV, v.CQKV});
        else if constexpr (s == 2) phase_conv(cx, p, layer);
        else if constexpr (s == 3) phase_prep2(cx, p, layer);
        else if constexpr (s == 4) phase_mix(cx, p, layer);
        else if constexpr (s == 5) run_gemm8(LDSPASS v.XN, v.WZ + (size_t)layer * NZ * DM, mrows, NZ, DM, StPlain{v.Z, NZ});
        else if constexpr (s == 6) phase_y(cx, p, layer);
        else if constexpr (s == 7) run_gemm8(LDSPASS v.XN, v.WM + (size_t)layer * NMG * DM, mrows, NMG, DM, StPlain{v.L, NMG});
        else if constexpr (s >= 8 && s <= 10) { constexpr int br = s - 8;
            run_gemm8(LDSPASS v.Y + (size_t)br * MT * 512, v.WB + ((size_t)layer * 3 + br) * DM * 512, mrows, DM, 512, StMerge{v.L, v.MRG, br}); }
        else run_gemm4(LDSPASS v.MRG, v.WO + (size_t)layer * DM * DM, mrows, DM, DM,
                       StResid{layer == 0 ? p.x : p.out, layer == 0 ? p.ctx : v.CTX1, p.out, v.CTX1, v.MOD + (size_t)layer * (NB + 1) * 3072});
    }
}
#define MK_PHASE_LIST(X) X(0) X(1) X(2) X(3) X(4) X(5) X(6) X(7) X(8) X(9) X(10) X(11) X(12) X(13) X(14) X(15) X(16) X(17) X(18) X(19) X(20) X(21) X(22) X(23) X(24) X(25)
static_assert(NPHASE == 26, "phase list");
#ifdef CPU_EMU
inline void run_phase(const Ctx& cx, const Params& p, int ph) {
    switch (ph) {
#define X(k) case k: run_phase_t<k>(cx, p); break;
        MK_PHASE_LIST(X)
#undef X
    }
}
#endif

#ifndef CPU_EMU
constexpr int LDS_BYTES = 147456;
__global__ void __launch_bounds__(512, 2) mk_fwd(Params p) {
    extern __shared__ __attribute__((aligned(16))) unsigned char lds_raw[];
    PG8_LAS unsigned char* lds = (PG8_LAS unsigned char*)lds_raw;
    cg::grid_group grid = cg::this_grid();
    const int ph_lo = p.ph_lo, ph_hi = p.ph_hi;
#define X(k) if (ph_lo <= k && k < ph_hi) { \
        const Params* q = (const Params*)__builtin_amdgcn_kernarg_segment_ptr(); asm volatile("" : "+s"(q) :: "memory"); \
        Ctx cx; cx.tid = (int)threadIdx.x; cx.bid = (int)blockIdx.x; cx.nblk = (int)gridDim.x; \
        asm volatile("" : "+v"(cx.tid)); asm volatile("" : "+s"(cx.bid), "+s"(cx.nblk)); \
        run_phase_t<k>(lds, cx, *q); \
        if (k + 1 < ph_hi) grid.sync(); }
    MK_PHASE_LIST(X)
#undef X
}

#ifndef MK_SINGLE
#define MK_SINGLE 1
#endif
extern "C" void kernel_launch(void* const* d_in, const int* in_sizes, int n_in, void* d_out, int out_size, void* d_ws, size_t ws_size, hipStream_t stream) {
    static int grid = 0;
    if (grid == 0) {
        if (n_in != 18 || in_sizes[0] != ML * DM || out_size != ML * DM || ws_size < WS_END) { fprintf(stderr, "kernel_launch: unexpected shapes (n_in %d, in0 %d, out %d, ws %zu < %zu)\n", n_in, n_in > 0 ? in_sizes[0] : -1, out_size, ws_size, (size_t)WS_END); grid = -1; return; }
        int dev = 0, cus = 0, per_cu = 0;
        if (hipGetDevice(&dev) != hipSuccess || hipDeviceGetAttribute(&cus, hipDeviceAttributeMultiprocessorCount, dev) != hipSuccess) { grid = -1; return; }
        if (hipFuncSetAttribute((const void*)mk_fwd, hipFuncAttributeMaxDynamicSharedMemorySize, LDS_BYTES) != hipSuccess) { fprintf(stderr, "kernel_launch: hipFuncSetAttribute failed\n"); grid = -1; return; }
        if (hipOccupancyMaxActiveBlocksPerMultiprocessor(&per_cu, (const void*)mk_fwd, 512, LDS_BYTES) != hipSuccess || per_cu < 1) { fprintf(stderr, "kernel_launch: occupancy query says %d\n", per_cu); (void)hipGetLastError(); grid = -1; return; }
        grid = cus;
    }
    if (grid < 0) return;
    Params p{};
    const float** pp = (const float**)&p;
    for (int i = 0; i < 18; ++i) pp[i] = (const float*)d_in[i];
    p.out = (float*)d_out; p.ws = (unsigned char*)d_ws;
#if MK_SINGLE
    p.ph_lo = 0; p.ph_hi = NPHASE;
    { void* args[] = {&p}; hipError_t e = hipLaunchCooperativeKernel((const void*)mk_fwd, dim3(grid), dim3(512), args, LDS_BYTES, stream);
      if (e != hipSuccess) fprintf(stderr, "cooperative launch failed: %s\n", hipGetErrorString(e)); }
#else
    for (int ph = 0; ph < NPHASE; ++ph) {
        p.ph_lo = ph; p.ph_hi = ph + 1;
        void* args[] = {&p}; hipError_t e = hipLaunchCooperativeKernel((const void*)mk_fwd, dim3(grid), dim3(512), args, LDS_BYTES, stream);
        if (e != hipSuccess) { fprintf(stderr, "cooperative launch %d failed: %s\n", ph, hipGetErrorString(e)); break; }
    }
#endif
}
#endif
```

```cpp
#ifndef CPU_EMU
#include <hip/hip_runtime.h>
#include <hip/hip_cooperative_groups.h>
#include <cstdio>
#include <cstdint>
namespace cg = cooperative_groups;
#define DEVI __device__ __forceinline__
#define HD __host__ __device__ __forceinline__
#define CFENCE() asm volatile("" ::: "memory")
#else
#define CFENCE() do {} while (0)
#include <cstring>
#include <cmath>
#include <cstdio>
#include <cstdint>
#include <cstddef>
#define DEVI inline
#define HD inline
#endif

#ifndef CPU_EMU
#define LQ __attribute__((address_space(3)))
typedef short bf16x8 __attribute__((ext_vector_type(8)));
typedef float f32x4 __attribute__((ext_vector_type(4)));
typedef short s16x4 __attribute__((ext_vector_type(4)));
typedef long long i64x2 __attribute__((ext_vector_type(2)));
typedef unsigned u32x4 __attribute__((ext_vector_type(4)));
#define MFMA16(a, b, c) __builtin_amdgcn_mfma_f32_16x16x32_bf16(a, b, c, 0, 0, 0)
#define SYNC() __syncthreads()
#define WSYNC() __builtin_amdgcn_wave_barrier()
__device__ __forceinline__ s16x4 trread(LQ const unsigned char* p) { return __builtin_bit_cast(s16x4, __builtin_amdgcn_ds_read_tr16_b64_v4i16((LQ s16x4*)p)); }
__device__ __forceinline__ float shfl_f(float v, int src) { return __shfl(v, src, 64); }
#define RFL(x) __builtin_amdgcn_readfirstlane(x)
#define FEXP(x) __expf(x)
#else
#define LQ
using simt::bf16x8; using simt::f32x4; using simt::s16x4;
typedef long long i64x2 __attribute__((vector_size(16)));
typedef unsigned u32x4 __attribute__((vector_size(16)));
#define MFMA16(a, b, c) simt::mfma16(a, b, c)
#define SYNC() simt::syncthreads()
#define WSYNC() ((void)simt::shfl(0.f, 0))
inline s16x4 trread(const unsigned char* p) { return simt::tr16_b64(p); }
inline float shfl_f(float v, int src) { return simt::shfl(v, src); }
#define RFL(x) (x)
#define FEXP(x) expf(x)
#endif

#ifndef NB
#define NB 8
#endif
#ifndef SEQ
#define SEQ 4096
#endif
#ifndef CTXL
#define CTXL 256
#endif
constexpr int DM = 1024, INW = 8464, GRIDW = 64;
constexpr int ML = NB * SEQ, MC = NB * CTXL, MT = ML + MC;
constexpr int N1 = 3840;
constexpr int NZ = 1536;
constexpr int NMG = 3072;
constexpr float EPSF = 1e-6f;
constexpr int NLAYER = 2;
static_assert(MT % 256 == 0 && ML % 256 == 0, "row tiles");

typedef unsigned short bf16_t;
struct alignas(16) U4 { unsigned x, y, z, w; };
DEVI void st16l(LQ unsigned char* p, const U4& w) { u32x4 t; t[0] = w.x; t[1] = w.y; t[2] = w.z; t[3] = w.w; *(LQ u32x4*)p = t; }
DEVI U4 ld16l(LQ const unsigned char* p) { const u32x4 t = *(LQ const u32x4*)p; U4 w; w.x = t[0]; w.y = t[1]; w.z = t[2]; w.w = t[3]; return w; }

constexpr size_t MiB = 1u << 20;
constexpr size_t al1(size_t x) { return (x + MiB - 1) & ~(MiB - 1); }
constexpr size_t WS_CTL = 0;
constexpr size_t WS_MOD = 256 * 1024;
constexpr size_t WS_W1 = 1 * MiB;
constexpr size_t WS_WZ = WS_W1 + al1((size_t)2 * N1 * DM * 2);
constexpr size_t WS_WM = WS_WZ + al1((size_t)2 * NZ * DM * 2);
constexpr size_t WS_WB = WS_WM + al1((size_t)2 * NMG * DM * 2);
constexpr size_t WS_WO = WS_WB + al1((size_t)2 * 3 * DM * 512 * 2);
constexpr size_t WS_G = WS_WO + al1((size_t)2 * DM * DM * 2);
constexpr size_t WS_BETA = WS_G + al1((size_t)MT * 8 * 4);
constexpr size_t WS_CTX1 = WS_BETA + al1((size_t)MT * 8 * 4);
constexpr size_t WS_XN = WS_CTX1 + al1((size_t)MC * DM * 4);
constexpr size_t WS_AQKV = WS_XN + al1((size_t)MT * DM * 2);
constexpr size_t WS_CQKV = WS_AQKV + al1((size_t)MT * 1536 * 2);
constexpr size_t WS_BQ = WS_CQKV + al1((size_t)MT * 1536 * 2);
constexpr size_t WS_BKV = WS_BQ + al1((size_t)MT * 512 * 2);
constexpr size_t WS_PA = WS_BKV + al1((size_t)MT * 256 * 2);
constexpr size_t WS_PC = WS_PA + al1((size_t)MT * 512 * 2);
constexpr size_t WS_T = WS_PC + al1((size_t)MT * 512 * 2);
constexpr size_t WS_END = WS_T + al1((size_t)(MT / 64) * 8 * 8192);
static_assert(WS_CQKV + (size_t)MT * NMG * 2 <= WS_END, "L overlay");
static_assert(WS_END <= (size_t)512 * MiB, "workspace");

struct Params {
    const float *x, *c, *ctx, *c_ctx, *w_ada, *b_ada, *norm_w, *w_in, *a_conv_w, *a_log, *a_dt_bias, *a_norm_w, *b_sink, *c_decay, *c_norm_w, *w_branch, *w_out, *final_norm_w;
    float* out; unsigned char* ws;
    int ph_lo, ph_hi;
};

#ifdef CPU_EMU
inline float u2f(unsigned u) { float f; memcpy(&f, &u, 4); return f; }
inline unsigned f2u(float f) { unsigned u; memcpy(&u, &f, 4); return u; }
#else
DEVI float u2f(unsigned u) { return __uint_as_float(u); }
DEVI unsigned f2u(float f) { return __float_as_uint(f); }
#endif
DEVI float bf2f(bf16_t h) { return u2f((unsigned)h << 16); }
DEVI bf16_t f2bf(float f) { unsigned u = f2u(f); return (bf16_t)((u + 0x7fffu + ((u >> 16) & 1u)) >> 16); }
DEVI unsigned pk2(float lo, float hi) { return (unsigned)f2bf(lo) | ((unsigned)f2bf(hi) << 16); }
DEVI float lo16(unsigned w) { return u2f(w << 16); }
DEVI float hi16(unsigned w) { return u2f(w & 0xffff0000u); }
DEVI float sigmoidf_(float x) { return 1.0f / (1.0f + expf(-x)); }
DEVI float siluf_(float x) { return x / (1.0f + expf(-x)); }
DEVI float softplusf_(float x) { return x > 20.f ? x : log1pf(expf(x)); }
DEVI void unpack8(const U4& w, float* v) { v[0] = lo16(w.x); v[1] = hi16(w.x); v[2] = lo16(w.y); v[3] = hi16(w.y); v[4] = lo16(w.z); v[5] = hi16(w.z); v[6] = lo16(w.w); v[7] = hi16(w.w); }
DEVI U4 pack8(const float* v) { U4 w; w.x = pk2(v[0], v[1]); w.y = pk2(v[2], v[3]); w.z = pk2(v[4], v[5]); w.w = pk2(v[6], v[7]); return w; }

struct Ctx { int tid, bid, nblk; };
struct TI { long id, n; };
DEVI TI thread_info(const Ctx& c) {
    const int wave = c.tid >> 6, lane = c.tid & 63;
    return TI{((long)wave * c.nblk + c.bid) * 64 + lane, (long)c.nblk * 512};
}

struct Views {
    float* MOD; bf16_t *W1, *WZ, *WM, *WB, *WO; float *G, *BETA, *CTX1; bf16_t *XN, *AQKV, *CQKV, *BQ, *BKV, *PA, *PC, *Y, *Z, *L, *MRG, *T;
};
DEVI Views make_views(unsigned char* ws) {
    Views v;
    v.MOD = (float*)(ws + WS_MOD); v.W1 = (bf16_t*)(ws + WS_W1); v.WZ = (bf16_t*)(ws + WS_WZ); v.WM = (bf16_t*)(ws + WS_WM); v.WB = (bf16_t*)(ws + WS_WB); v.WO = (bf16_t*)(ws + WS_WO);
    v.G = (float*)(ws + WS_G); v.BETA = (float*)(ws + WS_BETA); v.CTX1 = (float*)(ws + WS_CTX1);
    v.XN = (bf16_t*)(ws + WS_XN); v.AQKV = (bf16_t*)(ws + WS_AQKV); v.CQKV = (bf16_t*)(ws + WS_CQKV); v.BQ = (bf16_t*)(ws + WS_BQ); v.BKV = (bf16_t*)(ws + WS_BKV);
    v.PA = (bf16_t*)(ws + WS_PA); v.PC = (bf16_t*)(ws + WS_PC); v.Y = v.AQKV; v.Z = v.CQKV; v.L = v.CQKV; v.MRG = v.XN; v.T = (bf16_t*)(ws + WS_T);
    return v;
}

HD int map_g1(int n) { return n < 1536 ? n : (n < 2048 ? 2064 + (n - 1536) : (n < 2304 ? 2576 + (n - 2048) : 3344 + (n - 2304))); }
HD int map_z(int n) { return n < 512 ? 1536 + n : (n < 1024 ? 2832 + (n - 512) : 4880 + (n - 1024)); }

DEVI void phase_prep(const Ctx& cx, const Params& p) {
    const Views v = make_views(p.ws); const TI ti = thread_info(cx);
    const long n1 = (long)2 * N1 * DM, nz = (long)2 * NZ * DM, nm = (long)2 * NMG * DM, nb = (long)2 * 3 * DM * 512, no = (long)2 * DM * DM;
    const long tot = n1 + nz + nm + nb + no;
    for (long i = ti.id; i < tot; i += ti.n) {
        long r = i;
        if (r < n1) { const int l = (int)(r / ((long)N1 * DM)), rem = (int)(r % ((long)N1 * DM)), n = rem / DM, k = rem % DM; v.W1[r] = f2bf(p.w_in[((size_t)l * DM + k) * INW + map_g1(n)]); continue; } r -= n1;
        if (r < nz) { const int l = (int)(r / ((long)NZ * DM)), rem = (int)(r % ((long)NZ * DM)), n = rem / DM, k = rem % DM; v.WZ[r] = f2bf(p.w_in[((size_t)l * DM + k) * INW + map_z(n)]); continue; } r -= nz;
        if (r < nm) { const int l = (int)(r / ((long)NMG * DM)), rem = (int)(r % ((long)NMG * DM)), n = rem / DM, k = rem % DM; v.WM[r] = f2bf(p.w_in[((size_t)l * DM + k) * INW + 5392 + n]); continue; } r -= nm;
        if (r < nb) { const int lb = (int)(r / ((long)DM * 512)), rem = (int)(r % ((long)DM * 512)), n = rem / 512, k = rem % 512; v.WB[r] = f2bf(p.w_branch[((size_t)lb * 512 + k) * DM + n]); continue; } r -= nb;
        { const int l = (int)(r / ((long)DM * DM)), rem = (int)(r % ((long)DM * DM)), n = rem / DM, k = rem % DM; v.WO[r] = f2bf(p.w_out[((size_t)l * DM + k) * DM + n]); }
    }
    const long nmod = (long)NLAYER * (NB + 1) * 3072;
    for (long i = ti.id; i < nmod; i += ti.n) {
        const int l = (int)(i / ((NB + 1) * 3072)), rem = (int)(i % ((NB + 1) * 3072)), b = rem / 3072, n = rem % 3072;
        const float* cv = b < NB ? p.c + (size_t)b * DM : p.c_ctx;
        const float* w = p.w_ada + (size_t)l * DM * 3072 + n;
        float acc = 0.f;
        for (int k = 0; k < DM; ++k) acc += siluf_(cv[k]) * w[(size_t)k * 3072];
        v.MOD[i] = acc + p.b_ada[l * 3072 + n];
    }
}

DEVI const float* xrow_in(const Params& p, const Views& v, int layer, int m) {
    if (layer == 0) return m < ML ? p.x + (size_t)m * DM : p.ctx + (size_t)(m - ML) * DM;
    return m < ML ? p.out + (size_t)m * DM : v.CTX1 + (size_t)(m - ML) * DM;
}
DEVI void phase_norm(const Ctx& cx, const Params& p, int layer) {
    const Views v = make_views(p.ws); const TI ti = thread_info(cx);
    for (long m = ti.id; m < MT; m += ti.n) {
        const float* xr = xrow_in(p, v, layer, (int)m);
        const int b = m < ML ? (int)(m / SEQ) : NB;
        const float* mod = v.MOD + ((size_t)layer * (NB + 1) + b) * 3072;
        const float* nw = p.norm_w + layer * DM;
        float ss = 0.f;
        for (int k = 0; k < DM; ++k) ss += xr[k] * xr[k];
        const float r = 1.0f / sqrtf(ss * (1.0f / DM) + EPSF);
        float a[16];
#pragma unroll
        for (int j = 0; j < 16; ++j) a[j] = 0.f;
        const float* wab = p.w_in + (size_t)layer * DM * INW + 2048;
        for (int k = 0; k < DM; ++k) {
            const float hv = xr[k] * r * nw[k] * (1.0f + mod[1024 + k]) + mod[k];
            v.XN[(size_t)m * DM + k] = f2bf(hv);
            const float* wr_ = wab + (size_t)k * INW;
#pragma unroll
            for (int j = 0; j < 16; ++j) a[j] += hv * wr_[j];
        }
#pragma unroll
        for (int h = 0; h < 8; ++h) {
            v.BETA[(size_t)m * 8 + h] = sigmoidf_(a[h]);
            v.G[(size_t)m * 8 + h] = -expf(p.a_log[layer * 8 + h]) * softplusf_(a[8 + h] + p.a_dt_bias[layer * 8 + h]);
        }
    }
}

DEVI void phase_conv(const Ctx& cx, const Params& p, int layer) {
    const Views v = make_views(p.ws); const TI ti = thread_info(cx);
    const float* cw = p.a_conv_w + (size_t)layer * 5 * 1536;
    for (long it = ti.id; it < (long)2 * NB * 1536; it += ti.n) {
        const int s = (int)(it / 1536), c = (int)(it % 1536);
        const int len = s < NB ? SEQ : CTXL; const size_t m0 = s < NB ? (size_t)s * SEQ : (size_t)ML + (size_t)(s - NB) * CTXL;
        bf16_t* col = v.AQKV + m0 * 1536 + c;
        const float w0 = cw[c], w1 = cw[1536 + c], w2 = cw[2 * 1536 + c], w3 = cw[3 * 1536 + c], w4 = cw[4 * 1536 + c];
        float xm2 = 0.f, xm1 = 0.f, x0 = bf2f(col[0]), x1 = bf2f(col[1536]);
        for (int t = 0; t < len; ++t) {
            const float x2 = (t + 2 < len) ? bf2f(col[(size_t)(t + 2) * 1536]) : 0.f;
            const float y = w0 * xm2 + w1 * xm1 + w2 * x0 + w3 * x1 + w4 * x2;
            col[(size_t)t * 1536] = f2bf(siluf_(y));
            xm2 = xm1; xm1 = x0; x0 = x1; x1 = x2;
        }
    }
}

DEVI void phase_prep2(const Ctx& cx, const Params& p, int layer) {
    const Views v = make_views(p.ws); const TI ti = thread_info(cx);
    for (long it = ti.id; it < (long)MT * 8; it += ti.n) {
        const long m = it >> 3; const int wh = (int)(it & 7), which = wh >> 2, h = wh & 3;
        bf16_t* ptr = v.AQKV + (size_t)m * 1536 + which * 512 + h * 128;
        float ss = 0.f;
        for (int d = 0; d < 128; ++d) { const float f = bf2f(ptr[d]); ss += f * f; }
        const float sc = (1.0f / sqrtf(ss + EPSF)) * (which == 0 ? 0.08838834764831845f : 1.0f);
        for (int d = 0; d < 128; ++d) ptr[d] = f2bf(bf2f(ptr[d]) * sc);
    }
    for (long it = ti.id; it < (long)ML * 10; it += ti.n) {
        const long m = it / 10; const int hh = (int)(it % 10);
        const int t = (int)(m % SEQ); const float rowp = (float)(t / GRIDW), colp = (float)(t % GRIDW);
        bf16_t* ptr = hh < 8 ? v.BQ + (size_t)m * 512 + hh * 64 : v.BKV + (size_t)m * 256 + (hh - 8) * 64;
        for (int half = 0; half < 2; ++half) {
            const float pos = half == 0 ? rowp : colp;
            for (int i = 0; i < 16; ++i) {
                const float inv = powf(10000.0f, -(float)i / 16.0f);
                const float ang = pos * inv; const float cs = cosf(ang), sn = sinf(ang);
                const float x1 = bf2f(ptr[half * 32 + i]), x2 = bf2f(ptr[half * 32 + 16 + i]);
                ptr[half * 32 + i] = f2bf(x1 * cs - x2 * sn); ptr[half * 32 + 16 + i] = f2bf(x1 * sn + x2 * cs);
            }
        }
    }
    for (long it = ti.id; it < (long)MT * 8; it += ti.n) {
        const long m = it >> 3; const int wh = (int)(it & 7), which = wh >> 2, h = wh & 3;
        bf16_t* ptr = v.CQKV + (size_t)m * 1536 + which * 512 + h * 128;
        const float sc = which == 1 ? 0.08838834764831845f : 1.0f;
        if (m < ML) {
            const float pos = (float)(m % SEQ);
            for (int i = 0; i < 64; ++i) {
                const float inv = powf(10000.0f, -(float)i / 64.0f);
                const float ang = pos * inv; const float cs = cosf(ang), sn = sinf(ang);
                const float x1 = bf2f(ptr[i]) * sc, x2 = bf2f(ptr[64 + i]) * sc;
                ptr[i] = f2bf(x1 * cs - x2 * sn); ptr[64 + i] = f2bf(x1 * sn + x2 * cs);
            }
        } else if (which == 1) {
            for (int d = 0; d < 128; ++d) ptr[d] = f2bf(bf2f(ptr[d]) * sc);
        }
    }
}

template <int MIX> DEVI void scan_item(const Params& p, const Views& v, int layer, int item) {
    const int j = item & 127, h = (item >> 7) & 3, b = item >> 9;
    const bf16_t* QKV = MIX == 0 ? v.AQKV : v.CQKV; bf16_t* PARK = MIX == 0 ? v.PA : v.PC;
    float S[128];
    for (int dir = 0; dir < 2; ++dir) {
#pragma unroll
        for (int d = 0; d < 128; ++d) S[d] = 0.f;
        const float gam = MIX == 1 ? sigmoidf_(p.c_decay[layer * 8 + dir * 4 + h]) : 0.f;
        for (int seg = 0; seg < 2; ++seg) {
            const int len = seg == 0 ? CTXL : SEQ; const size_t m0 = seg == 0 ? (size_t)ML + (size_t)b * CTXL : (size_t)b * SEQ;
            for (int i = 0; i < len; ++i) {
                const int t = dir == 0 ? i : len - 1 - i; const size_t m = m0 + t;
                const bf16_t* row = QKV + m * 1536 + h * 128;
                const float vj = bf2f(row[1024 + j]);
                float o = 0.f;
                if (MIX == 0) {
                    const float a = expf(v.G[m * 8 + dir * 4 + h]), be = v.BETA[m * 8 + dir * 4 + h];
                    float dot = 0.f;
#pragma unroll
                    for (int c8 = 0; c8 < 16; ++c8) { float kk[8]; unpack8(*(const U4*)(row + 512 + c8 * 8), kk);
#pragma unroll
                        for (int e = 0; e < 8; ++e) dot += S[c8 * 8 + e] * kk[e];
                        if ((c8 & 3) == 3) CFENCE(); }
                    const float vn = be * (vj - a * dot);
#pragma unroll
                    for (int c8 = 0; c8 < 16; ++c8) { float kk[8], qq[8]; unpack8(*(const U4*)(row + 512 + c8 * 8), kk); unpack8(*(const U4*)(row + c8 * 8), qq);
#pragma unroll
                        for (int e = 0; e < 8; ++e) { const float s = a * S[c8 * 8 + e] + kk[e] * vn; S[c8 * 8 + e] = s; o += s * qq[e]; }
                        if ((c8 & 3) == 3) CFENCE(); }
                } else {
#pragma unroll
                    for (int c8 = 0; c8 < 16; ++c8) { float kk[8], qq[8]; unpack8(*(const U4*)(row + 512 + c8 * 8), kk); unpack8(*(const U4*)(row + c8 * 8), qq);
#pragma unroll
                        for (int e = 0; e < 8; ++e) { const float s = gam * S[c8 * 8 + e] + kk[e] * vj; S[c8 * 8 + e] = s; o += s * qq[e]; }
                        if ((c8 & 3) == 3) CFENCE(); }
                }
                bf16_t* pp = PARK + m * 512 + h * 128 + j;
                *pp = f2bf(dir == 0 ? o : bf2f(*pp) + o);
            }
        }
    }
}

DEVI void attn_item(const Params& p, const Views& v, int layer, long m, int hq) {
    const int hk = hq >> 2;
    bf16_t* qp = v.BQ + (size_t)m * 512 + hq * 64;
    float q[64], acc[64];
#pragma unroll
    for (int c8 = 0; c8 < 8; ++c8) unpack8(*(const U4*)(qp + c8 * 8), q + c8 * 8);
#pragma unroll
    for (int d = 0; d < 64; ++d) acc[d] = 0.f;
    float mrun = p.b_sink[layer * 8 + hq], lrun = 1.0f;
    const int b = m < ML ? (int)(m / SEQ) : (int)((m - ML) / CTXL);
    const int t = m < ML ? (int)(m % SEQ) : 0;
    const int lo = t - 128 < 0 ? 0 : t - 128, hi = t + 128 > SEQ - 1 ? SEQ - 1 : t + 128;
    const int nwin = m < ML ? hi - lo + 1 : 0;
    for (int i = 0; i < CTXL + nwin; ++i) {
        const size_t kr = i < CTXL ? (size_t)ML + (size_t)b * CTXL + i : (size_t)b * SEQ + lo + (i - CTXL);
        const bf16_t* kp = v.BKV + kr * 256 + hk * 64;
        float s = 0.f;
#pragma unroll
        for (int c8 = 0; c8 < 8; ++c8) { float kk[8]; unpack8(*(const U4*)(kp + c8 * 8), kk);
#pragma unroll
            for (int e = 0; e < 8; ++e) s += q[c8 * 8 + e] * kk[e]; }
        CFENCE();
        s *= 0.125f;
        float pw;
        if (s > mrun) { const float f = expf(mrun - s); lrun *= f;
#pragma unroll
            for (int d = 0; d < 64; ++d) acc[d] *= f;
            mrun = s; pw = 1.0f; }
        else pw = expf(s - mrun);
        lrun += pw;
#pragma unroll
        for (int c8 = 0; c8 < 8; ++c8) { float vv[8]; unpack8(*(const U4*)(kp + 128 + c8 * 8), vv);
#pragma unroll
            for (int e = 0; e < 8; ++e) acc[c8 * 8 + e] += pw * vv[e]; }
        CFENCE();
    }
    const float il = 1.0f / lrun;
#pragma unroll
    for (int c8 = 0; c8 < 8; ++c8) { float o8[8];
#pragma unroll
        for (int e = 0; e < 8; ++e) o8[e] = acc[c8 * 8 + e] * il;
        *(U4*)(qp + c8 * 8) = pack8(o8); }
}
DEVI void phase_mix(const Ctx& cx, const Params& p, int layer) {
    const Views v = make_views(p.ws); const TI ti = thread_info(cx);
#ifdef USE_V1_SCAN
    const long nscan = (long)NB * 4 * 128;
    for (long it = ti.id; it < 2 * nscan; it += ti.n) { if (it < nscan) scan_item<0>(p, v, layer, (int)it); else scan_item<1>(p, v, layer, (int)(it - nscan)); }
#endif
    const long mrows = layer == 0 ? MT : ML;
    for (long it = ti.n - 1 - ti.id; it < mrows * 8; it += ti.n) attn_item(p, v, layer, it >> 3, (int)(it & 7));
}

DEVI void phase_y(const Ctx& cx, const Params& p, int layer) {
    const Views v = make_views(p.ws); const TI ti = thread_info(cx);
    const long mrows = layer == 0 ? MT : ML;
    for (long it = ti.id; it < mrows * 12; it += ti.n) {
        const long m = it / 12; const int r = (int)(it % 12), mix = r >> 2, h = r & 3;
        const bf16_t* zp = v.Z + (size_t)m * 1536 + mix * 512 + h * 128;
        bf16_t* yp = v.Y + ((size_t)mix * MT + m) * 512 + h * 128;
        if (mix == 0) {
            const bf16_t* op = v.PA + (size_t)m * 512 + h * 128; float ss = 0.f;
            for (int d = 0; d < 128; ++d) { const float f = bf2f(op[d]); ss += f * f; }
            const float rs = 1.0f / sqrtf(ss * (1.0f / 128.0f) + EPSF);
            for (int d = 0; d < 128; ++d) yp[d] = f2bf(bf2f(op[d]) * rs * p.a_norm_w[layer * 128 + d] * siluf_(bf2f(zp[d])));
        } else if (mix == 1) {
            const bf16_t* op = v.BQ + (size_t)m * 512 + h * 128;
            for (int d = 0; d < 128; ++d) yp[d] = f2bf(bf2f(op[d]) * siluf_(bf2f(zp[d])));
        } else {
            const bf16_t* op = v.PC + (size_t)m * 512 + h * 128; float s = 0.f;
            for (int d = 0; d < 128; ++d) s += bf2f(op[d]);
            const float mu = s * (1.0f / 128.0f); float q = 0.f;
            for (int d = 0; d < 128; ++d) { const float f = bf2f(op[d]) - mu; q += f * f; }
            const float rs = 1.0f / sqrtf(q * (1.0f / 128.0f) + EPSF);
            for (int d = 0; d < 128; ++d) yp[d] = f2bf((bf2f(op[d]) - mu) * rs * p.c_norm_w[layer * 512 + h * 128 + d] * siluf_(bf2f(zp[d])));
        }
    }
}

DEVI void phase_final(const Ctx& cx, const Params& p) {
    const TI ti = thread_info(cx);
    for (long m = ti.id; m < ML; m += ti.n) {
        float* xr = p.out + (size_t)m * DM; float ss = 0.f;
        for (int k = 0; k < DM; ++k) ss += xr[k] * xr[k];
        const float r = 1.0f / sqrtf(ss * (1.0f / DM) + EPSF);
        for (int k = 0; k < DM; ++k) xr[k] = xr[k] * r * p.final_norm_w[k];
    }
}


DEVI bf16x8 ld8g(const bf16_t* p) { bf16x8 v; __builtin_memcpy(&v, p, 16); return v; }
DEVI bf16x8 ld8l(LQ const unsigned char* p) { return *(LQ const bf16x8*)p; }
DEVI bf16x8 ld44l(LQ const unsigned char* p) { i64x2 t; t[0] = *(LQ const long long*)p; t[1] = *(LQ const long long*)(p + 32); return __builtin_bit_cast(bf16x8, t); }
DEVI f32x4 ld4fl(LQ const unsigned char* p) { return *(LQ const f32x4*)p; }
DEVI bf16x8 packb(const f32x4& x0, const f32x4& x1) { bf16x8 r; r[0] = (short)f2bf(x0[0]); r[1] = (short)f2bf(x0[1]); r[2] = (short)f2bf(x0[2]); r[3] = (short)f2bf(x0[3]); r[4] = (short)f2bf(x1[0]); r[5] = (short)f2bf(x1[1]); r[6] = (short)f2bf(x1[2]); r[7] = (short)f2bf(x1[3]); return r; }
DEVI float wave_incl_scan(float v, int lane) {
#pragma unroll
    for (int d = 1; d < 64; d <<= 1) { const float t = shfl_f(v, lane - d < 0 ? 0 : lane - d); if (lane >= d) v += t; }
    return v;
}
constexpr int NCH_C = CTXL / 64, NCH_L = SEQ / 64, NSTEP = NCH_C + NCH_L;
DEVI int chain_row0(int b, int dir, int n) {
    if (n < NCH_C) { const int c = dir ? NCH_C - 1 - n : n; return ML + b * CTXL + 64 * c; }
    int c = n - NCH_C; if (dir) c = NCH_L - 1 - c; return b * SEQ + 64 * c;
}

constexpr int TM_WAVE_BYTES = 16384 + 512;
DEVI void phase_tmat(const Ctx& cx, const Params& p, LQ unsigned char* lds, int layer) {
    const Views v = make_views(p.ws);
    const int wave = RFL(cx.tid >> 6), lane = cx.tid & 63, q = lane >> 4, c = lane & 15;
    LQ unsigned char* wl = lds + wave * TM_WAVE_BYTES;
    LQ float* Am = (LQ float*)wl; LQ float* tab = (LQ float*)(wl + 16384);
    const int nitem = (MT / 64) * 8;
    for (int item = wave * cx.nblk + cx.bid; item < nitem; item += 8 * cx.nblk) {
        const int gchunk = item >> 3, h = (item >> 1) & 3, dir = item & 1; const size_t m0 = (size_t)gchunk * 64;
        { const size_t m = m0 + (dir ? 63 - lane : lane); const float g = v.G[m * 8 + dir * 4 + h], be = v.BETA[m * 8 + dir * 4 + h];
          tab[lane] = wave_incl_scan(g, lane); tab[64 + lane] = be; }
        bf16x8 fr[4][4];
#pragma unroll
        for (int t = 0; t < 4; ++t) { const int row = 16 * t + c; const size_t m = m0 + (dir ? 63 - row : row);
#pragma unroll
            for (int s2 = 0; s2 < 4; ++s2) fr[t][s2] = ld8g(v.AQKV + m * 1536 + 512 + h * 128 + 32 * s2 + 8 * q); }
        WSYNC();
#pragma unroll
        for (int it = 0; it < 4; ++it)
#pragma unroll
            for (int jt = 0; jt <= it; ++jt) {
                f32x4 acc = {0.f, 0.f, 0.f, 0.f};
#pragma unroll
                for (int s2 = 0; s2 < 4; ++s2) acc = MFMA16(fr[it][s2], fr[jt][s2], acc);
                const int col = 16 * jt + c; const float gcol = tab[col];
#pragma unroll
                for (int r = 0; r < 4; ++r) { const int row = 16 * it + 4 * q + r;
                    Am[row * 64 + col] = row > col ? tab[64 + row] * acc[r] * FEXP(tab[row] - gcol) : 0.f; }
            }
        WSYNC();
        float x[64];
#pragma unroll
        for (int i = 0; i < 64; ++i) {
            float sacc = (i == lane) ? 1.f : 0.f;
#pragma unroll
            for (int j4 = 0; j4 < (i + 3) / 4; ++j4) { const f32x4 a4 = ld4fl((LQ const unsigned char*)(Am + i * 64 + j4 * 4));
#pragma unroll
                for (int e = 0; e < 4; ++e) if (4 * j4 + e < i) sacc -= a4[e] * x[4 * j4 + e]; }
            x[i] = sacc;
        }
        WSYNC();
        LQ bf16_t* Ti = (LQ bf16_t*)wl;
#pragma unroll
        for (int i = 0; i < 64; ++i) Ti[i * 64 + lane] = f2bf(x[i]);
        WSYNC();
        bf16_t* Tg = v.T + (size_t)item * 4096;
#pragma unroll
        for (int j = 0; j < 8; ++j) { const int piece = lane + 64 * j; *(U4*)(Tg + piece * 8) = ld16l(wl + piece * 16); }
        WSYNC();
    }
}

constexpr int SC_KB = 0, SC_QB = 17408, SC_TB = 34816, SC_PB = 44032, SC_VB = 53248, SC_SC = 70656, SC_BUF = 71680;
template <int MIX, int DIR> DEVI void scan_chain(const Ctx& cx, const Params& p, const Views& v, LQ unsigned char* lds, int layer, int b, int h, int half) {
    const int tid = cx.tid, wave = RFL(tid >> 6), lane = tid & 63, q = lane >> 4, c = lane & 15;
    const bool helper = wave >= 4; const int ht = tid - 256;
    const bf16_t* QKV = MIX == 0 ? v.AQKV : v.CQKV; bf16_t* PARK = MIX == 0 ? v.PA : v.PC;
    const float lgam = MIX == 1 ? -softplusf_(-p.c_decay[layer * 8 + DIR * 4 + h]) : 0.f;
    U4 kreg[4], qreg[4], treg[2], vreg[2]; float breg = 1.f, greg = 0.f, bsc = 1.f;
    auto hload = [&](int n) {
        const size_t m0 = (size_t)chain_row0(b, DIR, n);
#pragma unroll
        for (int j = 0; j < 4; ++j) { const int piece = ht + 256 * j, row = piece >> 4, c16 = piece & 15; const size_t m = m0 + (DIR ? 63 - row : row);
            kreg[j] = *(const U4*)(QKV + m * 1536 + 512 + h * 128 + c16 * 8); qreg[j] = *(const U4*)(QKV + m * 1536 + h * 128 + c16 * 8); }
        if (MIX == 0) { const bf16_t* Tg = v.T + ((size_t)(m0 / 64) * 8 + h * 2 + DIR) * 4096;
#pragma unroll
            for (int j = 0; j < 2; ++j) treg[j] = *(const U4*)(Tg + (ht + 256 * j) * 8); }
        { const int row = ht & 63, cg = ht >> 6; const size_t m = m0 + (DIR ? 63 - row : row);
          const bf16_t* vp = QKV + m * 1536 + 1024 + h * 128 + 64 * half + 16 * cg; vreg[0] = *(const U4*)vp; vreg[1] = *(const U4*)(vp + 8);
          if (MIX == 0) bsc = v.BETA[m * 8 + DIR * 4 + h]; }
        if (MIX == 0 && wave == 4) { const size_t m = m0 + (DIR ? 63 - ht : ht); greg = v.G[m * 8 + DIR * 4 + h]; breg = v.BETA[m * 8 + DIR * 4 + h]; }
    };
    auto hwrite = [&](int bufi) {
        LQ unsigned char* B = lds + bufi * SC_BUF;
#pragma unroll
        for (int j = 0; j < 4; ++j) { const int piece = ht + 256 * j, row = piece >> 4, c16 = piece & 15;
            st16l(B + SC_KB + row * 272 + c16 * 16, kreg[j]); st16l(B + SC_QB + row * 272 + c16 * 16, qreg[j]); }
        if (MIX == 0) {
#pragma unroll
            for (int j = 0; j < 2; ++j) { const int piece = ht + 256 * j, row = piece >> 3, c8 = piece & 7; st16l(B + SC_TB + row * 144 + c8 * 16, treg[j]); } }
        { const int row = ht & 63, cg = ht >> 6; float f[16]; unpack8(vreg[0], f); unpack8(vreg[1], f + 8);
#pragma unroll
          for (int e = 0; e < 16; ++e) *(LQ float*)(B + SC_VB + (16 * cg + e) * 272 + row * 4) = f[e] * bsc; }
        if (wave == 4) { LQ float* sc = (LQ float*)(B + SC_SC);
            float Gc, g63;
            if (MIX == 0) { Gc = wave_incl_scan(greg, ht); g63 = shfl_f(Gc, 63); } else { Gc = (float)(ht + 1) * lgam; g63 = 64.f * lgam; }
            const float Gam = FEXP(Gc);
            sc[ht] = -breg * Gam; sc[64 + ht] = Gam; sc[128 + ht] = FEXP(g63 - Gc); sc[192 + ht] = Gc; }
    };
    auto hscore = [&](int bufi) {
        LQ unsigned char* B = lds + bufi * SC_BUF; LQ const float* sc = (LQ const float*)(B + SC_SC);
        const int it = wave - 4;
        bf16x8 qf[4];
#pragma unroll
        for (int s2 = 0; s2 < 4; ++s2) qf[s2] = ld8l(B + SC_QB + (16 * it + c) * 272 + (32 * s2 + 8 * q) * 2);
#pragma unroll
        for (int jt = 0; jt < 4; ++jt) {
            if (jt <= it) {
                f32x4 acc = {0.f, 0.f, 0.f, 0.f};
#pragma unroll
                for (int s2 = 0; s2 < 4; ++s2) acc = MFMA16(qf[s2], ld8l(B + SC_KB + (16 * jt + c) * 272 + (32 * s2 + 8 * q) * 2), acc);
                const int col = 16 * jt + c; const float gcol = sc[192 + col];
#pragma unroll
                for (int r = 0; r < 4; ++r) { const int row = 16 * it + 4 * q + r;
                    *(LQ bf16_t*)(B + SC_PB + row * 144 + col * 2) = f2bf(row >= col ? acc[r] * FEXP(sc[192 + row] - gcol) : 0.f); }
            } else if (jt == it + 1 && (it & 1) == 0) {
#pragma unroll
                for (int r = 0; r < 4; ++r) *(LQ bf16_t*)(B + SC_PB + (16 * it + 4 * q + r) * 144 + (16 * jt + c) * 2) = 0;
            }
        }
    };
    if (helper) {
        hload(0); hwrite(0); if (NSTEP > 1) hload(1);
        SYNC();
        for (int n = 0; n < NSTEP; ++n) {
            hscore(n & 1);
            SYNC();
            if (n + 1 < NSTEP) hwrite((n + 1) & 1);
            if (n + 2 < NSTEP) hload(n + 2);
            SYNC();
        }
    } else {
        f32x4 St[8];
#pragma unroll
        for (int t = 0; t < 8; ++t) St[t] = (f32x4){0.f, 0.f, 0.f, 0.f};
        SYNC();
        for (int n = 0; n < NSTEP; ++n) {
            LQ unsigned char* B = lds + (n & 1) * SC_BUF; LQ const float* sc = (LQ const float*)(B + SC_SC);
            f32x4 o[4], vn[4];
            {
                bf16x8 Sb[4];
#pragma unroll
                for (int s2 = 0; s2 < 4; ++s2) Sb[s2] = packb(St[2 * s2], St[2 * s2 + 1]);
                f32x4 R[4];
#pragma unroll
                for (int i = 0; i < 4; ++i) {
                    f32x4 aK = {0.f, 0.f, 0.f, 0.f}, aQ = {0.f, 0.f, 0.f, 0.f};
#pragma unroll
                    for (int s2 = 0; s2 < 4; ++s2) { const int off = (16 * i + c) * 272 + (32 * s2 + 4 * q) * 2;
                        aQ = MFMA16(ld44l(B + SC_QB + off), Sb[s2], aQ);
                        if (MIX == 0) aK = MFMA16(ld44l(B + SC_KB + off), Sb[s2], aK); }
                    const f32x4 Gm = ld4fl(B + SC_SC + (64 + 16 * i + 4 * q) * 4);
                    o[i] = Gm * aQ;
                    const f32x4 Vt = ld4fl(B + SC_VB + (16 * wave + c) * 272 + (16 * i + 4 * q) * 4);
                    if (MIX == 0) { const f32x4 a4 = ld4fl(B + SC_SC + (16 * i + 4 * q) * 4); R[i] = Vt + a4 * aK; } else vn[i] = Vt;
                }
                if (MIX == 0) {
                    bf16x8 Rb[2]; Rb[0] = packb(R[0], R[1]); Rb[1] = packb(R[2], R[3]);
#pragma unroll
                    for (int i = 0; i < 4; ++i) { f32x4 acc = {0.f, 0.f, 0.f, 0.f};
#pragma unroll
                        for (int s2 = 0; s2 <= (i >> 1); ++s2) acc = MFMA16(ld44l(B + SC_TB + (16 * i + c) * 144 + (32 * s2 + 4 * q) * 2), Rb[s2], acc);
                        vn[i] = acc; }
                }
            }
            SYNC();
            {
                bf16x8 vnb[2], veb[2];
                vnb[0] = packb(vn[0], vn[1]); vnb[1] = packb(vn[2], vn[3]);
                { f32x4 ve[4];
#pragma unroll
                  for (int i = 0; i < 4; ++i) ve[i] = ld4fl(B + SC_SC + (128 + 16 * i + 4 * q) * 4) * vn[i];
                  veb[0] = packb(ve[0], ve[1]); veb[1] = packb(ve[2], ve[3]); }
#pragma unroll
                for (int i = 0; i < 4; ++i)
#pragma unroll
                    for (int s2 = 0; s2 <= (i >> 1); ++s2) o[i] = MFMA16(ld44l(B + SC_PB + (16 * i + c) * 144 + (32 * s2 + 4 * q) * 2), vnb[s2], o[i]);
                const float g63 = sc[64 + 63];
#pragma unroll
                for (int t = 0; t < 8; ++t) { f32x4 acc = St[t] * g63;
#pragma unroll
                    for (int s2 = 0; s2 < 2; ++s2) {
                        const s16x4 lo = trread(B + SC_KB + (32 * s2 + 4 * q + (c >> 2)) * 272 + (16 * t + 4 * (c & 3)) * 2);
                        const s16x4 hi = trread(B + SC_KB + (32 * s2 + 16 + 4 * q + (c >> 2)) * 272 + (16 * t + 4 * (c & 3)) * 2);
                        bf16x8 kt; kt[0] = lo[0]; kt[1] = lo[1]; kt[2] = lo[2]; kt[3] = lo[3]; kt[4] = hi[0]; kt[5] = hi[1]; kt[6] = hi[2]; kt[7] = hi[3];
                        acc = MFMA16(kt, veb[s2], acc); }
                    St[t] = acc; }
                const size_t m0 = (size_t)chain_row0(b, DIR, n);
#pragma unroll
                for (int i = 0; i < 4; ++i)
#pragma unroll
                    for (int r = 0; r < 4; ++r) { const int row = 16 * i + 4 * q + r; const size_t m = m0 + (DIR ? 63 - row : row);
                        bf16_t* pp = PARK + m * 512 + h * 128 + 64 * half + 16 * wave + c;
                        *pp = f2bf(DIR == 0 ? o[i][r] : bf2f(*pp) + o[i][r]); }
            }
            SYNC();
        }
    }
}
template <int DIR> DEVI void phase_scan(const Ctx& cx, const Params& p, LQ unsigned char* lds, int layer) {
    const Views v = make_views(p.ws);
    const int nitem = NB * 4 * 2;
    for (int item = cx.bid; item < nitem; item += cx.nblk) scan_chain<0, DIR>(cx, p, v, lds, layer, item >> 3, (item >> 1) & 3, item & 1);
    CFENCE();
    for (int item = (cx.bid + cx.nblk - (nitem % cx.nblk)) % cx.nblk; item < nitem; item += cx.nblk) scan_chain<1, DIR>(cx, p, v, lds, layer, item >> 3, (item >> 1) & 3, item & 1);
}

struct StG1 { bf16_t *AQKV, *BQ, *BKV, *CQKV;
    DEVI void st8(int row, int col, const float* a) const {
        bf16_t* dst = col < 1536 ? AQKV + (size_t)row * 1536 + col : (col < 2048 ? BQ + (size_t)row * 512 + (col - 1536) : (col < 2304 ? BKV + (size_t)row * 256 + (col - 2048) : CQKV + (size_t)row * 1536 + (col - 2304)));
        *(U4*)dst = pack8(a); } };
struct StPlain { bf16_t* O; int ld;
    DEVI void st8(int row, int col, const float* a) const { *(U4*)(O + (size_t)row * ld + col) = pack8(a); } };
struct StMerge { const bf16_t* L; bf16_t* MRG; int br;
    DEVI void st8(int row, int col, const float* a) const {
        float lg[8], o[8]; unpack8(*(const U4*)(L + (size_t)row * NMG + br * 1024 + col), lg);
        if (br) unpack8(*(const U4*)(MRG + (size_t)row * DM + col), o); else { for (int e = 0; e < 8; ++e) o[e] = 0.f; }
        for (int e = 0; e < 8; ++e) o[e] += sigmoidf_(lg[e]) * a[e];
        *(U4*)(MRG + (size_t)row * DM + col) = pack8(o); } };
struct StResid { const float *xlat, *xctx; float *olat, *octx; const float* mod;
    DEVI void st4(int row, int col, const float* a) const {
        const float* xi = row < ML ? xlat + (size_t)row * DM + col : xctx + (size_t)(row - ML) * DM + col;
        float* xo = row < ML ? olat + (size_t)row * DM + col : octx + (size_t)(row - ML) * DM + col;
        const int b = row < ML ? row / SEQ : NB; const float* g = mod + (size_t)b * 3072 + 2048 + col;
        for (int e = 0; e < 4; ++e) xo[e] = xi[e] + g[e] * a[e]; } };

#ifndef CPU_EMU
namespace pg8 {
#define PG8_LAS __attribute__((address_space(3)))
typedef short bf16x8 __attribute__((ext_vector_type(8)));
typedef float f32x4 __attribute__((ext_vector_type(4)));
constexpr int BM = 256, BK = 64, HALF = 128, HTB = HALF * BK * 2, STAGE_BYTES = 8 * HTB, NXCD = 8, WGM = 8;
__host__ __device__ __forceinline__ int lds_byte(int r, int c) { const int st = (r >> 4) * 2 + (c >> 5), rr = r & 15, cc = c & 31, ob = rr * 64 + cc * 2; return st * 1024 + (ob ^ (((ob >> 9) & 1) << 5)); }
__host__ __device__ __forceinline__ void stage_rc(int b, int& R, int& C) { const int st = b / 1024, sb = b % 1024, swz = sb ^ (((sb >> 9) & 1) << 5); R = (st >> 1) * 16 + swz / 64; C = (st & 1) * 32 + (swz % 64) / 2; }
__host__ __device__ __forceinline__ int perm32(int rho) { const int n = rho >> 4, i = rho & 15; return 8 * (i >> 2) + 4 * n + (i & 3); }
struct Unit { int pm, pn; };
struct Gemm { const bf16_t* A; const bf16_t* Bt; int M, N, K; };
struct StaticOrder {
    int nM, nN, nwg, G, c;
    __host__ __device__ void init(int M, int N, int G_, int c_) { nM = M / BM; nN = N / BM; nwg = nM * nN; G = G_; c = c_; }
    __host__ __device__ bool next(int i, Unit& u) const {
        const long L = (long)i * G + c; if (L >= nwg) return false;
        int wgid = (int)L; { const int q = nwg / NXCD, r = nwg % NXCD, xcd = wgid % NXCD, off = wgid / NXCD; wgid = (xcd < r ? xcd * (q + 1) : r * (q + 1) + (xcd - r) * q) + off; }
        const int nig = WGM * nN, gid = wgid / nig, fm = gid * WGM, gsz = (nM - fm) < WGM ? (nM - fm) : WGM;
        u.pm = fm + ((wgid % nig) % gsz); u.pn = (wgid % nig) / gsz; return true;
    }
    __device__ __forceinline__ void a_ready(const Unit&) const {}
    __device__ __forceinline__ void done(const Unit&) const {}
};
template <class F> struct Epi8 {
    static constexpr bool PERM = true, AFTER_DRAIN = false; F f;
    __device__ __forceinline__ void operator()(const f32x4 (&acc)[2][2][4][2], const Unit& u, int wr, int wc, int fr, int fq) const {
        const int row0 = u.pm * BM + wr * 64 + fr, col0 = u.pn * BM + wc * 32 + 8 * fq;
#pragma unroll
        for (int ai = 0; ai < 2; ++ai)
#pragma unroll
            for (int m = 0; m < 4; ++m)
#pragma unroll
                for (int bj = 0; bj < 2; ++bj) { const f32x4 v0 = acc[ai][bj][m][0], v1 = acc[ai][bj][m][1];
                    const float a[8] = {v0[0], v0[1], v0[2], v0[3], v1[0], v1[1], v1[2], v1[3]};
                    f.st8(row0 + ai * HALF + m * 16, col0 + bj * HALF, a); }
    }
};
template <class F> struct Epi4 {
    static constexpr bool PERM = false, AFTER_DRAIN = false; F f;
    __device__ __forceinline__ void operator()(const f32x4 (&acc)[2][2][4][2], const Unit& u, int wr, int wc, int fr, int fq) const {
        const int row0 = u.pm * BM + wr * 64 + fr, col0 = u.pn * BM + wc * 32 + 4 * fq;
#pragma unroll
        for (int ai = 0; ai < 2; ++ai)
#pragma unroll
            for (int m = 0; m < 4; ++m)
#pragma unroll
                for (int bj = 0; bj < 2; ++bj)
#pragma unroll
                    for (int n = 0; n < 2; ++n) { const f32x4 v0 = acc[ai][bj][m][n]; const float a[4] = {v0[0], v0[1], v0[2], v0[3]};
                        f.st4(row0 + ai * HALF + m * 16, col0 + bj * HALF + n * 16, a); }
    }
};

template <class Epi, class Sched, bool ALIGN_EPI = false, bool SP2 = false>
__device__ __forceinline__ void gemm_phase(PG8_LAS unsigned char* lds, const int tid, const Gemm g, const Sched& S, const Epi& E) {
    const int wid = __builtin_amdgcn_readfirstlane(tid >> 6), lane = tid & 63, wr = wid >> 2, wc = wid & 3, fr = lane & 15, fq = lane >> 4;
    const int K = g.K, nt = K / BK;
    unsigned voffA[2], voffB[2];
#pragma unroll
    for (int i = 0; i < 2; ++i) { int R, C; stage_rc(tid * 16 + i * 8192, R, C); const int Rb = Epi::PERM ? ((R & ~31) + perm32(R & 31)) : R;
        voffA[i] = (unsigned)(R * K + C) * 2u; voffB[i] = (unsigned)(Rb * K + C) * 2u; }
    const size_t kstep = (size_t)(BK * 2);
    const size_t hstep = (size_t)HALF * K * 2;
    const size_t tstep = 2 * hstep;
    const unsigned ldsw = (unsigned)wid * 1024u;
    const int aoff = lds_byte(wr * 64 + fr, fq * 8), boff = lds_byte(wc * 32 + fr, fq * 8);
#define PG8_SA(b, h) (((b) * 2 + (h)) * HTB)
#define PG8_SB(b, h) ((4 + (b) * 2 + (h)) * HTB)
#define PG8_STAGE(bufoff, gbase, voff) do { _Pragma("unroll") for (int _i = 0; _i < 2; ++_i) \
        __builtin_amdgcn_global_load_lds((const unsigned*)((const char*)(gbase) + (voff)[_i]), (PG8_LAS unsigned*)(lds + (bufoff) + ldsw + _i * 8192), 16, 0, 0); } while (0)
#define PG8_LDA(dst, b, h) do { _Pragma("unroll") for (int m = 0; m < 4; ++m) _Pragma("unroll") for (int k = 0; k < 2; ++k) dst[m][k] = *(const PG8_LAS bf16x8*)(lds + PG8_SA(b, h) + aoff + m * 2048 + k * 1024); } while (0)
#define PG8_LDB(dst, b, h) do { _Pragma("unroll") for (int n = 0; n < 2; ++n) _Pragma("unroll") for (int k = 0; k < 2; ++k) dst[n][k] = *(const PG8_LAS bf16x8*)(lds + PG8_SB(b, h) + boff + n * 2048 + k * 1024); } while (0)
#define PG8_MMA(ai, bj, At, Bt) do { __builtin_amdgcn_s_setprio(1); _Pragma("unroll") for (int m = 0; m < 4; ++m) _Pragma("unroll") for (int n = 0; n < 2; ++n) _Pragma("unroll") for (int k = 0; k < 2; ++k) \
        acc[ai][bj][m][n] = __builtin_amdgcn_mfma_f32_16x16x32_bf16(Bt[n][k], At[m][k], acc[ai][bj][m][n], 0, 0, 0); __builtin_amdgcn_s_setprio(0); } while (0)
#define PG8_WAIT_V(n) asm volatile("s_waitcnt vmcnt(" #n ")" ::: "memory")
#define PG8_WAIT_L(n) asm volatile("s_waitcnt lgkmcnt(" #n ")" ::: "memory")
#define PG8_BAR __builtin_amdgcn_s_barrier()
#define PG8_SCHED __builtin_amdgcn_sched_barrier(0)
    Unit cur, nxt; int ui = 0;
    if (!S.next(0, cur)) return;
    f32x4 acc[2][2][4][2];
#pragma unroll
    for (int a = 0; a < 2; ++a)
#pragma unroll
        for (int b = 0; b < 2; ++b)
#pragma unroll
            for (int m = 0; m < 4; ++m)
#pragma unroll
                for (int n = 0; n < 2; ++n) acc[a][b][m][n] = (f32x4){0.f, 0.f, 0.f, 0.f};
    bf16x8 At[4][2], B0[2][2], B1[2][2];
    const char* cA = (const char*)g.A + (size_t)cur.pm * tstep; const char* cB = (const char*)g.Bt + (size_t)cur.pn * tstep;
    S.a_ready(cur);
    if constexpr (SP2) {
        PG8_STAGE(PG8_SB(0, 0), cB, voffB); PG8_STAGE(PG8_SB(0, 1), cB + hstep, voffB); PG8_STAGE(PG8_SA(0, 0), cA, voffA); PG8_STAGE(PG8_SA(0, 1), cA + hstep, voffA);
        if (wr == 1) PG8_BAR;
        PG8_WAIT_V(2); PG8_BAR;
        PG8_STAGE(PG8_SB(1, 0), cB + kstep, voffB); PG8_STAGE(PG8_SA(1, 0), cA + kstep, voffA); PG8_STAGE(PG8_SB(1, 1), cB + hstep + kstep, voffB);
        PG8_WAIT_V(6); PG8_BAR;
    } else {
        PG8_STAGE(PG8_SB(0, 0), cB, voffB); PG8_STAGE(PG8_SA(0, 0), cA, voffA); PG8_STAGE(PG8_SB(0, 1), cB + hstep, voffB); PG8_STAGE(PG8_SA(0, 1), cA + hstep, voffA);
        if (wr == 1) PG8_BAR;
        PG8_WAIT_V(4); PG8_BAR;
        PG8_STAGE(PG8_SB(1, 0), cB + kstep, voffB); PG8_STAGE(PG8_SA(1, 0), cA + kstep, voffA); PG8_STAGE(PG8_SB(1, 1), cB + hstep + kstep, voffB);
        PG8_WAIT_V(6); PG8_BAR;
    }
    for (;;) {
        const bool has_next = S.next(ui + 1, nxt);
        const char* nA = has_next ? (const char*)g.A + (size_t)nxt.pm * tstep : cA; const char* nB = has_next ? (const char*)g.Bt + (size_t)nxt.pn * tstep : cB;
        for (int t = 0; t < nt; t += 2) {
            const bool last = (t == nt - 2);
            const char* a1 = cA + (size_t)(t + 1) * kstep;
            const char* a2 = last ? nA : cA + (size_t)(t + 2) * kstep; const char* b2 = last ? nB : cB + (size_t)(t + 2) * kstep;
            const char* a3 = a2 + kstep; const char* b3 = b2 + kstep;
            if (last && has_next) S.a_ready(nxt);
            if constexpr (SP2) {
            PG8_LDB(B0, 0, 0); PG8_LDB(B1, 0, 1); PG8_SCHED; PG8_LDA(At, 0, 0); PG8_STAGE(PG8_SA(1, 1), a1 + hstep, voffA);
            PG8_WAIT_V(8); PG8_WAIT_L(0); PG8_BAR; PG8_MMA(0, 0, At, B0); PG8_MMA(0, 1, At, B1); PG8_BAR; PG8_SCHED;
            PG8_LDA(At, 0, 1); PG8_STAGE(PG8_SB(0, 0), b2, voffB); PG8_STAGE(PG8_SB(0, 1), b2 + hstep, voffB); PG8_STAGE(PG8_SA(0, 0), a2, voffA);
            PG8_WAIT_V(8); PG8_WAIT_L(0); PG8_BAR; PG8_MMA(1, 0, At, B0); PG8_MMA(1, 1, At, B1); PG8_BAR; PG8_SCHED;
            PG8_LDB(B0, 1, 0); PG8_LDB(B1, 1, 1); PG8_SCHED; PG8_LDA(At, 1, 0); PG8_STAGE(PG8_SA(0, 1), a2 + hstep, voffA);
            PG8_WAIT_V(8); PG8_WAIT_L(0); PG8_BAR; PG8_MMA(0, 0, At, B0); PG8_MMA(0, 1, At, B1); PG8_BAR; PG8_SCHED;
            PG8_LDA(At, 1, 1); PG8_STAGE(PG8_SB(1, 0), b3, voffB); PG8_STAGE(PG8_SB(1, 1), b3 + hstep, voffB); PG8_STAGE(PG8_SA(1, 0), a3, voffA);
            PG8_WAIT_V(8); PG8_WAIT_L(0); PG8_BAR; PG8_MMA(1, 0, At, B0); PG8_MMA(1, 1, At, B1); PG8_BAR; PG8_SCHED;
            } else {
            PG8_LDB(B0, 0, 0); PG8_SCHED; PG8_LDA(At, 0, 0); PG8_STAGE(PG8_SA(1, 1), a1 + hstep, voffA);
            PG8_WAIT_L(8); PG8_BAR; PG8_WAIT_L(0); PG8_MMA(0, 0, At, B0); PG8_BAR; PG8_SCHED;
            PG8_LDB(B1, 0, 1); PG8_STAGE(PG8_SB(0, 0), b2, voffB);
            PG8_BAR; PG8_WAIT_L(0); PG8_MMA(0, 1, At, B1); PG8_BAR;
            PG8_LDA(At, 0, 1); PG8_STAGE(PG8_SA(0, 0), a2, voffA);
            PG8_BAR; PG8_WAIT_L(0); PG8_MMA(1, 0, At, B0); PG8_BAR; PG8_SCHED;
            PG8_STAGE(PG8_SB(0, 1), b2 + hstep, voffB);
            PG8_WAIT_V(6); PG8_BAR; PG8_MMA(1, 1, At, B1); PG8_BAR;
            PG8_LDB(B0, 1, 0); PG8_SCHED; PG8_LDA(At, 1, 0); PG8_STAGE(PG8_SA(0, 1), a2 + hstep, voffA);
            PG8_WAIT_L(8); PG8_BAR; PG8_WAIT_L(0); PG8_MMA(0, 0, At, B0); PG8_BAR; PG8_SCHED;
            PG8_LDB(B1, 1, 1); PG8_STAGE(PG8_SB(1, 0), b3, voffB);
            PG8_BAR; PG8_WAIT_L(0); PG8_MMA(0, 1, At, B1); PG8_BAR;
            PG8_LDA(At, 1, 1); PG8_STAGE(PG8_SA(1, 0), a3, voffA);
            PG8_BAR; PG8_WAIT_L(0); PG8_MMA(1, 0, At, B0); PG8_BAR; PG8_SCHED;
            PG8_STAGE(PG8_SB(1, 1), b3 + hstep, voffB);
            PG8_WAIT_V(6); PG8_BAR; PG8_MMA(1, 1, At, B1); PG8_BAR;
            }
        }
        if constexpr (ALIGN_EPI) { if (wr == 0) PG8_BAR; }
        if constexpr (!Epi::AFTER_DRAIN) { E(acc, cur, wr, wc, fr, fq); S.done(cur); }
        if (!has_next) break;
#pragma unroll
        for (int a = 0; a < 2; ++a)
#pragma unroll
            for (int b = 0; b < 2; ++b)
#pragma unroll
                for (int m = 0; m < 4; ++m)
#pragma unroll
                    for (int n = 0; n < 2; ++n) acc[a][b][m][n] = (f32x4){0.f, 0.f, 0.f, 0.f};
        cur = nxt; cA = nA; cB = nB; ++ui;
        if constexpr (ALIGN_EPI) { if (wr == 1) PG8_BAR; }
    }
    PG8_WAIT_V(0);
    if constexpr (!ALIGN_EPI) { if (wr == 0) PG8_BAR; }
    PG8_BAR;
#undef PG8_SA
#undef PG8_SB
#undef PG8_STAGE
#undef PG8_LDA
#undef PG8_LDB
#undef PG8_MMA
#undef PG8_WAIT_V
#undef PG8_WAIT_L
#undef PG8_BAR
#undef PG8_SCHED
}
}

template <class F> __device__ __forceinline__ void run_gemm8(PG8_LAS unsigned char* lds, const Ctx& cx, const bf16_t* A, const bf16_t* Bt, int M, int N, int K, const F& f) {
    pg8::Gemm g{A, Bt, M, N, K}; pg8::StaticOrder S; S.init(M, N, cx.nblk, cx.bid);
    pg8::Epi8<F> E{f};
    pg8::gemm_phase<pg8::Epi8<F>, pg8::StaticOrder, true, true>(lds, cx.tid, g, S, E);
}
template <class F> __device__ __forceinline__ void run_gemm4(PG8_LAS unsigned char* lds, const Ctx& cx, const bf16_t* A, const bf16_t* Bt, int M, int N, int K, const F& f) {
    pg8::Gemm g{A, Bt, M, N, K}; pg8::StaticOrder S; S.init(M, N, cx.nblk, cx.bid);
    pg8::Epi4<F> E{f};
    pg8::gemm_phase<pg8::Epi4<F>, pg8::StaticOrder, true, true>(lds, cx.tid, g, S, E);
}
#else
template <class F> void run_gemm8(unsigned char*, const Ctx&, const bf16_t* A, const bf16_t* Bt, int M, int N, int K, const F& f) {
#pragma omp parallel for schedule(dynamic, 8)
    for (int r = 0; r < M; ++r) for (int c0 = 0; c0 < N; c0 += 8) { float a[8];
        for (int e = 0; e < 8; ++e) { float s = 0.f; const bf16_t* ar = A + (size_t)r * K; const bf16_t* br = Bt + (size_t)(c0 + e) * K; for (int k = 0; k < K; ++k) s += bf2f(ar[k]) * bf2f(br[k]); a[e] = s; }
        f.st8(r, c0, a); }
}
template <class F> void run_gemm4(unsigned char*, const Ctx&, const bf16_t* A, const bf16_t* Bt, int M, int N, int K, const F& f) {
#pragma omp parallel for schedule(dynamic, 8)
    for (int r = 0; r < M; ++r) for (int c0 = 0; c0 < N; c0 += 4) { float a[4];
        for (int e = 0; e < 4; ++e) { float s = 0.f; const bf16_t* ar = A + (size_t)r * K; const bf16_t* br = Bt + (size_t)(c0 + e) * K; for (int k = 0; k < K; ++k) s += bf2f(ar[k]) * bf2f(br[k]); a[e] = s; }
        f.st4(r, c0, a); }
}
#endif

constexpr int PPL = 14;
constexpr int NPHASE = 2 + PPL * NLAYER;
template <int PH> DEVI void run_phase_t(LQ unsigned char* lds, const Ctx& cx, const Params& p) {
    const Views v = make_views(p.ws);
    if constexpr (PH == 0) { phase_prep(cx, p); }
    else if constexpr (PH == NPHASE - 1) { phase_final(cx, p); }
    else {
        constexpr int layer = (PH - 1) / PPL, s = (PH - 1) % PPL;
        constexpr int mrows = layer == NLAYER - 1 ? ML : MT;
        if constexpr (s == 0) phase_norm(cx, p, layer);
        else if constexpr (s == 1) run_gemm8(lds, cx, v.XN, v.W1 + (size_t)layer * N1 * DM, MT, N1, DM, StG1{v.AQKV, v.BQ, v.BKV, v.CQKV});
        else if constexpr (s == 2) phase_conv(cx, p, layer);
        else if constexpr (s == 3) phase_prep2(cx, p, layer);
        else if constexpr (s == 4) { phase_tmat(cx, p, lds, layer); phase_mix(cx, p, layer); }
        else if constexpr (s == 5) phase_scan<0>(cx, p, lds, layer);
        else if constexpr (s == 6) phase_scan<1>(cx, p, lds, layer);
        else if constexpr (s == 7) run_gemm8(lds, cx, v.XN, v.WZ + (size_t)layer * NZ * DM, mrows, NZ, DM, StPlain{v.Z, NZ});
        else if constexpr (s == 8) phase_y(cx, p, layer);
        else if constexpr (s == 9) run_gemm8(lds, cx, v.XN, v.WM + (size_t)layer * NMG * DM, mrows, NMG, DM, StPlain{v.L, NMG});
        else if constexpr (s >= 10 && s <= 12) { constexpr int br = s - 10;
            run_gemm8(lds, cx, v.Y + (size_t)br * MT * 512, v.WB + ((size_t)layer * 3 + br) * DM * 512, mrows, DM, 512, StMerge{v.L, v.MRG, br}); }
        else run_gemm4(lds, cx, v.MRG, v.WO + (size_t)layer * DM * DM, mrows, DM, DM,
                       StResid{layer == 0 ? p.x : p.out, layer == 0 ? p.ctx : v.CTX1, p.out, v.CTX1, v.MOD + (size_t)layer * (NB + 1) * 3072});
    }
}
HD bool phase_is_gemm(int ph) { if (ph == 0 || ph == NPHASE - 1) return false; const int s = (ph - 1) % PPL; return s == 1 || s == 7 || s >= 9; }
#define MK_PHASE_LIST(X) X(0) X(1) X(2) X(3) X(4) X(5) X(6) X(7) X(8) X(9) X(10) X(11) X(12) X(13) X(14) X(15) X(16) X(17) X(18) X(19) X(20) X(21) X(22) X(23) X(24) X(25) X(26) X(27) X(28) X(29)
static_assert(NPHASE == 30, "phase list");
#ifdef CPU_EMU
inline void run_phase(unsigned char* lds, const Ctx& cx, const Params& p, int ph) {
    switch (ph) {
#define X(k) case k: run_phase_t<k>(lds, cx, p); break;
        MK_PHASE_LIST(X)
#undef X
    }
}
#endif

#ifndef CPU_EMU
constexpr int LDS_BYTES = 147456;
__global__ void __launch_bounds__(512, 2) mk_fwd(Params p) {
    extern __shared__ __attribute__((aligned(16))) unsigned char lds_raw[];
    PG8_LAS unsigned char* lds = (PG8_LAS unsigned char*)lds_raw;
    cg::grid_group grid = cg::this_grid();
    const int ph_lo = p.ph_lo, ph_hi = p.ph_hi;
#define X(k) if (ph_lo <= k && k < ph_hi) { \
        const Params* q = (const Params*)__builtin_amdgcn_kernarg_segment_ptr(); asm volatile("" : "+s"(q) :: "memory"); \
        Ctx cx; cx.tid = (int)threadIdx.x; cx.bid = (int)blockIdx.x; cx.nblk = (int)gridDim.x; \
        asm volatile("" : "+v"(cx.tid)); asm volatile("" : "+s"(cx.bid), "+s"(cx.nblk)); \
        run_phase_t<k>(lds, cx, *q); \
        if (k + 1 < ph_hi) grid.sync(); }
    MK_PHASE_LIST(X)
#undef X
}

#ifndef MK_SINGLE
#define MK_SINGLE 1
#endif
extern "C" void kernel_launch(void* const* d_in, const int* in_sizes, int n_in, void* d_out, int out_size, void* d_ws, size_t ws_size, hipStream_t stream) {
    static int grid = 0;
    if (grid == 0) {
        if (n_in != 18 || in_sizes[0] != ML * DM || out_size != ML * DM || ws_size < WS_END) { fprintf(stderr, "kernel_launch: unexpected shapes (n_in %d, in0 %d, out %d, ws %zu < %zu)\n", n_in, n_in > 0 ? in_sizes[0] : -1, out_size, ws_size, (size_t)WS_END); grid = -1; return; }
        int dev = 0, cus = 0, per_cu = 0;
        if (hipGetDevice(&dev) != hipSuccess || hipDeviceGetAttribute(&cus, hipDeviceAttributeMultiprocessorCount, dev) != hipSuccess) { grid = -1; return; }
        if (hipFuncSetAttribute((const void*)mk_fwd, hipFuncAttributeMaxDynamicSharedMemorySize, LDS_BYTES) != hipSuccess) { fprintf(stderr, "kernel_launch: hipFuncSetAttribute failed\n"); grid = -1; return; }
        if (hipOccupancyMaxActiveBlocksPerMultiprocessor(&per_cu, (const void*)mk_fwd, 512, LDS_BYTES) != hipSuccess || per_cu < 1) { fprintf(stderr, "kernel_launch: occupancy query says %d\n", per_cu); (void)hipGetLastError(); grid = -1; return; }
        grid = cus;
    }
    if (grid < 0) return;
    Params p{};
    const float** pp = (const float**)&p;
    for (int i = 0; i < 18; ++i) pp[i] = (const float*)d_in[i];
    p.out = (float*)d_out; p.ws = (unsigned char*)d_ws;
#if MK_SINGLE
    p.ph_lo = 0; p.ph_hi = NPHASE;
    { void* args[] = {&p}; hipError_t e = hipLaunchCooperativeKernel((const void*)mk_fwd, dim3(grid), dim3(512), args, LDS_BYTES, stream);
      if (e != hipSuccess) fprintf(stderr, "cooperative launch failed: %s\n", hipGetErrorString(e)); }
#else
    for (int ph = 0; ph < NPHASE; ++ph) {
        p.ph_lo = ph; p.ph_hi = ph + 1;
        void* args[] = {&p}; hipError_t e = hipLaunchCooperativeKernel((const void*)mk_fwd, dim3(grid), dim3(512), args, LDS_BYTES, stream);
        if (e != hipSuccess) { fprintf(stderr, "cooperative launch %d failed: %s\n", ph, hipGetErrorString(e)); break; }
    }
#endif
}
#endif
```

```cpp
#ifndef CPU_EMU
#include <hip/hip_runtime.h>
#include <hip/hip_cooperative_groups.h>
#include <cstdio>
#include <cstdint>
namespace cg = cooperative_groups;
#define DEVI __device__ __forceinline__
#define HD __host__ __device__ __forceinline__
#define CFENCE() asm volatile("" ::: "memory")
#else
#define CFENCE() do {} while (0)
#include <cstring>
#include <cmath>
#include <cstdio>
#include <cstdint>
#include <cstddef>
#define DEVI inline
#define HD inline
#endif

#ifndef CPU_EMU
#define LQ __attribute__((address_space(3)))
typedef short bf16x8 __attribute__((ext_vector_type(8)));
typedef float f32x4 __attribute__((ext_vector_type(4)));
typedef short s16x4 __attribute__((ext_vector_type(4)));
typedef long long i64x2 __attribute__((ext_vector_type(2)));
typedef unsigned u32x4 __attribute__((ext_vector_type(4)));
#define MFMA16(a, b, c) __builtin_amdgcn_mfma_f32_16x16x32_bf16(a, b, c, 0, 0, 0)
#define SYNC() __syncthreads()
#define WSYNC() __builtin_amdgcn_wave_barrier()
__device__ __forceinline__ s16x4 trread(LQ const unsigned char* p) { return __builtin_bit_cast(s16x4, __builtin_amdgcn_ds_read_tr16_b64_v4i16((LQ s16x4*)p)); }
__device__ __forceinline__ float shfl_f(float v, int src) { return __shfl(v, src, 64); }
#define RFL(x) __builtin_amdgcn_readfirstlane(x)
#define FEXP(x) __expf(x)
#else
#define LQ
using simt::bf16x8; using simt::f32x4; using simt::s16x4;
typedef long long i64x2 __attribute__((vector_size(16)));
typedef unsigned u32x4 __attribute__((vector_size(16)));
#define MFMA16(a, b, c) simt::mfma16(a, b, c)
#define SYNC() simt::syncthreads()
#define WSYNC() ((void)simt::shfl(0.f, 0))
inline s16x4 trread(const unsigned char* p) { return simt::tr16_b64(p); }
inline float shfl_f(float v, int src) { return simt::shfl(v, src); }
#define RFL(x) (x)
#define FEXP(x) expf(x)
#endif

#ifndef NB
#define NB 8
#endif
#ifndef SEQ
#define SEQ 4096
#endif
#ifndef CTXL
#define CTXL 256
#endif
constexpr int DM = 1024, INW = 8464, GRIDW = 64;
constexpr int ML = NB * SEQ, MC = NB * CTXL, MT = ML + MC;
constexpr int N1 = 3840;
constexpr int NZ = 1536;
constexpr int NMG = 3072;
constexpr float EPSF = 1e-6f;
constexpr int NLAYER = 2;
static_assert(MT % 256 == 0 && ML % 256 == 0, "row tiles");
constexpr int NCH_C = CTXL / 64, NCH_L = SEQ / 64, NSTEP = NCH_C + NCH_L;

typedef unsigned short bf16_t;
struct alignas(16) U4 { unsigned x, y, z, w; };
DEVI void st16l(LQ unsigned char* p, const U4& w) { u32x4 t; t[0] = w.x; t[1] = w.y; t[2] = w.z; t[3] = w.w; *(LQ u32x4*)p = t; }
DEVI U4 ld16l(LQ const unsigned char* p) { const u32x4 t = *(LQ const u32x4*)p; U4 w; w.x = t[0]; w.y = t[1]; w.z = t[2]; w.w = t[3]; return w; }

constexpr size_t MiB = 1u << 20;
constexpr size_t al1(size_t x) { return (x + MiB - 1) & ~(MiB - 1); }
constexpr size_t WS_CTL = 0;
constexpr size_t WS_MOD = 256 * 1024;
constexpr size_t WS_W1 = 1 * MiB;
constexpr size_t WS_WZ = WS_W1 + al1((size_t)2 * N1 * DM * 2);
constexpr size_t WS_WM = WS_WZ + al1((size_t)2 * NZ * DM * 2);
constexpr size_t WS_WB = WS_WM + al1((size_t)2 * NMG * DM * 2);
constexpr size_t WS_WO = WS_WB + al1((size_t)2 * 3 * DM * 512 * 2);
constexpr size_t WS_G = WS_WO + al1((size_t)2 * DM * DM * 2);
constexpr size_t WS_BETA = WS_G + al1((size_t)MT * 8 * 4);
constexpr size_t WS_CTX1 = WS_BETA + al1((size_t)MT * 8 * 4);
constexpr size_t WS_XN = WS_CTX1 + al1((size_t)MC * DM * 4);
constexpr size_t WS_AQKV = WS_XN + al1((size_t)MT * DM * 2);
constexpr size_t WS_CQKV = WS_AQKV + al1((size_t)MT * 1536 * 2);
constexpr size_t WS_BQ = WS_CQKV + al1((size_t)MT * 1536 * 2);
constexpr size_t WS_BKV = WS_BQ + al1((size_t)MT * 512 * 2);
constexpr size_t WS_PA = WS_BKV + al1((size_t)MT * 256 * 2);
constexpr size_t WS_PC = WS_PA + al1((size_t)MT * 512 * 2);
constexpr size_t WS_T = WS_PC + al1((size_t)MT * 512 * 2);
constexpr size_t WS_HALO = WS_T + al1((size_t)(MT / 64) * 8 * 8192);
constexpr size_t WS_END = WS_HALO + al1((size_t)(MT / 64) * 4 * 1536 * 2);
static_assert(WS_CQKV + (size_t)MT * NMG * 2 <= WS_END, "L overlay");
static_assert(WS_END <= (size_t)512 * MiB, "workspace");

struct Params {
    const float *x, *c, *ctx, *c_ctx, *w_ada, *b_ada, *norm_w, *w_in, *a_conv_w, *a_log, *a_dt_bias, *a_norm_w, *b_sink, *c_decay, *c_norm_w, *w_branch, *w_out, *final_norm_w;
    float* out; unsigned char* ws;
    int ph_lo, ph_hi;
};

#ifdef CPU_EMU
inline float u2f(unsigned u) { float f; memcpy(&f, &u, 4); return f; }
inline unsigned f2u(float f) { unsigned u; memcpy(&u, &f, 4); return u; }
#else
DEVI float u2f(unsigned u) { return __uint_as_float(u); }
DEVI unsigned f2u(float f) { return __float_as_uint(f); }
#endif
DEVI float bf2f(bf16_t h) { return u2f((unsigned)h << 16); }
DEVI bf16_t f2bf(float f) { unsigned u = f2u(f); return (bf16_t)((u + 0x7fffu + ((u >> 16) & 1u)) >> 16); }
DEVI unsigned pk2(float lo, float hi) { return (unsigned)f2bf(lo) | ((unsigned)f2bf(hi) << 16); }
DEVI float lo16(unsigned w) { return u2f(w << 16); }
DEVI float hi16(unsigned w) { return u2f(w & 0xffff0000u); }
DEVI float sigmoidf_(float x) { return 1.0f / (1.0f + expf(-x)); }
DEVI float siluf_(float x) { return x / (1.0f + expf(-x)); }
DEVI float softplusf_(float x) { return x > 20.f ? x : log1pf(expf(x)); }
DEVI void unpack8(const U4& w, float* v) { v[0] = lo16(w.x); v[1] = hi16(w.x); v[2] = lo16(w.y); v[3] = hi16(w.y); v[4] = lo16(w.z); v[5] = hi16(w.z); v[6] = lo16(w.w); v[7] = hi16(w.w); }
DEVI U4 pack8(const float* v) { U4 w; w.x = pk2(v[0], v[1]); w.y = pk2(v[2], v[3]); w.z = pk2(v[4], v[5]); w.w = pk2(v[6], v[7]); return w; }

struct Ctx { int tid, bid, nblk; };
struct TI { long id, n; };
DEVI TI thread_info(const Ctx& c) {
    const int wave = c.tid >> 6, lane = c.tid & 63;
    return TI{((long)wave * c.nblk + c.bid) * 64 + lane, (long)c.nblk * 512};
}

struct Views {
    float* MOD; bf16_t *W1, *WZ, *WM, *WB, *WO; float *G, *BETA, *CTX1; bf16_t *XN, *AQKV, *CQKV, *BQ, *BKV, *PA, *PC, *Y, *Z, *L, *MRG, *T, *HALO;
};
DEVI Views make_views(unsigned char* ws) {
    Views v;
    v.MOD = (float*)(ws + WS_MOD); v.W1 = (bf16_t*)(ws + WS_W1); v.WZ = (bf16_t*)(ws + WS_WZ); v.WM = (bf16_t*)(ws + WS_WM); v.WB = (bf16_t*)(ws + WS_WB); v.WO = (bf16_t*)(ws + WS_WO);
    v.G = (float*)(ws + WS_G); v.BETA = (float*)(ws + WS_BETA); v.CTX1 = (float*)(ws + WS_CTX1);
    v.XN = (bf16_t*)(ws + WS_XN); v.AQKV = (bf16_t*)(ws + WS_AQKV); v.CQKV = (bf16_t*)(ws + WS_CQKV); v.BQ = (bf16_t*)(ws + WS_BQ); v.BKV = (bf16_t*)(ws + WS_BKV);
    v.PA = (bf16_t*)(ws + WS_PA); v.PC = (bf16_t*)(ws + WS_PC); v.Y = v.AQKV; v.Z = v.CQKV; v.L = v.CQKV; v.MRG = v.XN; v.T = (bf16_t*)(ws + WS_T); v.HALO = (bf16_t*)(ws + WS_HALO);
    return v;
}

HD int map_g1(int n) { return n < 1536 ? n : (n < 2048 ? 2064 + (n - 1536) : (n < 2304 ? 2576 + (n - 2048) : 3344 + (n - 2304))); }
HD int map_z(int n) { return n < 512 ? 1536 + n : (n < 1024 ? 2832 + (n - 512) : 4880 + (n - 1024)); }

DEVI void phase_prep(const Ctx& cx, const Params& p) {
    const Views v = make_views(p.ws); const TI ti = thread_info(cx);
    const long n1 = (long)2 * N1 * DM, nz = (long)2 * NZ * DM, nm = (long)2 * NMG * DM, nb = (long)2 * 3 * DM * 512, no = (long)2 * DM * DM;
    const long tot = n1 + nz + nm + nb + no;
    for (long i = ti.id; i < tot; i += ti.n) {
        long r = i;
        if (r < n1) { const int l = (int)(r / ((long)N1 * DM)), rem = (int)(r % ((long)N1 * DM)), n = rem / DM, k = rem % DM; v.W1[r] = f2bf(p.w_in[((size_t)l * DM + k) * INW + map_g1(n)]); continue; } r -= n1;
        if (r < nz) { const int l = (int)(r / ((long)NZ * DM)), rem = (int)(r % ((long)NZ * DM)), n = rem / DM, k = rem % DM; v.WZ[r] = f2bf(p.w_in[((size_t)l * DM + k) * INW + map_z(n)]); continue; } r -= nz;
        if (r < nm) { const int l = (int)(r / ((long)NMG * DM)), rem = (int)(r % ((long)NMG * DM)), n = rem / DM, k = rem % DM; v.WM[r] = f2bf(p.w_in[((size_t)l * DM + k) * INW + 5392 + n]); continue; } r -= nm;
        if (r < nb) { const int lb = (int)(r / ((long)DM * 512)), rem = (int)(r % ((long)DM * 512)), n = rem / 512, k = rem % 512; v.WB[r] = f2bf(p.w_branch[((size_t)lb * 512 + k) * DM + n]); continue; } r -= nb;
        { const int l = (int)(r / ((long)DM * DM)), rem = (int)(r % ((long)DM * DM)), n = rem / DM, k = rem % DM; v.WO[r] = f2bf(p.w_out[((size_t)l * DM + k) * DM + n]); }
    }
    const long nmod = (long)NLAYER * (NB + 1) * 3072;
    for (long i = ti.id; i < nmod; i += ti.n) {
        const int l = (int)(i / ((NB + 1) * 3072)), rem = (int)(i % ((NB + 1) * 3072)), b = rem / 3072, n = rem % 3072;
        const float* cv = b < NB ? p.c + (size_t)b * DM : p.c_ctx;
        const float* w = p.w_ada + (size_t)l * DM * 3072 + n;
        float acc = 0.f;
        for (int k = 0; k < DM; ++k) acc += siluf_(cv[k]) * w[(size_t)k * 3072];
        v.MOD[i] = acc + p.b_ada[l * 3072 + n];
    }
}

DEVI const float* xrow_in(const Params& p, const Views& v, int layer, int m) {
    if (layer == 0) return m < ML ? p.x + (size_t)m * DM : p.ctx + (size_t)(m - ML) * DM;
    return m < ML ? p.out + (size_t)m * DM : v.CTX1 + (size_t)(m - ML) * DM;
}
DEVI void phase_norm(const Ctx& cx, const Params& p, int layer) {
    const Views v = make_views(p.ws); const TI ti = thread_info(cx);
    for (long m = ti.id; m < MT; m += ti.n) {
        const float* xr = xrow_in(p, v, layer, (int)m);
        const int b = m < ML ? (int)(m / SEQ) : NB;
        const float* mod = v.MOD + ((size_t)layer * (NB + 1) + b) * 3072;
        const float* nw = p.norm_w + layer * DM;
        float ss = 0.f;
        for (int k = 0; k < DM; ++k) ss += xr[k] * xr[k];
        const float r = 1.0f / sqrtf(ss * (1.0f / DM) + EPSF);
        float a[16];
#pragma unroll
        for (int j = 0; j < 16; ++j) a[j] = 0.f;
        const float* wab = p.w_in + (size_t)layer * DM * INW + 2048;
        for (int k = 0; k < DM; ++k) {
            const float hv = xr[k] * r * nw[k] * (1.0f + mod[1024 + k]) + mod[k];
            v.XN[(size_t)m * DM + k] = f2bf(hv);
            const float* wr_ = wab + (size_t)k * INW;
#pragma unroll
            for (int j = 0; j < 16; ++j) a[j] += hv * wr_[j];
        }
#pragma unroll
        for (int h = 0; h < 8; ++h) {
            v.BETA[(size_t)m * 8 + h] = sigmoidf_(a[h]);
            v.G[(size_t)m * 8 + h] = -expf(p.a_log[layer * 8 + h]) * softplusf_(a[8 + h] + p.a_dt_bias[layer * 8 + h]);
        }
    }
}

DEVI void phase_conv(const Ctx& cx, const Params& p, int layer) {
    const Views v = make_views(p.ws); const TI ti = thread_info(cx);
    const float* cw = p.a_conv_w + (size_t)layer * 5 * 1536;
    for (long it = ti.id; it < (long)(MT / 64) * 1536; it += ti.n) {
        const int gch = (int)(it / 1536), c = (int)(it % 1536);
        const bool lat = gch < ML / 64; const int ci = lat ? gch % NCH_L : (gch - ML / 64) % NCH_C; const bool first = ci == 0, last = ci == (lat ? NCH_L : NCH_C) - 1;
        bf16_t* col = v.AQKV + (size_t)gch * 64 * 1536 + c;
        const float w0 = cw[c], w1 = cw[1536 + c], w2 = cw[2 * 1536 + c], w3 = cw[3 * 1536 + c], w4 = cw[4 * 1536 + c];
        float xv[68];
        xv[0] = first ? 0.f : bf2f(v.HALO[((size_t)(gch - 1) * 4 + 2) * 1536 + c]); xv[1] = first ? 0.f : bf2f(v.HALO[((size_t)(gch - 1) * 4 + 3) * 1536 + c]);
        xv[66] = last ? 0.f : bf2f(v.HALO[((size_t)(gch + 1) * 4 + 0) * 1536 + c]); xv[67] = last ? 0.f : bf2f(v.HALO[((size_t)(gch + 1) * 4 + 1) * 1536 + c]);
#pragma unroll
        for (int t = 0; t < 64; ++t) xv[2 + t] = bf2f(col[(size_t)t * 1536]);
#pragma unroll
        for (int t = 0; t < 64; ++t) { const float y = w0 * xv[t] + w1 * xv[t + 1] + w2 * xv[t + 2] + w3 * xv[t + 3] + w4 * xv[t + 4];
            col[(size_t)t * 1536] = f2bf(y / (1.0f + FEXP(-y))); }
    }
}

DEVI void phase_prep2(const Ctx& cx, const Params& p, int layer) {
    const Views v = make_views(p.ws); const TI ti = thread_info(cx);
    for (long it = ti.id; it < (long)MT * 8; it += ti.n) {
        const long m = it >> 3; const int wh = (int)(it & 7), which = wh >> 2, h = wh & 3;
        bf16_t* ptr = v.AQKV + (size_t)m * 1536 + which * 512 + h * 128;
        float ss = 0.f;
        for (int d = 0; d < 128; ++d) { const float f = bf2f(ptr[d]); ss += f * f; }
        const float sc = (1.0f / sqrtf(ss + EPSF)) * (which == 0 ? 0.08838834764831845f : 1.0f);
        for (int d = 0; d < 128; ++d) ptr[d] = f2bf(bf2f(ptr[d]) * sc);
    }
    for (long it = ti.id; it < (long)ML * 10; it += ti.n) {
        const long m = it / 10; const int hh = (int)(it % 10);
        const int t = (int)(m % SEQ); const float rowp = (float)(t / GRIDW), colp = (float)(t % GRIDW);
        bf16_t* ptr = hh < 8 ? v.BQ + (size_t)m * 512 + hh * 64 : v.BKV + (size_t)m * 256 + (hh - 8) * 64;
        for (int half = 0; half < 2; ++half) {
            const float pos = half == 0 ? rowp : colp;
            for (int i = 0; i < 16; ++i) {
                const float inv = powf(10000.0f, -(float)i / 16.0f);
                const float ang = pos * inv; const float cs = cosf(ang), sn = sinf(ang);
                const float x1 = bf2f(ptr[half * 32 + i]), x2 = bf2f(ptr[half * 32 + 16 + i]);
                ptr[half * 32 + i] = f2bf(x1 * cs - x2 * sn); ptr[half * 32 + 16 + i] = f2bf(x1 * sn + x2 * cs);
            }
        }
    }
    for (long it = ti.id; it < (long)MT * 8; it += ti.n) {
        const long m = it >> 3; const int wh = (int)(it & 7), which = wh >> 2, h = wh & 3;
        bf16_t* ptr = v.CQKV + (size_t)m * 1536 + which * 512 + h * 128;
        const float sc = which == 1 ? 0.08838834764831845f : 1.0f;
        if (m < ML) {
            const float pos = (float)(m % SEQ);
            for (int i = 0; i < 64; ++i) {
                const float inv = powf(10000.0f, -(float)i / 64.0f);
                const float ang = pos * inv; const float cs = cosf(ang), sn = sinf(ang);
                const float x1 = bf2f(ptr[i]) * sc, x2 = bf2f(ptr[64 + i]) * sc;
                ptr[i] = f2bf(x1 * cs - x2 * sn); ptr[64 + i] = f2bf(x1 * sn + x2 * cs);
            }
        } else if (which == 1) {
            for (int d = 0; d < 128; ++d) ptr[d] = f2bf(bf2f(ptr[d]) * sc);
        }
    }
}

template <int MIX> DEVI void scan_item(const Params& p, const Views& v, int layer, int item) {
    const int j = item & 127, h = (item >> 7) & 3, b = item >> 9;
    const bf16_t* QKV = MIX == 0 ? v.AQKV : v.CQKV; bf16_t* PARK = MIX == 0 ? v.PA : v.PC;
    float S[128];
    for (int dir = 0; dir < 2; ++dir) {
#pragma unroll
        for (int d = 0; d < 128; ++d) S[d] = 0.f;
        const float gam = MIX == 1 ? sigmoidf_(p.c_decay[layer * 8 + dir * 4 + h]) : 0.f;
        for (int seg = 0; seg < 2; ++seg) {
            const int len = seg == 0 ? CTXL : SEQ; const size_t m0 = seg == 0 ? (size_t)ML + (size_t)b * CTXL : (size_t)b * SEQ;
            for (int i = 0; i < len; ++i) {
                const int t = dir == 0 ? i : len - 1 - i; const size_t m = m0 + t;
                const bf16_t* row = QKV + m * 1536 + h * 128;
                const float vj = bf2f(row[1024 + j]);
                float o = 0.f;
                if (MIX == 0) {
                    const float a = expf(v.G[m * 8 + dir * 4 + h]), be = v.BETA[m * 8 + dir * 4 + h];
                    float dot = 0.f;
#pragma unroll
                    for (int c8 = 0; c8 < 16; ++c8) { float kk[8]; unpack8(*(const U4*)(row + 512 + c8 * 8), kk);
#pragma unroll
                        for (int e = 0; e < 8; ++e) dot += S[c8 * 8 + e] * kk[e];
                        if ((c8 & 3) == 3) CFENCE(); }
                    const float vn = be * (vj - a * dot);
#pragma unroll
                    for (int c8 = 0; c8 < 16; ++c8) { float kk[8], qq[8]; unpack8(*(const U4*)(row + 512 + c8 * 8), kk); unpack8(*(const U4*)(row + c8 * 8), qq);
#pragma unroll
                        for (int e = 0; e < 8; ++e) { const float s = a * S[c8 * 8 + e] + kk[e] * vn; S[c8 * 8 + e] = s; o += s * qq[e]; }
                        if ((c8 & 3) == 3) CFENCE(); }
                } else {
#pragma unroll
                    for (int c8 = 0; c8 < 16; ++c8) { float kk[8], qq[8]; unpack8(*(const U4*)(row + 512 + c8 * 8), kk); unpack8(*(const U4*)(row + c8 * 8), qq);
#pragma unroll
                        for (int e = 0; e < 8; ++e) { const float s = gam * S[c8 * 8 + e] + kk[e] * vj; S[c8 * 8 + e] = s; o += s * qq[e]; }
                        if ((c8 & 3) == 3) CFENCE(); }
                }
                bf16_t* pp = PARK + m * 512 + h * 128 + j;
                *pp = f2bf(dir == 0 ? o : bf2f(*pp) + o);
            }
        }
    }
}

DEVI void attn_item(const Params& p, const Views& v, int layer, long m, int hq) {
    const int hk = hq >> 2;
    bf16_t* qp = v.BQ + (size_t)m * 512 + hq * 64;
    float q[64], acc[64];
#pragma unroll
    for (int c8 = 0; c8 < 8; ++c8) unpack8(*(const U4*)(qp + c8 * 8), q + c8 * 8);
#pragma unroll
    for (int d = 0; d < 64; ++d) acc[d] = 0.f;
    float mrun = p.b_sink[layer * 8 + hq], lrun = 1.0f;
    const int b = m < ML ? (int)(m / SEQ) : (int)((m - ML) / CTXL);
    const int t = m < ML ? (int)(m % SEQ) : 0;
    const int lo = t - 128 < 0 ? 0 : t - 128, hi = t + 128 > SEQ - 1 ? SEQ - 1 : t + 128;
    const int nwin = m < ML ? hi - lo + 1 : 0;
    for (int i = 0; i < CTXL + nwin; ++i) {
        const size_t kr = i < CTXL ? (size_t)ML + (size_t)b * CTXL + i : (size_t)b * SEQ + lo + (i - CTXL);
        const bf16_t* kp = v.BKV + kr * 256 + hk * 64;
        float s = 0.f;
#pragma unroll
        for (int c8 = 0; c8 < 8; ++c8) { float kk[8]; unpack8(*(const U4*)(kp + c8 * 8), kk);
#pragma unroll
            for (int e = 0; e < 8; ++e) s += q[c8 * 8 + e] * kk[e]; }
        CFENCE();
        s *= 0.125f;
        float pw;
        if (s > mrun) { const float f = expf(mrun - s); lrun *= f;
#pragma unroll
            for (int d = 0; d < 64; ++d) acc[d] *= f;
            mrun = s; pw = 1.0f; }
        else pw = expf(s - mrun);
        lrun += pw;
#pragma unroll
        for (int c8 = 0; c8 < 8; ++c8) { float vv[8]; unpack8(*(const U4*)(kp + 128 + c8 * 8), vv);
#pragma unroll
            for (int e = 0; e < 8; ++e) acc[c8 * 8 + e] += pw * vv[e]; }
        CFENCE();
    }
    const float il = 1.0f / lrun;
#pragma unroll
    for (int c8 = 0; c8 < 8; ++c8) { float o8[8];
#pragma unroll
        for (int e = 0; e < 8; ++e) o8[e] = acc[c8 * 8 + e] * il;
        *(U4*)(qp + c8 * 8) = pack8(o8); }
}
DEVI void phase_mix(const Ctx& cx, const Params& p, int layer) {
    const Views v = make_views(p.ws); const TI ti = thread_info(cx);
#ifdef USE_V1_SCAN
    const long nscan = (long)NB * 4 * 128;
    for (long it = ti.id; it < 2 * nscan; it += ti.n) { if (it < nscan) scan_item<0>(p, v, layer, (int)it); else scan_item<1>(p, v, layer, (int)(it - nscan)); }
#endif
    const long mrows = layer == 0 ? MT : ML;
    for (long it = ti.n - 1 - ti.id; it < mrows * 8; it += ti.n) attn_item(p, v, layer, it >> 3, (int)(it & 7));
}

DEVI void phase_y(const Ctx& cx, const Params& p, int layer) {
    const Views v = make_views(p.ws); const TI ti = thread_info(cx);
    const long mrows = layer == 0 ? MT : ML;
    for (long it = ti.id; it < mrows * 12; it += ti.n) {
        const long m = it / 12; const int r = (int)(it % 12), mix = r >> 2, h = r & 3;
        const bf16_t* zp = v.Z + (size_t)m * 1536 + mix * 512 + h * 128;
        bf16_t* yp = v.Y + ((size_t)mix * MT + m) * 512 + h * 128;
        if (mix == 0) {
            const bf16_t* op = v.PA + (size_t)m * 512 + h * 128; float ss = 0.f;
            for (int d = 0; d < 128; ++d) { const float f = bf2f(op[d]); ss += f * f; }
            const float rs = 1.0f / sqrtf(ss * (1.0f / 128.0f) + EPSF);
            for (int d = 0; d < 128; ++d) yp[d] = f2bf(bf2f(op[d]) * rs * p.a_norm_w[layer * 128 + d] * siluf_(bf2f(zp[d])));
        } else if (mix == 1) {
            const bf16_t* op = v.BQ + (size_t)m * 512 + h * 128;
            for (int d = 0; d < 128; ++d) yp[d] = f2bf(bf2f(op[d]) * siluf_(bf2f(zp[d])));
        } else {
            const bf16_t* op = v.PC + (size_t)m * 512 + h * 128; float s = 0.f;
            for (int d = 0; d < 128; ++d) s += bf2f(op[d]);
            const float mu = s * (1.0f / 128.0f); float q = 0.f;
            for (int d = 0; d < 128; ++d) { const float f = bf2f(op[d]) - mu; q += f * f; }
            const float rs = 1.0f / sqrtf(q * (1.0f / 128.0f) + EPSF);
            for (int d = 0; d < 128; ++d) yp[d] = f2bf((bf2f(op[d]) - mu) * rs * p.c_norm_w[layer * 512 + h * 128 + d] * siluf_(bf2f(zp[d])));
        }
    }
}

DEVI void phase_final(const Ctx& cx, const Params& p) {
    const TI ti = thread_info(cx);
    for (long m = ti.id; m < ML; m += ti.n) {
        float* xr = p.out + (size_t)m * DM; float ss = 0.f;
        for (int k = 0; k < DM; ++k) ss += xr[k] * xr[k];
        const float r = 1.0f / sqrtf(ss * (1.0f / DM) + EPSF);
        for (int k = 0; k < DM; ++k) xr[k] = xr[k] * r * p.final_norm_w[k];
    }
}


DEVI bf16x8 ld8g(const bf16_t* p) { bf16x8 v; __builtin_memcpy(&v, p, 16); return v; }
DEVI bf16x8 ld8l(LQ const unsigned char* p) { return *(LQ const bf16x8*)p; }
DEVI bf16x8 ld44l(LQ const unsigned char* p) { i64x2 t; t[0] = *(LQ const long long*)p; t[1] = *(LQ const long long*)(p + 32); return __builtin_bit_cast(bf16x8, t); }
DEVI f32x4 ld4fl(LQ const unsigned char* p) { return *(LQ const f32x4*)p; }
DEVI bf16x8 packb(const f32x4& x0, const f32x4& x1) { bf16x8 r; r[0] = (short)f2bf(x0[0]); r[1] = (short)f2bf(x0[1]); r[2] = (short)f2bf(x0[2]); r[3] = (short)f2bf(x0[3]); r[4] = (short)f2bf(x1[0]); r[5] = (short)f2bf(x1[1]); r[6] = (short)f2bf(x1[2]); r[7] = (short)f2bf(x1[3]); return r; }
DEVI float wave_incl_scan(float v, int lane) {
#pragma unroll
    for (int d = 1; d < 64; d <<= 1) { const float t = shfl_f(v, lane - d < 0 ? 0 : lane - d); if (lane >= d) v += t; }
    return v;
}
DEVI int chain_row0(int b, int dir, int n) {
    if (n < NCH_C) { const int c = dir ? NCH_C - 1 - n : n; return ML + b * CTXL + 64 * c; }
    int c = n - NCH_C; if (dir) c = NCH_L - 1 - c; return b * SEQ + 64 * c;
}

constexpr int TM_WAVE_BYTES = 16384 + 512;
DEVI void phase_tmat(const Ctx& cx, const Params& p, LQ unsigned char* lds, int layer) {
    const Views v = make_views(p.ws);
    const int wave = RFL(cx.tid >> 6), lane = cx.tid & 63, q = lane >> 4, c = lane & 15;
    LQ unsigned char* wl = lds + wave * TM_WAVE_BYTES;
    LQ float* Am = (LQ float*)wl; LQ float* tab = (LQ float*)(wl + 16384);
    const int nitem = (MT / 64) * 8;
    for (int item = wave * cx.nblk + cx.bid; item < nitem; item += 8 * cx.nblk) {
        const int gchunk = item >> 3, h = (item >> 1) & 3, dir = item & 1; const size_t m0 = (size_t)gchunk * 64;
        { const size_t m = m0 + (dir ? 63 - lane : lane); const float g = v.G[m * 8 + dir * 4 + h], be = v.BETA[m * 8 + dir * 4 + h];
          tab[lane] = wave_incl_scan(g, lane); tab[64 + lane] = be; }
        bf16x8 fr[4][4];
#pragma unroll
        for (int t = 0; t < 4; ++t) { const int row = 16 * t + c; const size_t m = m0 + (dir ? 63 - row : row);
#pragma unroll
            for (int s2 = 0; s2 < 4; ++s2) fr[t][s2] = ld8g(v.AQKV + m * 1536 + 512 + h * 128 + 32 * s2 + 8 * q); }
        WSYNC();
#pragma unroll
        for (int it = 0; it < 4; ++it)
#pragma unroll
            for (int jt = 0; jt <= it; ++jt) {
                f32x4 acc = {0.f, 0.f, 0.f, 0.f};
#pragma unroll
                for (int s2 = 0; s2 < 4; ++s2) acc = MFMA16(fr[it][s2], fr[jt][s2], acc);
                const int col = 16 * jt + c; const float gcol = tab[col];
#pragma unroll
                for (int r = 0; r < 4; ++r) { const int row = 16 * it + 4 * q + r;
                    Am[row * 64 + col] = row > col ? tab[64 + row] * acc[r] * FEXP(tab[row] - gcol) : 0.f; }
            }
        WSYNC();
        float x[64];
#pragma unroll
        for (int i = 0; i < 64; ++i) {
            float sacc = (i == lane) ? 1.f : 0.f;
#pragma unroll
            for (int j4 = 0; j4 < (i + 3) / 4; ++j4) { const f32x4 a4 = ld4fl((LQ const unsigned char*)(Am + i * 64 + j4 * 4));
#pragma unroll
                for (int e = 0; e < 4; ++e) if (4 * j4 + e < i) sacc -= a4[e] * x[4 * j4 + e]; }
            x[i] = sacc;
        }
        WSYNC();
        LQ bf16_t* Ti = (LQ bf16_t*)wl;
#pragma unroll
        for (int i = 0; i < 64; ++i) Ti[i * 64 + lane] = f2bf(x[i]);
        WSYNC();
        bf16_t* Tg = v.T + (size_t)item * 4096;
#pragma unroll
        for (int j = 0; j < 8; ++j) { const int piece = lane + 64 * j; *(U4*)(Tg + piece * 8) = ld16l(wl + piece * 16); }
        WSYNC();
    }
}

constexpr int SC_KB = 0, SC_QB = 17408, SC_TB = 34816, SC_PB = 44032, SC_VB = 53248, SC_SC = 70656, SC_BUF = 71680;
template <int MIX, int DIR> DEVI void scan_chain(const Ctx& cx, const Params& p, const Views& v, LQ unsigned char* lds, int layer, int b, int h, int half) {
    const int tid = cx.tid, wave = RFL(tid >> 6), lane = tid & 63, q = lane >> 4, c = lane & 15;
    const bool helper = wave >= 4; const int ht = tid - 256;
    const bf16_t* QKV = MIX == 0 ? v.AQKV : v.CQKV; bf16_t* PARK = MIX == 0 ? v.PA : v.PC;
    const float lgam = MIX == 1 ? -softplusf_(-p.c_decay[layer * 8 + DIR * 4 + h]) : 0.f;
    U4 kreg[4], qreg[4], treg[2], vreg[2]; float breg = 1.f, greg = 0.f, bsc = 1.f;
    auto hload = [&](int n) {
        const size_t m0 = (size_t)chain_row0(b, DIR, n);
#pragma unroll
        for (int j = 0; j < 4; ++j) { const int piece = ht + 256 * j, row = piece >> 4, c16 = piece & 15; const size_t m = m0 + (DIR ? 63 - row : row);
            kreg[j] = *(const U4*)(QKV + m * 1536 + 512 + h * 128 + c16 * 8); qreg[j] = *(const U4*)(QKV + m * 1536 + h * 128 + c16 * 8); }
        if (MIX == 0) { const bf16_t* Tg = v.T + ((size_t)(m0 / 64) * 8 + h * 2 + DIR) * 4096;
#pragma unroll
            for (int j = 0; j < 2; ++j) treg[j] = *(const U4*)(Tg + (ht + 256 * j) * 8); }
        { const int row = ht & 63, cg = ht >> 6; const size_t m = m0 + (DIR ? 63 - row : row);
          const bf16_t* vp = QKV + m * 1536 + 1024 + h * 128 + 64 * half + 16 * cg; vreg[0] = *(const U4*)vp; vreg[1] = *(const U4*)(vp + 8);
          if (MIX == 0) bsc = v.BETA[m * 8 + DIR * 4 + h]; }
        if (MIX == 0 && wave == 4) { const size_t m = m0 + (DIR ? 63 - ht : ht); greg = v.G[m * 8 + DIR * 4 + h]; breg = v.BETA[m * 8 + DIR * 4 + h]; }
    };
    auto hwrite = [&](int bufi) {
        LQ unsigned char* B = lds + bufi * SC_BUF;
#pragma unroll
        for (int j = 0; j < 4; ++j) { const int piece = ht + 256 * j, row = piece >> 4, c16 = piece & 15;
            st16l(B + SC_KB + row * 272 + c16 * 16, kreg[j]); st16l(B + SC_QB + row * 272 + c16 * 16, qreg[j]); }
        if (MIX == 0) {
#pragma unroll
            for (int j = 0; j < 2; ++j) { const int piece = ht + 256 * j, row = piece >> 3, c8 = piece & 7; st16l(B + SC_TB + row * 144 + c8 * 16, treg[j]); } }
        { const int row = ht & 63, cg = ht >> 6; float f[16]; unpack8(vreg[0], f); unpack8(vreg[1], f + 8);
#pragma unroll
          for (int e = 0; e < 16; ++e) *(LQ float*)(B + SC_VB + (16 * cg + e) * 272 + row * 4) = f[e] * bsc; }
        if (wave == 4) { LQ float* sc = (LQ float*)(B + SC_SC);
            float Gc, g63;
            if (MIX == 0) { Gc = wave_incl_scan(greg, ht); g63 = shfl_f(Gc, 63); } else { Gc = (float)(ht + 1) * lgam; g63 = 64.f * lgam; }
            const float Gam = FEXP(Gc);
            sc[ht] = -breg * Gam; sc[64 + ht] = Gam; sc[128 + ht] = FEXP(g63 - Gc); sc[192 + ht] = Gc; }
    };
    auto hscore = [&](int bufi) {
        LQ unsigned char* B = lds + bufi * SC_BUF; LQ const float* sc = (LQ const float*)(B + SC_SC);
        const int it = wave - 4;
        bf16x8 qf[4];
#pragma unroll
        for (int s2 = 0; s2 < 4; ++s2) qf[s2] = ld8l(B + SC_QB + (16 * it + c) * 272 + (32 * s2 + 8 * q) * 2);
#pragma unroll
        for (int jt = 0; jt < 4; ++jt) {
            if (jt <= it) {
                f32x4 acc = {0.f, 0.f, 0.f, 0.f};
#pragma unroll
                for (int s2 = 0; s2 < 4; ++s2) acc = MFMA16(qf[s2], ld8l(B + SC_KB + (16 * jt + c) * 272 + (32 * s2 + 8 * q) * 2), acc);
                const int col = 16 * jt + c; const float gcol = sc[192 + col];
#pragma unroll
                for (int r = 0; r < 4; ++r) { const int row = 16 * it + 4 * q + r;
                    *(LQ bf16_t*)(B + SC_PB + row * 144 + col * 2) = f2bf(row >= col ? acc[r] * FEXP(sc[192 + row] - gcol) : 0.f); }
            } else if (jt == it + 1 && (it & 1) == 0) {
#pragma unroll
                for (int r = 0; r < 4; ++r) *(LQ bf16_t*)(B + SC_PB + (16 * it + 4 * q + r) * 144 + (16 * jt + c) * 2) = 0;
            }
        }
    };
    if (helper) {
        hload(0); hwrite(0); if (NSTEP > 1) hload(1);
        SYNC();
        for (int n = 0; n < NSTEP; ++n) {
            hscore(n & 1);
            SYNC();
            if (n + 1 < NSTEP) hwrite((n + 1) & 1);
            if (n + 2 < NSTEP) hload(n + 2);
            SYNC();
        }
    } else {
        f32x4 St[8];
#pragma unroll
        for (int t = 0; t < 8; ++t) St[t] = (f32x4){0.f, 0.f, 0.f, 0.f};
        SYNC();
        for (int n = 0; n < NSTEP; ++n) {
            LQ unsigned char* B = lds + (n & 1) * SC_BUF; LQ const float* sc = (LQ const float*)(B + SC_SC);
            f32x4 o[4], vn[4];
            {
                bf16x8 Sb[4];
#pragma unroll
                for (int s2 = 0; s2 < 4; ++s2) Sb[s2] = packb(St[2 * s2], St[2 * s2 + 1]);
                f32x4 R[4];
#pragma unroll
                for (int i = 0; i < 4; ++i) {
                    f32x4 aK = {0.f, 0.f, 0.f, 0.f}, aQ = {0.f, 0.f, 0.f, 0.f};
#pragma unroll
                    for (int s2 = 0; s2 < 4; ++s2) { const int off = (16 * i + c) * 272 + (32 * s2 + 4 * q) * 2;
                        aQ = MFMA16(ld44l(B + SC_QB + off), Sb[s2], aQ);
                        if (MIX == 0) aK = MFMA16(ld44l(B + SC_KB + off), Sb[s2], aK); }
                    const f32x4 Gm = ld4fl(B + SC_SC + (64 + 16 * i + 4 * q) * 4);
                    o[i] = Gm * aQ;
                    const f32x4 Vt = ld4fl(B + SC_VB + (16 * wave + c) * 272 + (16 * i + 4 * q) * 4);
                    if (MIX == 0) { const f32x4 a4 = ld4fl(B + SC_SC + (16 * i + 4 * q) * 4); R[i] = Vt + a4 * aK; } else vn[i] = Vt;
                }
                if (MIX == 0) {
                    bf16x8 Rb[2]; Rb[0] = packb(R[0], R[1]); Rb[1] = packb(R[2], R[3]);
#pragma unroll
                    for (int i = 0; i < 4; ++i) { f32x4 acc = {0.f, 0.f, 0.f, 0.f};
#pragma unroll
                        for (int s2 = 0; s2 <= (i >> 1); ++s2) acc = MFMA16(ld44l(B + SC_TB + (16 * i + c) * 144 + (32 * s2 + 4 * q) * 2), Rb[s2], acc);
                        vn[i] = acc; }
                }
            }
            SYNC();
            {
                bf16x8 vnb[2], veb[2];
                vnb[0] = packb(vn[0], vn[1]); vnb[1] = packb(vn[2], vn[3]);
                { f32x4 ve[4];
#pragma unroll
                  for (int i = 0; i < 4; ++i) ve[i] = ld4fl(B + SC_SC + (128 + 16 * i + 4 * q) * 4) * vn[i];
                  veb[0] = packb(ve[0], ve[1]); veb[1] = packb(ve[2], ve[3]); }
#pragma unroll
                for (int i = 0; i < 4; ++i)
#pragma unroll
                    for (int s2 = 0; s2 <= (i >> 1); ++s2) o[i] = MFMA16(ld44l(B + SC_PB + (16 * i + c) * 144 + (32 * s2 + 4 * q) * 2), vnb[s2], o[i]);
                const float g63 = sc[64 + 63];
#pragma unroll
                for (int t = 0; t < 8; ++t) { f32x4 acc = St[t] * g63;
#pragma unroll
                    for (int s2 = 0; s2 < 2; ++s2) {
                        const s16x4 lo = trread(B + SC_KB + (32 * s2 + 4 * q + (c >> 2)) * 272 + (16 * t + 4 * (c & 3)) * 2);
                        const s16x4 hi = trread(B + SC_KB + (32 * s2 + 16 + 4 * q + (c >> 2)) * 272 + (16 * t + 4 * (c & 3)) * 2);
                        bf16x8 kt; kt[0] = lo[0]; kt[1] = lo[1]; kt[2] = lo[2]; kt[3] = lo[3]; kt[4] = hi[0]; kt[5] = hi[1]; kt[6] = hi[2]; kt[7] = hi[3];
                        acc = MFMA16(kt, veb[s2], acc); }
                    St[t] = acc; }
                const size_t m0 = (size_t)chain_row0(b, DIR, n);
#pragma unroll
                for (int i = 0; i < 4; ++i)
#pragma unroll
                    for (int r = 0; r < 4; ++r) { const int row = 16 * i + 4 * q + r; const size_t m = m0 + (DIR ? 63 - row : row);
                        bf16_t* pp = PARK + m * 512 + h * 128 + 64 * half + 16 * wave + c;
                        *pp = f2bf(DIR == 0 ? o[i][r] : bf2f(*pp) + o[i][r]); }
            }
            SYNC();
        }
    }
}
template <int DIR> DEVI void phase_scan(const Ctx& cx, const Params& p, LQ unsigned char* lds, int layer) {
    const Views v = make_views(p.ws);
    const int nitem = NB * 4 * 2;
    for (int item = cx.bid; item < nitem; item += cx.nblk) scan_chain<0, DIR>(cx, p, v, lds, layer, item >> 3, (item >> 1) & 3, item & 1);
    CFENCE();
    for (int item = (cx.bid + cx.nblk - (nitem % cx.nblk)) % cx.nblk; item < nitem; item += cx.nblk) scan_chain<1, DIR>(cx, p, v, lds, layer, item >> 3, (item >> 1) & 3, item & 1);
}

constexpr int AT_V = 9216, AT_BUF = 18432;
template <bool CTXQ> DEVI void attn_unit(const Ctx& cx, const Params& p, const Views& v, LQ unsigned char* lds, int layer, int b, int hkv, int blk) {
    const int tid = cx.tid, wave = RFL(tid >> 6), lane = tid & 63, q = lane >> 4, c = lane & 15;
    const int g = wave >> 1, rh = wave & 1, hq = 4 * hkv + g;
    const size_t mq0 = (CTXQ ? (size_t)ML + (size_t)b * CTXL : (size_t)b * SEQ) + 64 * blk + 32 * rh;
    bf16x8 qf[2][2];
#pragma unroll
    for (int i = 0; i < 2; ++i)
#pragma unroll
        for (int s2 = 0; s2 < 2; ++s2) qf[i][s2] = ld8g(v.BQ + (mq0 + 16 * i + c) * 512 + hq * 64 + 32 * s2 + 8 * q);
    const int wlo = CTXQ ? 0 : (2 - blk > 0 ? 2 - blk : 0), whi = CTXQ ? 0 : (NCH_L + 2 - blk < 5 ? NCH_L + 2 - blk : 5);
    const int ntile = NCH_C + (whi - wlo);
    const int lrow = tid >> 3, lpc = tid & 7;
    auto tile_row0 = [&](int j, int& tstart) -> size_t { if (j < NCH_C) { tstart = -100000; return (size_t)ML + (size_t)b * CTXL + 64 * j; } tstart = 64 * (blk - 2 + wlo + (j - NCH_C)); return (size_t)b * SEQ + tstart; };
    U4 kreg, vreg;
    auto tload = [&](int j) { int ts; const size_t r0 = tile_row0(j, ts); const bf16_t* src = v.BKV + (r0 + lrow) * 256 + hkv * 64 + lpc * 8; kreg = *(const U4*)src; vreg = *(const U4*)(src + 128); };
    auto twrite = [&](int bufi) { LQ unsigned char* B = lds + bufi * AT_BUF; st16l(B + lrow * 144 + lpc * 16, kreg); st16l(B + AT_V + lrow * 144 + lpc * 16, vreg); };
    float mrun[2], lrun[2]; f32x4 ot[4][2];
    mrun[0] = mrun[1] = p.b_sink[layer * 8 + hq]; lrun[0] = lrun[1] = 1.0f;
#pragma unroll
    for (int dt = 0; dt < 4; ++dt) { ot[dt][0] = (f32x4){0.f, 0.f, 0.f, 0.f}; ot[dt][1] = (f32x4){0.f, 0.f, 0.f, 0.f}; }
    SYNC();
    tload(0); twrite(0);
    SYNC();
    for (int j = 0; j < ntile; ++j) {
        LQ unsigned char* B = lds + (j & 1) * AT_BUF;
        if (j + 1 < ntile) tload(j + 1);
        int tstart; (void)tile_row0(j, tstart);
        f32x4 st[4][2];
#pragma unroll
        for (int kt = 0; kt < 4; ++kt) {
            const bf16x8 k0 = ld8l(B + (16 * kt + c) * 144 + (8 * q) * 2), k1 = ld8l(B + (16 * kt + c) * 144 + (32 + 8 * q) * 2);
#pragma unroll
            for (int i = 0; i < 2; ++i) { f32x4 acc = {0.f, 0.f, 0.f, 0.f}; acc = MFMA16(k0, qf[i][0], acc); acc = MFMA16(k1, qf[i][1], acc); st[kt][i] = acc * 0.125f; }
        }
        if (j >= NCH_C) {
#pragma unroll
            for (int i = 0; i < 2; ++i) { const int tq = 64 * blk + 32 * rh + 16 * i + c;
#pragma unroll
                for (int kt = 0; kt < 4; ++kt)
#pragma unroll
                    for (int r = 0; r < 4; ++r) { const int d = tstart + 16 * kt + 4 * q + r - tq; if (d > 128 || d < -128) st[kt][i][r] = -INFINITY; } }
        }
        bf16x8 pb[2][2];
#pragma unroll
        for (int i = 0; i < 2; ++i) {
            float mx = st[0][i][0];
#pragma unroll
            for (int kt = 0; kt < 4; ++kt)
#pragma unroll
                for (int r = 0; r < 4; ++r) mx = fmaxf(mx, st[kt][i][r]);
            mx = fmaxf(mx, shfl_f(mx, lane ^ 16)); mx = fmaxf(mx, shfl_f(mx, lane ^ 32));
            const float mnew = fmaxf(mrun[i], mx), alpha = FEXP(mrun[i] - mnew);
            float ls = 0.f;
#pragma unroll
            for (int kt = 0; kt < 4; ++kt)
#pragma unroll
                for (int r = 0; r < 4; ++r) { const float e = FEXP(st[kt][i][r] - mnew); st[kt][i][r] = e; ls += e; }
            ls += shfl_f(ls, lane ^ 16); ls += shfl_f(ls, lane ^ 32);
            lrun[i] = lrun[i] * alpha + ls; mrun[i] = mnew;
#pragma unroll
            for (int dt = 0; dt < 4; ++dt) ot[dt][i] = ot[dt][i] * alpha;
            pb[i][0] = packb(st[0][i], st[1][i]); pb[i][1] = packb(st[2][i], st[3][i]);
        }
#pragma unroll
        for (int dt = 0; dt < 4; ++dt)
#pragma unroll
            for (int ks = 0; ks < 2; ++ks) {
                const s16x4 lo = trread(B + AT_V + (32 * ks + 4 * q + (c >> 2)) * 144 + (16 * dt + 4 * (c & 3)) * 2);
                const s16x4 hi = trread(B + AT_V + (32 * ks + 16 + 4 * q + (c >> 2)) * 144 + (16 * dt + 4 * (c & 3)) * 2);
                bf16x8 vt; vt[0] = lo[0]; vt[1] = lo[1]; vt[2] = lo[2]; vt[3] = lo[3]; vt[4] = hi[0]; vt[5] = hi[1]; vt[6] = hi[2]; vt[7] = hi[3];
                ot[dt][0] = MFMA16(vt, pb[0][ks], ot[dt][0]); ot[dt][1] = MFMA16(vt, pb[1][ks], ot[dt][1]);
            }
        if (j + 1 < ntile) twrite((j + 1) & 1);
        SYNC();
    }
#pragma unroll
    for (int i = 0; i < 2; ++i) { const float il = 1.0f / lrun[i];
#pragma unroll
        for (int dt = 0; dt < 4; ++dt) { const f32x4 o4 = ot[dt][i] * il;
            unsigned long long w = (unsigned long long)pk2(o4[0], o4[1]) | ((unsigned long long)pk2(o4[2], o4[3]) << 32);
            *(unsigned long long*)(v.BQ + (mq0 + 16 * i + c) * 512 + hq * 64 + 16 * dt + 4 * q) = w; } }
}
DEVI void phase_attn(const Ctx& cx, const Params& p, LQ unsigned char* lds, int layer) {
    const Views v = make_views(p.ws);
    const int nlat = NB * 2 * NCH_L, nctx = layer == 0 ? NB * 2 * NCH_C : 0;
    for (int item = cx.bid; item < nlat + nctx; item += cx.nblk) {
        if (item < nlat) attn_unit<false>(cx, p, v, lds, layer, item / (2 * NCH_L), (item / NCH_L) & 1, item % NCH_L);
        else { const int it = item - nlat; attn_unit<true>(cx, p, v, lds, layer, it / (2 * NCH_C), (it / NCH_C) & 1, it % NCH_C); }
    }
}

struct StG1 { bf16_t *AQKV, *BQ, *BKV, *CQKV, *HALO;
    DEVI void st8(int row, int col, const float* a) const {
        bf16_t* dst = col < 1536 ? AQKV + (size_t)row * 1536 + col : (col < 2048 ? BQ + (size_t)row * 512 + (col - 1536) : (col < 2304 ? BKV + (size_t)row * 256 + (col - 2048) : CQKV + (size_t)row * 1536 + (col - 2304)));
        const U4 w = pack8(a); *(U4*)dst = w;
        const int r64 = row & 63;
        if (col < 1536 && (r64 < 2 || r64 >= 62)) *(U4*)(HALO + ((size_t)(row >> 6) * 4 + (r64 < 2 ? r64 : r64 - 60)) * 1536 + col) = w; } };
struct StPlain { bf16_t* O; int ld;
    DEVI void st8(int row, int col, const float* a) const { *(U4*)(O + (size_t)row * ld + col) = pack8(a); } };
struct StMerge { const bf16_t* L; bf16_t* MRG; int br;
    DEVI void st8(int row, int col, const float* a) const {
        float lg[8], o[8]; unpack8(*(const U4*)(L + (size_t)row * NMG + br * 1024 + col), lg);
        if (br) unpack8(*(const U4*)(MRG + (size_t)row * DM + col), o); else { for (int e = 0; e < 8; ++e) o[e] = 0.f; }
        for (int e = 0; e < 8; ++e) o[e] += sigmoidf_(lg[e]) * a[e];
        *(U4*)(MRG + (size_t)row * DM + col) = pack8(o); } };
struct StResid { const float *xlat, *xctx; float *olat, *octx; const float* mod;
    DEVI void st4(int row, int col, const float* a) const {
        const float* xi = row < ML ? xlat + (size_t)row * DM + col : xctx + (size_t)(row - ML) * DM + col;
        float* xo = row < ML ? olat + (size_t)row * DM + col : octx + (size_t)(row - ML) * DM + col;
        const int b = row < ML ? row / SEQ : NB; const float* g = mod + (size_t)b * 3072 + 2048 + col;
        for (int e = 0; e < 4; ++e) xo[e] = xi[e] + g[e] * a[e]; } };

#ifndef CPU_EMU
namespace pg8 {
#define PG8_LAS __attribute__((address_space(3)))
typedef short bf16x8 __attribute__((ext_vector_type(8)));
typedef float f32x4 __attribute__((ext_vector_type(4)));
constexpr int BM = 256, BK = 64, HALF = 128, HTB = HALF * BK * 2, STAGE_BYTES = 8 * HTB, NXCD = 8, WGM = 8;
__host__ __device__ __forceinline__ int lds_byte(int r, int c) { const int st = (r >> 4) * 2 + (c >> 5), rr = r & 15, cc = c & 31, ob = rr * 64 + cc * 2; return st * 1024 + (ob ^ (((ob >> 9) & 1) << 5)); }
__host__ __device__ __forceinline__ void stage_rc(int b, int& R, int& C) { const int st = b / 1024, sb = b % 1024, swz = sb ^ (((sb >> 9) & 1) << 5); R = (st >> 1) * 16 + swz / 64; C = (st & 1) * 32 + (swz % 64) / 2; }
__host__ __device__ __forceinline__ int perm32(int rho) { const int n = rho >> 4, i = rho & 15; return 8 * (i >> 2) + 4 * n + (i & 3); }
struct Unit { int pm, pn; };
struct Gemm { const bf16_t* A; const bf16_t* Bt; int M, N, K; };
struct StaticOrder {
    int nM, nN, nwg, G, c;
    __host__ __device__ void init(int M, int N, int G_, int c_) { nM = M / BM; nN = N / BM; nwg = nM * nN; G = G_; c = c_; }
    __host__ __device__ bool next(int i, Unit& u) const {
        const long L = (long)i * G + c; if (L >= nwg) return false;
        int wgid = (int)L; { const int q = nwg / NXCD, r = nwg % NXCD, xcd = wgid % NXCD, off = wgid / NXCD; wgid = (xcd < r ? xcd * (q + 1) : r * (q + 1) + (xcd - r) * q) + off; }
        const int nig = WGM * nN, gid = wgid / nig, fm = gid * WGM, gsz = (nM - fm) < WGM ? (nM - fm) : WGM;
        u.pm = fm + ((wgid % nig) % gsz); u.pn = (wgid % nig) / gsz; return true;
    }
    __device__ __forceinline__ void a_ready(const Unit&) const {}
    __device__ __forceinline__ void done(const Unit&) const {}
};
template <class F> struct Epi8 {
    static constexpr bool PERM = true, AFTER_DRAIN = false; F f;
    __device__ __forceinline__ void operator()(const f32x4 (&acc)[2][2][4][2], const Unit& u, int wr, int wc, int fr, int fq) const {
        const int row0 = u.pm * BM + wr * 64 + fr, col0 = u.pn * BM + wc * 32 + 8 * fq;
#pragma unroll
        for (int ai = 0; ai < 2; ++ai)
#pragma unroll
            for (int m = 0; m < 4; ++m)
#pragma unroll
                for (int bj = 0; bj < 2; ++bj) { const f32x4 v0 = acc[ai][bj][m][0], v1 = acc[ai][bj][m][1];
                    const float a[8] = {v0[0], v0[1], v0[2], v0[3], v1[0], v1[1], v1[2], v1[3]};
                    f.st8(row0 + ai * HALF + m * 16, col0 + bj * HALF, a); }
    }
};
template <class F> struct Epi4 {
    static constexpr bool PERM = false, AFTER_DRAIN = false; F f;
    __device__ __forceinline__ void operator()(const f32x4 (&acc)[2][2][4][2], const Unit& u, int wr, int wc, int fr, int fq) const {
        const int row0 = u.pm * BM + wr * 64 + fr, col0 = u.pn * BM + wc * 32 + 4 * fq;
#pragma unroll
        for (int ai = 0; ai < 2; ++ai)
#pragma unroll
            for (int m = 0; m < 4; ++m)
#pragma unroll
                for (int bj = 0; bj < 2; ++bj)
#pragma unroll
                    for (int n = 0; n < 2; ++n) { const f32x4 v0 = acc[ai][bj][m][n]; const float a[4] = {v0[0], v0[1], v0[2], v0[3]};
                        f.st4(row0 + ai * HALF + m * 16, col0 + bj * HALF + n * 16, a); }
    }
};

template <class Epi, class Sched, bool ALIGN_EPI = false, bool SP2 = false>
__device__ __forceinline__ void gemm_phase(PG8_LAS unsigned char* lds, const int tid, const Gemm g, const Sched& S, const Epi& E) {
    const int wid = __builtin_amdgcn_readfirstlane(tid >> 6), lane = tid & 63, wr = wid >> 2, wc = wid & 3, fr = lane & 15, fq = lane >> 4;
    const int K = g.K, nt = K / BK;
    unsigned voffA[2], voffB[2];
#pragma unroll
    for (int i = 0; i < 2; ++i) { int R, C; stage_rc(tid * 16 + i * 8192, R, C); const int Rb = Epi::PERM ? ((R & ~31) + perm32(R & 31)) : R;
        voffA[i] = (unsigned)(R * K + C) * 2u; voffB[i] = (unsigned)(Rb * K + C) * 2u; }
    const size_t kstep = (size_t)(BK * 2);
    const size_t hstep = (size_t)HALF * K * 2;
    const size_t tstep = 2 * hstep;
    const unsigned ldsw = (unsigned)wid * 1024u;
    const int aoff = lds_byte(wr * 64 + fr, fq * 8), boff = lds_byte(wc * 32 + fr, fq * 8);
#define PG8_SA(b, h) (((b) * 2 + (h)) * HTB)
#define PG8_SB(b, h) ((4 + (b) * 2 + (h)) * HTB)
#define PG8_STAGE(bufoff, gbase, voff) do { _Pragma("unroll") for (int _i = 0; _i < 2; ++_i) \
        __builtin_amdgcn_global_load_lds((const unsigned*)((const char*)(gbase) + (voff)[_i]), (PG8_LAS unsigned*)(lds + (bufoff) + ldsw + _i * 8192), 16, 0, 0); } while (0)
#define PG8_LDA(dst, b, h) do { _Pragma("unroll") for (int m = 0; m < 4; ++m) _Pragma("unroll") for (int k = 0; k < 2; ++k) dst[m][k] = *(const PG8_LAS bf16x8*)(lds + PG8_SA(b, h) + aoff + m * 2048 + k * 1024); } while (0)
#define PG8_LDB(dst, b, h) do { _Pragma("unroll") for (int n = 0; n < 2; ++n) _Pragma("unroll") for (int k = 0; k < 2; ++k) dst[n][k] = *(const PG8_LAS bf16x8*)(lds + PG8_SB(b, h) + boff + n * 2048 + k * 1024); } while (0)
#define PG8_MMA(ai, bj, At, Bt) do { __builtin_amdgcn_s_setprio(1); _Pragma("unroll") for (int m = 0; m < 4; ++m) _Pragma("unroll") for (int n = 0; n < 2; ++n) _Pragma("unroll") for (int k = 0; k < 2; ++k) \
        acc[ai][bj][m][n] = __builtin_amdgcn_mfma_f32_16x16x32_bf16(Bt[n][k], At[m][k], acc[ai][bj][m][n], 0, 0, 0); __builtin_amdgcn_s_setprio(0); } while (0)
#define PG8_WAIT_V(n) asm volatile("s_waitcnt vmcnt(" #n ")" ::: "memory")
#define PG8_WAIT_L(n) asm volatile("s_waitcnt lgkmcnt(" #n ")" ::: "memory")
#define PG8_BAR __builtin_amdgcn_s_barrier()
#define PG8_SCHED __builtin_amdgcn_sched_barrier(0)
    Unit cur, nxt; int ui = 0;
    if (!S.next(0, cur)) return;
    f32x4 acc[2][2][4][2];
#pragma unroll
    for (int a = 0; a < 2; ++a)
#pragma unroll
        for (int b = 0; b < 2; ++b)
#pragma unroll
            for (int m = 0; m < 4; ++m)
#pragma unroll
                for (int n = 0; n < 2; ++n) acc[a][b][m][n] = (f32x4){0.f, 0.f, 0.f, 0.f};
    bf16x8 At[4][2], B0[2][2], B1[2][2];
    const char* cA = (const char*)g.A + (size_t)cur.pm * tstep; const char* cB = (const char*)g.Bt + (size_t)cur.pn * tstep;
    S.a_ready(cur);
    if constexpr (SP2) {
        PG8_STAGE(PG8_SB(0, 0), cB, voffB); PG8_STAGE(PG8_SB(0, 1), cB + hstep, voffB); PG8_STAGE(PG8_SA(0, 0), cA, voffA); PG8_STAGE(PG8_SA(0, 1), cA + hstep, voffA);
        if (wr == 1) PG8_BAR;
        PG8_WAIT_V(2); PG8_BAR;
        PG8_STAGE(PG8_SB(1, 0), cB + kstep, voffB); PG8_STAGE(PG8_SA(1, 0), cA + kstep, voffA); PG8_STAGE(PG8_SB(1, 1), cB + hstep + kstep, voffB);
        PG8_WAIT_V(6); PG8_BAR;
    } else {
        PG8_STAGE(PG8_SB(0, 0), cB, voffB); PG8_STAGE(PG8_SA(0, 0), cA, voffA); PG8_STAGE(PG8_SB(0, 1), cB + hstep, voffB); PG8_STAGE(PG8_SA(0, 1), cA + hstep, voffA);
        if (wr == 1) PG8_BAR;
        PG8_WAIT_V(4); PG8_BAR;
        PG8_STAGE(PG8_SB(1, 0), cB + kstep, voffB); PG8_STAGE(PG8_SA(1, 0), cA + kstep, voffA); PG8_STAGE(PG8_SB(1, 1), cB + hstep + kstep, voffB);
        PG8_WAIT_V(6); PG8_BAR;
    }
    for (;;) {
        const bool has_next = S.next(ui + 1, nxt);
        const char* nA = has_next ? (const char*)g.A + (size_t)nxt.pm * tstep : cA; const char* nB = has_next ? (const char*)g.Bt + (size_t)nxt.pn * tstep : cB;
        for (int t = 0; t < nt; t += 2) {
            const bool last = (t == nt - 2);
            const char* a1 = cA + (size_t)(t + 1) * kstep;
            const char* a2 = last ? nA : cA + (size_t)(t + 2) * kstep; const char* b2 = last ? nB : cB + (size_t)(t + 2) * kstep;
            const char* a3 = a2 + kstep; const char* b3 = b2 + kstep;
            if (last && has_next) S.a_ready(nxt);
            if constexpr (SP2) {
            PG8_LDB(B0, 0, 0); PG8_LDB(B1, 0, 1); PG8_SCHED; PG8_LDA(At, 0, 0); PG8_STAGE(PG8_SA(1, 1), a1 + hstep, voffA);
            PG8_WAIT_V(8); PG8_WAIT_L(0); PG8_BAR; PG8_MMA(0, 0, At, B0); PG8_MMA(0, 1, At, B1); PG8_BAR; PG8_SCHED;
            PG8_LDA(At, 0, 1); PG8_STAGE(PG8_SB(0, 0), b2, voffB); PG8_STAGE(PG8_SB(0, 1), b2 + hstep, voffB); PG8_STAGE(PG8_SA(0, 0), a2, voffA);
            PG8_WAIT_V(8); PG8_WAIT_L(0); PG8_BAR; PG8_MMA(1, 0, At, B0); PG8_MMA(1, 1, At, B1); PG8_BAR; PG8_SCHED;
            PG8_LDB(B0, 1, 0); PG8_LDB(B1, 1, 1); PG8_SCHED; PG8_LDA(At, 1, 0); PG8_STAGE(PG8_SA(0, 1), a2 + hstep, voffA);
            PG8_WAIT_V(8); PG8_WAIT_L(0); PG8_BAR; PG8_MMA(0, 0, At, B0); PG8_MMA(0, 1, At, B1); PG8_BAR; PG8_SCHED;
            PG8_LDA(At, 1, 1); PG8_STAGE(PG8_SB(1, 0), b3, voffB); PG8_STAGE(PG8_SB(1, 1), b3 + hstep, voffB); PG8_STAGE(PG8_SA(1, 0), a3, voffA);
            PG8_WAIT_V(8); PG8_WAIT_L(0); PG8_BAR; PG8_MMA(1, 0, At, B0); PG8_MMA(1, 1, At, B1); PG8_BAR; PG8_SCHED;
            } else {
            PG8_LDB(B0, 0, 0); PG8_SCHED; PG8_LDA(At, 0, 0); PG8_STAGE(PG8_SA(1, 1), a1 + hstep, voffA);
            PG8_WAIT_L(8); PG8_BAR; PG8_WAIT_L(0); PG8_MMA(0, 0, At, B0); PG8_BAR; PG8_SCHED;
            PG8_LDB(B1, 0, 1); PG8_STAGE(PG8_SB(0, 0), b2, voffB);
            PG8_BAR; PG8_WAIT_L(0); PG8_MMA(0, 1, At, B1); PG8_BAR;
            PG8_LDA(At, 0, 1); PG8_STAGE(PG8_SA(0, 0), a2, voffA);
            PG8_BAR; PG8_WAIT_L(0); PG8_MMA(1, 0, At, B0); PG8_BAR; PG8_SCHED;
            PG8_STAGE(PG8_SB(0, 1), b2 + hstep, voffB);
            PG8_WAIT_V(6); PG8_BAR; PG8_MMA(1, 1, At, B1); PG8_BAR;
            PG8_LDB(B0, 1, 0); PG8_SCHED; PG8_LDA(At, 1, 0); PG8_STAGE(PG8_SA(0, 1), a2 + hstep, voffA);
            PG8_WAIT_L(8); PG8_BAR; PG8_WAIT_L(0); PG8_MMA(0, 0, At, B0); PG8_BAR; PG8_SCHED;
            PG8_LDB(B1, 1, 1); PG8_STAGE(PG8_SB(1, 0), b3, voffB);
            PG8_BAR; PG8_WAIT_L(0); PG8_MMA(0, 1, At, B1); PG8_BAR;
            PG8_LDA(At, 1, 1); PG8_STAGE(PG8_SA(1, 0), a3, voffA);
            PG8_BAR; PG8_WAIT_L(0); PG8_MMA(1, 0, At, B0); PG8_BAR; PG8_SCHED;
            PG8_STAGE(PG8_SB(1, 1), b3 + hstep, voffB);
            PG8_WAIT_V(6); PG8_BAR; PG8_MMA(1, 1, At, B1); PG8_BAR;
            }
        }
        if constexpr (ALIGN_EPI) { if (wr == 0) PG8_BAR; }
        if constexpr (!Epi::AFTER_DRAIN) { E(acc, cur, wr, wc, fr, fq); S.done(cur); }
        if (!has_next) break;
#pragma unroll
        for (int a = 0; a < 2; ++a)
#pragma unroll
            for (int b = 0; b < 2; ++b)
#pragma unroll
                for (int m = 0; m < 4; ++m)
#pragma unroll
                    for (int n = 0; n < 2; ++n) acc[a][b][m][n] = (f32x4){0.f, 0.f, 0.f, 0.f};
        cur = nxt; cA = nA; cB = nB; ++ui;
        if constexpr (ALIGN_EPI) { if (wr == 1) PG8_BAR; }
    }
    PG8_WAIT_V(0);
    if constexpr (!ALIGN_EPI) { if (wr == 0) PG8_BAR; }
    PG8_BAR;
#undef PG8_SA
#undef PG8_SB
#undef PG8_STAGE
#undef PG8_LDA
#undef PG8_LDB
#undef PG8_MMA
#undef PG8_WAIT_V
#undef PG8_WAIT_L
#undef PG8_BAR
#undef PG8_SCHED
}
}

template <class F> __device__ __forceinline__ void run_gemm8(PG8_LAS unsigned char* lds, const Ctx& cx, const bf16_t* A, const bf16_t* Bt, int M, int N, int K, const F& f) {
    pg8::Gemm g{A, Bt, M, N, K}; pg8::StaticOrder S; S.init(M, N, cx.nblk, cx.bid);
    pg8::Epi8<F> E{f};
    pg8::gemm_phase<pg8::Epi8<F>, pg8::StaticOrder, true, true>(lds, cx.tid, g, S, E);
}
template <class F> __device__ __forceinline__ void run_gemm4(PG8_LAS unsigned char* lds, const Ctx& cx, const bf16_t* A, const bf16_t* Bt, int M, int N, int K, const F& f) {
    pg8::Gemm g{A, Bt, M, N, K}; pg8::StaticOrder S; S.init(M, N, cx.nblk, cx.bid);
    pg8::Epi4<F> E{f};
    pg8::gemm_phase<pg8::Epi4<F>, pg8::StaticOrder, true, true>(lds, cx.tid, g, S, E);
}
#else
template <class F> void run_gemm8(unsigned char*, const Ctx&, const bf16_t* A, const bf16_t* Bt, int M, int N, int K, const F& f) {
#pragma omp parallel for schedule(dynamic, 8)
    for (int r = 0; r < M; ++r) for (int c0 = 0; c0 < N; c0 += 8) { float a[8];
        for (int e = 0; e < 8; ++e) { float s = 0.f; const bf16_t* ar = A + (size_t)r * K; const bf16_t* br = Bt + (size_t)(c0 + e) * K; for (int k = 0; k < K; ++k) s += bf2f(ar[k]) * bf2f(br[k]); a[e] = s; }
        f.st8(r, c0, a); }
}
template <class F> void run_gemm4(unsigned char*, const Ctx&, const bf16_t* A, const bf16_t* Bt, int M, int N, int K, const F& f) {
#pragma omp parallel for schedule(dynamic, 8)
    for (int r = 0; r < M; ++r) for (int c0 = 0; c0 < N; c0 += 4) { float a[4];
        for (int e = 0; e < 4; ++e) { float s = 0.f; const bf16_t* ar = A + (size_t)r * K; const bf16_t* br = Bt + (size_t)(c0 + e) * K; for (int k = 0; k < K; ++k) s += bf2f(ar[k]) * bf2f(br[k]); a[e] = s; }
        f.st4(r, c0, a); }
}
#endif

constexpr int PPL = 14;
constexpr int NPHASE = 2 + PPL * NLAYER;
template <int PH> DEVI void run_phase_t(LQ unsigned char* lds, const Ctx& cx, const Params& p) {
    const Views v = make_views(p.ws);
    if constexpr (PH == 0) { phase_prep(cx, p); }
    else if constexpr (PH == NPHASE - 1) { phase_final(cx, p); }
    else {
        constexpr int layer = (PH - 1) / PPL, s = (PH - 1) % PPL;
        constexpr int mrows = layer == NLAYER - 1 ? ML : MT;
        if constexpr (s == 0) phase_norm(cx, p, layer);
        else if constexpr (s == 1) run_gemm8(lds, cx, v.XN, v.W1 + (size_t)layer * N1 * DM, MT, N1, DM, StG1{v.AQKV, v.BQ, v.BKV, v.CQKV, v.HALO});
        else if constexpr (s == 2) phase_conv(cx, p, layer);
        else if constexpr (s == 3) phase_prep2(cx, p, layer);
        else if constexpr (s == 4) { phase_tmat(cx, p, lds, layer); phase_attn(cx, p, lds, layer); }
        else if constexpr (s == 5) phase_scan<0>(cx, p, lds, layer);
        else if constexpr (s == 6) phase_scan<1>(cx, p, lds, layer);
        else if constexpr (s == 7) run_gemm8(lds, cx, v.XN, v.WZ + (size_t)layer * NZ * DM, mrows, NZ, DM, StPlain{v.Z, NZ});
        else if constexpr (s == 8) phase_y(cx, p, layer);
        else if constexpr (s == 9) run_gemm8(lds, cx, v.XN, v.WM + (size_t)layer * NMG * DM, mrows, NMG, DM, StPlain{v.L, NMG});
        else if constexpr (s >= 10 && s <= 12) { constexpr int br = s - 10;
            run_gemm8(lds, cx, v.Y + (size_t)br * MT * 512, v.WB + ((size_t)layer * 3 + br) * DM * 512, mrows, DM, 512, StMerge{v.L, v.MRG, br}); }
        else run_gemm4(lds, cx, v.MRG, v.WO + (size_t)layer * DM * DM, mrows, DM, DM,
                       StResid{layer == 0 ? p.x : p.out, layer == 0 ? p.ctx : v.CTX1, p.out, v.CTX1, v.MOD + (size_t)layer * (NB + 1) * 3072});
    }
}
HD bool phase_is_gemm(int ph) { if (ph == 0 || ph == NPHASE - 1) return false; const int s = (ph - 1) % PPL; return s == 1 || s == 7 || s >= 9; }
#define MK_PHASE_LIST(X) X(0) X(1) X(2) X(3) X(4) X(5) X(6) X(7) X(8) X(9) X(10) X(11) X(12) X(13) X(14) X(15) X(16) X(17) X(18) X(19) X(20) X(21) X(22) X(23) X(24) X(25) X(26) X(27) X(28) X(29)
static_assert(NPHASE == 30, "phase list");
#ifdef CPU_EMU
inline void run_phase(unsigned char* lds, const Ctx& cx, const Params& p, int ph) {
    switch (ph) {
#define X(k) case k: run_phase_t<k>(lds, cx, p); break;
        MK_PHASE_LIST(X)
#undef X
    }
}
#endif

#ifndef CPU_EMU
constexpr int LDS_BYTES = 147456;
__global__ void __launch_bounds__(512, 2) mk_fwd(Params p) {
    extern __shared__ __attribute__((aligned(16))) unsigned char lds_raw[];
    PG8_LAS unsigned char* lds = (PG8_LAS unsigned char*)lds_raw;
    cg::grid_group grid = cg::this_grid();
    const int ph_lo = p.ph_lo, ph_hi = p.ph_hi;
#define X(k) if (ph_lo <= k && k < ph_hi) { \
        const Params* q = (const Params*)__builtin_amdgcn_kernarg_segment_ptr(); asm volatile("" : "+s"(q) :: "memory"); \
        Ctx cx; cx.tid = (int)threadIdx.x; cx.bid = (int)blockIdx.x; cx.nblk = (int)gridDim.x; \
        asm volatile("" : "+v"(cx.tid)); asm volatile("" : "+s"(cx.bid), "+s"(cx.nblk)); \
        run_phase_t<k>(lds, cx, *q); \
        if (k + 1 < ph_hi) grid.sync(); }
    MK_PHASE_LIST(X)
#undef X
}

#ifndef MK_SINGLE
#define MK_SINGLE 1
#endif
extern "C" void kernel_launch(void* const* d_in, const int* in_sizes, int n_in, void* d_out, int out_size, void* d_ws, size_t ws_size, hipStream_t stream) {
    static int grid = 0;
    if (grid == 0) {
        if (n_in != 18 || in_sizes[0] != ML * DM || out_size != ML * DM || ws_size < WS_END) { fprintf(stderr, "kernel_launch: unexpected shapes (n_in %d, in0 %d, out %d, ws %zu < %zu)\n", n_in, n_in > 0 ? in_sizes[0] : -1, out_size, ws_size, (size_t)WS_END); grid = -1; return; }
        int dev = 0, cus = 0, per_cu = 0;
        if (hipGetDevice(&dev) != hipSuccess || hipDeviceGetAttribute(&cus, hipDeviceAttributeMultiprocessorCount, dev) != hipSuccess) { grid = -1; return; }
        if (hipFuncSetAttribute((const void*)mk_fwd, hipFuncAttributeMaxDynamicSharedMemorySize, LDS_BYTES) != hipSuccess) { fprintf(stderr, "kernel_launch: hipFuncSetAttribute failed\n"); grid = -1; return; }
        if (hipOccupancyMaxActiveBlocksPerMultiprocessor(&per_cu, (const void*)mk_fwd, 512, LDS_BYTES) != hipSuccess || per_cu < 1) { fprintf(stderr, "kernel_launch: occupancy query says %d\n", per_cu); (void)hipGetLastError(); grid = -1; return; }
        grid = cus;
    }
    if (grid < 0) return;
    Params p{};
    const float** pp = (const float**)&p;
    for (int i = 0; i < 18; ++i) pp[i] = (const float*)d_in[i];
    p.out = (float*)d_out; p.ws = (unsigned char*)d_ws;
#if MK_SINGLE
    p.ph_lo = 0; p.ph_hi = NPHASE;
    { void* args[] = {&p}; hipError_t e = hipLaunchCooperativeKernel((const void*)mk_fwd, dim3(grid), dim3(512), args, LDS_BYTES, stream);
      if (e != hipSuccess) fprintf(stderr, "cooperative launch failed: %s\n", hipGetErrorString(e)); }
#else
    for (int ph = 0; ph < NPHASE; ++ph) {
        p.ph_lo = ph; p.ph_hi = ph + 1;
        void* args[] = {&p}; hipError_t e = hipLaunchCooperativeKernel((const void*)mk_fwd, dim3(grid), dim3(512), args, LDS_BYTES, stream);
        if (e != hipSuccess) { fprintf(stderr, "cooperative launch %d failed: %s\n", ph, hipGetErrorString(e)); break; }
    }
#endif
}
#endif
```

```cpp
#ifndef CPU_EMU
#include <hip/hip_runtime.h>
#include <hip/hip_cooperative_groups.h>
#include <cstdio>
#include <cstdint>
namespace cg = cooperative_groups;
#define DEVI __device__ __forceinline__
#define HD __host__ __device__ __forceinline__
#define CFENCE() asm volatile("" ::: "memory")
#define LAUNDER(x) asm volatile("" : "+v"(x))
#else
#define CFENCE() do {} while (0)
#define LAUNDER(x) do {} while (0)
#include <cstring>
#include <cmath>
#include <cstdio>
#include <cstdint>
#include <cstddef>
#define DEVI inline
#define HD inline
#endif

#ifndef CPU_EMU
#define LQ __attribute__((address_space(3)))
typedef short bf16x8 __attribute__((ext_vector_type(8)));
typedef float f32x4 __attribute__((ext_vector_type(4)));
typedef short s16x4 __attribute__((ext_vector_type(4)));
typedef long long i64x2 __attribute__((ext_vector_type(2)));
typedef unsigned u32x4 __attribute__((ext_vector_type(4)));
#define MFMA16(a, b, c) __builtin_amdgcn_mfma_f32_16x16x32_bf16(a, b, c, 0, 0, 0)
#define SYNC() __syncthreads()
#define WSYNC() __builtin_amdgcn_wave_barrier()
__device__ __forceinline__ s16x4 trread(LQ const unsigned char* p) { return __builtin_bit_cast(s16x4, __builtin_amdgcn_ds_read_tr16_b64_v4i16((LQ s16x4*)p)); }
__device__ __forceinline__ float shfl_f(float v, int src) { return __shfl(v, src, 64); }
#define RFL(x) __builtin_amdgcn_readfirstlane(x)
#define FEXP(x) __expf(x)
#else
#define LQ
using simt::bf16x8; using simt::f32x4; using simt::s16x4;
typedef long long i64x2 __attribute__((vector_size(16)));
typedef unsigned u32x4 __attribute__((vector_size(16)));
#define MFMA16(a, b, c) simt::mfma16(a, b, c)
#define SYNC() simt::syncthreads()
#define WSYNC() ((void)simt::shfl(0.f, 0))
inline s16x4 trread(const unsigned char* p) { return simt::tr16_b64(p); }
inline float shfl_f(float v, int src) { return simt::shfl(v, src); }
#define RFL(x) (x)
#define FEXP(x) expf(x)
#endif

#ifndef NB
#define NB 8
#endif
#ifndef SEQ
#define SEQ 4096
#endif
#ifndef CTXL
#define CTXL 256
#endif
constexpr int DM = 1024, INW = 8464, GRIDW = 64;
constexpr int ML = NB * SEQ, MC = NB * CTXL, MT = ML + MC;
constexpr int N1 = 3840;
constexpr int NZ = 1536;
constexpr int NMG = 3072;
constexpr float EPSF = 1e-6f;
constexpr int NLAYER = 2;
static_assert(MT % 256 == 0 && ML % 256 == 0, "row tiles");
constexpr int NCH_C = CTXL / 64, NCH_L = SEQ / 64, NSTEP = NCH_C + NCH_L;

typedef unsigned short bf16_t;
struct alignas(16) U4 { unsigned x, y, z, w; };
DEVI void st16l(LQ unsigned char* p, const U4& w) { u32x4 t; t[0] = w.x; t[1] = w.y; t[2] = w.z; t[3] = w.w; *(LQ u32x4*)p = t; }
DEVI U4 ld16l(LQ const unsigned char* p) { const u32x4 t = *(LQ const u32x4*)p; U4 w; w.x = t[0]; w.y = t[1]; w.z = t[2]; w.w = t[3]; return w; }

constexpr size_t MiB = 1u << 20;
constexpr size_t al1(size_t x) { return (x + MiB - 1) & ~(MiB - 1); }
constexpr size_t WS_CTL = 0;
constexpr size_t WS_MOD = 256 * 1024;
constexpr size_t WS_WAB = 512 * 1024;
constexpr size_t WS_TAX = 640 * 1024;
constexpr size_t WS_W1 = 1 * MiB;
constexpr size_t WS_WZ = WS_W1 + al1((size_t)2 * N1 * DM * 2);
constexpr size_t WS_WM = WS_WZ + al1((size_t)2 * NZ * DM * 2);
constexpr size_t WS_WB = WS_WM + al1((size_t)2 * NMG * DM * 2);
constexpr size_t WS_WO = WS_WB + al1((size_t)2 * 3 * DM * 512 * 2);
constexpr size_t WS_G = WS_WO + al1((size_t)2 * DM * DM * 2);
constexpr size_t WS_BETA = WS_G + al1((size_t)MT * 8 * 4);
constexpr size_t WS_CTX1 = WS_BETA + al1((size_t)MT * 8 * 4);
constexpr size_t WS_XN = WS_CTX1 + al1((size_t)MC * DM * 4);
constexpr size_t WS_AQKV = WS_XN + al1((size_t)MT * DM * 2);
constexpr size_t WS_CQKV = WS_AQKV + al1((size_t)MT * 1536 * 2);
constexpr size_t WS_BQ = WS_CQKV + al1((size_t)MT * 1536 * 2);
constexpr size_t WS_BKV = WS_BQ + al1((size_t)MT * 512 * 2);
constexpr size_t WS_PA = WS_BKV + al1((size_t)MT * 256 * 2);
constexpr size_t WS_PC = WS_PA + al1((size_t)MT * 512 * 2);
constexpr size_t WS_T = WS_PC + al1((size_t)MT * 512 * 2);
constexpr size_t WS_HALO = WS_T + al1((size_t)(MT / 64) * 8 * 8192);
constexpr size_t WS_TRET = WS_HALO + al1((size_t)(MT / 64) * 4 * 1536 * 2);
constexpr size_t WS_END = WS_TRET + al1((size_t)2 * SEQ * 64 * 4);
static_assert(WS_CQKV + (size_t)MT * NMG * 2 <= WS_END, "L overlay");
static_assert(WS_END <= (size_t)512 * MiB, "workspace");

struct Params {
    const float *x, *c, *ctx, *c_ctx, *w_ada, *b_ada, *norm_w, *w_in, *a_conv_w, *a_log, *a_dt_bias, *a_norm_w, *b_sink, *c_decay, *c_norm_w, *w_branch, *w_out, *final_norm_w;
    float* out; unsigned char* ws;
    int ph_lo, ph_hi;
};

#ifdef CPU_EMU
inline float u2f(unsigned u) { float f; memcpy(&f, &u, 4); return f; }
inline unsigned f2u(float f) { unsigned u; memcpy(&u, &f, 4); return u; }
#else
DEVI float u2f(unsigned u) { return __uint_as_float(u); }
DEVI unsigned f2u(float f) { return __float_as_uint(f); }
#endif
DEVI float bf2f(bf16_t h) { return u2f((unsigned)h << 16); }
DEVI bf16_t f2bf(float f) { unsigned u = f2u(f); return (bf16_t)((u + 0x7fffu + ((u >> 16) & 1u)) >> 16); }
DEVI unsigned pk2(float lo, float hi) { return (unsigned)f2bf(lo) | ((unsigned)f2bf(hi) << 16); }
DEVI float lo16(unsigned w) { return u2f(w << 16); }
DEVI float hi16(unsigned w) { return u2f(w & 0xffff0000u); }
DEVI float sigmoidf_(float x) { return 1.0f / (1.0f + expf(-x)); }
DEVI float siluf_(float x) { return x / (1.0f + expf(-x)); }
DEVI float softplusf_(float x) { return x > 20.f ? x : log1pf(expf(x)); }
DEVI void unpack8(const U4& w, float* v) { v[0] = lo16(w.x); v[1] = hi16(w.x); v[2] = lo16(w.y); v[3] = hi16(w.y); v[4] = lo16(w.z); v[5] = hi16(w.z); v[6] = lo16(w.w); v[7] = hi16(w.w); }
DEVI U4 pack8(const float* v) { U4 w; w.x = pk2(v[0], v[1]); w.y = pk2(v[2], v[3]); w.z = pk2(v[4], v[5]); w.w = pk2(v[6], v[7]); return w; }

struct Ctx { int tid, bid, nblk; };
struct TI { long id, n; };
DEVI TI thread_info(const Ctx& c) {
    const int wave = c.tid >> 6, lane = c.tid & 63;
    return TI{((long)wave * c.nblk + c.bid) * 64 + lane, (long)c.nblk * 512};
}

struct Views {
    float *MOD, *WAB, *TAX, *TRET; bf16_t *W1, *WZ, *WM, *WB, *WO; float *G, *BETA, *CTX1; bf16_t *XN, *AQKV, *CQKV, *BQ, *BKV, *PA, *PC, *Y, *Z, *L, *MRG, *T, *HALO;
};
DEVI Views make_views(unsigned char* ws) {
    Views v;
    v.MOD = (float*)(ws + WS_MOD); v.WAB = (float*)(ws + WS_WAB); v.TAX = (float*)(ws + WS_TAX); v.TRET = (float*)(ws + WS_TRET); v.W1 = (bf16_t*)(ws + WS_W1); v.WZ = (bf16_t*)(ws + WS_WZ); v.WM = (bf16_t*)(ws + WS_WM); v.WB = (bf16_t*)(ws + WS_WB); v.WO = (bf16_t*)(ws + WS_WO);
    v.G = (float*)(ws + WS_G); v.BETA = (float*)(ws + WS_BETA); v.CTX1 = (float*)(ws + WS_CTX1);
    v.XN = (bf16_t*)(ws + WS_XN); v.AQKV = (bf16_t*)(ws + WS_AQKV); v.CQKV = (bf16_t*)(ws + WS_CQKV); v.BQ = (bf16_t*)(ws + WS_BQ); v.BKV = (bf16_t*)(ws + WS_BKV);
    v.PA = (bf16_t*)(ws + WS_PA); v.PC = (bf16_t*)(ws + WS_PC); v.Y = v.AQKV; v.Z = v.CQKV; v.L = v.CQKV; v.MRG = v.XN; v.T = (bf16_t*)(ws + WS_T); v.HALO = (bf16_t*)(ws + WS_HALO);
    return v;
}

HD int map_g1(int n) { return n < 1536 ? n : (n < 2048 ? 2064 + (n - 1536) : (n < 2304 ? 2576 + (n - 2048) : 3344 + (n - 2304))); }
HD int map_z(int n) { return n < 512 ? 1536 + n : (n < 1024 ? 2832 + (n - 512) : 4880 + (n - 1024)); }

DEVI float wave_sum(float v, int lane) {
#pragma unroll
    for (int o = 32; o >= 1; o >>= 1) v += shfl_f(v, lane ^ o);
    return v;
}
template <int W> DEVI float grp_sum(float v, int lane) {
#pragma unroll
    for (int o = W / 2; o >= 1; o >>= 1) v += shfl_f(v, lane ^ o);
    return v;
}
DEVI f32x4 ldg4(const float* p) { f32x4 v; __builtin_memcpy(&v, p, 16); return v; }
DEVI void stg4(float* p, const f32x4& v) { __builtin_memcpy(p, &v, 16); }

DEVI void prep_tile(const Ctx& cx, LQ unsigned char* lds, const float* src, int ld, int srccol0, int k0, bf16_t* dst, int K, int n0) {
    LQ float* tl = (LQ float*)lds; const int tid = cx.tid;
    { const int r = tid >> 4, c4 = (tid & 15) * 4;
#pragma unroll
      for (int rr = 0; rr < 64; rr += 32) { const f32x4 w = ldg4(src + (size_t)(k0 + r + rr) * ld + srccol0 + c4);
#pragma unroll
          for (int e = 0; e < 4; ++e) tl[(r + rr) * 65 + c4 + e] = w[e]; } }
    SYNC();
    { const int n = tid >> 3, kc = (tid & 7) * 8; float a[8];
#pragma unroll
      for (int e = 0; e < 8; ++e) a[e] = tl[(kc + e) * 65 + n];
      *(U4*)(dst + (size_t)(n0 + n) * K + k0 + kc) = pack8(a); }
    SYNC();
}
DEVI void phase_prep(const Ctx& cx, const Params& p, LQ unsigned char* lds) {
    const Views v = make_views(p.ws); const TI ti = thread_info(cx);
    constexpr int T1 = (N1 / 64) * 16, TZ = (NZ / 64) * 16, TM = (NMG / 64) * 16, TB = 3 * 16 * 8, TO = 16 * 16, TL = T1 + TZ + TM + TB + TO;
    for (int t = cx.bid; t < NLAYER * TL; t += cx.nblk) {
        const int l = t / TL; int r = t % TL;
        const float* win = p.w_in + (size_t)l * DM * INW;
        if (r < T1) { const int nt = r / 16, kt = r % 16; prep_tile(cx, lds, win, INW, map_g1(nt * 64), kt * 64, v.W1 + (size_t)l * N1 * DM, DM, nt * 64); continue; } r -= T1;
        if (r < TZ) { const int nt = r / 16, kt = r % 16; prep_tile(cx, lds, win, INW, map_z(nt * 64), kt * 64, v.WZ + (size_t)l * NZ * DM, DM, nt * 64); continue; } r -= TZ;
        if (r < TM) { const int nt = r / 16, kt = r % 16; prep_tile(cx, lds, win, INW, 5392 + nt * 64, kt * 64, v.WM + (size_t)l * NMG * DM, DM, nt * 64); continue; } r -= TM;
        if (r < TB) { const int br = r / 128, r2 = r % 128, nt = r2 / 8, kt = r2 % 8; prep_tile(cx, lds, p.w_branch + ((size_t)l * 3 + br) * 512 * DM, DM, nt * 64, kt * 64, v.WB + ((size_t)l * 3 + br) * DM * 512, 512, nt * 64); continue; } r -= TB;
        { const int nt = r / 16, kt = r % 16; prep_tile(cx, lds, p.w_out + (size_t)l * DM * DM, DM, nt * 64, kt * 64, v.WO + (size_t)l * DM * DM, DM, nt * 64); }
    }
    long tb = ti.id; LAUNDER(tb);
    for (long i = tb; i < (long)NLAYER * 16 * DM; i += ti.n) { const int l = (int)(i / (16 * DM)), j = (int)((i / DM) % 16), k = (int)(i % DM); v.WAB[i] = p.w_in[((size_t)l * DM + k) * INW + 2048 + j]; }
    LAUNDER(tb);
    for (long i = tb; i < 64 * 16; i += ti.n) { const int pos = (int)(i >> 4), f = (int)(i & 15); const float ang = (float)pos * powf(10000.0f, -(float)f / 16.0f); v.TAX[i] = cosf(ang); v.TAX[1024 + i] = sinf(ang); }
    LAUNDER(tb);
    for (long i = tb; i < (long)SEQ * 64; i += ti.n) { const int pos = (int)(i >> 6), f = (int)(i & 63); const float ang = (float)pos * powf(10000.0f, -(float)f / 64.0f); v.TRET[i] = cosf(ang); v.TRET[(size_t)SEQ * 64 + i] = sinf(ang); }
    const long nmod = (long)NLAYER * (NB + 1) * 3072;
    LAUNDER(tb);
    for (long i = tb; i < nmod; i += ti.n) {
        const int l = (int)(i / ((NB + 1) * 3072)), rem = (int)(i % ((NB + 1) * 3072)), b = rem / 3072, n = rem % 3072;
        const float* cv = b < NB ? p.c + (size_t)b * DM : p.c_ctx;
        const float* w = p.w_ada + (size_t)l * DM * 3072 + n;
        float acc = 0.f;
#pragma unroll 8
        for (int k = 0; k < DM; ++k) { const float cvk = cv[k]; acc += (cvk / (1.0f + FEXP(-cvk))) * w[(size_t)k * 3072]; }
        v.MOD[i] = acc + p.b_ada[l * 3072 + n];
    }
}

DEVI const float* xrow_in(const Params& p, const Views& v, int layer, int m) {
    if (layer == 0) return m < ML ? p.x + (size_t)m * DM : p.ctx + (size_t)(m - ML) * DM;
    return m < ML ? p.out + (size_t)m * DM : v.CTX1 + (size_t)(m - ML) * DM;
}
DEVI void phase_norm(const Ctx& cx, const Params& p, int layer) {
    const Views v = make_views(p.ws);
    const int wave = RFL(cx.tid >> 6), lane = cx.tid & 63;
    const float* nw = p.norm_w + layer * DM; const float* wab = v.WAB + (size_t)layer * 16 * DM;
    for (int m = wave * cx.nblk + cx.bid; m < MT; m += 8 * cx.nblk) {
        const float* xr = xrow_in(p, v, layer, m);
        const int b = m < ML ? m / SEQ : NB;
        const float* mod = v.MOD + ((size_t)layer * (NB + 1) + b) * 3072;
        f32x4 xv[4]; float ss = 0.f;
#pragma unroll
        for (int j = 0; j < 4; ++j) { xv[j] = ldg4(xr + 256 * j + 4 * lane); ss += xv[j][0] * xv[j][0] + xv[j][1] * xv[j][1] + xv[j][2] * xv[j][2] + xv[j][3] * xv[j][3]; }
        ss = wave_sum(ss, lane);
        const float r = 1.0f / sqrtf(ss * (1.0f / DM) + EPSF);
#pragma unroll
        for (int j = 0; j < 4; ++j) { const int k0 = 256 * j + 4 * lane; const f32x4 n4 = ldg4(nw + k0), s4 = ldg4(mod + 1024 + k0), h4 = ldg4(mod + k0);
#pragma unroll
            for (int e = 0; e < 4; ++e) xv[j][e] = xv[j][e] * r * n4[e] * (1.0f + s4[e]) + h4[e];
            unsigned long long w = (unsigned long long)pk2(xv[j][0], xv[j][1]) | ((unsigned long long)pk2(xv[j][2], xv[j][3]) << 32);
            *(unsigned long long*)(v.XN + (size_t)m * DM + k0) = w; }
        float mine = 0.f;
#pragma unroll 2
        for (int jj = 0; jj < 16; ++jj) { float a = 0.f;
#pragma unroll
            for (int j = 0; j < 4; ++j) { const f32x4 w4 = ldg4(wab + jj * DM + 256 * j + 4 * lane); a += xv[j][0] * w4[0] + xv[j][1] * w4[1] + xv[j][2] * w4[2] + xv[j][3] * w4[3]; }
            a = wave_sum(a, lane); if (lane == jj) mine = a; }
        if (lane < 8) v.BETA[(size_t)m * 8 + lane] = sigmoidf_(mine);
        else if (lane < 16) v.G[(size_t)m * 8 + lane - 8] = -expf(p.a_log[layer * 8 + lane - 8]) * softplusf_(mine + p.a_dt_bias[layer * 8 + lane - 8]);
    }
}

DEVI void phase_conv(const Ctx& cx, const Params& p, int layer) {
    const Views v = make_views(p.ws); const TI ti = thread_info(cx);
    const float* cw = p.a_conv_w + (size_t)layer * 5 * 1536;
    for (long it = ti.id; it < (long)(MT / 64) * 1536; it += ti.n) {
        const int gch = (int)(it / 1536), c = (int)(it % 1536);
        const bool lat = gch < ML / 64; const int ci = lat ? gch % NCH_L : (gch - ML / 64) % NCH_C; const bool first = ci == 0, last = ci == (lat ? NCH_L : NCH_C) - 1;
        bf16_t* col = v.AQKV + (size_t)gch * 64 * 1536 + c;
        const float w0 = cw[c], w1 = cw[1536 + c], w2 = cw[2 * 1536 + c], w3 = cw[3 * 1536 + c], w4 = cw[4 * 1536 + c];
        float xv[68];
        xv[0] = first ? 0.f : bf2f(v.HALO[((size_t)(gch - 1) * 4 + 2) * 1536 + c]); xv[1] = first ? 0.f : bf2f(v.HALO[((size_t)(gch - 1) * 4 + 3) * 1536 + c]);
        xv[66] = last ? 0.f : bf2f(v.HALO[((size_t)(gch + 1) * 4 + 0) * 1536 + c]); xv[67] = last ? 0.f : bf2f(v.HALO[((size_t)(gch + 1) * 4 + 1) * 1536 + c]);
#pragma unroll
        for (int t = 0; t < 64; ++t) xv[2 + t] = bf2f(col[(size_t)t * 1536]);
#pragma unroll
        for (int t = 0; t < 64; ++t) { const float y = w0 * xv[t] + w1 * xv[t + 1] + w2 * xv[t + 2] + w3 * xv[t + 3] + w4 * xv[t + 4];
            col[(size_t)t * 1536] = f2bf(y / (1.0f + FEXP(-y))); }
    }
}

DEVI void phase_prep2(const Ctx& cx, const Params& p, int layer) {
    const Views v = make_views(p.ws);
    const int wave = RFL(cx.tid >> 6), lane = cx.tid & 63;
    for (int m = wave * cx.nblk + cx.bid; m < MT; m += 8 * cx.nblk) {
        {
            bf16_t* ptr = v.AQKV + (size_t)m * 1536 + 16 * lane; float f[16]; unpack8(*(const U4*)ptr, f); unpack8(*(const U4*)(ptr + 8), f + 8);
            float ss = 0.f;
#pragma unroll
            for (int e = 0; e < 16; ++e) ss += f[e] * f[e];
            ss = grp_sum<8>(ss, lane);
            const float sc = (1.0f / sqrtf(ss + EPSF)) * (lane < 32 ? 0.08838834764831845f : 1.0f);
#pragma unroll
            for (int e = 0; e < 16; ++e) f[e] *= sc;
            *(U4*)ptr = pack8(f); *(U4*)(ptr + 8) = pack8(f + 8);
        }
        if (m < ML && lane < 40) {
            const int t = m % SEQ, hh = lane >> 2, pu = lane & 3, half = pu >> 1, ch = pu & 1; const int pos = half == 0 ? t / GRIDW : t % GRIDW;
            bf16_t* ptr = (hh < 8 ? v.BQ + (size_t)m * 512 + hh * 64 : v.BKV + (size_t)m * 256 + (hh - 8) * 64) + half * 32 + ch * 8;
            float x1[8], x2[8]; unpack8(*(const U4*)ptr, x1); unpack8(*(const U4*)(ptr + 16), x2);
            const float* cs = v.TAX + pos * 16 + ch * 8; const float* sn = cs + 1024;
#pragma unroll
            for (int e = 0; e < 8; ++e) { const float a = x1[e], bb = x2[e]; x1[e] = a * cs[e] - bb * sn[e]; x2[e] = a * sn[e] + bb * cs[e]; }
            *(U4*)ptr = pack8(x1); *(U4*)(ptr + 16) = pack8(x2);
        }
        {
            const int which = lane >> 5, h = (lane >> 3) & 3, pu = lane & 7;
            bf16_t* ptr = v.CQKV + (size_t)m * 1536 + which * 512 + h * 128 + pu * 8;
            const float sc = which == 1 ? 0.08838834764831845f : 1.0f;
            if (m < ML) {
                float x1[8], x2[8]; unpack8(*(const U4*)ptr, x1); unpack8(*(const U4*)(ptr + 64), x2);
                const float* cs = v.TRET + (size_t)(m % SEQ) * 64 + pu * 8; const float* sn = cs + (size_t)SEQ * 64;
#pragma unroll
                for (int e = 0; e < 8; ++e) { const float a = x1[e] * sc, bb = x2[e] * sc; x1[e] = a * cs[e] - bb * sn[e]; x2[e] = a * sn[e] + bb * cs[e]; }
                *(U4*)ptr = pack8(x1); *(U4*)(ptr + 64) = pack8(x2);
            } else if (which == 1) {
                float x1[8], x2[8]; unpack8(*(const U4*)ptr, x1); unpack8(*(const U4*)(ptr + 64), x2);
#pragma unroll
                for (int e = 0; e < 8; ++e) { x1[e] *= sc; x2[e] *= sc; }
                *(U4*)ptr = pack8(x1); *(U4*)(ptr + 64) = pack8(x2);
            }
        }
    }
}

DEVI void phase_y(const Ctx& cx, const Params& p, int layer) {
    const Views v = make_views(p.ws);
    const int wave = RFL(cx.tid >> 6), lane = cx.tid & 63;
    const int mrows = layer == 0 ? MT : ML;
    for (int m = wave * cx.nblk + cx.bid; m < mrows; m += 8 * cx.nblk) {
        const int c0 = 8 * lane; float o[8], z[8], y[8];
        {   unpack8(*(const U4*)(v.PA + (size_t)m * 512 + c0), o); unpack8(*(const U4*)(v.Z + (size_t)m * 1536 + c0), z);
            float ss = 0.f;
#pragma unroll
            for (int e = 0; e < 8; ++e) ss += o[e] * o[e];
            ss = grp_sum<16>(ss, lane); const float rs = 1.0f / sqrtf(ss * (1.0f / 128.0f) + EPSF);
            const float* w = p.a_norm_w + layer * 128 + (c0 & 127);
#pragma unroll
            for (int e = 0; e < 8; ++e) y[e] = o[e] * rs * w[e] * (z[e] / (1.0f + FEXP(-z[e])));
            *(U4*)(v.Y + (size_t)m * 512 + c0) = pack8(y); }
        {   unpack8(*(const U4*)(v.BQ + (size_t)m * 512 + c0), o); unpack8(*(const U4*)(v.Z + (size_t)m * 1536 + 512 + c0), z);
#pragma unroll
            for (int e = 0; e < 8; ++e) y[e] = o[e] * (z[e] / (1.0f + FEXP(-z[e])));
            *(U4*)(v.Y + ((size_t)MT + m) * 512 + c0) = pack8(y); }
        {   unpack8(*(const U4*)(v.PC + (size_t)m * 512 + c0), o); unpack8(*(const U4*)(v.Z + (size_t)m * 1536 + 1024 + c0), z);
            float sm = 0.f;
#pragma unroll
            for (int e = 0; e < 8; ++e) sm += o[e];
            const float mu = grp_sum<16>(sm, lane) * (1.0f / 128.0f); float qv = 0.f;
#pragma unroll
            for (int e = 0; e < 8; ++e) { o[e] -= mu; qv += o[e] * o[e]; }
            const float rs = 1.0f / sqrtf(grp_sum<16>(qv, lane) * (1.0f / 128.0f) + EPSF);
            const float* w = p.c_norm_w + layer * 512 + c0;
#pragma unroll
            for (int e = 0; e < 8; ++e) y[e] = o[e] * rs * w[e] * (z[e] / (1.0f + FEXP(-z[e])));
            *(U4*)(v.Y + ((size_t)2 * MT + m) * 512 + c0) = pack8(y); }
    }
}

DEVI void phase_final(const Ctx& cx, const Params& p) {
    const int wave = RFL(cx.tid >> 6), lane = cx.tid & 63;
    for (int m = wave * cx.nblk + cx.bid; m < ML; m += 8 * cx.nblk) {
        float* xr = p.out + (size_t)m * DM; f32x4 xv[4]; float ss = 0.f;
#pragma unroll
        for (int j = 0; j < 4; ++j) { xv[j] = ldg4(xr + 256 * j + 4 * lane); ss += xv[j][0] * xv[j][0] + xv[j][1] * xv[j][1] + xv[j][2] * xv[j][2] + xv[j][3] * xv[j][3]; }
        ss = wave_sum(ss, lane);
        const float r = 1.0f / sqrtf(ss * (1.0f / DM) + EPSF);
#pragma unroll
        for (int j = 0; j < 4; ++j) { const f32x4 w4 = ldg4(p.final_norm_w + 256 * j + 4 * lane); f32x4 o4;
#pragma unroll
            for (int e = 0; e < 4; ++e) o4[e] = xv[j][e] * r * w4[e];
            stg4(xr + 256 * j + 4 * lane, o4); }
    }
}

DEVI bf16x8 ld8g(const bf16_t* p) { bf16x8 v; __builtin_memcpy(&v, p, 16); return v; }
DEVI bf16x8 ld8l(LQ const unsigned char* p) { return *(LQ const bf16x8*)p; }
DEVI bf16x8 ld44l(LQ const unsigned char* p) { i64x2 t; t[0] = *(LQ const long long*)p; t[1] = *(LQ const long long*)(p + 32); return __builtin_bit_cast(bf16x8, t); }
DEVI f32x4 ld4fl(LQ const unsigned char* p) { return *(LQ const f32x4*)p; }
DEVI bf16x8 packb(const f32x4& x0, const f32x4& x1) { bf16x8 r; r[0] = (short)f2bf(x0[0]); r[1] = (short)f2bf(x0[1]); r[2] = (short)f2bf(x0[2]); r[3] = (short)f2bf(x0[3]); r[4] = (short)f2bf(x1[0]); r[5] = (short)f2bf(x1[1]); r[6] = (short)f2bf(x1[2]); r[7] = (short)f2bf(x1[3]); return r; }
DEVI float wave_incl_scan(float v, int lane) {
#pragma unroll
    for (int d = 1; d < 64; d <<= 1) { const float t = shfl_f(v, lane - d < 0 ? 0 : lane - d); if (lane >= d) v += t; }
    return v;
}
DEVI int chain_row0(int b, int dir, int n) {
    if (n < NCH_C) { const int c = dir ? NCH_C - 1 - n : n; return ML + b * CTXL + 64 * c; }
    int c = n - NCH_C; if (dir) c = NCH_L - 1 - c; return b * SEQ + 64 * c;
}

constexpr int TM_WAVE_BYTES = 16384 + 512;
DEVI void phase_tmat(const Ctx& cx, const Params& p, LQ unsigned char* lds, int layer) {
    const Views v = make_views(p.ws);
    const int wave = RFL(cx.tid >> 6), lane = cx.tid & 63, q = lane >> 4, c = lane & 15;
    LQ unsigned char* wl = lds + wave * TM_WAVE_BYTES;
    LQ float* Am = (LQ float*)wl; LQ float* tab = (LQ float*)(wl + 16384);
    const int nitem = (MT / 64) * 8;
    for (int item = wave * cx.nblk + cx.bid; item < nitem; item += 8 * cx.nblk) {
        const int gchunk = item >> 3, h = (item >> 1) & 3, dir = item & 1; const size_t m0 = (size_t)gchunk * 64;
        { const size_t m = m0 + (dir ? 63 - lane : lane); const float g = v.G[m * 8 + dir * 4 + h], be = v.BETA[m * 8 + dir * 4 + h];
          tab[lane] = wave_incl_scan(g, lane); tab[64 + lane] = be; }
        bf16x8 fr[4][4];
#pragma unroll
        for (int t = 0; t < 4; ++t) { const int row = 16 * t + c; const size_t m = m0 + (dir ? 63 - row : row);
#pragma unroll
            for (int s2 = 0; s2 < 4; ++s2) fr[t][s2] = ld8g(v.AQKV + m * 1536 + 512 + h * 128 + 32 * s2 + 8 * q); }
        WSYNC();
#pragma unroll
        for (int it = 0; it < 4; ++it)
#pragma unroll
            for (int jt = 0; jt <= it; ++jt) {
                f32x4 acc = {0.f, 0.f, 0.f, 0.f};
#pragma unroll
                for (int s2 = 0; s2 < 4; ++s2) acc = MFMA16(fr[it][s2], fr[jt][s2], acc);
                const int col = 16 * jt + c; const float gcol = tab[col];
#pragma unroll
                for (int r = 0; r < 4; ++r) { const int row = 16 * it + 4 * q + r;
                    Am[row * 64 + col] = row > col ? tab[64 + row] * acc[r] * FEXP(tab[row] - gcol) : 0.f; }
            }
        WSYNC();
        float x[64];
#pragma unroll
        for (int i = 0; i < 64; ++i) {
            float sacc = (i == lane) ? 1.f : 0.f;
#pragma unroll
            for (int j4 = 0; j4 < (i + 3) / 4; ++j4) { const f32x4 a4 = ld4fl((LQ const unsigned char*)(Am + i * 64 + j4 * 4));
#pragma unroll
                for (int e = 0; e < 4; ++e) if (4 * j4 + e < i) sacc -= a4[e] * x[4 * j4 + e]; }
            x[i] = sacc;
        }
        WSYNC();
        LQ bf16_t* Ti = (LQ bf16_t*)wl;
#pragma unroll
        for (int i = 0; i < 64; ++i) Ti[i * 64 + lane] = f2bf(x[i]);
        WSYNC();
        bf16_t* Tg = v.T + (size_t)item * 4096;
#pragma unroll
        for (int j = 0; j < 8; ++j) { const int piece = lane + 64 * j; *(U4*)(Tg + piece * 8) = ld16l(wl + piece * 16); }
        WSYNC();
    }
}

constexpr int SC_KB = 0, SC_QB = 17408, SC_TB = 34816, SC_PB = 44032, SC_VB = 53248, SC_SC = 70656, SC_BUF = 71680;
template <int MIX, int DIR> DEVI void scan_chain(const Ctx& cx, const Params& p, const Views& v, LQ unsigned char* lds, int layer, int b, int h, int half) {
    const int tid = cx.tid, wave = RFL(tid >> 6), lane = tid & 63, q = lane >> 4, c = lane & 15;
    const bool helper = wave >= 4; const int ht = tid - 256;
    const bf16_t* QKV = MIX == 0 ? v.AQKV : v.CQKV; bf16_t* PARK = MIX == 0 ? v.PA : v.PC;
    const float lgam = MIX == 1 ? -softplusf_(-p.c_decay[layer * 8 + DIR * 4 + h]) : 0.f;
    U4 kreg[4], qreg[4], treg[2], vreg[2]; float breg = 1.f, greg = 0.f, bsc = 1.f;
    auto hload = [&](int n) {
        const size_t m0 = (size_t)chain_row0(b, DIR, n);
#pragma unroll
        for (int j = 0; j < 4; ++j) { const int piece = ht + 256 * j, row = piece >> 4, c16 = piece & 15; const size_t m = m0 + (DIR ? 63 - row : row);
            kreg[j] = *(const U4*)(QKV + m * 1536 + 512 + h * 128 + c16 * 8); qreg[j] = *(const U4*)(QKV + m * 1536 + h * 128 + c16 * 8); }
        if (MIX == 0) { const bf16_t* Tg = v.T + ((size_t)(m0 / 64) * 8 + h * 2 + DIR) * 4096;
#pragma unroll
            for (int j = 0; j < 2; ++j) treg[j] = *(const U4*)(Tg + (ht + 256 * j) * 8); }
        { const int row = ht & 63, cg = ht >> 6; const size_t m = m0 + (DIR ? 63 - row : row);
          const bf16_t* vp = QKV + m * 1536 + 1024 + h * 128 + 64 * half + 16 * cg; vreg[0] = *(const U4*)vp; vreg[1] = *(const U4*)(vp + 8);
          if (MIX == 0) bsc = v.BETA[m * 8 + DIR * 4 + h]; }
        if (MIX == 0 && wave == 4) { const size_t m = m0 + (DIR ? 63 - ht : ht); greg = v.G[m * 8 + DIR * 4 + h]; breg = v.BETA[m * 8 + DIR * 4 + h]; }
    };
    auto hwrite = [&](int bufi) {
        LQ unsigned char* B = lds + bufi * SC_BUF;
#pragma unroll
        for (int j = 0; j < 4; ++j) { const int piece = ht + 256 * j, row = piece >> 4, c16 = piece & 15;
            st16l(B + SC_KB + row * 272 + c16 * 16, kreg[j]); st16l(B + SC_QB + row * 272 + c16 * 16, qreg[j]); }
        if (MIX == 0) {
#pragma unroll
            for (int j = 0; j < 2; ++j) { const int piece = ht + 256 * j, row = piece >> 3, c8 = piece & 7; st16l(B + SC_TB + row * 144 + c8 * 16, treg[j]); } }
        { const int row = ht & 63, cg = ht >> 6; float f[16]; unpack8(vreg[0], f); unpack8(vreg[1], f + 8);
#pragma unroll
          for (int e = 0; e < 16; ++e) *(LQ float*)(B + SC_VB + (16 * cg + e) * 272 + row * 4) = f[e] * bsc; }
        if (wave == 4) { LQ float* sc = (LQ float*)(B + SC_SC);
            float Gc, g63;
            if (MIX == 0) { Gc = wave_incl_scan(greg, ht); g63 = shfl_f(Gc, 63); } else { Gc = (float)(ht + 1) * lgam; g63 = 64.f * lgam; }
            const float Gam = FEXP(Gc);
            sc[ht] = -breg * Gam; sc[64 + ht] = Gam; sc[128 + ht] = FEXP(g63 - Gc); sc[192 + ht] = Gc; }
    };
    auto hscore = [&](int bufi) {
        LQ unsigned char* B = lds + bufi * SC_BUF; LQ const float* sc = (LQ const float*)(B + SC_SC);
        const int it = wave - 4;
        bf16x8 qf[4];
#pragma unroll
        for (int s2 = 0; s2 < 4; ++s2) qf[s2] = ld8l(B + SC_QB + (16 * it + c) * 272 + (32 * s2 + 8 * q) * 2);
#pragma unroll
        for (int jt = 0; jt < 4; ++jt) {
            if (jt <= it) {
                f32x4 acc = {0.f, 0.f, 0.f, 0.f};
#pragma unroll
                for (int s2 = 0; s2 < 4; ++s2) acc = MFMA16(qf[s2], ld8l(B + SC_KB + (16 * jt + c) * 272 + (32 * s2 + 8 * q) * 2), acc);
                const int col = 16 * jt + c; const float gcol = sc[192 + col];
#pragma unroll
                for (int r = 0; r < 4; ++r) { const int row = 16 * it + 4 * q + r;
                    *(LQ bf16_t*)(B + SC_PB + row * 144 + col * 2) = f2bf(row >= col ? acc[r] * FEXP(sc[192 + row] - gcol) : 0.f); }
            } else if (jt == it + 1 && (it & 1) == 0) {
#pragma unroll
                for (int r = 0; r < 4; ++r) *(LQ bf16_t*)(B + SC_PB + (16 * it + 4 * q + r) * 144 + (16 * jt + c) * 2) = 0;
            }
        }
    };
    if (helper) {
        hload(0); hwrite(0); if (NSTEP > 1) hload(1);
        SYNC();
        for (int n = 0; n < NSTEP; ++n) {
            hscore(n & 1);
            SYNC();
            if (n + 1 < NSTEP) hwrite((n + 1) & 1);
            if (n + 2 < NSTEP) hload(n + 2);
            SYNC();
        }
    } else {
        f32x4 St[8];
#pragma unroll
        for (int t = 0; t < 8; ++t) St[t] = (f32x4){0.f, 0.f, 0.f, 0.f};
        SYNC();
        for (int n = 0; n < NSTEP; ++n) {
            LQ unsigned char* B = lds + (n & 1) * SC_BUF; LQ const float* sc = (LQ const float*)(B + SC_SC);
            f32x4 o[4], vn[4];
            {
                bf16x8 Sb[4];
#pragma unroll
                for (int s2 = 0; s2 < 4; ++s2) Sb[s2] = packb(St[2 * s2], St[2 * s2 + 1]);
                f32x4 R[4];
#pragma unroll
                for (int i = 0; i < 4; ++i) {
                    f32x4 aK = {0.f, 0.f, 0.f, 0.f}, aQ = {0.f, 0.f, 0.f, 0.f};
#pragma unroll
                    for (int s2 = 0; s2 < 4; ++s2) { const int off = (16 * i + c) * 272 + (32 * s2 + 4 * q) * 2;
                        aQ = MFMA16(ld44l(B + SC_QB + off), Sb[s2], aQ);
                        if (MIX == 0) aK = MFMA16(ld44l(B + SC_KB + off), Sb[s2], aK); }
                    const f32x4 Gm = ld4fl(B + SC_SC + (64 + 16 * i + 4 * q) * 4);
                    o[i] = Gm * aQ;
                    const f32x4 Vt = ld4fl(B + SC_VB + (16 * wave + c) * 272 + (16 * i + 4 * q) * 4);
                    if (MIX == 0) { const f32x4 a4 = ld4fl(B + SC_SC + (16 * i + 4 * q) * 4); R[i] = Vt + a4 * aK; } else vn[i] = Vt;
                }
                if (MIX == 0) {
                    bf16x8 Rb[2]; Rb[0] = packb(R[0], R[1]); Rb[1] = packb(R[2], R[3]);
#pragma unroll
                    for (int i = 0; i < 4; ++i) { f32x4 acc = {0.f, 0.f, 0.f, 0.f};
#pragma unroll
                        for (int s2 = 0; s2 <= (i >> 1); ++s2) acc = MFMA16(ld44l(B + SC_TB + (16 * i + c) * 144 + (32 * s2 + 4 * q) * 2), Rb[s2], acc);
                        vn[i] = acc; }
                }
            }
            SYNC();
            {
                bf16x8 vnb[2], veb[2];
                vnb[0] = packb(vn[0], vn[1]); vnb[1] = packb(vn[2], vn[3]);
                { f32x4 ve[4];
#pragma unroll
                  for (int i = 0; i < 4; ++i) ve[i] = ld4fl(B + SC_SC + (128 + 16 * i + 4 * q) * 4) * vn[i];
                  veb[0] = packb(ve[0], ve[1]); veb[1] = packb(ve[2], ve[3]); }
#pragma unroll
                for (int i = 0; i < 4; ++i)
#pragma unroll
                    for (int s2 = 0; s2 <= (i >> 1); ++s2) o[i] = MFMA16(ld44l(B + SC_PB + (16 * i + c) * 144 + (32 * s2 + 4 * q) * 2), vnb[s2], o[i]);
                const float g63 = sc[64 + 63];
#pragma unroll
                for (int t = 0; t < 8; ++t) { f32x4 acc = St[t] * g63;
#pragma unroll
                    for (int s2 = 0; s2 < 2; ++s2) {
                        const s16x4 lo = trread(B + SC_KB + (32 * s2 + 4 * q + (c >> 2)) * 272 + (16 * t + 4 * (c & 3)) * 2);
                        const s16x4 hi = trread(B + SC_KB + (32 * s2 + 16 + 4 * q + (c >> 2)) * 272 + (16 * t + 4 * (c & 3)) * 2);
                        bf16x8 kt; kt[0] = lo[0]; kt[1] = lo[1]; kt[2] = lo[2]; kt[3] = lo[3]; kt[4] = hi[0]; kt[5] = hi[1]; kt[6] = hi[2]; kt[7] = hi[3];
                        acc = MFMA16(kt, veb[s2], acc); }
                    St[t] = acc; }
                const size_t m0 = (size_t)chain_row0(b, DIR, n);
#pragma unroll
                for (int i = 0; i < 4; ++i)
#pragma unroll
                    for (int r = 0; r < 4; ++r) { const int row = 16 * i + 4 * q + r; const size_t m = m0 + (DIR ? 63 - row : row);
                        bf16_t* pp = PARK + m * 512 + h * 128 + 64 * half + 16 * wave + c;
                        *pp = f2bf(DIR == 0 ? o[i][r] : bf2f(*pp) + o[i][r]); }
            }
            SYNC();
        }
    }
}
template <int DIR> DEVI void phase_scan(const Ctx& cx, const Params& p, LQ unsigned char* lds, int layer) {
    const Views v = make_views(p.ws);
    const int nitem = NB * 4 * 2;
    for (int item = cx.bid; item < nitem; item += cx.nblk) scan_chain<0, DIR>(cx, p, v, lds, layer, item >> 3, (item >> 1) & 3, item & 1);
    CFENCE();
    for (int item = (cx.bid + cx.nblk - (nitem % cx.nblk)) % cx.nblk; item < nitem; item += cx.nblk) scan_chain<1, DIR>(cx, p, v, lds, layer, item >> 3, (item >> 1) & 3, item & 1);
}

constexpr int AT_V = 9216, AT_BUF = 18432;
template <bool CTXQ> DEVI void attn_unit(const Ctx& cx, const Params& p, const Views& v, LQ unsigned char* lds, int layer, int b, int hkv, int blk) {
    const int tid = cx.tid, wave = RFL(tid >> 6), lane = tid & 63, q = lane >> 4, c = lane & 15;
    const int g = wave >> 1, rh = wave & 1, hq = 4 * hkv + g;
    const size_t mq0 = (CTXQ ? (size_t)ML + (size_t)b * CTXL : (size_t)b * SEQ) + 64 * blk + 32 * rh;
    bf16x8 qf[2][2];
#pragma unroll
    for (int i = 0; i < 2; ++i)
#pragma unroll
        for (int s2 = 0; s2 < 2; ++s2) qf[i][s2] = ld8g(v.BQ + (mq0 + 16 * i + c) * 512 + hq * 64 + 32 * s2 + 8 * q);
    const int wlo = CTXQ ? 0 : (2 - blk > 0 ? 2 - blk : 0), whi = CTXQ ? 0 : (NCH_L + 2 - blk < 5 ? NCH_L + 2 - blk : 5);
    const int ntile = NCH_C + (whi - wlo);
    const int lrow = tid >> 3, lpc = tid & 7;
    auto tile_row0 = [&](int j, int& tstart) -> size_t { if (j < NCH_C) { tstart = -100000; return (size_t)ML + (size_t)b * CTXL + 64 * j; } tstart = 64 * (blk - 2 + wlo + (j - NCH_C)); return (size_t)b * SEQ + tstart; };
    U4 kreg, vreg;
    auto tload = [&](int j) { int ts; const size_t r0 = tile_row0(j, ts); const bf16_t* src = v.BKV + (r0 + lrow) * 256 + hkv * 64 + lpc * 8; kreg = *(const U4*)src; vreg = *(const U4*)(src + 128); };
    auto twrite = [&](int bufi) { LQ unsigned char* B = lds + bufi * AT_BUF; st16l(B + lrow * 144 + lpc * 16, kreg); st16l(B + AT_V + lrow * 144 + lpc * 16, vreg); };
    float mrun[2], lrun[2]; f32x4 ot[4][2];
    mrun[0] = mrun[1] = p.b_sink[layer * 8 + hq]; lrun[0] = lrun[1] = 1.0f;
#pragma unroll
    for (int dt = 0; dt < 4; ++dt) { ot[dt][0] = (f32x4){0.f, 0.f, 0.f, 0.f}; ot[dt][1] = (f32x4){0.f, 0.f, 0.f, 0.f}; }
    SYNC();
    tload(0); twrite(0);
    SYNC();
    for (int j = 0; j < ntile; ++j) {
        LQ unsigned char* B = lds + (j & 1) * AT_BUF;
        if (j + 1 < ntile) tload(j + 1);
        int tstart; (void)tile_row0(j, tstart);
        f32x4 st[4][2];
#pragma unroll
        for (int kt = 0; kt < 4; ++kt) {
            const bf16x8 k0 = ld8l(B + (16 * kt + c) * 144 + (8 * q) * 2), k1 = ld8l(B + (16 * kt + c) * 144 + (32 + 8 * q) * 2);
#pragma unroll
            for (int i = 0; i < 2; ++i) { f32x4 acc = {0.f, 0.f, 0.f, 0.f}; acc = MFMA16(k0, qf[i][0], acc); acc = MFMA16(k1, qf[i][1], acc); st[kt][i] = acc * 0.125f; }
        }
        if (j >= NCH_C) {
#pragma unroll
            for (int i = 0; i < 2; ++i) { const int tq = 64 * blk + 32 * rh + 16 * i + c;
#pragma unroll
                for (int kt = 0; kt < 4; ++kt)
#pragma unroll
                    for (int r = 0; r < 4; ++r) { const int d = tstart + 16 * kt + 4 * q + r - tq; if (d > 128 || d < -128) st[kt][i][r] = -INFINITY; } }
        }
        bf16x8 pb[2][2];
#pragma unroll
        for (int i = 0; i < 2; ++i) {
            float mx = st[0][i][0];
#pragma unroll
            for (int kt = 0; kt < 4; ++kt)
#pragma unroll
                for (int r = 0; r < 4; ++r) mx = fmaxf(mx, st[kt][i][r]);
            mx = fmaxf(mx, shfl_f(mx, lane ^ 16)); mx = fmaxf(mx, shfl_f(mx, lane ^ 32));
            const float mnew = fmaxf(mrun[i], mx), alpha = FEXP(mrun[i] - mnew);
            float ls = 0.f;
#pragma unroll
            for (int kt = 0; kt < 4; ++kt)
#pragma unroll
                for (int r = 0; r < 4; ++r) { const float e = FEXP(st[kt][i][r] - mnew); st[kt][i][r] = e; ls += e; }
            ls += shfl_f(ls, lane ^ 16); ls += shfl_f(ls, lane ^ 32);
            lrun[i] = lrun[i] * alpha + ls; mrun[i] = mnew;
#pragma unroll
            for (int dt = 0; dt < 4; ++dt) ot[dt][i] = ot[dt][i] * alpha;
            pb[i][0] = packb(st[0][i], st[1][i]); pb[i][1] = packb(st[2][i], st[3][i]);
        }
#pragma unroll
        for (int dt = 0; dt < 4; ++dt)
#pragma unroll
            for (int ks = 0; ks < 2; ++ks) {
                const s16x4 lo = trread(B + AT_V + (32 * ks + 4 * q + (c >> 2)) * 144 + (16 * dt + 4 * (c & 3)) * 2);
                const s16x4 hi = trread(B + AT_V + (32 * ks + 16 + 4 * q + (c >> 2)) * 144 + (16 * dt + 4 * (c & 3)) * 2);
                bf16x8 vt; vt[0] = lo[0]; vt[1] = lo[1]; vt[2] = lo[2]; vt[3] = lo[3]; vt[4] = hi[0]; vt[5] = hi[1]; vt[6] = hi[2]; vt[7] = hi[3];
                ot[dt][0] = MFMA16(vt, pb[0][ks], ot[dt][0]); ot[dt][1] = MFMA16(vt, pb[1][ks], ot[dt][1]);
            }
        if (j + 1 < ntile) twrite((j + 1) & 1);
        SYNC();
    }
#pragma unroll
    for (int i = 0; i < 2; ++i) { const float il = 1.0f / lrun[i];
#pragma unroll
        for (int dt = 0; dt < 4; ++dt) { const f32x4 o4 = ot[dt][i] * il;
            unsigned long long w = (unsigned long long)pk2(o4[0], o4[1]) | ((unsigned long long)pk2(o4[2], o4[3]) << 32);
            *(unsigned long long*)(v.BQ + (mq0 + 16 * i + c) * 512 + hq * 64 + 16 * dt + 4 * q) = w; } }
}
DEVI void phase_attn(const Ctx& cx, const Params& p, LQ unsigned char* lds, int layer) {
    const Views v = make_views(p.ws);
    const int nlat = NB * 2 * NCH_L, nctx = layer == 0 ? NB * 2 * NCH_C : 0;
    for (int item = cx.bid; item < nlat + nctx; item += cx.nblk) {
        if (item < nlat) attn_unit<false>(cx, p, v, lds, layer, item / (2 * NCH_L), (item / NCH_L) & 1, item % NCH_L);
        else { const int it = item - nlat; attn_unit<true>(cx, p, v, lds, layer, it / (2 * NCH_C), (it / NCH_C) & 1, it % NCH_C); }
    }
}

struct StG1 { bf16_t *AQKV, *BQ, *BKV, *CQKV, *HALO;
    DEVI void st8(int row, int col, const float* a) const {
        bf16_t* dst = col < 1536 ? AQKV + (size_t)row * 1536 + col : (col < 2048 ? BQ + (size_t)row * 512 + (col - 1536) : (col < 2304 ? BKV + (size_t)row * 256 + (col - 2048) : CQKV + (size_t)row * 1536 + (col - 2304)));
        const U4 w = pack8(a); *(U4*)dst = w;
        const int r64 = row & 63;
        if (col < 1536 && (r64 < 2 || r64 >= 62)) *(U4*)(HALO + ((size_t)(row >> 6) * 4 + (r64 < 2 ? r64 : r64 - 60)) * 1536 + col) = w; } };
struct StPlain { bf16_t* O; int ld;
    DEVI void st8(int row, int col, const float* a) const { *(U4*)(O + (size_t)row * ld + col) = pack8(a); } };
struct StMerge { const bf16_t* L; bf16_t* MRG; int br;
    DEVI void st8(int row, int col, const float* a) const {
        float lg[8], o[8]; unpack8(*(const U4*)(L + (size_t)row * NMG + br * 1024 + col), lg);
        if (br) unpack8(*(const U4*)(MRG + (size_t)row * DM + col), o); else { for (int e = 0; e < 8; ++e) o[e] = 0.f; }
        for (int e = 0; e < 8; ++e) o[e] += sigmoidf_(lg[e]) * a[e];
        *(U4*)(MRG + (size_t)row * DM + col) = pack8(o); } };
struct StResid { const float *xlat, *xctx; float *olat, *octx; const float* mod;
    DEVI void st4(int row, int col, const float* a) const {
        const float* xi = row < ML ? xlat + (size_t)row * DM + col : xctx + (size_t)(row - ML) * DM + col;
        float* xo = row < ML ? olat + (size_t)row * DM + col : octx + (size_t)(row - ML) * DM + col;
        const int b = row < ML ? row / SEQ : NB; const float* g = mod + (size_t)b * 3072 + 2048 + col;
        for (int e = 0; e < 4; ++e) xo[e] = xi[e] + g[e] * a[e]; } };

#ifndef CPU_EMU
namespace pg8 {
#define PG8_LAS __attribute__((address_space(3)))
typedef short bf16x8 __attribute__((ext_vector_type(8)));
typedef float f32x4 __attribute__((ext_vector_type(4)));
constexpr int BM = 256, BK = 64, HALF = 128, HTB = HALF * BK * 2, STAGE_BYTES = 8 * HTB, NXCD = 8, WGM = 8;
__host__ __device__ __forceinline__ int lds_byte(int r, int c) { const int st = (r >> 4) * 2 + (c >> 5), rr = r & 15, cc = c & 31, ob = rr * 64 + cc * 2; return st * 1024 + (ob ^ (((ob >> 9) & 1) << 5)); }
__host__ __device__ __forceinline__ void stage_rc(int b, int& R, int& C) { const int st = b / 1024, sb = b % 1024, swz = sb ^ (((sb >> 9) & 1) << 5); R = (st >> 1) * 16 + swz / 64; C = (st & 1) * 32 + (swz % 64) / 2; }
__host__ __device__ __forceinline__ int perm32(int rho) { const int n = rho >> 4, i = rho & 15; return 8 * (i >> 2) + 4 * n + (i & 3); }
struct Unit { int pm, pn; };
struct Gemm { const bf16_t* A; const bf16_t* Bt; int M, N, K; };
struct StaticOrder {
    int nM, nN, nwg, G, c;
    __host__ __device__ void init(int M, int N, int G_, int c_) { nM = M / BM; nN = N / BM; nwg = nM * nN; G = G_; c = c_; }
    __host__ __device__ bool next(int i, Unit& u) const {
        const long L = (long)i * G + c; if (L >= nwg) return false;
        int wgid = (int)L; { const int q = nwg / NXCD, r = nwg % NXCD, xcd = wgid % NXCD, off = wgid / NXCD; wgid = (xcd < r ? xcd * (q + 1) : r * (q + 1) + (xcd - r) * q) + off; }
        const int nig = WGM * nN, gid = wgid / nig, fm = gid * WGM, gsz = (nM - fm) < WGM ? (nM - fm) : WGM;
        u.pm = fm + ((wgid % nig) % gsz); u.pn = (wgid % nig) / gsz; return true;
    }
    __device__ __forceinline__ void a_ready(const Unit&) const {}
    __device__ __forceinline__ void done(const Unit&) const {}
};
template <class F> struct Epi8 {
    static constexpr bool PERM = true, AFTER_DRAIN = false; F f;
    __device__ __forceinline__ void operator()(const f32x4 (&acc)[2][2][4][2], const Unit& u, int wr, int wc, int fr, int fq) const {
        const int row0 = u.pm * BM + wr * 64 + fr, col0 = u.pn * BM + wc * 32 + 8 * fq;
#pragma unroll
        for (int ai = 0; ai < 2; ++ai)
#pragma unroll
            for (int m = 0; m < 4; ++m)
#pragma unroll
                for (int bj = 0; bj < 2; ++bj) { const f32x4 v0 = acc[ai][bj][m][0], v1 = acc[ai][bj][m][1];
                    const float a[8] = {v0[0], v0[1], v0[2], v0[3], v1[0], v1[1], v1[2], v1[3]};
                    f.st8(row0 + ai * HALF + m * 16, col0 + bj * HALF, a); }
    }
};
template <class F> struct Epi4 {
    static constexpr bool PERM = false, AFTER_DRAIN = false; F f;
    __device__ __forceinline__ void operator()(const f32x4 (&acc)[2][2][4][2], const Unit& u, int wr, int wc, int fr, int fq) const {
        const int row0 = u.pm * BM + wr * 64 + fr, col0 = u.pn * BM + wc * 32 + 4 * fq;
#pragma unroll
        for (int ai = 0; ai < 2; ++ai)
#pragma unroll
            for (int m = 0; m < 4; ++m)
#pragma unroll
                for (int bj = 0; bj < 2; ++bj)
#pragma unroll
                    for (int n = 0; n < 2; ++n) { const f32x4 v0 = acc[ai][bj][m][n]; const float a[4] = {v0[0], v0[1], v0[2], v0[3]};
                        f.st4(row0 + ai * HALF + m * 16, col0 + bj * HALF + n * 16, a); }
    }
};

template <class Epi, class Sched, bool ALIGN_EPI = false, bool SP2 = false>
__device__ __forceinline__ void gemm_phase(PG8_LAS unsigned char* lds, const int tid, const Gemm g, const Sched& S, const Epi& E) {
    const int wid = __builtin_amdgcn_readfirstlane(tid >> 6), lane = tid & 63, wr = wid >> 2, wc = wid & 3, fr = lane & 15, fq = lane >> 4;
    const int K = g.K, nt = K / BK;
    unsigned voffA[2], voffB[2];
#pragma unroll
    for (int i = 0; i < 2; ++i) { int R, C; stage_rc(tid * 16 + i * 8192, R, C); const int Rb = Epi::PERM ? ((R & ~31) + perm32(R & 31)) : R;
        voffA[i] = (unsigned)(R * K + C) * 2u; voffB[i] = (unsigned)(Rb * K + C) * 2u; }
    const size_t kstep = (size_t)(BK * 2);
    const size_t hstep = (size_t)HALF * K * 2;
    const size_t tstep = 2 * hstep;
    const unsigned ldsw = (unsigned)wid * 1024u;
    const int aoff = lds_byte(wr * 64 + fr, fq * 8), boff = lds_byte(wc * 32 + fr, fq * 8);
#define PG8_SA(b, h) (((b) * 2 + (h)) * HTB)
#define PG8_SB(b, h) ((4 + (b) * 2 + (h)) * HTB)
#define PG8_STAGE(bufoff, gbase, voff) do { _Pragma("unroll") for (int _i = 0; _i < 2; ++_i) \
        __builtin_amdgcn_global_load_lds((const unsigned*)((const char*)(gbase) + (voff)[_i]), (PG8_LAS unsigned*)(lds + (bufoff) + ldsw + _i * 8192), 16, 0, 0); } while (0)
#define PG8_LDA(dst, b, h) do { _Pragma("unroll") for (int m = 0; m < 4; ++m) _Pragma("unroll") for (int k = 0; k < 2; ++k) dst[m][k] = *(const PG8_LAS bf16x8*)(lds + PG8_SA(b, h) + aoff + m * 2048 + k * 1024); } while (0)
#define PG8_LDB(dst, b, h) do { _Pragma("unroll") for (int n = 0; n < 2; ++n) _Pragma("unroll") for (int k = 0; k < 2; ++k) dst[n][k] = *(const PG8_LAS bf16x8*)(lds + PG8_SB(b, h) + boff + n * 2048 + k * 1024); } while (0)
#define PG8_MMA(ai, bj, At, Bt) do { __builtin_amdgcn_s_setprio(1); _Pragma("unroll") for (int m = 0; m < 4; ++m) _Pragma("unroll") for (int n = 0; n < 2; ++n) _Pragma("unroll") for (int k = 0; k < 2; ++k) \
        acc[ai][bj][m][n] = __builtin_amdgcn_mfma_f32_16x16x32_bf16(Bt[n][k], At[m][k], acc[ai][bj][m][n], 0, 0, 0); __builtin_amdgcn_s_setprio(0); } while (0)
#define PG8_WAIT_V(n) asm volatile("s_waitcnt vmcnt(" #n ")" ::: "memory")
#define PG8_WAIT_L(n) asm volatile("s_waitcnt lgkmcnt(" #n ")" ::: "memory")
#define PG8_BAR __builtin_amdgcn_s_barrier()
#define PG8_SCHED __builtin_amdgcn_sched_barrier(0)
    Unit cur, nxt; int ui = 0;
    if (!S.next(0, cur)) return;
    f32x4 acc[2][2][4][2];
#pragma unroll
    for (int a = 0; a < 2; ++a)
#pragma unroll
        for (int b = 0; b < 2; ++b)
#pragma unroll
            for (int m = 0; m < 4; ++m)
#pragma unroll
                for (int n = 0; n < 2; ++n) acc[a][b][m][n] = (f32x4){0.f, 0.f, 0.f, 0.f};
    bf16x8 At[4][2], B0[2][2], B1[2][2];
    const char* cA = (const char*)g.A + (size_t)cur.pm * tstep; const char* cB = (const char*)g.Bt + (size_t)cur.pn * tstep;
    S.a_ready(cur);
    if constexpr (SP2) {
        PG8_STAGE(PG8_SB(0, 0), cB, voffB); PG8_STAGE(PG8_SB(0, 1), cB + hstep, voffB); PG8_STAGE(PG8_SA(0, 0), cA, voffA); PG8_STAGE(PG8_SA(0, 1), cA + hstep, voffA);
        if (wr == 1) PG8_BAR;
        PG8_WAIT_V(2); PG8_BAR;
        PG8_STAGE(PG8_SB(1, 0), cB + kstep, voffB); PG8_STAGE(PG8_SA(1, 0), cA + kstep, voffA); PG8_STAGE(PG8_SB(1, 1), cB + hstep + kstep, voffB);
        PG8_WAIT_V(6); PG8_BAR;
    } else {
        PG8_STAGE(PG8_SB(0, 0), cB, voffB); PG8_STAGE(PG8_SA(0, 0), cA, voffA); PG8_STAGE(PG8_SB(0, 1), cB + hstep, voffB); PG8_STAGE(PG8_SA(0, 1), cA + hstep, voffA);
        if (wr == 1) PG8_BAR;
        PG8_WAIT_V(4); PG8_BAR;
        PG8_STAGE(PG8_SB(1, 0), cB + kstep, voffB); PG8_STAGE(PG8_SA(1, 0), cA + kstep, voffA); PG8_STAGE(PG8_SB(1, 1), cB + hstep + kstep, voffB);
        PG8_WAIT_V(6); PG8_BAR;
    }
    for (;;) {
        const bool has_next = S.next(ui + 1, nxt);
        const char* nA = has_next ? (const char*)g.A + (size_t)nxt.pm * tstep : cA; const char* nB = has_next ? (const char*)g.Bt + (size_t)nxt.pn * tstep : cB;
        for (int t = 0; t < nt; t += 2) {
            const bool last = (t == nt - 2);
            const char* a1 = cA + (size_t)(t + 1) * kstep;
            const char* a2 = last ? nA : cA + (size_t)(t + 2) * kstep; const char* b2 = last ? nB : cB + (size_t)(t + 2) * kstep;
            const char* a3 = a2 + kstep; const char* b3 = b2 + kstep;
            if (last && has_next) S.a_ready(nxt);
            if constexpr (SP2) {
            PG8_LDB(B0, 0, 0); PG8_LDB(B1, 0, 1); PG8_SCHED; PG8_LDA(At, 0, 0); PG8_STAGE(PG8_SA(1, 1), a1 + hstep, voffA);
            PG8_WAIT_V(8); PG8_WAIT_L(0); PG8_BAR; PG8_MMA(0, 0, At, B0); PG8_MMA(0, 1, At, B1); PG8_BAR; PG8_SCHED;
            PG8_LDA(At, 0, 1); PG8_STAGE(PG8_SB(0, 0), b2, voffB); PG8_STAGE(PG8_SB(0, 1), b2 + hstep, voffB); PG8_STAGE(PG8_SA(0, 0), a2, voffA);
            PG8_WAIT_V(8); PG8_WAIT_L(0); PG8_BAR; PG8_MMA(1, 0, At, B0); PG8_MMA(1, 1, At, B1); PG8_BAR; PG8_SCHED;
            PG8_LDB(B0, 1, 0); PG8_LDB(B1, 1, 1); PG8_SCHED; PG8_LDA(At, 1, 0); PG8_STAGE(PG8_SA(0, 1), a2 + hstep, voffA);
            PG8_WAIT_V(8); PG8_WAIT_L(0); PG8_BAR; PG8_MMA(0, 0, At, B0); PG8_MMA(0, 1, At, B1); PG8_BAR; PG8_SCHED;
            PG8_LDA(At, 1, 1); PG8_STAGE(PG8_SB(1, 0), b3, voffB); PG8_STAGE(PG8_SB(1, 1), b3 + hstep, voffB); PG8_STAGE(PG8_SA(1, 0), a3, voffA);
            PG8_WAIT_V(8); PG8_WAIT_L(0); PG8_BAR; PG8_MMA(1, 0, At, B0); PG8_MMA(1, 1, At, B1); PG8_BAR; PG8_SCHED;
            } else {
            PG8_LDB(B0, 0, 0); PG8_SCHED; PG8_LDA(At, 0, 0); PG8_STAGE(PG8_SA(1, 1), a1 + hstep, voffA);
            PG8_WAIT_L(8); PG8_BAR; PG8_WAIT_L(0); PG8_MMA(0, 0, At, B0); PG8_BAR; PG8_SCHED;
            PG8_LDB(B1, 0, 1); PG8_STAGE(PG8_SB(0, 0), b2, voffB);
            PG8_BAR; PG8_WAIT_L(0); PG8_MMA(0, 1, At, B1); PG8_BAR;
            PG8_LDA(At, 0, 1); PG8_STAGE(PG8_SA(0, 0), a2, voffA);
            PG8_BAR; PG8_WAIT_L(0); PG8_MMA(1, 0, At, B0); PG8_BAR; PG8_SCHED;
            PG8_STAGE(PG8_SB(0, 1), b2 + hstep, voffB);
            PG8_WAIT_V(6); PG8_BAR; PG8_MMA(1, 1, At, B1); PG8_BAR;
            PG8_LDB(B0, 1, 0); PG8_SCHED; PG8_LDA(At, 1, 0); PG8_STAGE(PG8_SA(0, 1), a2 + hstep, voffA);
            PG8_WAIT_L(8); PG8_BAR; PG8_WAIT_L(0); PG8_MMA(0, 0, At, B0); PG8_BAR; PG8_SCHED;
            PG8_LDB(B1, 1, 1); PG8_STAGE(PG8_SB(1, 0), b3, voffB);
            PG8_BAR; PG8_WAIT_L(0); PG8_MMA(0, 1, At, B1); PG8_BAR;
            PG8_LDA(At, 1, 1); PG8_STAGE(PG8_SA(1, 0), a3, voffA);
            PG8_BAR; PG8_WAIT_L(0); PG8_MMA(1, 0, At, B0); PG8_BAR; PG8_SCHED;
            PG8_STAGE(PG8_SB(1, 1), b3 + hstep, voffB);
            PG8_WAIT_V(6); PG8_BAR; PG8_MMA(1, 1, At, B1); PG8_BAR;
            }
        }
        if constexpr (ALIGN_EPI) { if (wr == 0) PG8_BAR; }
        if constexpr (!Epi::AFTER_DRAIN) { E(acc, cur, wr, wc, fr, fq); S.done(cur); }
        if (!has_next) break;
#pragma unroll
        for (int a = 0; a < 2; ++a)
#pragma unroll
            for (int b = 0; b < 2; ++b)
#pragma unroll
                for (int m = 0; m < 4; ++m)
#pragma unroll
                    for (int n = 0; n < 2; ++n) acc[a][b][m][n] = (f32x4){0.f, 0.f, 0.f, 0.f};
        cur = nxt; cA = nA; cB = nB; ++ui;
        if constexpr (ALIGN_EPI) { if (wr == 1) PG8_BAR; }
    }
    PG8_WAIT_V(0);
    if constexpr (!ALIGN_EPI) { if (wr == 0) PG8_BAR; }
    PG8_BAR;
#undef PG8_SA
#undef PG8_SB
#undef PG8_STAGE
#undef PG8_LDA
#undef PG8_LDB
#undef PG8_MMA
#undef PG8_WAIT_V
#undef PG8_WAIT_L
#undef PG8_BAR
#undef PG8_SCHED
}
}

template <class F> __device__ __forceinline__ void run_gemm8(PG8_LAS unsigned char* lds, const Ctx& cx, const bf16_t* A, const bf16_t* Bt, int M, int N, int K, const F& f) {
    pg8::Gemm g{A, Bt, M, N, K}; pg8::StaticOrder S; S.init(M, N, cx.nblk, cx.bid);
    pg8::Epi8<F> E{f};
    pg8::gemm_phase<pg8::Epi8<F>, pg8::StaticOrder, true, true>(lds, cx.tid, g, S, E);
}
template <class F> __device__ __forceinline__ void run_gemm4(PG8_LAS unsigned char* lds, const Ctx& cx, const bf16_t* A, const bf16_t* Bt, int M, int N, int K, const F& f) {
    pg8::Gemm g{A, Bt, M, N, K}; pg8::StaticOrder S; S.init(M, N, cx.nblk, cx.bid);
    pg8::Epi4<F> E{f};
    pg8::gemm_phase<pg8::Epi4<F>, pg8::StaticOrder, true, true>(lds, cx.tid, g, S, E);
}
#else
template <class F> void run_gemm8(unsigned char*, const Ctx&, const bf16_t* A, const bf16_t* Bt, int M, int N, int K, const F& f) {
#pragma omp parallel for schedule(dynamic, 8)
    for (int r = 0; r < M; ++r) for (int c0 = 0; c0 < N; c0 += 8) { float a[8];
        for (int e = 0; e < 8; ++e) { float s = 0.f; const bf16_t* ar = A + (size_t)r * K; const bf16_t* br = Bt + (size_t)(c0 + e) * K; for (int k = 0; k < K; ++k) s += bf2f(ar[k]) * bf2f(br[k]); a[e] = s; }
        f.st8(r, c0, a); }
}
template <class F> void run_gemm4(unsigned char*, const Ctx&, const bf16_t* A, const bf16_t* Bt, int M, int N, int K, const F& f) {
#pragma omp parallel for schedule(dynamic, 8)
    for (int r = 0; r < M; ++r) for (int c0 = 0; c0 < N; c0 += 4) { float a[4];
        for (int e = 0; e < 4; ++e) { float s = 0.f; const bf16_t* ar = A + (size_t)r * K; const bf16_t* br = Bt + (size_t)(c0 + e) * K; for (int k = 0; k < K; ++k) s += bf2f(ar[k]) * bf2f(br[k]); a[e] = s; }
        f.st4(r, c0, a); }
}
#endif

constexpr int PPL = 14;
constexpr int NPHASE = 2 + PPL * NLAYER;
template <int PH> DEVI void run_phase_t(LQ unsigned char* lds, const Ctx& cx, const Params& p) {
    const Views v = make_views(p.ws);
    if constexpr (PH == 0) { phase_prep(cx, p, lds); }
    else if constexpr (PH == NPHASE - 1) { phase_final(cx, p); }
    else {
        constexpr int layer = (PH - 1) / PPL, s = (PH - 1) % PPL;
        constexpr int mrows = layer == NLAYER - 1 ? ML : MT;
        if constexpr (s == 0) phase_norm(cx, p, layer);
        else if constexpr (s == 1) run_gemm8(lds, cx, v.XN, v.W1 + (size_t)layer * N1 * DM, MT, N1, DM, StG1{v.AQKV, v.BQ, v.BKV, v.CQKV, v.HALO});
        else if constexpr (s == 2) phase_conv(cx, p, layer);
        else if constexpr (s == 3) phase_prep2(cx, p, layer);
        else if constexpr (s == 4) { phase_tmat(cx, p, lds, layer); phase_attn(cx, p, lds, layer); }
        else if constexpr (s == 5) phase_scan<0>(cx, p, lds, layer);
        else if constexpr (s == 6) phase_scan<1>(cx, p, lds, layer);
        else if constexpr (s == 7) run_gemm8(lds, cx, v.XN, v.WZ + (size_t)layer * NZ * DM, mrows, NZ, DM, StPlain{v.Z, NZ});
        else if constexpr (s == 8) phase_y(cx, p, layer);
        else if constexpr (s == 9) run_gemm8(lds, cx, v.XN, v.WM + (size_t)layer * NMG * DM, mrows, NMG, DM, StPlain{v.L, NMG});
        else if constexpr (s >= 10 && s <= 12) { constexpr int br = s - 10;
            run_gemm8(lds, cx, v.Y + (size_t)br * MT * 512, v.WB + ((size_t)layer * 3 + br) * DM * 512, mrows, DM, 512, StMerge{v.L, v.MRG, br}); }
        else run_gemm4(lds, cx, v.MRG, v.WO + (size_t)layer * DM * DM, mrows, DM, DM,
                       StResid{layer == 0 ? p.x : p.out, layer == 0 ? p.ctx : v.CTX1, p.out, v.CTX1, v.MOD + (size_t)layer * (NB + 1) * 3072});
    }
}
HD bool phase_is_gemm(int ph) { if (ph == 0 || ph == NPHASE - 1) return false; const int s = (ph - 1) % PPL; return s == 1 || s == 7 || s >= 9; }
#define MK_PHASE_LIST(X) X(0) X(1) X(2) X(3) X(4) X(5) X(6) X(7) X(8) X(9) X(10) X(11) X(12) X(13) X(14) X(15) X(16) X(17) X(18) X(19) X(20) X(21) X(22) X(23) X(24) X(25) X(26) X(27) X(28) X(29)
static_assert(NPHASE == 30, "phase list");
#ifdef CPU_EMU
inline void run_phase(unsigned char* lds, const Ctx& cx, const Params& p, int ph) {
    switch (ph) {
#define X(k) case k: run_phase_t<k>(lds, cx, p); break;
        MK_PHASE_LIST(X)
#undef X
    }
}
#endif

#ifndef CPU_EMU
constexpr int LDS_BYTES = 147456;
constexpr int LDS_BARST = 147392;
#define XB_TMO      128
#define XB_XCNT(j)  (256  + 64 * (j))
#define XB_XSUB(j)  (1280 + 64 * (j))
#define XB_XGEN(j)  (2304 + 64 * (j))
#define XB_TOP      3328
#define XB_TOPGEN   3392
#define XCD_BAR_WORDS 3456
#define XB_SPIN_CAP (1u << 22)
__device__ __forceinline__ unsigned xb_ld(unsigned* p)              { return __hip_atomic_load(p, __ATOMIC_RELAXED, __HIP_MEMORY_SCOPE_AGENT); }
__device__ __forceinline__ unsigned xb_add(unsigned* p, unsigned v) { return __hip_atomic_fetch_add(p, v, __ATOMIC_RELAXED, __HIP_MEMORY_SCOPE_AGENT); }
__device__ __forceinline__ unsigned xb_xcc_id() { return (unsigned)__builtin_amdgcn_s_getreg((3 << 11) | 20) & 0xFu; }
#define XB_SPIN(cond, bar) do { unsigned _sp = 0; while (cond) { __builtin_amdgcn_s_sleep(1); \
    if ((++_sp & 255u) == 0u) { if (xb_ld(&(bar)[XB_TMO])) break; if (_sp > XB_SPIN_CAP) { atomicAdd(&(bar)[XB_TMO], 1u); break; } } } } while (0)
struct XcdBarrier { unsigned* bar; unsigned x; volatile PG8_LAS unsigned* st; };
__device__ __forceinline__ void xcd_barrier_complete(unsigned* bar, unsigned x, unsigned G, unsigned& nloc, unsigned& nx) {
    unsigned sum, cnt, mine, sp = 0u;
    for (;;) {
        sum = 0u; cnt = 0u; mine = 0u;
#pragma unroll
        for (unsigned j = 0; j < 16; ++j) { const unsigned c = xb_ld(&bar[XB_XCNT(j)]); sum += c; cnt += (c > 0u) ? 1u : 0u; mine = (j == x) ? c : mine; }
        if (sum == G) break;
        __builtin_amdgcn_s_sleep(1);
        if ((++sp & 255u) == 0u) { if (xb_ld(&bar[XB_TMO])) break; if (sp > XB_SPIN_CAP) { atomicAdd(&bar[XB_TMO], 1u); break; } }
    }
    nloc = mine > 0u ? mine : 1u; nx = cnt > 0u ? cnt : 1u;
}
__device__ __forceinline__ void xcd_barrier(const XcdBarrier& b, int tid, unsigned G) {
    asm volatile("s_waitcnt vmcnt(0)" ::: "memory");
    __syncthreads();
    if (tid == 0) {
        unsigned* bar = b.bar;
        __builtin_amdgcn_s_waitcnt(0);
        unsigned nloc = b.st[0], nx = b.st[1];
        if (nloc == 0u) { xcd_barrier_complete(bar, b.x, G, nloc, nx); b.st[0] = nloc; b.st[1] = nx; }
        const unsigned old = xb_add(&bar[XB_XSUB(b.x)], 1u);
        const unsigned gen = old / nloc;
        if (old + 1u == (gen + 1u) * nloc) {
            __builtin_amdgcn_fence(__ATOMIC_RELEASE, "agent");
            asm volatile("s_waitcnt vmcnt(0)" ::: "memory");
            const unsigned og = xb_add(&bar[XB_TOP], 1u);
            const unsigned tg = og / nx;
            if (og + 1u == (tg + 1u) * nx) xb_add(&bar[XB_TOPGEN], 1u);
            else XB_SPIN(xb_ld(&bar[XB_TOPGEN]) == tg, bar);
            __builtin_amdgcn_fence(__ATOMIC_ACQUIRE, "agent");
            xb_add(&bar[XB_XGEN(b.x)], 1u);
            asm volatile("s_waitcnt vmcnt(0)" ::: "memory");
        } else {
            XB_SPIN(xb_ld(&bar[XB_XGEN(b.x)]) == gen, bar);
            __builtin_amdgcn_fence(__ATOMIC_ACQUIRE, "agent");
            asm volatile("s_waitcnt vmcnt(0)" ::: "memory");
        }
    }
    __syncthreads();
}

__global__ void __launch_bounds__(512, 2) mk_fwd(Params p) {
    extern __shared__ __attribute__((aligned(16))) unsigned char lds_raw[];
    PG8_LAS unsigned char* lds = (PG8_LAS unsigned char*)lds_raw;
    cg::grid_group grid = cg::this_grid();
    const int ph_lo = p.ph_lo, ph_hi = p.ph_hi;
    const int wave_s = __builtin_amdgcn_readfirstlane((int)threadIdx.x >> 6);
    volatile PG8_LAS unsigned* bst = (volatile PG8_LAS unsigned*)(lds + LDS_BARST);
    if (threadIdx.x < 2) bst[threadIdx.x] = 0u;
    __syncthreads();
    XcdBarrier bar; bar.bar = (unsigned*)p.ws; bar.x = xb_xcc_id(); bar.st = bst;
    if (threadIdx.x == 0) (void)xb_add(&bar.bar[XB_XCNT(bar.x)], 1u);
#define X(k) if (ph_lo <= k && k < ph_hi) { \
        const Params* q = (const Params*)__builtin_amdgcn_kernarg_segment_ptr(); asm volatile("" : "+s"(q) :: "memory"); \
        Ctx cx; cx.tid = wave_s * 64 + (int)__builtin_amdgcn_mbcnt_hi(~0u, __builtin_amdgcn_mbcnt_lo(~0u, 0u)); cx.bid = (int)blockIdx.x; cx.nblk = (int)gridDim.x; \
        asm volatile("" : "+v"(cx.tid)); asm volatile("" : "+s"(cx.bid), "+s"(cx.nblk)); \
        run_phase_t<k>(lds, cx, *q); \
        if (k + 1 < ph_hi) { if (k == 0) grid.sync(); else { unsigned z0 = 0u; asm volatile("" : "+v"(z0)); const int t2 = wave_s * 64 + (int)__builtin_amdgcn_mbcnt_hi(~0u, __builtin_amdgcn_mbcnt_lo(~0u, z0)); xcd_barrier(bar, t2, gridDim.x); } } }
    MK_PHASE_LIST(X)
#undef X
}

#ifndef MK_SINGLE
#define MK_SINGLE 1
#endif
extern "C" void kernel_launch(void* const* d_in, const int* in_sizes, int n_in, void* d_out, int out_size, void* d_ws, size_t ws_size, hipStream_t stream) {
    static int grid = 0;
    if (grid == 0) {
        if (n_in != 18 || in_sizes[0] != ML * DM || out_size != ML * DM || ws_size < WS_END) { fprintf(stderr, "kernel_launch: unexpected shapes (n_in %d, in0 %d, out %d, ws %zu < %zu)\n", n_in, n_in > 0 ? in_sizes[0] : -1, out_size, ws_size, (size_t)WS_END); grid = -1; return; }
        int dev = 0, cus = 0, per_cu = 0;
        if (hipGetDevice(&dev) != hipSuccess || hipDeviceGetAttribute(&cus, hipDeviceAttributeMultiprocessorCount, dev) != hipSuccess) { grid = -1; return; }
        if (hipFuncSetAttribute((const void*)mk_fwd, hipFuncAttributeMaxDynamicSharedMemorySize, LDS_BYTES) != hipSuccess) { fprintf(stderr, "kernel_launch: hipFuncSetAttribute failed\n"); grid = -1; return; }
        if (hipOccupancyMaxActiveBlocksPerMultiprocessor(&per_cu, (const void*)mk_fwd, 512, LDS_BYTES) != hipSuccess || per_cu < 1) { fprintf(stderr, "kernel_launch: occupancy query says %d\n", per_cu); (void)hipGetLastError(); grid = -1; return; }
        grid = cus;
    }
    if (grid < 0) return;
    if (hipMemsetAsync(d_ws, 0, 16384, stream) != hipSuccess) { fprintf(stderr, "kernel_launch: memset failed\n"); return; }
    Params p{};
    const float** pp = (const float**)&p;
    for (int i = 0; i < 18; ++i) pp[i] = (const float*)d_in[i];
    p.out = (float*)d_out; p.ws = (unsigned char*)d_ws;
#if MK_SINGLE
    p.ph_lo = 0; p.ph_hi = NPHASE;
    { void* args[] = {&p}; hipError_t e = hipLaunchCooperativeKernel((const void*)mk_fwd, dim3(grid), dim3(512), args, LDS_BYTES, stream);
      if (e != hipSuccess) fprintf(stderr, "cooperative launch failed: %s\n", hipGetErrorString(e)); }
#else
    for (int ph = 0; ph < NPHASE; ++ph) {
        p.ph_lo = ph; p.ph_hi = ph + 1;
        void* args[] = {&p}; hipError_t e = hipLaunchCooperativeKernel((const void*)mk_fwd, dim3(grid), dim3(512), args, LDS_BYTES, stream);
        if (e != hipSuccess) { fprintf(stderr, "cooperative launch %d failed: %s\n", ph, hipGetErrorString(e)); break; }
    }
#endif
}
#endif
```

```cpp
#ifndef CPU_EMU
#include <hip/hip_runtime.h>
#include <hip/hip_cooperative_groups.h>
#include <cstdio>
#include <cstdint>
namespace cg = cooperative_groups;
#define DEVI __device__ __forceinline__
#define HD __host__ __device__ __forceinline__
#define CFENCE() asm volatile("" ::: "memory")
#define LAUNDER(x) asm volatile("" : "+v"(x))
#define SCHEDB() __builtin_amdgcn_sched_barrier(0)
#else
#define CFENCE() do {} while (0)
#define LAUNDER(x) do {} while (0)
#define SCHEDB() do {} while (0)
#include <cstring>
#include <cmath>
#include <cstdio>
#include <cstdint>
#include <cstddef>
#define DEVI inline
#define HD inline
#endif

#ifndef CPU_EMU
#define LQ __attribute__((address_space(3)))
typedef short bf16x8 __attribute__((ext_vector_type(8)));
typedef float f32x4 __attribute__((ext_vector_type(4)));
typedef short s16x4 __attribute__((ext_vector_type(4)));
typedef long long i64x2 __attribute__((ext_vector_type(2)));
typedef unsigned u32x4 __attribute__((ext_vector_type(4)));
#define MFMA16(a, b, c) __builtin_amdgcn_mfma_f32_16x16x32_bf16(a, b, c, 0, 0, 0)
#define SYNC() __syncthreads()
#define LSYNC() do { asm volatile("s_waitcnt lgkmcnt(0)" ::: "memory"); __builtin_amdgcn_s_barrier(); asm volatile("" ::: "memory"); } while (0)
#define WSYNC() __builtin_amdgcn_wave_barrier()
__device__ __forceinline__ s16x4 trread(LQ const unsigned char* p) { return __builtin_bit_cast(s16x4, __builtin_amdgcn_ds_read_tr16_b64_v4i16((LQ s16x4*)p)); }
__device__ __forceinline__ float shfl_f(float v, int src) { return __shfl(v, src, 64); }
#define RFL(x) __builtin_amdgcn_readfirstlane(x)
#define FEXP(x) __expf(x)
#else
#define LQ
using simt::bf16x8; using simt::f32x4; using simt::s16x4;
typedef long long i64x2 __attribute__((vector_size(16)));
typedef unsigned u32x4 __attribute__((vector_size(16)));
#define MFMA16(a, b, c) simt::mfma16(a, b, c)
#define SYNC() simt::syncthreads()
#define LSYNC() simt::syncthreads()
#define WSYNC() ((void)simt::shfl(0.f, 0))
inline s16x4 trread(const unsigned char* p) { return simt::tr16_b64(p); }
inline float shfl_f(float v, int src) { return simt::shfl(v, src); }
#define RFL(x) (x)
#define FEXP(x) expf(x)
#endif

#ifndef NB
#define NB 8
#endif
#ifndef SEQ
#define SEQ 4096
#endif
#ifndef CTXL
#define CTXL 256
#endif
constexpr int DM = 1024, INW = 8464, GRIDW = 64;
constexpr int ML = NB * SEQ, MC = NB * CTXL, MT = ML + MC;
constexpr int N1 = 3840;
constexpr int NZ = 1536;
constexpr int NMG = 3072;
constexpr float EPSF = 1e-6f;
constexpr int NLAYER = 2;
static_assert(MT % 256 == 0 && ML % 256 == 0, "row tiles");
constexpr int NCH_C = CTXL / 64, NCH_L = SEQ / 64, NSTEP = NCH_C + NCH_L;

typedef unsigned short bf16_t;
struct alignas(16) U4 { unsigned x, y, z, w; };
DEVI void st16l(LQ unsigned char* p, const U4& w) { u32x4 t; t[0] = w.x; t[1] = w.y; t[2] = w.z; t[3] = w.w; *(LQ u32x4*)p = t; }
DEVI U4 ld16l(LQ const unsigned char* p) { const u32x4 t = *(LQ const u32x4*)p; U4 w; w.x = t[0]; w.y = t[1]; w.z = t[2]; w.w = t[3]; return w; }

constexpr size_t MiB = 1u << 20;
constexpr size_t al1(size_t x) { return (x + MiB - 1) & ~(MiB - 1); }
constexpr size_t WS_CTL = 0;
constexpr size_t WS_MOD = 256 * 1024;
constexpr size_t WS_WAB = 512 * 1024;
constexpr size_t WS_TAX = 640 * 1024;
constexpr size_t WS_W1 = 1 * MiB;
constexpr size_t WS_WZ = WS_W1 + al1((size_t)2 * N1 * DM * 2);
constexpr size_t WS_WM = WS_WZ + al1((size_t)2 * NZ * DM * 2);
constexpr size_t WS_WB = WS_WM + al1((size_t)2 * NMG * DM * 2);
constexpr size_t WS_WO = WS_WB + al1((size_t)2 * 3 * DM * 512 * 2);
constexpr size_t WS_G = WS_WO + al1((size_t)2 * DM * DM * 2);
constexpr size_t WS_BETA = WS_G + al1((size_t)MT * 8 * 4);
constexpr size_t WS_CTX1 = WS_BETA + al1((size_t)MT * 8 * 4);
constexpr size_t WS_XN = WS_CTX1 + al1((size_t)MC * DM * 4);
constexpr size_t WS_AQKV = WS_XN + al1((size_t)MT * DM * 2);
constexpr size_t WS_CQKV = WS_AQKV + al1((size_t)MT * 1536 * 2);
constexpr size_t WS_BQ = WS_CQKV + al1((size_t)MT * 1536 * 2);
constexpr size_t WS_BKV = WS_BQ + al1((size_t)MT * 512 * 2);
constexpr size_t WS_PA = WS_BKV + al1((size_t)MT * 256 * 2);
constexpr size_t WS_PC = WS_PA + al1((size_t)MT * 512 * 2);
constexpr size_t WS_T = WS_PC + al1((size_t)MT * 512 * 2);
constexpr size_t WS_HALO = WS_T + al1((size_t)(MT / 64) * 8 * 8192);
constexpr size_t WS_TRET = WS_HALO + al1((size_t)(MT / 64) * 4 * 1536 * 2);
constexpr size_t WS_END = WS_TRET + al1((size_t)2 * SEQ * 64 * 4);
static_assert(WS_CQKV + (size_t)MT * NMG * 2 <= WS_END, "L overlay");
static_assert(WS_END <= (size_t)512 * MiB, "workspace");

struct Params {
    const float *x, *c, *ctx, *c_ctx, *w_ada, *b_ada, *norm_w, *w_in, *a_conv_w, *a_log, *a_dt_bias, *a_norm_w, *b_sink, *c_decay, *c_norm_w, *w_branch, *w_out, *final_norm_w;
    float* out; unsigned char* ws;
    int ph_lo, ph_hi;
};

#ifdef CPU_EMU
inline float u2f(unsigned u) { float f; memcpy(&f, &u, 4); return f; }
inline unsigned f2u(float f) { unsigned u; memcpy(&u, &f, 4); return u; }
#else
DEVI float u2f(unsigned u) { return __uint_as_float(u); }
DEVI unsigned f2u(float f) { return __float_as_uint(f); }
#endif
DEVI float bf2f(bf16_t h) { return u2f((unsigned)h << 16); }
DEVI bf16_t f2bf(float f) { unsigned u = f2u(f); return (bf16_t)((u + 0x7fffu + ((u >> 16) & 1u)) >> 16); }
#ifndef CPU_EMU
typedef float f32x2_t __attribute__((ext_vector_type(2))); typedef __bf16 bf16x2_t __attribute__((ext_vector_type(2)));
__device__ __forceinline__ unsigned pk2(float lo, float hi) { const f32x2_t v = {lo, hi}; const bf16x2_t b = __builtin_convertvector(v, bf16x2_t); return __builtin_bit_cast(unsigned, b); }
#else
DEVI unsigned pk2(float lo, float hi) { return (unsigned)f2bf(lo) | ((unsigned)f2bf(hi) << 16); }
#endif
DEVI float lo16(unsigned w) { return u2f(w << 16); }
DEVI float hi16(unsigned w) { return u2f(w & 0xffff0000u); }
DEVI float sigmoidf_(float x) { return 1.0f / (1.0f + expf(-x)); }
DEVI float siluf_(float x) { return x / (1.0f + expf(-x)); }
DEVI float softplusf_(float x) { return x > 20.f ? x : log1pf(expf(x)); }
DEVI void unpack8(const U4& w, float* v) { v[0] = lo16(w.x); v[1] = hi16(w.x); v[2] = lo16(w.y); v[3] = hi16(w.y); v[4] = lo16(w.z); v[5] = hi16(w.z); v[6] = lo16(w.w); v[7] = hi16(w.w); }
DEVI U4 pack8(const float* v) { U4 w; w.x = pk2(v[0], v[1]); w.y = pk2(v[2], v[3]); w.z = pk2(v[4], v[5]); w.w = pk2(v[6], v[7]); return w; }

struct Ctx { int tid, bid, nblk; };
struct TI { long id, n; };
DEVI TI thread_info(const Ctx& c) {
    const int wave = c.tid >> 6, lane = c.tid & 63;
    return TI{((long)wave * c.nblk + c.bid) * 64 + lane, (long)c.nblk * 512};
}

struct Views {
    float *MOD, *WAB, *TAX, *TRET; bf16_t *W1, *WZ, *WM, *WB, *WO; float *G, *BETA, *CTX1; bf16_t *XN, *AQKV, *CQKV, *BQ, *BKV, *PA, *PC, *Y, *Z, *L, *MRG, *T, *HALO;
};
DEVI Views make_views(unsigned char* ws) {
    Views v;
    v.MOD = (float*)(ws + WS_MOD); v.WAB = (float*)(ws + WS_WAB); v.TAX = (float*)(ws + WS_TAX); v.TRET = (float*)(ws + WS_TRET); v.W1 = (bf16_t*)(ws + WS_W1); v.WZ = (bf16_t*)(ws + WS_WZ); v.WM = (bf16_t*)(ws + WS_WM); v.WB = (bf16_t*)(ws + WS_WB); v.WO = (bf16_t*)(ws + WS_WO);
    v.G = (float*)(ws + WS_G); v.BETA = (float*)(ws + WS_BETA); v.CTX1 = (float*)(ws + WS_CTX1);
    v.XN = (bf16_t*)(ws + WS_XN); v.AQKV = (bf16_t*)(ws + WS_AQKV); v.CQKV = (bf16_t*)(ws + WS_CQKV); v.BQ = (bf16_t*)(ws + WS_BQ); v.BKV = (bf16_t*)(ws + WS_BKV);
    v.PA = (bf16_t*)(ws + WS_PA); v.PC = (bf16_t*)(ws + WS_PC); v.Y = v.AQKV; v.Z = v.CQKV; v.L = v.CQKV; v.MRG = v.XN; v.T = (bf16_t*)(ws + WS_T); v.HALO = (bf16_t*)(ws + WS_HALO);
    return v;
}

HD int map_g1(int n) { return n < 1536 ? n : (n < 2048 ? 2064 + (n - 1536) : (n < 2304 ? 2576 + (n - 2048) : 3344 + (n - 2304))); }
HD int map_z(int n) { return n < 512 ? 1536 + n : (n < 1024 ? 2832 + (n - 512) : 4880 + (n - 1024)); }

DEVI float wave_sum(float v, int lane) {
#pragma unroll
    for (int o = 32; o >= 1; o >>= 1) v += shfl_f(v, lane ^ o);
    return v;
}
template <int W> DEVI float grp_sum(float v, int lane) {
#pragma unroll
    for (int o = W / 2; o >= 1; o >>= 1) v += shfl_f(v, lane ^ o);
    return v;
}
DEVI f32x4 ldg4(const float* p) { f32x4 v; __builtin_memcpy(&v, p, 16); return v; }
DEVI void stg4(float* p, const f32x4& v) { __builtin_memcpy(p, &v, 16); }

DEVI void prep_tile(const Ctx& cx, LQ unsigned char* lds, const float* src, int ld, int srccol0, int k0, bf16_t* dst, int K, int n0) {
    LQ float* tl = (LQ float*)lds; const int tid = cx.tid;
    { const int r = tid >> 4, c4 = (tid & 15) * 4;
#pragma unroll
      for (int rr = 0; rr < 64; rr += 32) { const f32x4 w = ldg4(src + (size_t)(k0 + r + rr) * ld + srccol0 + c4);
#pragma unroll
          for (int e = 0; e < 4; ++e) tl[(r + rr) * 65 + c4 + e] = w[e]; } }
    SYNC();
    { const int n = tid >> 3, kc = (tid & 7) * 8; float a[8];
#pragma unroll
      for (int e = 0; e < 8; ++e) a[e] = tl[(kc + e) * 65 + n];
      *(U4*)(dst + (size_t)(n0 + n) * K + k0 + kc) = pack8(a); }
    SYNC();
}
DEVI void phase_prep(const Ctx& cx, const Params& p, LQ unsigned char* lds) {
    const Views v = make_views(p.ws); const TI ti = thread_info(cx);
    constexpr int T1 = (N1 / 64) * 16, TZ = (NZ / 64) * 16, TM = (NMG / 64) * 16, TB = 3 * 16 * 8, TO = 16 * 16, TL = T1 + TZ + TM + TB + TO;
    for (int t = cx.bid; t < NLAYER * TL; t += cx.nblk) {
        const int l = t / TL; int r = t % TL;
        const float* win = p.w_in + (size_t)l * DM * INW;
        if (r < T1) { const int nt = r / 16, kt = r % 16; prep_tile(cx, lds, win, INW, map_g1(nt * 64), kt * 64, v.W1 + (size_t)l * N1 * DM, DM, nt * 64); continue; } r -= T1;
        if (r < TZ) { const int nt = r / 16, kt = r % 16; prep_tile(cx, lds, win, INW, map_z(nt * 64), kt * 64, v.WZ + (size_t)l * NZ * DM, DM, nt * 64); continue; } r -= TZ;
        if (r < TM) { const int nt = r / 16, kt = r % 16; prep_tile(cx, lds, win, INW, 5392 + nt * 64, kt * 64, v.WM + (size_t)l * NMG * DM, DM, nt * 64); continue; } r -= TM;
        if (r < TB) { const int br = r / 128, r2 = r % 128, nt = r2 / 8, kt = r2 % 8; prep_tile(cx, lds, p.w_branch + ((size_t)l * 3 + br) * 512 * DM, DM, nt * 64, kt * 64, v.WB + ((size_t)l * 3 + br) * DM * 512, 512, nt * 64); continue; } r -= TB;
        { const int nt = r / 16, kt = r % 16; prep_tile(cx, lds, p.w_out + (size_t)l * DM * DM, DM, nt * 64, kt * 64, v.WO + (size_t)l * DM * DM, DM, nt * 64); }
    }
    long tb = ti.id; LAUNDER(tb);
    for (long i = tb; i < (long)NLAYER * 16 * DM; i += ti.n) { const int l = (int)(i / (16 * DM)), j = (int)((i / DM) % 16), k = (int)(i % DM); v.WAB[i] = p.w_in[((size_t)l * DM + k) * INW + 2048 + j]; }
    LAUNDER(tb);
    for (long i = tb; i < 64 * 16; i += ti.n) { const int pos = (int)(i >> 4), f = (int)(i & 15); const float ang = (float)pos * powf(10000.0f, -(float)f / 16.0f); v.TAX[i] = cosf(ang); v.TAX[1024 + i] = sinf(ang); }
    LAUNDER(tb);
    for (long i = tb; i < (long)SEQ * 64; i += ti.n) { const int pos = (int)(i >> 6), f = (int)(i & 63); const float ang = (float)pos * powf(10000.0f, -(float)f / 64.0f); v.TRET[i] = cosf(ang); v.TRET[(size_t)SEQ * 64 + i] = sinf(ang); }
    const long nmod = (long)NLAYER * (NB + 1) * 3072;
    LAUNDER(tb);
    for (long i = tb; i < nmod; i += ti.n) {
        const int l = (int)(i / ((NB + 1) * 3072)), rem = (int)(i % ((NB + 1) * 3072)), b = rem / 3072, n = rem % 3072;
        const float* cv = b < NB ? p.c + (size_t)b * DM : p.c_ctx;
        const float* w = p.w_ada + (size_t)l * DM * 3072 + n;
        float acc = 0.f;
#pragma unroll 8
        for (int k = 0; k < DM; ++k) { const float cvk = cv[k]; acc += (cvk / (1.0f + FEXP(-cvk))) * w[(size_t)k * 3072]; }
        v.MOD[i] = acc + p.b_ada[l * 3072 + n];
    }
}

DEVI const float* xrow_in(const Params& p, const Views& v, int layer, int m) {
    if (layer == 0) return m < ML ? p.x + (size_t)m * DM : p.ctx + (size_t)(m - ML) * DM;
    return m < ML ? p.out + (size_t)m * DM : v.CTX1 + (size_t)(m - ML) * DM;
}
DEVI void phase_norm(const Ctx& cx, const Params& p, int layer) {
    const Views v = make_views(p.ws);
    const int wave = RFL(cx.tid >> 6), lane = cx.tid & 63;
    const float* nw = p.norm_w + layer * DM; const float* wab = v.WAB + (size_t)layer * 16 * DM;
    for (int m = wave * cx.nblk + cx.bid; m < MT; m += 8 * cx.nblk) {
        const float* xr = xrow_in(p, v, layer, m);
        const int b = m < ML ? m / SEQ : NB;
        const float* mod = v.MOD + ((size_t)layer * (NB + 1) + b) * 3072;
        f32x4 xv[4]; float ss = 0.f;
#pragma unroll
        for (int j = 0; j < 4; ++j) { xv[j] = ldg4(xr + 256 * j + 4 * lane); ss += xv[j][0] * xv[j][0] + xv[j][1] * xv[j][1] + xv[j][2] * xv[j][2] + xv[j][3] * xv[j][3]; }
        ss = wave_sum(ss, lane);
        const float r = 1.0f / sqrtf(ss * (1.0f / DM) + EPSF);
#pragma unroll
        for (int j = 0; j < 4; ++j) { const int k0 = 256 * j + 4 * lane; const f32x4 n4 = ldg4(nw + k0), s4 = ldg4(mod + 1024 + k0), h4 = ldg4(mod + k0);
#pragma unroll
            for (int e = 0; e < 4; ++e) xv[j][e] = xv[j][e] * r * n4[e] * (1.0f + s4[e]) + h4[e];
            unsigned long long w = (unsigned long long)pk2(xv[j][0], xv[j][1]) | ((unsigned long long)pk2(xv[j][2], xv[j][3]) << 32);
            *(unsigned long long*)(v.XN + (size_t)m * DM + k0) = w; }
        float mine = 0.f;
#pragma unroll 2
        for (int jj = 0; jj < 16; ++jj) { float a = 0.f;
#pragma unroll
            for (int j = 0; j < 4; ++j) { const f32x4 w4 = ldg4(wab + jj * DM + 256 * j + 4 * lane); a += xv[j][0] * w4[0] + xv[j][1] * w4[1] + xv[j][2] * w4[2] + xv[j][3] * w4[3]; }
            a = wave_sum(a, lane); if (lane == jj) mine = a; }
        if (lane < 8) v.BETA[(size_t)m * 8 + lane] = sigmoidf_(mine);
        else if (lane < 16) v.G[(size_t)m * 8 + lane - 8] = -expf(p.a_log[layer * 8 + lane - 8]) * softplusf_(mine + p.a_dt_bias[layer * 8 + lane - 8]);
    }
}

DEVI void phase_conv(const Ctx& cx, const Params& p, int layer) {
    const Views v = make_views(p.ws); const TI ti = thread_info(cx);
    const float* cw = p.a_conv_w + (size_t)layer * 5 * 1536;
    for (long it = ti.id; it < (long)(MT / 64) * 1536; it += ti.n) {
        const int gch = (int)(it / 1536), c = (int)(it % 1536);
        const bool lat = gch < ML / 64; const int ci = lat ? gch % NCH_L : (gch - ML / 64) % NCH_C; const bool first = ci == 0, last = ci == (lat ? NCH_L : NCH_C) - 1;
        bf16_t* col = v.AQKV + (size_t)gch * 64 * 1536 + c;
        const float w0 = cw[c], w1 = cw[1536 + c], w2 = cw[2 * 1536 + c], w3 = cw[3 * 1536 + c], w4 = cw[4 * 1536 + c];
        float xv[68];
        xv[0] = first ? 0.f : bf2f(v.HALO[((size_t)(gch - 1) * 4 + 2) * 1536 + c]); xv[1] = first ? 0.f : bf2f(v.HALO[((size_t)(gch - 1) * 4 + 3) * 1536 + c]);
        xv[66] = last ? 0.f : bf2f(v.HALO[((size_t)(gch + 1) * 4 + 0) * 1536 + c]); xv[67] = last ? 0.f : bf2f(v.HALO[((size_t)(gch + 1) * 4 + 1) * 1536 + c]);
#pragma unroll
        for (int t = 0; t < 64; ++t) xv[2 + t] = bf2f(col[(size_t)t * 1536]);
#pragma unroll
        for (int t = 0; t < 64; ++t) { const float y = w0 * xv[t] + w1 * xv[t + 1] + w2 * xv[t + 2] + w3 * xv[t + 3] + w4 * xv[t + 4];
            col[(size_t)t * 1536] = f2bf(y / (1.0f + FEXP(-y))); }
    }
}

DEVI void phase_prep2(const Ctx& cx, const Params& p, int layer) {
    const Views v = make_views(p.ws);
    const int wave = RFL(cx.tid >> 6), lane = cx.tid & 63;
    for (int m = wave * cx.nblk + cx.bid; m < MT; m += 8 * cx.nblk) {
        {
            bf16_t* ptr = v.AQKV + (size_t)m * 1536 + 16 * lane; float f[16]; unpack8(*(const U4*)ptr, f); unpack8(*(const U4*)(ptr + 8), f + 8);
            float ss = 0.f;
#pragma unroll
            for (int e = 0; e < 16; ++e) ss += f[e] * f[e];
            ss = grp_sum<8>(ss, lane);
            const float sc = (1.0f / sqrtf(ss + EPSF)) * (lane < 32 ? 0.08838834764831845f : 1.0f);
#pragma unroll
            for (int e = 0; e < 16; ++e) f[e] *= sc;
            *(U4*)ptr = pack8(f); *(U4*)(ptr + 8) = pack8(f + 8);
        }
        if (m < ML && lane < 40) {
            const int t = m % SEQ, hh = lane >> 2, pu = lane & 3, half = pu >> 1, ch = pu & 1; const int pos = half == 0 ? t / GRIDW : t % GRIDW;
            bf16_t* ptr = (hh < 8 ? v.BQ + (size_t)m * 512 + hh * 64 : v.BKV + (size_t)m * 256 + (hh - 8) * 64) + half * 32 + ch * 8;
            float x1[8], x2[8]; unpack8(*(const U4*)ptr, x1); unpack8(*(const U4*)(ptr + 16), x2);
            const float* cs = v.TAX + pos * 16 + ch * 8; const float* sn = cs + 1024;
#pragma unroll
            for (int e = 0; e < 8; ++e) { const float a = x1[e], bb = x2[e]; x1[e] = a * cs[e] - bb * sn[e]; x2[e] = a * sn[e] + bb * cs[e]; }
            *(U4*)ptr = pack8(x1); *(U4*)(ptr + 16) = pack8(x2);
        }
        {
            const int which = lane >> 5, h = (lane >> 3) & 3, pu = lane & 7;
            bf16_t* ptr = v.CQKV + (size_t)m * 1536 + which * 512 + h * 128 + pu * 8;
            const float sc = which == 1 ? 0.08838834764831845f : 1.0f;
            if (m < ML) {
                float x1[8], x2[8]; unpack8(*(const U4*)ptr, x1); unpack8(*(const U4*)(ptr + 64), x2);
                const float* cs = v.TRET + (size_t)(m % SEQ) * 64 + pu * 8; const float* sn = cs + (size_t)SEQ * 64;
#pragma unroll
                for (int e = 0; e < 8; ++e) { const float a = x1[e] * sc, bb = x2[e] * sc; x1[e] = a * cs[e] - bb * sn[e]; x2[e] = a * sn[e] + bb * cs[e]; }
                *(U4*)ptr = pack8(x1); *(U4*)(ptr + 64) = pack8(x2);
            } else if (which == 1) {
                float x1[8], x2[8]; unpack8(*(const U4*)ptr, x1); unpack8(*(const U4*)(ptr + 64), x2);
#pragma unroll
                for (int e = 0; e < 8; ++e) { x1[e] *= sc; x2[e] *= sc; }
                *(U4*)ptr = pack8(x1); *(U4*)(ptr + 64) = pack8(x2);
            }
        }
    }
}

DEVI void phase_y(const Ctx& cx, const Params& p, int layer) {
    const Views v = make_views(p.ws);
    const int wave = RFL(cx.tid >> 6), lane = cx.tid & 63;
    const int mrows = layer == 0 ? MT : ML;
    for (int m = wave * cx.nblk + cx.bid; m < mrows; m += 8 * cx.nblk) {
        const int c0 = 8 * lane; float o[8], z[8], y[8];
        {   unpack8(*(const U4*)(v.PA + (size_t)m * 512 + c0), o); unpack8(*(const U4*)(v.Z + (size_t)m * 1536 + c0), z);
            float ss = 0.f;
#pragma unroll
            for (int e = 0; e < 8; ++e) ss += o[e] * o[e];
            ss = grp_sum<16>(ss, lane); const float rs = 1.0f / sqrtf(ss * (1.0f / 128.0f) + EPSF);
            const float* w = p.a_norm_w + layer * 128 + (c0 & 127);
#pragma unroll
            for (int e = 0; e < 8; ++e) y[e] = o[e] * rs * w[e] * (z[e] / (1.0f + FEXP(-z[e])));
            *(U4*)(v.Y + (size_t)m * 512 + c0) = pack8(y); }
        {   unpack8(*(const U4*)(v.BQ + (size_t)m * 512 + c0), o); unpack8(*(const U4*)(v.Z + (size_t)m * 1536 + 512 + c0), z);
#pragma unroll
            for (int e = 0; e < 8; ++e) y[e] = o[e] * (z[e] / (1.0f + FEXP(-z[e])));
            *(U4*)(v.Y + ((size_t)MT + m) * 512 + c0) = pack8(y); }
        {   unpack8(*(const U4*)(v.PC + (size_t)m * 512 + c0), o); unpack8(*(const U4*)(v.Z + (size_t)m * 1536 + 1024 + c0), z);
            float sm = 0.f;
#pragma unroll
            for (int e = 0; e < 8; ++e) sm += o[e];
            const float mu = grp_sum<16>(sm, lane) * (1.0f / 128.0f); float qv = 0.f;
#pragma unroll
            for (int e = 0; e < 8; ++e) { o[e] -= mu; qv += o[e] * o[e]; }
            const float rs = 1.0f / sqrtf(grp_sum<16>(qv, lane) * (1.0f / 128.0f) + EPSF);
            const float* w = p.c_norm_w + layer * 512 + c0;
#pragma unroll
            for (int e = 0; e < 8; ++e) y[e] = o[e] * rs * w[e] * (z[e] / (1.0f + FEXP(-z[e])));
            *(U4*)(v.Y + ((size_t)2 * MT + m) * 512 + c0) = pack8(y); }
    }
}

DEVI void phase_final(const Ctx& cx, const Params& p) {
    const int wave = RFL(cx.tid >> 6), lane = cx.tid & 63;
    for (int m = wave * cx.nblk + cx.bid; m < ML; m += 8 * cx.nblk) {
        float* xr = p.out + (size_t)m * DM; f32x4 xv[4]; float ss = 0.f;
#pragma unroll
        for (int j = 0; j < 4; ++j) { xv[j] = ldg4(xr + 256 * j + 4 * lane); ss += xv[j][0] * xv[j][0] + xv[j][1] * xv[j][1] + xv[j][2] * xv[j][2] + xv[j][3] * xv[j][3]; }
        ss = wave_sum(ss, lane);
        const float r = 1.0f / sqrtf(ss * (1.0f / DM) + EPSF);
#pragma unroll
        for (int j = 0; j < 4; ++j) { const f32x4 w4 = ldg4(p.final_norm_w + 256 * j + 4 * lane); f32x4 o4;
#pragma unroll
            for (int e = 0; e < 4; ++e) o4[e] = xv[j][e] * r * w4[e];
            stg4(xr + 256 * j + 4 * lane, o4); }
    }
}

DEVI bf16x8 ld8g(const bf16_t* p) { bf16x8 v; __builtin_memcpy(&v, p, 16); return v; }
DEVI bf16x8 ld8l(LQ const unsigned char* p) { return *(LQ const bf16x8*)p; }
DEVI bf16x8 ld44l(LQ const unsigned char* p) { i64x2 t; t[0] = *(LQ const long long*)p; t[1] = *(LQ const long long*)(p + 32); return __builtin_bit_cast(bf16x8, t); }
DEVI f32x4 ld4fl(LQ const unsigned char* p) { return *(LQ const f32x4*)p; }
DEVI bf16x8 packb(const f32x4& x0, const f32x4& x1) { u32x4 t; t[0] = pk2(x0[0], x0[1]); t[1] = pk2(x0[2], x0[3]); t[2] = pk2(x1[0], x1[1]); t[3] = pk2(x1[2], x1[3]); return __builtin_bit_cast(bf16x8, t); }
DEVI float wave_incl_scan(float v, int lane) {
#pragma unroll
    for (int d = 1; d < 64; d <<= 1) { const float t = shfl_f(v, lane - d < 0 ? 0 : lane - d); if (lane >= d) v += t; }
    return v;
}
DEVI int chain_row0(int b, int dir, int n) {
    if (n < NCH_C) { const int c = dir ? NCH_C - 1 - n : n; return ML + b * CTXL + 64 * c; }
    int c = n - NCH_C; if (dir) c = NCH_L - 1 - c; return b * SEQ + 64 * c;
}

constexpr int TM_WAVE_BYTES = 16384 + 512;
DEVI void phase_tmat(const Ctx& cx, const Params& p, LQ unsigned char* lds, int layer) {
    const Views v = make_views(p.ws);
    const int wave = RFL(cx.tid >> 6), lane = cx.tid & 63, q = lane >> 4, c = lane & 15;
    LQ unsigned char* wl = lds + wave * TM_WAVE_BYTES;
    LQ float* Am = (LQ float*)wl; LQ float* tab = (LQ float*)(wl + 16384);
    const int nitem = (MT / 64) * 8;
    for (int item = wave * cx.nblk + cx.bid; item < nitem; item += 8 * cx.nblk) {
        const int gchunk = item >> 3, h = (item >> 1) & 3, dir = item & 1; const size_t m0 = (size_t)gchunk * 64;
        { const size_t m = m0 + (dir ? 63 - lane : lane); const float g = v.G[m * 8 + dir * 4 + h], be = v.BETA[m * 8 + dir * 4 + h];
          tab[lane] = wave_incl_scan(g, lane); tab[64 + lane] = be; }
        bf16x8 fr[4][4];
#pragma unroll
        for (int t = 0; t < 4; ++t) { const int row = 16 * t + c; const size_t m = m0 + (dir ? 63 - row : row);
#pragma unroll
            for (int s2 = 0; s2 < 4; ++s2) fr[t][s2] = ld8g(v.AQKV + m * 1536 + 512 + h * 128 + 32 * s2 + 8 * q); }
        WSYNC();
#pragma unroll
        for (int it = 0; it < 4; ++it)
#pragma unroll
            for (int jt = 0; jt <= it; ++jt) {
                f32x4 acc = {0.f, 0.f, 0.f, 0.f};
#pragma unroll
                for (int s2 = 0; s2 < 4; ++s2) acc = MFMA16(fr[it][s2], fr[jt][s2], acc);
                const int col = 16 * jt + c; const float gcol = tab[col];
#pragma unroll
                for (int r = 0; r < 4; ++r) { const int row = 16 * it + 4 * q + r;
                    Am[row * 64 + col] = row > col ? tab[64 + row] * acc[r] * FEXP(tab[row] - gcol) : 0.f; }
            }
        WSYNC();
        float x[64];
#pragma unroll
        for (int i = 0; i < 64; ++i) {
            float sacc = (i == lane) ? 1.f : 0.f;
#pragma unroll
            for (int j4 = 0; j4 < (i + 3) / 4; ++j4) { const f32x4 a4 = ld4fl((LQ const unsigned char*)(Am + i * 64 + j4 * 4));
#pragma unroll
                for (int e = 0; e < 4; ++e) if (4 * j4 + e < i) sacc -= a4[e] * x[4 * j4 + e]; }
            x[i] = sacc;
        }
        WSYNC();
        LQ bf16_t* Ti = (LQ bf16_t*)wl;
#pragma unroll
        for (int i = 0; i < 64; ++i) Ti[i * 64 + lane] = f2bf(x[i]);
        WSYNC();
        bf16_t* Tg = v.T + (size_t)item * 4096;
#pragma unroll
        for (int j = 0; j < 8; ++j) { const int piece = lane + 64 * j; *(U4*)(Tg + piece * 8) = ld16l(wl + piece * 16); }
        WSYNC();
    }
}

constexpr int SC_KB = 0, SC_QB = 17408, SC_TB = 34816, SC_PB = 44032, SC_VB = 53248, SC_SC = 70656, SC_BUF = 71680;
template <int MIX, int DIR, int PF = 0> DEVI void scan_chain(const Ctx& cx, const Params& p, const Views& v, LQ unsigned char* lds, int layer, int b, int h, int half) {
    const int tid = cx.tid, wave = RFL(tid >> 6), lane = tid & 63, q = lane >> 4, c = lane & 15;
    const bool helper = wave >= 4; const int ht = tid - 256;
    const bf16_t* QKV = MIX == 0 ? v.AQKV : v.CQKV; bf16_t* PARK = MIX == 0 ? v.PA : v.PC;
    const float lgam = MIX == 1 ? -softplusf_(-p.c_decay[layer * 8 + DIR * 4 + h]) : 0.f;
    U4 kreg[4], qreg[4], treg[2], vreg[2]; float breg = 1.f, greg = 0.f, bsc = 1.f;
    auto hload = [&](int n) {
        const size_t m0 = (size_t)chain_row0(b, DIR, n);
#pragma unroll
        for (int j = 0; j < 4; ++j) { const int piece = ht + 256 * j, row = piece >> 4, c16 = piece & 15; const size_t m = m0 + (DIR ? 63 - row : row);
            kreg[j] = *(const U4*)(QKV + m * 1536 + 512 + h * 128 + c16 * 8); qreg[j] = *(const U4*)(QKV + m * 1536 + h * 128 + c16 * 8); }
        if (MIX == 0) { const bf16_t* Tg = v.T + ((size_t)(m0 / 64) * 8 + h * 2 + DIR) * 4096;
#pragma unroll
            for (int j = 0; j < 2; ++j) treg[j] = *(const U4*)(Tg + (ht + 256 * j) * 8); }
        { const int row = ht & 63, cg = ht >> 6; const size_t m = m0 + (DIR ? 63 - row : row);
          const bf16_t* vp = QKV + m * 1536 + 1024 + h * 128 + 64 * half + 16 * cg; vreg[0] = *(const U4*)vp; vreg[1] = *(const U4*)(vp + 8);
          if (MIX == 0) bsc = v.BETA[m * 8 + DIR * 4 + h]; }
        if (MIX == 0 && wave == 4) { const size_t m = m0 + (DIR ? 63 - ht : ht); greg = v.G[m * 8 + DIR * 4 + h]; breg = v.BETA[m * 8 + DIR * 4 + h]; }
    };
    auto hwrite = [&](int bufi) {
        LQ unsigned char* B = lds + bufi * SC_BUF;
#pragma unroll
        for (int j = 0; j < 4; ++j) { const int piece = ht + 256 * j, row = piece >> 4, c16 = piece & 15;
            st16l(B + SC_KB + row * 272 + c16 * 16, kreg[j]); st16l(B + SC_QB + row * 272 + c16 * 16, qreg[j]); }
        if (MIX == 0) {
#pragma unroll
            for (int j = 0; j < 2; ++j) { const int piece = ht + 256 * j, row = piece >> 3, c8 = piece & 7; st16l(B + SC_TB + row * 144 + c8 * 16, treg[j]); } }
        { const int row = ht & 63, cg = ht >> 6; float f[16]; unpack8(vreg[0], f); unpack8(vreg[1], f + 8);
#pragma unroll
          for (int e = 0; e < 16; ++e) *(LQ float*)(B + SC_VB + (16 * cg + e) * 272 + row * 4) = f[e] * bsc; }
        if (wave == 4) { LQ float* sc = (LQ float*)(B + SC_SC);
            float Gc, g63;
            if (MIX == 0) { Gc = wave_incl_scan(greg, ht); g63 = shfl_f(Gc, 63); } else { Gc = (float)(ht + 1) * lgam; g63 = 64.f * lgam; }
            const float Gam = FEXP(Gc);
            sc[ht] = -breg * Gam; sc[64 + ht] = Gam; sc[128 + ht] = FEXP(g63 - Gc); sc[192 + ht] = Gc; }
    };
    auto hscore = [&](int bufi) {
        LQ unsigned char* B = lds + bufi * SC_BUF; LQ const float* sc = (LQ const float*)(B + SC_SC);
        const int it = wave - 4;
        bf16x8 qf[4];
#pragma unroll
        for (int s2 = 0; s2 < 4; ++s2) qf[s2] = ld8l(B + SC_QB + (16 * it + c) * 272 + (32 * s2 + 8 * q) * 2);
#pragma unroll 1
        for (int jt = 0; jt < 4; ++jt) {
            if (jt <= it) {
                f32x4 acc = {0.f, 0.f, 0.f, 0.f};
#pragma unroll
                for (int s2 = 0; s2 < 4; ++s2) acc = MFMA16(qf[s2], ld8l(B + SC_KB + (16 * jt + c) * 272 + (32 * s2 + 8 * q) * 2), acc);
                const int col = 16 * jt + c; const float gcol = sc[192 + col];
#pragma unroll
                for (int r = 0; r < 4; ++r) { const int row = 16 * it + 4 * q + r;
                    *(LQ bf16_t*)(B + SC_PB + row * 144 + col * 2) = f2bf(row >= col ? acc[r] * FEXP(sc[192 + row] - gcol) : 0.f); }
            } else if (jt == it + 1 && (it & 1) == 0) {
#pragma unroll
                for (int r = 0; r < 4; ++r) *(LQ bf16_t*)(B + SC_PB + (16 * it + 4 * q + r) * 144 + (16 * jt + c) * 2) = 0;
            }
        }
    };
    if (helper) {
        hload(0); hwrite(0); if (NSTEP > 1) hload(1);
        LSYNC();
        for (int n = 0; n < NSTEP; ++n) {
            hscore(n & 1);
            LSYNC();
            if (n + 1 < NSTEP) hwrite((n + 1) & 1);
            if (n + 2 < NSTEP && !(PF & 1)) hload(n + 2);
            LSYNC();
        }
    } else {
        f32x4 St[8];
#pragma unroll
        for (int t = 0; t < 8; ++t) St[t] = (f32x4){0.f, 0.f, 0.f, 0.f};
        const int arow = 8 * (c >> 2) + (c & 3);
        LSYNC();
        for (int n = 0; n < NSTEP; ++n) {
            LQ unsigned char* B = lds + (n & 1) * SC_BUF; LQ const float* sc = (LQ const float*)(B + SC_SC);
            f32x4 o[4], vn[4];
            {
                bf16x8 Sb[4];
#pragma unroll
                for (int s2 = 0; s2 < 4; ++s2) Sb[s2] = packb(St[2 * s2], St[2 * s2 + 1]);
                f32x4 R[4];
                bf16x8 fq[2][4], fk[2][4];
#pragma unroll
                for (int s2 = 0; s2 < 4; ++s2) { const int off = arow * 272 + (32 * s2 + 8 * q) * 2; fq[0][s2] = ld8l(B + SC_QB + off); if (MIX == 0) fk[0][s2] = ld8l(B + SC_KB + off); }
#pragma unroll
                for (int i = 0; i < 4; ++i) {
                    if (i < 3) {
#pragma unroll
                        for (int s2 = 0; s2 < 4; ++s2) { const int off = (32 * ((i + 1) >> 1) + 4 * ((i + 1) & 1) + arow) * 272 + (32 * s2 + 8 * q) * 2; fq[(i + 1) & 1][s2] = ld8l(B + SC_QB + off); if (MIX == 0) fk[(i + 1) & 1][s2] = ld8l(B + SC_KB + off); } }
                    const int r0 = 32 * (i >> 1) + 8 * q + 4 * (i & 1);
                    const f32x4 Gm = ld4fl(B + SC_SC + (64 + r0) * 4);
                    const f32x4 Vt = ld4fl(B + SC_VB + (16 * wave + c) * 272 + r0 * 4);
                    f32x4 a4 = {0.f, 0.f, 0.f, 0.f}; if (MIX == 0) a4 = ld4fl(B + SC_SC + r0 * 4);
                    f32x4 aK = {0.f, 0.f, 0.f, 0.f}, aQ = {0.f, 0.f, 0.f, 0.f};
                    SCHEDB();
#pragma unroll
                    for (int s2 = 0; s2 < 4; ++s2) { aQ = MFMA16(fq[i & 1][s2], Sb[s2], aQ); if (MIX == 0) aK = MFMA16(fk[i & 1][s2], Sb[s2], aK); }
                    SCHEDB();
                    o[i] = Gm * aQ;
                    if (MIX == 0) R[i] = Vt + a4 * aK; else vn[i] = Vt;
                }
                if (MIX == 0) {
                    bf16x8 Rb[2]; Rb[0] = packb(R[0], R[1]); Rb[1] = packb(R[2], R[3]);
                    bf16x8 tf[6];
                    tf[0] = ld8l(B + SC_TB + arow * 144 + (8 * q) * 2); tf[1] = ld8l(B + SC_TB + (4 + arow) * 144 + (8 * q) * 2);
                    tf[2] = ld8l(B + SC_TB + (32 + arow) * 144 + (8 * q) * 2); tf[3] = ld8l(B + SC_TB + (32 + arow) * 144 + (32 + 8 * q) * 2);
                    tf[4] = ld8l(B + SC_TB + (36 + arow) * 144 + (8 * q) * 2); tf[5] = ld8l(B + SC_TB + (36 + arow) * 144 + (32 + 8 * q) * 2);
                    const f32x4 z4 = {0.f, 0.f, 0.f, 0.f};
                    SCHEDB();
                    vn[0] = MFMA16(tf[0], Rb[0], z4); vn[1] = MFMA16(tf[1], Rb[0], z4);
                    vn[2] = MFMA16(tf[3], Rb[1], MFMA16(tf[2], Rb[0], z4)); vn[3] = MFMA16(tf[5], Rb[1], MFMA16(tf[4], Rb[0], z4));
                }
            }
            LSYNC();
            {
                bf16x8 vnb[2], veb[2];
                vnb[0] = packb(vn[0], vn[1]); vnb[1] = packb(vn[2], vn[3]);
                { f32x4 ve[4];
#pragma unroll
                  for (int i = 0; i < 4; ++i) ve[i] = ld4fl(B + SC_SC + (128 + 32 * (i >> 1) + 8 * q + 4 * (i & 1)) * 4) * vn[i];
                  veb[0] = packb(ve[0], ve[1]); veb[1] = packb(ve[2], ve[3]); }
                { bf16x8 pf[6];
                  pf[0] = ld8l(B + SC_PB + arow * 144 + (8 * q) * 2); pf[1] = ld8l(B + SC_PB + (4 + arow) * 144 + (8 * q) * 2);
                  pf[2] = ld8l(B + SC_PB + (32 + arow) * 144 + (8 * q) * 2); pf[3] = ld8l(B + SC_PB + (32 + arow) * 144 + (32 + 8 * q) * 2);
                  pf[4] = ld8l(B + SC_PB + (36 + arow) * 144 + (8 * q) * 2); pf[5] = ld8l(B + SC_PB + (36 + arow) * 144 + (32 + 8 * q) * 2);
                  SCHEDB();
                  o[0] = MFMA16(pf[0], vnb[0], o[0]); o[1] = MFMA16(pf[1], vnb[0], o[1]);
                  o[2] = MFMA16(pf[3], vnb[1], MFMA16(pf[2], vnb[0], o[2])); o[3] = MFMA16(pf[5], vnb[1], MFMA16(pf[4], vnb[0], o[3])); }
                const float g63 = sc[64 + 63];
#pragma unroll
                for (int tp = 0; tp < 8; tp += 4) {
                    s16x4 lo[4][2], hi[4][2];
#pragma unroll
                    for (int t = 0; t < 4; ++t)
#pragma unroll
                        for (int s2 = 0; s2 < 2; ++s2) { const int colb = (32 * ((tp + t) >> 1) + 8 * (c & 3) + 4 * ((tp + t) & 1)) * 2;
                            lo[t][s2] = trread(B + SC_KB + (32 * s2 + 8 * q + (c >> 2)) * 272 + colb);
                            hi[t][s2] = trread(B + SC_KB + (32 * s2 + 8 * q + 4 + (c >> 2)) * 272 + colb); }
                    SCHEDB();
#pragma unroll
                    for (int t = 0; t < 4; ++t) { f32x4 acc = St[tp + t] * g63;
#pragma unroll
                        for (int s2 = 0; s2 < 2; ++s2) { bf16x8 kt; kt[0] = lo[t][s2][0]; kt[1] = lo[t][s2][1]; kt[2] = lo[t][s2][2]; kt[3] = lo[t][s2][3]; kt[4] = hi[t][s2][0]; kt[5] = hi[t][s2][1]; kt[6] = hi[t][s2][2]; kt[7] = hi[t][s2][3];
                            acc = MFMA16(kt, veb[s2], acc); }
                        St[tp + t] = acc; }
                }
                const size_t m0 = (size_t)chain_row0(b, DIR, n);
#pragma unroll
                for (int i = 0; i < 4; ++i)
#pragma unroll
                    for (int r = 0; r < 4; ++r) { const int row = 32 * (i >> 1) + 8 * q + 4 * (i & 1) + r; const size_t m = m0 + (DIR ? 63 - row : row);
                        bf16_t* pp = PARK + m * 512 + h * 128 + 64 * half + 16 * wave + c;
                        if (!(PF & 2)) *pp = f2bf(DIR == 0 ? o[i][r] : bf2f(*pp) + o[i][r]); else if (o[i][r] == 12345.678f) *pp = 0; }
            }
            LSYNC();
        }
    }
}
template <int DIR, int PF = 0> DEVI void phase_scan(const Ctx& cx, const Params& p, LQ unsigned char* lds, int layer) {
    const Views v = make_views(p.ws);
    const int nitem = NB * 4 * 2;
    for (int item = cx.bid; item < nitem; item += cx.nblk) scan_chain<0, DIR, PF>(cx, p, v, lds, layer, item >> 3, (item >> 1) & 3, item & 1);
    CFENCE();
    for (int item = (cx.bid + cx.nblk - (nitem % cx.nblk)) % cx.nblk; item < nitem; item += cx.nblk) scan_chain<1, DIR, PF>(cx, p, v, lds, layer, item >> 3, (item >> 1) & 3, item & 1);
}

constexpr int AT_V = 9216, AT_BUF = 18432;
template <bool CTXQ> DEVI void attn_unit(const Ctx& cx, const Params& p, const Views& v, LQ unsigned char* lds, int layer, int b, int hkv, int blk) {
    const int tid = cx.tid, wave = RFL(tid >> 6), lane = tid & 63, q = lane >> 4, c = lane & 15;
    const int g = wave >> 1, rh = wave & 1, hq = 4 * hkv + g;
    const size_t mq0 = (CTXQ ? (size_t)ML + (size_t)b * CTXL : (size_t)b * SEQ) + 64 * blk + 32 * rh;
    bf16x8 qf[2][2];
#pragma unroll
    for (int i = 0; i < 2; ++i)
#pragma unroll
        for (int s2 = 0; s2 < 2; ++s2) qf[i][s2] = ld8g(v.BQ + (mq0 + 16 * i + c) * 512 + hq * 64 + 32 * s2 + 8 * q);
    const int wlo = CTXQ ? 0 : (2 - blk > 0 ? 2 - blk : 0), whi = CTXQ ? 0 : (NCH_L + 2 - blk < 5 ? NCH_L + 2 - blk : 5);
    const int ntile = NCH_C + (whi - wlo);
    const int lrow = tid >> 3, lpc = tid & 7;
    auto tile_row0 = [&](int j, int& tstart) -> size_t { if (j < NCH_C) { tstart = -100000; return (size_t)ML + (size_t)b * CTXL + 64 * j; } tstart = 64 * (blk - 2 + wlo + (j - NCH_C)); return (size_t)b * SEQ + tstart; };
    U4 kreg, vreg;
    auto tload = [&](int j) { int ts; const size_t r0 = tile_row0(j, ts); const bf16_t* src = v.BKV + (r0 + lrow) * 256 + hkv * 64 + lpc * 8; kreg = *(const U4*)src; vreg = *(const U4*)(src + 128); };
    auto twrite = [&](int bufi) { LQ unsigned char* B = lds + bufi * AT_BUF; st16l(B + lrow * 144 + lpc * 16, kreg); st16l(B + AT_V + lrow * 144 + lpc * 16, vreg); };
    float mrun[2], lrun[2]; f32x4 ot[4][2];
    mrun[0] = mrun[1] = p.b_sink[layer * 8 + hq]; lrun[0] = lrun[1] = 1.0f;
#pragma unroll
    for (int dt = 0; dt < 4; ++dt) { ot[dt][0] = (f32x4){0.f, 0.f, 0.f, 0.f}; ot[dt][1] = (f32x4){0.f, 0.f, 0.f, 0.f}; }
    SYNC();
    tload(0); twrite(0);
    SYNC();
    for (int j = 0; j < ntile; ++j) {
        LQ unsigned char* B = lds + (j & 1) * AT_BUF;
        if (j + 1 < ntile) tload(j + 1);
        int tstart; (void)tile_row0(j, tstart);
        f32x4 st[4][2];
#pragma unroll
        for (int kt = 0; kt < 4; ++kt) {
            const bf16x8 k0 = ld8l(B + (16 * kt + c) * 144 + (8 * q) * 2), k1 = ld8l(B + (16 * kt + c) * 144 + (32 + 8 * q) * 2);
#pragma unroll
            for (int i = 0; i < 2; ++i) { f32x4 acc = {0.f, 0.f, 0.f, 0.f}; acc = MFMA16(k0, qf[i][0], acc); acc = MFMA16(k1, qf[i][1], acc); st[kt][i] = acc * 0.125f; }
        }
        if (j >= NCH_C) {
#pragma unroll
            for (int i = 0; i < 2; ++i) { const int tq = 64 * blk + 32 * rh + 16 * i + c;
#pragma unroll
                for (int kt = 0; kt < 4; ++kt)
#pragma unroll
                    for (int r = 0; r < 4; ++r) { const int d = tstart + 16 * kt + 4 * q + r - tq; if (d > 128 || d < -128) st[kt][i][r] = -INFINITY; } }
        }
        bf16x8 pb[2][2];
#pragma unroll
        for (int i = 0; i < 2; ++i) {
            float mx = st[0][i][0];
#pragma unroll
            for (int kt = 0; kt < 4; ++kt)
#pragma unroll
                for (int r = 0; r < 4; ++r) mx = fmaxf(mx, st[kt][i][r]);
            mx = fmaxf(mx, shfl_f(mx, lane ^ 16)); mx = fmaxf(mx, shfl_f(mx, lane ^ 32));
            const float mnew = fmaxf(mrun[i], mx), alpha = FEXP(mrun[i] - mnew);
            float ls = 0.f;
#pragma unroll
            for (int kt = 0; kt < 4; ++kt)
#pragma unroll
                for (int r = 0; r < 4; ++r) { const float e = FEXP(st[kt][i][r] - mnew); st[kt][i][r] = e; ls += e; }
            ls += shfl_f(ls, lane ^ 16); ls += shfl_f(ls, lane ^ 32);
            lrun[i] = lrun[i] * alpha + ls; mrun[i] = mnew;
#pragma unroll
            for (int dt = 0; dt < 4; ++dt) ot[dt][i] = ot[dt][i] * alpha;
            pb[i][0] = packb(st[0][i], st[1][i]); pb[i][1] = packb(st[2][i], st[3][i]);
        }
#pragma unroll
        for (int dt = 0; dt < 4; ++dt)
#pragma unroll
            for (int ks = 0; ks < 2; ++ks) {
                const s16x4 lo = trread(B + AT_V + (32 * ks + 4 * q + (c >> 2)) * 144 + (16 * dt + 4 * (c & 3)) * 2);
                const s16x4 hi = trread(B + AT_V + (32 * ks + 16 + 4 * q + (c >> 2)) * 144 + (16 * dt + 4 * (c & 3)) * 2);
                bf16x8 vt; vt[0] = lo[0]; vt[1] = lo[1]; vt[2] = lo[2]; vt[3] = lo[3]; vt[4] = hi[0]; vt[5] = hi[1]; vt[6] = hi[2]; vt[7] = hi[3];
                ot[dt][0] = MFMA16(vt, pb[0][ks], ot[dt][0]); ot[dt][1] = MFMA16(vt, pb[1][ks], ot[dt][1]);
            }
        if (j + 1 < ntile) twrite((j + 1) & 1);
        SYNC();
    }
#pragma unroll
    for (int i = 0; i < 2; ++i) { const float il = 1.0f / lrun[i];
#pragma unroll
        for (int dt = 0; dt < 4; ++dt) { const f32x4 o4 = ot[dt][i] * il;
            unsigned long long w = (unsigned long long)pk2(o4[0], o4[1]) | ((unsigned long long)pk2(o4[2], o4[3]) << 32);
            *(unsigned long long*)(v.BQ + (mq0 + 16 * i + c) * 512 + hq * 64 + 16 * dt + 4 * q) = w; } }
}
DEVI void phase_attn(const Ctx& cx, const Params& p, LQ unsigned char* lds, int layer) {
    const Views v = make_views(p.ws);
    const int nlat = NB * 2 * NCH_L, nctx = layer == 0 ? NB * 2 * NCH_C : 0;
    for (int item = cx.bid; item < nlat + nctx; item += cx.nblk) {
        if (item < nlat) attn_unit<false>(cx, p, v, lds, layer, item / (2 * NCH_L), (item / NCH_L) & 1, item % NCH_L);
        else { const int it = item - nlat; attn_unit<true>(cx, p, v, lds, layer, it / (2 * NCH_C), (it / NCH_C) & 1, it % NCH_C); }
    }
}

struct StG1 { bf16_t *AQKV, *BQ, *BKV, *CQKV, *HALO;
    DEVI void st8(int row, int col, const float* a) const {
        bf16_t* dst = col < 1536 ? AQKV + (size_t)row * 1536 + col : (col < 2048 ? BQ + (size_t)row * 512 + (col - 1536) : (col < 2304 ? BKV + (size_t)row * 256 + (col - 2048) : CQKV + (size_t)row * 1536 + (col - 2304)));
        const U4 w = pack8(a); *(U4*)dst = w;
        const int r64 = row & 63;
        if (col < 1536 && (r64 < 2 || r64 >= 62)) *(U4*)(HALO + ((size_t)(row >> 6) * 4 + (r64 < 2 ? r64 : r64 - 60)) * 1536 + col) = w; } };
struct StPlain { bf16_t* O; int ld;
    DEVI void st8(int row, int col, const float* a) const { *(U4*)(O + (size_t)row * ld + col) = pack8(a); } };
struct StMerge { const bf16_t* L; bf16_t* MRG; int br;
    DEVI void st8(int row, int col, const float* a) const {
        float lg[8], o[8]; unpack8(*(const U4*)(L + (size_t)row * NMG + br * 1024 + col), lg);
        if (br) unpack8(*(const U4*)(MRG + (size_t)row * DM + col), o); else { for (int e = 0; e < 8; ++e) o[e] = 0.f; }
        for (int e = 0; e < 8; ++e) o[e] += sigmoidf_(lg[e]) * a[e];
        *(U4*)(MRG + (size_t)row * DM + col) = pack8(o); } };
struct StResid { const float *xlat, *xctx; float *olat, *octx; const float* mod;
    DEVI void st4(int row, int col, const float* a) const {
        const float* xi = row < ML ? xlat + (size_t)row * DM + col : xctx + (size_t)(row - ML) * DM + col;
        float* xo = row < ML ? olat + (size_t)row * DM + col : octx + (size_t)(row - ML) * DM + col;
        const int b = row < ML ? row / SEQ : NB; const float* g = mod + (size_t)b * 3072 + 2048 + col;
        for (int e = 0; e < 4; ++e) xo[e] = xi[e] + g[e] * a[e]; } };

#ifndef CPU_EMU
namespace pg8 {
#define PG8_LAS __attribute__((address_space(3)))
typedef short bf16x8 __attribute__((ext_vector_type(8)));
typedef float f32x4 __attribute__((ext_vector_type(4)));
constexpr int BM = 256, BK = 64, HALF = 128, HTB = HALF * BK * 2, STAGE_BYTES = 8 * HTB, NXCD = 8, WGM = 8;
__host__ __device__ __forceinline__ int lds_byte(int r, int c) { const int st = (r >> 4) * 2 + (c >> 5), rr = r & 15, cc = c & 31, ob = rr * 64 + cc * 2; return st * 1024 + (ob ^ (((ob >> 9) & 1) << 5)); }
__host__ __device__ __forceinline__ void stage_rc(int b, int& R, int& C) { const int st = b / 1024, sb = b % 1024, swz = sb ^ (((sb >> 9) & 1) << 5); R = (st >> 1) * 16 + swz / 64; C = (st & 1) * 32 + (swz % 64) / 2; }
__host__ __device__ __forceinline__ int perm32(int rho) { const int n = rho >> 4, i = rho & 15; return 8 * (i >> 2) + 4 * n + (i & 3); }
struct Unit { int pm, pn; };
struct Gemm { const bf16_t* A; const bf16_t* Bt; int M, N, K; };
struct StaticOrder {
    int nM, nN, nwg, G, c;
    __host__ __device__ void init(int M, int N, int G_, int c_) { nM = M / BM; nN = N / BM; nwg = nM * nN; G = G_; c = c_; }
    __host__ __device__ bool next(int i, Unit& u) const {
        const long L = (long)i * G + c; if (L >= nwg) return false;
        int wgid = (int)L; { const int q = nwg / NXCD, r = nwg % NXCD, xcd = wgid % NXCD, off = wgid / NXCD; wgid = (xcd < r ? xcd * (q + 1) : r * (q + 1) + (xcd - r) * q) + off; }
        const int nig = WGM * nN, gid = wgid / nig, fm = gid * WGM, gsz = (nM - fm) < WGM ? (nM - fm) : WGM;
        u.pm = fm + ((wgid % nig) % gsz); u.pn = (wgid % nig) / gsz; return true;
    }
    __device__ __forceinline__ void a_ready(const Unit&) const {}
    __device__ __forceinline__ void done(const Unit&) const {}
};
template <class F> struct Epi8 {
    static constexpr bool PERM = true, AFTER_DRAIN = false; F f;
    __device__ __forceinline__ void operator()(const f32x4 (&acc)[2][2][4][2], const Unit& u, int wr, int wc, int fr, int fq) const {
        const int row0 = u.pm * BM + wr * 64 + fr, col0 = u.pn * BM + wc * 32 + 8 * fq;
#pragma unroll
        for (int ai = 0; ai < 2; ++ai)
#pragma unroll
            for (int m = 0; m < 4; ++m)
#pragma unroll
                for (int bj = 0; bj < 2; ++bj) { const f32x4 v0 = acc[ai][bj][m][0], v1 = acc[ai][bj][m][1];
                    const float a[8] = {v0[0], v0[1], v0[2], v0[3], v1[0], v1[1], v1[2], v1[3]};
                    f.st8(row0 + ai * HALF + m * 16, col0 + bj * HALF, a); }
    }
};
template <class F> struct Epi4 {
    static constexpr bool PERM = false, AFTER_DRAIN = false; F f;
    __device__ __forceinline__ void operator()(const f32x4 (&acc)[2][2][4][2], const Unit& u, int wr, int wc, int fr, int fq) const {
        const int row0 = u.pm * BM + wr * 64 + fr, col0 = u.pn * BM + wc * 32 + 4 * fq;
#pragma unroll
        for (int ai = 0; ai < 2; ++ai)
#pragma unroll
            for (int m = 0; m < 4; ++m)
#pragma unroll
                for (int bj = 0; bj < 2; ++bj)
#pragma unroll
                    for (int n = 0; n < 2; ++n) { const f32x4 v0 = acc[ai][bj][m][n]; const float a[4] = {v0[0], v0[1], v0[2], v0[3]};
                        f.st4(row0 + ai * HALF + m * 16, col0 + bj * HALF + n * 16, a); }
    }
};

template <class Epi, class Sched, bool ALIGN_EPI = false, bool SP2 = false>
__device__ __forceinline__ void gemm_phase(PG8_LAS unsigned char* lds, const int tid, const Gemm g, const Sched& S, const Epi& E) {
    const int wid = __builtin_amdgcn_readfirstlane(tid >> 6), lane = tid & 63, wr = wid >> 2, wc = wid & 3, fr = lane & 15, fq = lane >> 4;
    const int K = g.K, nt = K / BK;
    unsigned voffA[2], voffB[2];
#pragma unroll
    for (int i = 0; i < 2; ++i) { int R, C; stage_rc(tid * 16 + i * 8192, R, C); const int Rb = Epi::PERM ? ((R & ~31) + perm32(R & 31)) : R;
        voffA[i] = (unsigned)(R * K + C) * 2u; voffB[i] = (unsigned)(Rb * K + C) * 2u; }
    const size_t kstep = (size_t)(BK * 2);
    const size_t hstep = (size_t)HALF * K * 2;
    const size_t tstep = 2 * hstep;
    const unsigned ldsw = (unsigned)wid * 1024u;
    const int aoff = lds_byte(wr * 64 + fr, fq * 8), boff = lds_byte(wc * 32 + fr, fq * 8);
#define PG8_SA(b, h) (((b) * 2 + (h)) * HTB)
#define PG8_SB(b, h) ((4 + (b) * 2 + (h)) * HTB)
#define PG8_STAGE(bufoff, gbase, voff) do { _Pragma("unroll") for (int _i = 0; _i < 2; ++_i) \
        __builtin_amdgcn_global_load_lds((const unsigned*)((const char*)(gbase) + (voff)[_i]), (PG8_LAS unsigned*)(lds + (bufoff) + ldsw + _i * 8192), 16, 0, 0); } while (0)
#define PG8_LDA(dst, b, h) do { _Pragma("unroll") for (int m = 0; m < 4; ++m) _Pragma("unroll") for (int k = 0; k < 2; ++k) dst[m][k] = *(const PG8_LAS bf16x8*)(lds + PG8_SA(b, h) + aoff + m * 2048 + k * 1024); } while (0)
#define PG8_LDB(dst, b, h) do { _Pragma("unroll") for (int n = 0; n < 2; ++n) _Pragma("unroll") for (int k = 0; k < 2; ++k) dst[n][k] = *(const PG8_LAS bf16x8*)(lds + PG8_SB(b, h) + boff + n * 2048 + k * 1024); } while (0)
#define PG8_MMA(ai, bj, At, Bt) do { __builtin_amdgcn_s_setprio(1); _Pragma("unroll") for (int m = 0; m < 4; ++m) _Pragma("unroll") for (int n = 0; n < 2; ++n) _Pragma("unroll") for (int k = 0; k < 2; ++k) \
        acc[ai][bj][m][n] = __builtin_amdgcn_mfma_f32_16x16x32_bf16(Bt[n][k], At[m][k], acc[ai][bj][m][n], 0, 0, 0); __builtin_amdgcn_s_setprio(0); } while (0)
#define PG8_WAIT_V(n) asm volatile("s_waitcnt vmcnt(" #n ")" ::: "memory")
#define PG8_WAIT_L(n) asm volatile("s_waitcnt lgkmcnt(" #n ")" ::: "memory")
#define PG8_BAR __builtin_amdgcn_s_barrier()
#define PG8_SCHED __builtin_amdgcn_sched_barrier(0)
    Unit cur, nxt; int ui = 0;
    if (!S.next(0, cur)) return;
    f32x4 acc[2][2][4][2];
#pragma unroll
    for (int a = 0; a < 2; ++a)
#pragma unroll
        for (int b = 0; b < 2; ++b)
#pragma unroll
            for (int m = 0; m < 4; ++m)
#pragma unroll
                for (int n = 0; n < 2; ++n) acc[a][b][m][n] = (f32x4){0.f, 0.f, 0.f, 0.f};
    bf16x8 At[4][2], B0[2][2], B1[2][2];
    const char* cA = (const char*)g.A + (size_t)cur.pm * tstep; const char* cB = (const char*)g.Bt + (size_t)cur.pn * tstep;
    S.a_ready(cur);
    if constexpr (SP2) {
        PG8_STAGE(PG8_SB(0, 0), cB, voffB); PG8_STAGE(PG8_SB(0, 1), cB + hstep, voffB); PG8_STAGE(PG8_SA(0, 0), cA, voffA); PG8_STAGE(PG8_SA(0, 1), cA + hstep, voffA);
        if (wr == 1) PG8_BAR;
        PG8_WAIT_V(2); PG8_BAR;
        PG8_STAGE(PG8_SB(1, 0), cB + kstep, voffB); PG8_STAGE(PG8_SA(1, 0), cA + kstep, voffA); PG8_STAGE(PG8_SB(1, 1), cB + hstep + kstep, voffB);
        PG8_WAIT_V(6); PG8_BAR;
    } else {
        PG8_STAGE(PG8_SB(0, 0), cB, voffB); PG8_STAGE(PG8_SA(0, 0), cA, voffA); PG8_STAGE(PG8_SB(0, 1), cB + hstep, voffB); PG8_STAGE(PG8_SA(0, 1), cA + hstep, voffA);
        if (wr == 1) PG8_BAR;
        PG8_WAIT_V(4); PG8_BAR;
        PG8_STAGE(PG8_SB(1, 0), cB + kstep, voffB); PG8_STAGE(PG8_SA(1, 0), cA + kstep, voffA); PG8_STAGE(PG8_SB(1, 1), cB + hstep + kstep, voffB);
        PG8_WAIT_V(6); PG8_BAR;
    }
    for (;;) {
        const bool has_next = S.next(ui + 1, nxt);
        const char* nA = has_next ? (const char*)g.A + (size_t)nxt.pm * tstep : cA; const char* nB = has_next ? (const char*)g.Bt + (size_t)nxt.pn * tstep : cB;
        for (int t = 0; t < nt; t += 2) {
            const bool last = (t == nt - 2);
            const char* a1 = cA + (size_t)(t + 1) * kstep;
            const char* a2 = last ? nA : cA + (size_t)(t + 2) * kstep; const char* b2 = last ? nB : cB + (size_t)(t + 2) * kstep;
            const char* a3 = a2 + kstep; const char* b3 = b2 + kstep;
            if (last && has_next) S.a_ready(nxt);
            if constexpr (SP2) {
            PG8_LDB(B0, 0, 0); PG8_LDB(B1, 0, 1); PG8_SCHED; PG8_LDA(At, 0, 0); PG8_STAGE(PG8_SA(1, 1), a1 + hstep, voffA);
            PG8_WAIT_V(8); PG8_WAIT_L(0); PG8_BAR; PG8_MMA(0, 0, At, B0); PG8_MMA(0, 1, At, B1); PG8_BAR; PG8_SCHED;
            PG8_LDA(At, 0, 1); PG8_STAGE(PG8_SB(0, 0), b2, voffB); PG8_STAGE(PG8_SB(0, 1), b2 + hstep, voffB); PG8_STAGE(PG8_SA(0, 0), a2, voffA);
            PG8_WAIT_V(8); PG8_WAIT_L(0); PG8_BAR; PG8_MMA(1, 0, At, B0); PG8_MMA(1, 1, At, B1); PG8_BAR; PG8_SCHED;
            PG8_LDB(B0, 1, 0); PG8_LDB(B1, 1, 1); PG8_SCHED; PG8_LDA(At, 1, 0); PG8_STAGE(PG8_SA(0, 1), a2 + hstep, voffA);
            PG8_WAIT_V(8); PG8_WAIT_L(0); PG8_BAR; PG8_MMA(0, 0, At, B0); PG8_MMA(0, 1, At, B1); PG8_BAR; PG8_SCHED;
            PG8_LDA(At, 1, 1); PG8_STAGE(PG8_SB(1, 0), b3, voffB); PG8_STAGE(PG8_SB(1, 1), b3 + hstep, voffB); PG8_STAGE(PG8_SA(1, 0), a3, voffA);
            PG8_WAIT_V(8); PG8_WAIT_L(0); PG8_BAR; PG8_MMA(1, 0, At, B0); PG8_MMA(1, 1, At, B1); PG8_BAR; PG8_SCHED;
            } else {
            PG8_LDB(B0, 0, 0); PG8_SCHED; PG8_LDA(At, 0, 0); PG8_STAGE(PG8_SA(1, 1), a1 + hstep, voffA);
            PG8_WAIT_L(8); PG8_BAR; PG8_WAIT_L(0); PG8_MMA(0, 0, At, B0); PG8_BAR; PG8_SCHED;
            PG8_LDB(B1, 0, 1); PG8_STAGE(PG8_SB(0, 0), b2, voffB);
            PG8_BAR; PG8_WAIT_L(0); PG8_MMA(0, 1, At, B1); PG8_BAR;
            PG8_LDA(At, 0, 1); PG8_STAGE(PG8_SA(0, 0), a2, voffA);
            PG8_BAR; PG8_WAIT_L(0); PG8_MMA(1, 0, At, B0); PG8_BAR; PG8_SCHED;
            PG8_STAGE(PG8_SB(0, 1), b2 + hstep, voffB);
            PG8_WAIT_V(6); PG8_BAR; PG8_MMA(1, 1, At, B1); PG8_BAR;
            PG8_LDB(B0, 1, 0); PG8_SCHED; PG8_LDA(At, 1, 0); PG8_STAGE(PG8_SA(0, 1), a2 + hstep, voffA);
            PG8_WAIT_L(8); PG8_BAR; PG8_WAIT_L(0); PG8_MMA(0, 0, At, B0); PG8_BAR; PG8_SCHED;
            PG8_LDB(B1, 1, 1); PG8_STAGE(PG8_SB(1, 0), b3, voffB);
            PG8_BAR; PG8_WAIT_L(0); PG8_MMA(0, 1, At, B1); PG8_BAR;
            PG8_LDA(At, 1, 1); PG8_STAGE(PG8_SA(1, 0), a3, voffA);
            PG8_BAR; PG8_WAIT_L(0); PG8_MMA(1, 0, At, B0); PG8_BAR; PG8_SCHED;
            PG8_STAGE(PG8_SB(1, 1), b3 + hstep, voffB);
            PG8_WAIT_V(6); PG8_BAR; PG8_MMA(1, 1, At, B1); PG8_BAR;
            }
        }
        if constexpr (ALIGN_EPI) { if (wr == 0) PG8_BAR; }
        if constexpr (!Epi::AFTER_DRAIN) { E(acc, cur, wr, wc, fr, fq); S.done(cur); }
        if (!has_next) break;
#pragma unroll
        for (int a = 0; a < 2; ++a)
#pragma unroll
            for (int b = 0; b < 2; ++b)
#pragma unroll
                for (int m = 0; m < 4; ++m)
#pragma unroll
                    for (int n = 0; n < 2; ++n) acc[a][b][m][n] = (f32x4){0.f, 0.f, 0.f, 0.f};
        cur = nxt; cA = nA; cB = nB; ++ui;
        if constexpr (ALIGN_EPI) { if (wr == 1) PG8_BAR; }
    }
    PG8_WAIT_V(0);
    if constexpr (!ALIGN_EPI) { if (wr == 0) PG8_BAR; }
    PG8_BAR;
#undef PG8_SA
#undef PG8_SB
#undef PG8_STAGE
#undef PG8_LDA
#undef PG8_LDB
#undef PG8_MMA
#undef PG8_WAIT_V
#undef PG8_WAIT_L
#undef PG8_BAR
#undef PG8_SCHED
}
}

template <class F> __device__ __forceinline__ void run_gemm8(PG8_LAS unsigned char* lds, const Ctx& cx, const bf16_t* A, const bf16_t* Bt, int M, int N, int K, const F& f) {
    pg8::Gemm g{A, Bt, M, N, K}; pg8::StaticOrder S; S.init(M, N, cx.nblk, cx.bid);
    pg8::Epi8<F> E{f};
    pg8::gemm_phase<pg8::Epi8<F>, pg8::StaticOrder, true, true>(lds, cx.tid, g, S, E);
}
template <class F> __device__ __forceinline__ void run_gemm4(PG8_LAS unsigned char* lds, const Ctx& cx, const bf16_t* A, const bf16_t* Bt, int M, int N, int K, const F& f) {
    pg8::Gemm g{A, Bt, M, N, K}; pg8::StaticOrder S; S.init(M, N, cx.nblk, cx.bid);
    pg8::Epi4<F> E{f};
    pg8::gemm_phase<pg8::Epi4<F>, pg8::StaticOrder, true, true>(lds, cx.tid, g, S, E);
}
#else
template <class F> void run_gemm8(unsigned char*, const Ctx&, const bf16_t* A, const bf16_t* Bt, int M, int N, int K, const F& f) {
#pragma omp parallel for schedule(dynamic, 8)
    for (int r = 0; r < M; ++r) for (int c0 = 0; c0 < N; c0 += 8) { float a[8];
        for (int e = 0; e < 8; ++e) { float s = 0.f; const bf16_t* ar = A + (size_t)r * K; const bf16_t* br = Bt + (size_t)(c0 + e) * K; for (int k = 0; k < K; ++k) s += bf2f(ar[k]) * bf2f(br[k]); a[e] = s; }
        f.st8(r, c0, a); }
}
template <class F> void run_gemm4(unsigned char*, const Ctx&, const bf16_t* A, const bf16_t* Bt, int M, int N, int K, const F& f) {
#pragma omp parallel for schedule(dynamic, 8)
    for (int r = 0; r < M; ++r) for (int c0 = 0; c0 < N; c0 += 4) { float a[4];
        for (int e = 0; e < 4; ++e) { float s = 0.f; const bf16_t* ar = A + (size_t)r * K; const bf16_t* br = Bt + (size_t)(c0 + e) * K; for (int k = 0; k < K; ++k) s += bf2f(ar[k]) * bf2f(br[k]); a[e] = s; }
        f.st4(r, c0, a); }
}
#endif

#ifndef PROBE_S
#define PROBE_S -1
#endif
constexpr int PPL = 14;
constexpr int NPHASE = 2 + PPL * NLAYER;
template <int PH> DEVI void run_phase_t(LQ unsigned char* lds, const Ctx& cx, const Params& p) {
    const Views v = make_views(p.ws);
    if constexpr (PH == 0) { phase_prep(cx, p, lds); if (PROBE_S == 100) { SYNC(); phase_prep(cx, p, lds); } }
    else if constexpr (PH == NPHASE - 1) { phase_final(cx, p); }
    else {
        constexpr int layer = (PH - 1) / PPL, s = (PH - 1) % PPL;
        constexpr int mrows = layer == NLAYER - 1 ? ML : MT;
        if constexpr (s == 0) { phase_norm(cx, p, layer); if (PROBE_S == 0) phase_norm(cx, p, layer); }
        else if constexpr (s == 1) run_gemm8(lds, cx, v.XN, v.W1 + (size_t)layer * N1 * DM, MT, N1, DM, StG1{v.AQKV, v.BQ, v.BKV, v.CQKV, v.HALO});
        else if constexpr (s == 2) phase_conv(cx, p, layer);
        else if constexpr (s == 3) phase_prep2(cx, p, layer);
        else if constexpr (s == 4) { phase_tmat(cx, p, lds, layer); if (PROBE_S == 41) { SYNC(); phase_tmat(cx, p, lds, layer); } phase_attn(cx, p, lds, layer); }
        else if constexpr (s == 5) { if (PROBE_S == 51) { phase_scan<0, 3>(cx, p, lds, layer); SYNC(); } if (PROBE_S == 52) { phase_scan<0, 2>(cx, p, lds, layer); SYNC(); } phase_scan<0>(cx, p, lds, layer); if (PROBE_S == 5) { SYNC(); phase_scan<0>(cx, p, lds, layer); } }
        else if constexpr (s == 6) phase_scan<1>(cx, p, lds, layer);
        else if constexpr (s == 7) run_gemm8(lds, cx, v.XN, v.WZ + (size_t)layer * NZ * DM, mrows, NZ, DM, StPlain{v.Z, NZ});
        else if constexpr (s == 8) { phase_y(cx, p, layer); if (PROBE_S == 8) phase_y(cx, p, layer); }
        else if constexpr (s == 9) run_gemm8(lds, cx, v.XN, v.WM + (size_t)layer * NMG * DM, mrows, NMG, DM, StPlain{v.L, NMG});
        else if constexpr (s >= 10 && s <= 12) { constexpr int br = s - 10;
            run_gemm8(lds, cx, v.Y + (size_t)br * MT * 512, v.WB + ((size_t)layer * 3 + br) * DM * 512, mrows, DM, 512, StMerge{v.L, v.MRG, br}); }
        else run_gemm4(lds, cx, v.MRG, v.WO + (size_t)layer * DM * DM, mrows, DM, DM,
                       StResid{layer == 0 ? p.x : p.out, layer == 0 ? p.ctx : v.CTX1, p.out, v.CTX1, v.MOD + (size_t)layer * (NB + 1) * 3072});
    }
}
HD bool phase_is_gemm(int ph) { if (ph == 0 || ph == NPHASE - 1) return false; const int s = (ph - 1) % PPL; return s == 1 || s == 7 || s >= 9; }
#define MK_PHASE_LIST(X) X(0) X(1) X(2) X(3) X(4) X(5) X(6) X(7) X(8) X(9) X(10) X(11) X(12) X(13) X(14) X(15) X(16) X(17) X(18) X(19) X(20) X(21) X(22) X(23) X(24) X(25) X(26) X(27) X(28) X(29)
static_assert(NPHASE == 30, "phase list");
#ifdef CPU_EMU
inline void run_phase(unsigned char* lds, const Ctx& cx, const Params& p, int ph) {
    switch (ph) {
#define X(k) case k: run_phase_t<k>(lds, cx, p); break;
        MK_PHASE_LIST(X)
#undef X
    }
}
#endif

#ifndef CPU_EMU
constexpr int LDS_BYTES = 147456;
constexpr int LDS_BARST = 147392;
#define XB_TMO      128
#define XB_XCNT(j)  (256  + 64 * (j))
#define XB_XSUB(j)  (1280 + 64 * (j))
#define XB_XGEN(j)  (2304 + 64 * (j))
#define XB_TOP      3328
#define XB_TOPGEN   3392
#define XCD_BAR_WORDS 3456
#define XB_SPIN_CAP (1u << 22)
__device__ __forceinline__ unsigned xb_ld(unsigned* p)              { return __hip_atomic_load(p, __ATOMIC_RELAXED, __HIP_MEMORY_SCOPE_AGENT); }
__device__ __forceinline__ unsigned xb_add(unsigned* p, unsigned v) { return __hip_atomic_fetch_add(p, v, __ATOMIC_RELAXED, __HIP_MEMORY_SCOPE_AGENT); }
__device__ __forceinline__ unsigned xb_xcc_id() { return (unsigned)__builtin_amdgcn_s_getreg((3 << 11) | 20) & 0xFu; }
#define XB_SPIN(cond, bar) do { unsigned _sp = 0; while (cond) { __builtin_amdgcn_s_sleep(1); \
    if ((++_sp & 255u) == 0u) { if (xb_ld(&(bar)[XB_TMO])) break; if (_sp > XB_SPIN_CAP) { atomicAdd(&(bar)[XB_TMO], 1u); break; } } } } while (0)
struct XcdBarrier { unsigned* bar; unsigned x; volatile PG8_LAS unsigned* st; };
__device__ __forceinline__ void xcd_barrier_complete(unsigned* bar, unsigned x, unsigned G, unsigned& nloc, unsigned& nx) {
    unsigned sum, cnt, mine, sp = 0u;
    for (;;) {
        sum = 0u; cnt = 0u; mine = 0u;
#pragma unroll
        for (unsigned j = 0; j < 16; ++j) { const unsigned c = xb_ld(&bar[XB_XCNT(j)]); sum += c; cnt += (c > 0u) ? 1u : 0u; mine = (j == x) ? c : mine; }
        if (sum == G) break;
        __builtin_amdgcn_s_sleep(1);
        if ((++sp & 255u) == 0u) { if (xb_ld(&bar[XB_TMO])) break; if (sp > XB_SPIN_CAP) { atomicAdd(&bar[XB_TMO], 1u); break; } }
    }
    nloc = mine > 0u ? mine : 1u; nx = cnt > 0u ? cnt : 1u;
}
__device__ __forceinline__ void xcd_barrier(const XcdBarrier& b, int tid, unsigned G) {
    asm volatile("s_waitcnt vmcnt(0)" ::: "memory");
    __syncthreads();
    if (tid == 0) {
        unsigned* bar = b.bar;
        __builtin_amdgcn_s_waitcnt(0);
        unsigned nloc = b.st[0], nx = b.st[1];
        if (nloc == 0u) { xcd_barrier_complete(bar, b.x, G, nloc, nx); b.st[0] = nloc; b.st[1] = nx; }
        const unsigned old = xb_add(&bar[XB_XSUB(b.x)], 1u);
        const unsigned gen = old / nloc;
        if (old + 1u == (gen + 1u) * nloc) {
            __builtin_amdgcn_fence(__ATOMIC_RELEASE, "agent");
            asm volatile("s_waitcnt vmcnt(0)" ::: "memory");
            const unsigned og = xb_add(&bar[XB_TOP], 1u);
            const unsigned tg = og / nx;
            if (og + 1u == (tg + 1u) * nx) xb_add(&bar[XB_TOPGEN], 1u);
            else XB_SPIN(xb_ld(&bar[XB_TOPGEN]) == tg, bar);
            __builtin_amdgcn_fence(__ATOMIC_ACQUIRE, "agent");
            xb_add(&bar[XB_XGEN(b.x)], 1u);
            asm volatile("s_waitcnt vmcnt(0)" ::: "memory");
        } else {
            XB_SPIN(xb_ld(&bar[XB_XGEN(b.x)]) == gen, bar);
            __builtin_amdgcn_fence(__ATOMIC_ACQUIRE, "agent");
            asm volatile("s_waitcnt vmcnt(0)" ::: "memory");
        }
    }
    __syncthreads();
}

__global__ void __launch_bounds__(512, 2) mk_fwd(Params p) {
    extern __shared__ __attribute__((aligned(16))) unsigned char lds_raw[];
    PG8_LAS unsigned char* lds = (PG8_LAS unsigned char*)lds_raw;
    cg::grid_group grid = cg::this_grid();
    const int ph_lo = p.ph_lo, ph_hi = p.ph_hi;
    const int wave_s = __builtin_amdgcn_readfirstlane((int)threadIdx.x >> 6);
    volatile PG8_LAS unsigned* bst = (volatile PG8_LAS unsigned*)(lds + LDS_BARST);
    if (threadIdx.x < 2) bst[threadIdx.x] = 0u;
    __syncthreads();
    XcdBarrier bar; bar.bar = (unsigned*)p.ws; bar.x = xb_xcc_id(); bar.st = bst;
    if (threadIdx.x == 0) (void)xb_add(&bar.bar[XB_XCNT(bar.x)], 1u);
#define X(k) if (ph_lo <= k && k < ph_hi) { \
        const Params* q = (const Params*)__builtin_amdgcn_kernarg_segment_ptr(); asm volatile("" : "+s"(q) :: "memory"); \
        Ctx cx; cx.tid = wave_s * 64 + (int)__builtin_amdgcn_mbcnt_hi(~0u, __builtin_amdgcn_mbcnt_lo(~0u, 0u)); cx.bid = (int)blockIdx.x; cx.nblk = (int)gridDim.x; \
        asm volatile("" : "+v"(cx.tid)); asm volatile("" : "+s"(cx.bid), "+s"(cx.nblk)); \
        run_phase_t<k>(lds, cx, *q); \
        if (k + 1 < ph_hi) { if (k == 0) grid.sync(); else { unsigned z0 = 0u; asm volatile("" : "+v"(z0)); const int t2 = wave_s * 64 + (int)__builtin_amdgcn_mbcnt_hi(~0u, __builtin_amdgcn_mbcnt_lo(~0u, z0)); xcd_barrier(bar, t2, gridDim.x); } } }
    MK_PHASE_LIST(X)
#undef X
}

#ifndef MK_SINGLE
#define MK_SINGLE 1
#endif
extern "C" void kernel_launch(void* const* d_in, const int* in_sizes, int n_in, void* d_out, int out_size, void* d_ws, size_t ws_size, hipStream_t stream) {
    static int grid = 0;
    if (grid == 0) {
        if (n_in != 18 || in_sizes[0] != ML * DM || out_size != ML * DM || ws_size < WS_END) { fprintf(stderr, "kernel_launch: unexpected shapes (n_in %d, in0 %d, out %d, ws %zu < %zu)\n", n_in, n_in > 0 ? in_sizes[0] : -1, out_size, ws_size, (size_t)WS_END); grid = -1; return; }
        int dev = 0, cus = 0, per_cu = 0;
        if (hipGetDevice(&dev) != hipSuccess || hipDeviceGetAttribute(&cus, hipDeviceAttributeMultiprocessorCount, dev) != hipSuccess) { grid = -1; return; }
        if (hipFuncSetAttribute((const void*)mk_fwd, hipFuncAttributeMaxDynamicSharedMemorySize, LDS_BYTES) != hipSuccess) { fprintf(stderr, "kernel_launch: hipFuncSetAttribute failed\n"); grid = -1; return; }
        if (hipOccupancyMaxActiveBlocksPerMultiprocessor(&per_cu, (const void*)mk_fwd, 512, LDS_BYTES) != hipSuccess || per_cu < 1) { fprintf(stderr, "kernel_launch: occupancy query says %d\n", per_cu); (void)hipGetLastError(); grid = -1; return; }
        grid = cus;
    }
    if (grid < 0) return;
    if (hipMemsetAsync(d_ws, 0, 16384, stream) != hipSuccess) { fprintf(stderr, "kernel_launch: memset failed\n"); return; }
    Params p{};
    const float** pp = (const float**)&p;
    for (int i = 0; i < 18; ++i) pp[i] = (const float*)d_in[i];
    p.out = (float*)d_out; p.ws = (unsigned char*)d_ws;
#if MK_SINGLE
    p.ph_lo = 0; p.ph_hi = NPHASE;
    { void* args[] = {&p}; hipError_t e = hipLaunchCooperativeKernel((const void*)mk_fwd, dim3(grid), dim3(512), args, LDS_BYTES, stream);
      if (e != hipSuccess) fprintf(stderr, "cooperative launch failed: %s\n", hipGetErrorString(e)); }
#else
    for (int ph = 0; ph < NPHASE; ++ph) {
        p.ph_lo = ph; p.ph_hi = ph + 1;
        void* args[] = {&p}; hipError_t e = hipLaunchCooperativeKernel((const void*)mk_fwd, dim3(grid), dim3(512), args, LDS_BYTES, stream);
        if (e != hipSuccess) { fprintf(stderr, "cooperative launch %d failed: %s\n", ph, hipGetErrorString(e)); break; }
    }
#endif
}
#endif
```

```cpp
#ifndef CPU_EMU
#include <hip/hip_runtime.h>
#include <hip/hip_cooperative_groups.h>
#include <cstdio>
#include <cstdint>
namespace cg = cooperative_groups;
#define DEVI __device__ __forceinline__
#define HD __host__ __device__ __forceinline__
#define CFENCE() asm volatile("" ::: "memory")
#define LAUNDER(x) asm volatile("" : "+v"(x))
#define SCHEDB() __builtin_amdgcn_sched_barrier(0)
#else
#define CFENCE() do {} while (0)
#define LAUNDER(x) do {} while (0)
#define SCHEDB() do {} while (0)
#include <cstring>
#include <cmath>
#include <cstdio>
#include <cstdint>
#include <cstddef>
#define DEVI inline
#define HD inline
#endif

#ifndef CPU_EMU
#define LQ __attribute__((address_space(3)))
typedef short bf16x8 __attribute__((ext_vector_type(8)));
typedef float f32x4 __attribute__((ext_vector_type(4)));
typedef short s16x4 __attribute__((ext_vector_type(4)));
typedef long long i64x2 __attribute__((ext_vector_type(2)));
typedef unsigned u32x4 __attribute__((ext_vector_type(4)));
#define MFMA16(a, b, c) __builtin_amdgcn_mfma_f32_16x16x32_bf16(a, b, c, 0, 0, 0)
#define SYNC() __syncthreads()
#define LSYNC() do { asm volatile("s_waitcnt lgkmcnt(0)" ::: "memory"); __builtin_amdgcn_s_barrier(); asm volatile("" ::: "memory"); } while (0)
#define WSYNC() __builtin_amdgcn_wave_barrier()
__device__ __forceinline__ s16x4 trread(LQ const unsigned char* p) { return __builtin_bit_cast(s16x4, __builtin_amdgcn_ds_read_tr16_b64_v4i16((LQ s16x4*)p)); }
__device__ __forceinline__ float shfl_f(float v, int src) { return __shfl(v, src, 64); }
#define RFL(x) __builtin_amdgcn_readfirstlane(x)
#define FEXP(x) __expf(x)
#else
#define LQ
using simt::bf16x8; using simt::f32x4; using simt::s16x4;
typedef long long i64x2 __attribute__((vector_size(16)));
typedef unsigned u32x4 __attribute__((vector_size(16)));
#define MFMA16(a, b, c) simt::mfma16(a, b, c)
#define SYNC() simt::syncthreads()
#define LSYNC() simt::syncthreads()
#define WSYNC() ((void)simt::shfl(0.f, 0))
inline s16x4 trread(const unsigned char* p) { return simt::tr16_b64(p); }
inline float shfl_f(float v, int src) { return simt::shfl(v, src); }
#define RFL(x) (x)
#define FEXP(x) expf(x)
#endif

#ifndef NB
#define NB 8
#endif
#ifndef SEQ
#define SEQ 4096
#endif
#ifndef CTXL
#define CTXL 256
#endif
constexpr int DM = 1024, INW = 8464, GRIDW = 64;
constexpr int ML = NB * SEQ, MC = NB * CTXL, MT = ML + MC;
constexpr int N1 = 3840;
constexpr int NZ = 1536;
constexpr int NMG = 3072;
constexpr float EPSF = 1e-6f;
constexpr int NLAYER = 2;
static_assert(MT % 256 == 0 && ML % 256 == 0, "row tiles");
constexpr int NCH_C = CTXL / 64, NCH_L = SEQ / 64, NSTEP = NCH_C + NCH_L;

typedef unsigned short bf16_t;
struct alignas(16) U4 { unsigned x, y, z, w; };
DEVI void st16l(LQ unsigned char* p, const U4& w) { u32x4 t; t[0] = w.x; t[1] = w.y; t[2] = w.z; t[3] = w.w; *(LQ u32x4*)p = t; }
DEVI U4 ld16l(LQ const unsigned char* p) { const u32x4 t = *(LQ const u32x4*)p; U4 w; w.x = t[0]; w.y = t[1]; w.z = t[2]; w.w = t[3]; return w; }

constexpr size_t MiB = 1u << 20;
constexpr size_t al1(size_t x) { return (x + MiB - 1) & ~(MiB - 1); }
constexpr size_t WS_CTL = 0;
constexpr size_t WS_MOD = 256 * 1024;
constexpr size_t WS_WAB = 512 * 1024;
constexpr size_t WS_TAX = 640 * 1024;
constexpr size_t WS_W1 = 1 * MiB;
constexpr size_t WS_WZ = WS_W1 + al1((size_t)2 * N1 * DM * 2);
constexpr size_t WS_WM = WS_WZ + al1((size_t)2 * NZ * DM * 2);
constexpr size_t WS_WB = WS_WM + al1((size_t)2 * NMG * DM * 2);
constexpr size_t WS_WO = WS_WB + al1((size_t)2 * 3 * DM * 512 * 2);
constexpr size_t WS_G = WS_WO + al1((size_t)2 * DM * DM * 2);
constexpr size_t WS_BETA = WS_G + al1((size_t)MT * 8 * 4);
constexpr size_t WS_CTX1 = WS_BETA + al1((size_t)MT * 8 * 4);
constexpr size_t WS_XN = WS_CTX1 + al1((size_t)MC * DM * 4);
constexpr size_t WS_AQKV = WS_XN + al1((size_t)MT * DM * 2);
constexpr size_t WS_CQKV = WS_AQKV + al1((size_t)MT * 1536 * 2);
constexpr size_t WS_BQ = WS_CQKV + al1((size_t)MT * 1536 * 2);
constexpr size_t WS_BKV = WS_BQ + al1((size_t)MT * 512 * 2);
constexpr size_t WS_PA = WS_BKV + al1((size_t)MT * 256 * 2);
constexpr size_t WS_PC = WS_PA + al1((size_t)MT * 512 * 2);
constexpr size_t WS_T = WS_PC + al1((size_t)MT * 512 * 2);
constexpr size_t WS_HALO = WS_T + al1((size_t)(MT / 64) * 8 * 8192);
constexpr size_t WS_GC = WS_HALO + al1((size_t)(MT / 64) * 4 * 1536 * 2);
constexpr size_t WS_TRET = WS_GC + al1((size_t)MT * 8 * 4);
constexpr size_t WS_END = WS_TRET + al1((size_t)2 * SEQ * 64 * 4);
static_assert(WS_CQKV + (size_t)MT * NMG * 2 <= WS_END, "L overlay");
static_assert(WS_END <= (size_t)512 * MiB, "workspace");

struct Params {
    const float *x, *c, *ctx, *c_ctx, *w_ada, *b_ada, *norm_w, *w_in, *a_conv_w, *a_log, *a_dt_bias, *a_norm_w, *b_sink, *c_decay, *c_norm_w, *w_branch, *w_out, *final_norm_w;
    float* out; unsigned char* ws;
    int ph_lo, ph_hi;
};

#ifdef CPU_EMU
inline float u2f(unsigned u) { float f; memcpy(&f, &u, 4); return f; }
inline unsigned f2u(float f) { unsigned u; memcpy(&u, &f, 4); return u; }
#else
DEVI float u2f(unsigned u) { return __uint_as_float(u); }
DEVI unsigned f2u(float f) { return __float_as_uint(f); }
#endif
DEVI float bf2f(bf16_t h) { return u2f((unsigned)h << 16); }
DEVI bf16_t f2bf(float f) { unsigned u = f2u(f); return (bf16_t)((u + 0x7fffu + ((u >> 16) & 1u)) >> 16); }
#ifndef CPU_EMU
typedef float f32x2_t __attribute__((ext_vector_type(2))); typedef __bf16 bf16x2_t __attribute__((ext_vector_type(2)));
__device__ __forceinline__ unsigned pk2(float lo, float hi) { const f32x2_t v = {lo, hi}; const bf16x2_t b = __builtin_convertvector(v, bf16x2_t); return __builtin_bit_cast(unsigned, b); }
#else
DEVI unsigned pk2(float lo, float hi) { return (unsigned)f2bf(lo) | ((unsigned)f2bf(hi) << 16); }
#endif
DEVI float lo16(unsigned w) { return u2f(w << 16); }
DEVI float hi16(unsigned w) { return u2f(w & 0xffff0000u); }
DEVI float sigmoidf_(float x) { return 1.0f / (1.0f + expf(-x)); }
DEVI float siluf_(float x) { return x / (1.0f + expf(-x)); }
DEVI float softplusf_(float x) { return x > 20.f ? x : log1pf(expf(x)); }
DEVI void unpack8(const U4& w, float* v) { v[0] = lo16(w.x); v[1] = hi16(w.x); v[2] = lo16(w.y); v[3] = hi16(w.y); v[4] = lo16(w.z); v[5] = hi16(w.z); v[6] = lo16(w.w); v[7] = hi16(w.w); }
DEVI U4 pack8(const float* v) { U4 w; w.x = pk2(v[0], v[1]); w.y = pk2(v[2], v[3]); w.z = pk2(v[4], v[5]); w.w = pk2(v[6], v[7]); return w; }

struct Ctx { int tid, bid, nblk; };
struct TI { long id, n; };
DEVI TI thread_info(const Ctx& c) {
    const int wave = c.tid >> 6, lane = c.tid & 63;
    return TI{((long)wave * c.nblk + c.bid) * 64 + lane, (long)c.nblk * 512};
}

struct Views {
    float *MOD, *WAB, *TAX, *TRET, *GC; bf16_t *W1, *WZ, *WM, *WB, *WO; float *G, *BETA, *CTX1; bf16_t *XN, *AQKV, *CQKV, *BQ, *BKV, *PA, *PC, *Y, *Z, *L, *MRG, *T, *HALO;
};
DEVI Views make_views(unsigned char* ws) {
    Views v;
    v.MOD = (float*)(ws + WS_MOD); v.WAB = (float*)(ws + WS_WAB); v.TAX = (float*)(ws + WS_TAX); v.TRET = (float*)(ws + WS_TRET); v.GC = (float*)(ws + WS_GC); v.W1 = (bf16_t*)(ws + WS_W1); v.WZ = (bf16_t*)(ws + WS_WZ); v.WM = (bf16_t*)(ws + WS_WM); v.WB = (bf16_t*)(ws + WS_WB); v.WO = (bf16_t*)(ws + WS_WO);
    v.G = (float*)(ws + WS_G); v.BETA = (float*)(ws + WS_BETA); v.CTX1 = (float*)(ws + WS_CTX1);
    v.XN = (bf16_t*)(ws + WS_XN); v.AQKV = (bf16_t*)(ws + WS_AQKV); v.CQKV = (bf16_t*)(ws + WS_CQKV); v.BQ = (bf16_t*)(ws + WS_BQ); v.BKV = (bf16_t*)(ws + WS_BKV);
    v.PA = (bf16_t*)(ws + WS_PA); v.PC = (bf16_t*)(ws + WS_PC); v.Y = v.AQKV; v.Z = v.CQKV; v.L = v.CQKV; v.MRG = v.XN; v.T = (bf16_t*)(ws + WS_T); v.HALO = (bf16_t*)(ws + WS_HALO);
    return v;
}

HD int map_g1(int n) { return n < 1536 ? n : (n < 2048 ? 2064 + (n - 1536) : (n < 2304 ? 2576 + (n - 2048) : 3344 + (n - 2304))); }
HD int map_z(int n) { return n < 512 ? 1536 + n : (n < 1024 ? 2832 + (n - 512) : 4880 + (n - 1024)); }

DEVI float wave_sum(float v, int lane) {
#pragma unroll
    for (int o = 32; o >= 1; o >>= 1) v += shfl_f(v, lane ^ o);
    return v;
}
template <int W> DEVI float grp_sum(float v, int lane) {
#pragma unroll
    for (int o = W / 2; o >= 1; o >>= 1) v += shfl_f(v, lane ^ o);
    return v;
}
DEVI f32x4 ldg4(const float* p) { f32x4 v; __builtin_memcpy(&v, p, 16); return v; }
DEVI void stg4(float* p, const f32x4& v) { __builtin_memcpy(p, &v, 16); }

DEVI void prep_tile(const Ctx& cx, LQ unsigned char* lds, const float* src, int ld, int srccol0, int k0, bf16_t* dst, int K, int n0) {
    LQ float* tl = (LQ float*)lds; const int tid = cx.tid;
    { const int r = tid >> 4, c4 = (tid & 15) * 4;
#pragma unroll
      for (int rr = 0; rr < 64; rr += 32) { const f32x4 w = ldg4(src + (size_t)(k0 + r + rr) * ld + srccol0 + c4);
#pragma unroll
          for (int e = 0; e < 4; ++e) tl[(r + rr) * 65 + c4 + e] = w[e]; } }
    SYNC();
    { const int n = tid >> 3, kc = (tid & 7) * 8; float a[8];
#pragma unroll
      for (int e = 0; e < 8; ++e) a[e] = tl[(kc + e) * 65 + n];
      *(U4*)(dst + (size_t)(n0 + n) * K + k0 + kc) = pack8(a); }
    SYNC();
}
DEVI void phase_prep(const Ctx& cx, const Params& p, LQ unsigned char* lds) {
    const Views v = make_views(p.ws); const TI ti = thread_info(cx);
    constexpr int T1 = (N1 / 64) * 16, TZ = (NZ / 64) * 16, TM = (NMG / 64) * 16, TB = 3 * 16 * 8, TO = 16 * 16, TL = T1 + TZ + TM + TB + TO;
    for (int t = cx.bid; t < NLAYER * TL; t += cx.nblk) {
        const int l = t / TL; int r = t % TL;
        const float* win = p.w_in + (size_t)l * DM * INW;
        if (r < T1) { const int nt = r / 16, kt = r % 16; prep_tile(cx, lds, win, INW, map_g1(nt * 64), kt * 64, v.W1 + (size_t)l * N1 * DM, DM, nt * 64); continue; } r -= T1;
        if (r < TZ) { const int nt = r / 16, kt = r % 16; prep_tile(cx, lds, win, INW, map_z(nt * 64), kt * 64, v.WZ + (size_t)l * NZ * DM, DM, nt * 64); continue; } r -= TZ;
        if (r < TM) { const int nt = r / 16, kt = r % 16; prep_tile(cx, lds, win, INW, 5392 + nt * 64, kt * 64, v.WM + (size_t)l * NMG * DM, DM, nt * 64); continue; } r -= TM;
        if (r < TB) { const int br = r / 128, r2 = r % 128, nt = r2 / 8, kt = r2 % 8; prep_tile(cx, lds, p.w_branch + ((size_t)l * 3 + br) * 512 * DM, DM, nt * 64, kt * 64, v.WB + ((size_t)l * 3 + br) * DM * 512, 512, nt * 64); continue; } r -= TB;
        { const int nt = r / 16, kt = r % 16; prep_tile(cx, lds, p.w_out + (size_t)l * DM * DM, DM, nt * 64, kt * 64, v.WO + (size_t)l * DM * DM, DM, nt * 64); }
    }
    long tb = ti.id; LAUNDER(tb);
    for (long i = tb; i < (long)NLAYER * 16 * DM; i += ti.n) { const int l = (int)(i / (16 * DM)), j = (int)((i / DM) % 16), k = (int)(i % DM); v.WAB[i] = p.w_in[((size_t)l * DM + k) * INW + 2048 + j]; }
    LAUNDER(tb);
    for (long i = tb; i < 64 * 16; i += ti.n) { const int pos = (int)(i >> 4), f = (int)(i & 15); const float ang = (float)pos * powf(10000.0f, -(float)f / 16.0f); v.TAX[i] = cosf(ang); v.TAX[1024 + i] = sinf(ang); }
    LAUNDER(tb);
    for (long i = tb; i < (long)SEQ * 64; i += ti.n) { const int pos = (int)(i >> 6), f = (int)(i & 63); const float ang = (float)pos * powf(10000.0f, -(float)f / 64.0f); v.TRET[i] = cosf(ang); v.TRET[(size_t)SEQ * 64 + i] = sinf(ang); }
    const long nmod = (long)NLAYER * (NB + 1) * 3072;
    LAUNDER(tb);
    for (long i = tb; i < nmod; i += ti.n) {
        const int l = (int)(i / ((NB + 1) * 3072)), rem = (int)(i % ((NB + 1) * 3072)), b = rem / 3072, n = rem % 3072;
        const float* cv = b < NB ? p.c + (size_t)b * DM : p.c_ctx;
        const float* w = p.w_ada + (size_t)l * DM * 3072 + n;
        float acc = 0.f;
#pragma unroll 8
        for (int k = 0; k < DM; ++k) { const float cvk = cv[k]; acc += (cvk / (1.0f + FEXP(-cvk))) * w[(size_t)k * 3072]; }
        v.MOD[i] = acc + p.b_ada[l * 3072 + n];
    }
}

DEVI const float* xrow_in(const Params& p, const Views& v, int layer, int m) {
    if (layer == 0) return m < ML ? p.x + (size_t)m * DM : p.ctx + (size_t)(m - ML) * DM;
    return m < ML ? p.out + (size_t)m * DM : v.CTX1 + (size_t)(m - ML) * DM;
}
DEVI void phase_norm(const Ctx& cx, const Params& p, int layer) {
    const Views v = make_views(p.ws);
    const int wave = RFL(cx.tid >> 6), lane = cx.tid & 63;
    const float* nw = p.norm_w + layer * DM; const float* wab = v.WAB + (size_t)layer * 16 * DM;
    for (int qd = wave * cx.nblk + cx.bid; qd < MT / 4; qd += 8 * cx.nblk) {
        f32x4 xv[4][4];
#pragma unroll
        for (int r = 0; r < 4; ++r) { const int m = 4 * qd + r; const float* xr = xrow_in(p, v, layer, m); float ss = 0.f;
#pragma unroll
            for (int j = 0; j < 4; ++j) { xv[r][j] = ldg4(xr + 256 * j + 4 * lane); ss += xv[r][j][0] * xv[r][j][0] + xv[r][j][1] * xv[r][j][1] + xv[r][j][2] * xv[r][j][2] + xv[r][j][3] * xv[r][j][3]; }
            ss = wave_sum(ss, lane);
            const float rr = 1.0f / sqrtf(ss * (1.0f / DM) + EPSF);
            const int b = m < ML ? m / SEQ : NB; const float* mod = v.MOD + ((size_t)layer * (NB + 1) + b) * 3072;
#pragma unroll
            for (int j = 0; j < 4; ++j) { const int k0 = 256 * j + 4 * lane; const f32x4 n4 = ldg4(nw + k0), s4 = ldg4(mod + 1024 + k0), h4 = ldg4(mod + k0);
#pragma unroll
                for (int e = 0; e < 4; ++e) xv[r][j][e] = xv[r][j][e] * rr * n4[e] * (1.0f + s4[e]) + h4[e];
                unsigned long long w = (unsigned long long)pk2(xv[r][j][0], xv[r][j][1]) | ((unsigned long long)pk2(xv[r][j][2], xv[r][j][3]) << 32);
                *(unsigned long long*)(v.XN + (size_t)m * DM + k0) = w; } }
        float mine[4] = {0.f, 0.f, 0.f, 0.f};
#pragma unroll 2
        for (int jj = 0; jj < 16; ++jj) { float a[4] = {0.f, 0.f, 0.f, 0.f};
#pragma unroll
            for (int j = 0; j < 4; ++j) { const f32x4 w4 = ldg4(wab + jj * DM + 256 * j + 4 * lane);
#pragma unroll
                for (int r = 0; r < 4; ++r) a[r] += xv[r][j][0] * w4[0] + xv[r][j][1] * w4[1] + xv[r][j][2] * w4[2] + xv[r][j][3] * w4[3]; }
#pragma unroll
            for (int r = 0; r < 4; ++r) { a[r] = wave_sum(a[r], lane); if (lane == jj) mine[r] = a[r]; } }
#pragma unroll
        for (int r = 0; r < 4; ++r) { const size_t m = (size_t)4 * qd + r;
            if (lane < 8) v.BETA[m * 8 + lane] = sigmoidf_(mine[r]);
            else if (lane < 16) v.G[m * 8 + lane - 8] = -expf(p.a_log[layer * 8 + lane - 8]) * softplusf_(mine[r] + p.a_dt_bias[layer * 8 + lane - 8]); }
    }
}

template <int PRB = 0> DEVI void phase_conv(const Ctx& cx, const Params& p, int layer) {
    const Views v = make_views(p.ws); const TI ti = thread_info(cx);
    const float* cw = p.a_conv_w + (size_t)layer * 5 * 1536;
    for (long it = ti.id; it < (long)(MT / 64) * 1536; it += ti.n) {
        const int gch = (int)(it / 1536), c = (int)(it % 1536);
        const bool lat = gch < ML / 64; const int ci = lat ? gch % NCH_L : (gch - ML / 64) % NCH_C; const bool first = ci == 0, last = ci == (lat ? NCH_L : NCH_C) - 1;
        bf16_t* col = v.AQKV + (size_t)gch * 64 * 1536 + c;
        const float w0 = cw[c], w1 = cw[1536 + c], w2 = cw[2 * 1536 + c], w3 = cw[3 * 1536 + c], w4 = cw[4 * 1536 + c];
        float xv[68];
        xv[0] = first ? 0.f : bf2f(v.HALO[((size_t)(gch - 1) * 4 + 2) * 1536 + c]); xv[1] = first ? 0.f : bf2f(v.HALO[((size_t)(gch - 1) * 4 + 3) * 1536 + c]);
        xv[66] = last ? 0.f : bf2f(v.HALO[((size_t)(gch + 1) * 4 + 0) * 1536 + c]); xv[67] = last ? 0.f : bf2f(v.HALO[((size_t)(gch + 1) * 4 + 1) * 1536 + c]);
#pragma unroll
        for (int t = 0; t < 64; ++t) xv[2 + t] = bf2f(col[(size_t)t * 1536]);
#pragma unroll
        for (int t = 0; t < 64; ++t) { const float y = w0 * xv[t] + w1 * xv[t + 1] + w2 * xv[t + 2] + w3 * xv[t + 3] + w4 * xv[t + 4];
            if (PRB) v.PA[((size_t)gch * 64 + t) * 512 + (c & 511)] = f2bf(y / (1.0f + FEXP(-y))); else col[(size_t)t * 1536] = f2bf(y / (1.0f + FEXP(-y))); }
    }
}

DEVI void phase_prep2(const Ctx& cx, const Params& p, int layer) {
    const Views v = make_views(p.ws);
    const int wave = RFL(cx.tid >> 6), lane = cx.tid & 63;
    for (int m = wave * cx.nblk + cx.bid; m < MT; m += 8 * cx.nblk) {
        {
            bf16_t* ptr = v.AQKV + (size_t)m * 1536 + 16 * lane; float f[16]; unpack8(*(const U4*)ptr, f); unpack8(*(const U4*)(ptr + 8), f + 8);
            float ss = 0.f;
#pragma unroll
            for (int e = 0; e < 16; ++e) ss += f[e] * f[e];
            ss = grp_sum<8>(ss, lane);
            const float sc = (1.0f / sqrtf(ss + EPSF)) * (lane < 32 ? 0.08838834764831845f : 1.0f);
#pragma unroll
            for (int e = 0; e < 16; ++e) f[e] *= sc;
            *(U4*)ptr = pack8(f); *(U4*)(ptr + 8) = pack8(f + 8);
        }
        if (m < ML && lane < 40) {
            const int t = m % SEQ, hh = lane >> 2, pu = lane & 3, half = pu >> 1, ch = pu & 1; const int pos = half == 0 ? t / GRIDW : t % GRIDW;
            bf16_t* ptr = (hh < 8 ? v.BQ + (size_t)m * 512 + hh * 64 : v.BKV + (size_t)m * 256 + (hh - 8) * 64) + half * 32 + ch * 8;
            float x1[8], x2[8]; unpack8(*(const U4*)ptr, x1); unpack8(*(const U4*)(ptr + 16), x2);
            const float* cs = v.TAX + pos * 16 + ch * 8; const float* sn = cs + 1024;
#pragma unroll
            for (int e = 0; e < 8; ++e) { const float a = x1[e], bb = x2[e]; x1[e] = a * cs[e] - bb * sn[e]; x2[e] = a * sn[e] + bb * cs[e]; }
            *(U4*)ptr = pack8(x1); *(U4*)(ptr + 16) = pack8(x2);
        }
        {
            const int which = lane >> 5, h = (lane >> 3) & 3, pu = lane & 7;
            bf16_t* ptr = v.CQKV + (size_t)m * 1536 + which * 512 + h * 128 + pu * 8;
            const float sc = which == 1 ? 0.08838834764831845f : 1.0f;
            if (m < ML) {
                float x1[8], x2[8]; unpack8(*(const U4*)ptr, x1); unpack8(*(const U4*)(ptr + 64), x2);
                const float* cs = v.TRET + (size_t)(m % SEQ) * 64 + pu * 8; const float* sn = cs + (size_t)SEQ * 64;
#pragma unroll
                for (int e = 0; e < 8; ++e) { const float a = x1[e] * sc, bb = x2[e] * sc; x1[e] = a * cs[e] - bb * sn[e]; x2[e] = a * sn[e] + bb * cs[e]; }
                *(U4*)ptr = pack8(x1); *(U4*)(ptr + 64) = pack8(x2);
            } else if (which == 1) {
                float x1[8], x2[8]; unpack8(*(const U4*)ptr, x1); unpack8(*(const U4*)(ptr + 64), x2);
#pragma unroll
                for (int e = 0; e < 8; ++e) { x1[e] *= sc; x2[e] *= sc; }
                *(U4*)ptr = pack8(x1); *(U4*)(ptr + 64) = pack8(x2);
            }
        }
    }
}

DEVI void phase_y(const Ctx& cx, const Params& p, int layer) {
    const Views v = make_views(p.ws);
    const int wave = RFL(cx.tid >> 6), lane = cx.tid & 63;
    const int mrows = layer == 0 ? MT : ML;
    for (int m = wave * cx.nblk + cx.bid; m < mrows; m += 8 * cx.nblk) {
        const int c0 = 8 * lane; float o[8], z[8], y[8];
        {   unpack8(*(const U4*)(v.PA + (size_t)m * 512 + c0), o); unpack8(*(const U4*)(v.Z + (size_t)m * 1536 + c0), z);
            float ss = 0.f;
#pragma unroll
            for (int e = 0; e < 8; ++e) ss += o[e] * o[e];
            ss = grp_sum<16>(ss, lane); const float rs = 1.0f / sqrtf(ss * (1.0f / 128.0f) + EPSF);
            const float* w = p.a_norm_w + layer * 128 + (c0 & 127);
#pragma unroll
            for (int e = 0; e < 8; ++e) y[e] = o[e] * rs * w[e] * (z[e] / (1.0f + FEXP(-z[e])));
            *(U4*)(v.Y + (size_t)m * 512 + c0) = pack8(y); }
        {   unpack8(*(const U4*)(v.BQ + (size_t)m * 512 + c0), o); unpack8(*(const U4*)(v.Z + (size_t)m * 1536 + 512 + c0), z);
#pragma unroll
            for (int e = 0; e < 8; ++e) y[e] = o[e] * (z[e] / (1.0f + FEXP(-z[e])));
            *(U4*)(v.Y + ((size_t)MT + m) * 512 + c0) = pack8(y); }
        {   unpack8(*(const U4*)(v.PC + (size_t)m * 512 + c0), o); unpack8(*(const U4*)(v.Z + (size_t)m * 1536 + 1024 + c0), z);
            float sm = 0.f;
#pragma unroll
            for (int e = 0; e < 8; ++e) sm += o[e];
            const float mu = grp_sum<16>(sm, lane) * (1.0f / 128.0f); float qv = 0.f;
#pragma unroll
            for (int e = 0; e < 8; ++e) { o[e] -= mu; qv += o[e] * o[e]; }
            const float rs = 1.0f / sqrtf(grp_sum<16>(qv, lane) * (1.0f / 128.0f) + EPSF);
            const float* w = p.c_norm_w + layer * 512 + c0;
#pragma unroll
            for (int e = 0; e < 8; ++e) y[e] = o[e] * rs * w[e] * (z[e] / (1.0f + FEXP(-z[e])));
            *(U4*)(v.Y + ((size_t)2 * MT + m) * 512 + c0) = pack8(y); }
    }
}

DEVI void phase_final(const Ctx& cx, const Params& p) {
    const int wave = RFL(cx.tid >> 6), lane = cx.tid & 63;
    for (int m = wave * cx.nblk + cx.bid; m < ML; m += 8 * cx.nblk) {
        float* xr = p.out + (size_t)m * DM; f32x4 xv[4]; float ss = 0.f;
#pragma unroll
        for (int j = 0; j < 4; ++j) { xv[j] = ldg4(xr + 256 * j + 4 * lane); ss += xv[j][0] * xv[j][0] + xv[j][1] * xv[j][1] + xv[j][2] * xv[j][2] + xv[j][3] * xv[j][3]; }
        ss = wave_sum(ss, lane);
        const float r = 1.0f / sqrtf(ss * (1.0f / DM) + EPSF);
#pragma unroll
        for (int j = 0; j < 4; ++j) { const f32x4 w4 = ldg4(p.final_norm_w + 256 * j + 4 * lane); f32x4 o4;
#pragma unroll
            for (int e = 0; e < 4; ++e) o4[e] = xv[j][e] * r * w4[e];
            stg4(xr + 256 * j + 4 * lane, o4); }
    }
}

DEVI bf16x8 ld8g(const bf16_t* p) { bf16x8 v; __builtin_memcpy(&v, p, 16); return v; }
DEVI bf16x8 ld8l(LQ const unsigned char* p) { return *(LQ const bf16x8*)p; }
DEVI bf16x8 ld44l(LQ const unsigned char* p) { i64x2 t; t[0] = *(LQ const long long*)p; t[1] = *(LQ const long long*)(p + 32); return __builtin_bit_cast(bf16x8, t); }
DEVI f32x4 ld4fl(LQ const unsigned char* p) { return *(LQ const f32x4*)p; }
DEVI bf16x8 packb(const f32x4& x0, const f32x4& x1) { u32x4 t; t[0] = pk2(x0[0], x0[1]); t[1] = pk2(x0[2], x0[3]); t[2] = pk2(x1[0], x1[1]); t[3] = pk2(x1[2], x1[3]); return __builtin_bit_cast(bf16x8, t); }
DEVI float wave_incl_scan(float v, int lane) {
#pragma unroll
    for (int d = 1; d < 64; d <<= 1) { const float t = shfl_f(v, lane - d < 0 ? 0 : lane - d); if (lane >= d) v += t; }
    return v;
}
DEVI int chain_row0(int b, int dir, int n) {
    if (n < NCH_C) { const int c = dir ? NCH_C - 1 - n : n; return ML + b * CTXL + 64 * c; }
    int c = n - NCH_C; if (dir) c = NCH_L - 1 - c; return b * SEQ + 64 * c;
}

constexpr int TM_WAVE_BYTES = 16384 + 512;
DEVI void phase_tmat(const Ctx& cx, const Params& p, LQ unsigned char* lds, int layer) {
    const Views v = make_views(p.ws);
    const int wave = RFL(cx.tid >> 6), lane = cx.tid & 63, q = lane >> 4, c = lane & 15;
    LQ unsigned char* wl = lds + wave * TM_WAVE_BYTES;
    LQ float* Am = (LQ float*)wl; LQ float* tab = (LQ float*)(wl + 16384);
    const int nitem = (MT / 64) * 8;
    for (int item = wave * cx.nblk + cx.bid; item < nitem; item += 8 * cx.nblk) {
        const int gchunk = item >> 3, h = (item >> 1) & 3, dir = item & 1; const size_t m0 = (size_t)gchunk * 64;
        { const size_t m = m0 + (dir ? 63 - lane : lane); const float g = v.G[m * 8 + dir * 4 + h], be = v.BETA[m * 8 + dir * 4 + h];
          const float gc = wave_incl_scan(g, lane); tab[lane] = gc; tab[64 + lane] = be; v.GC[m * 8 + dir * 4 + h] = gc; }
        bf16x8 fr[4][4];
#pragma unroll
        for (int t = 0; t < 4; ++t) { const int row = 16 * t + c; const size_t m = m0 + (dir ? 63 - row : row);
#pragma unroll
            for (int s2 = 0; s2 < 4; ++s2) fr[t][s2] = ld8g(v.AQKV + m * 1536 + 512 + h * 128 + 32 * s2 + 8 * q); }
        WSYNC();
#pragma unroll
        for (int it = 0; it < 4; ++it)
#pragma unroll
            for (int jt = 0; jt <= it; ++jt) {
                f32x4 acc = {0.f, 0.f, 0.f, 0.f};
#pragma unroll
                for (int s2 = 0; s2 < 4; ++s2) acc = MFMA16(fr[it][s2], fr[jt][s2], acc);
                const int col = 16 * jt + c; const float gcol = tab[col];
#pragma unroll
                for (int r = 0; r < 4; ++r) { const int row = 16 * it + 4 * q + r;
                    Am[row * 64 + col] = row > col ? tab[64 + row] * acc[r] * FEXP(tab[row] - gcol) : 0.f; }
            }
        WSYNC();
        float x[64];
#pragma unroll
        for (int i = 0; i < 64; ++i) {
            float sacc = (i == lane) ? 1.f : 0.f;
#pragma unroll
            for (int j4 = 0; j4 < (i + 3) / 4; ++j4) { const f32x4 a4 = ld4fl((LQ const unsigned char*)(Am + i * 64 + j4 * 4));
#pragma unroll
                for (int e = 0; e < 4; ++e) if (4 * j4 + e < i) sacc -= a4[e] * x[4 * j4 + e]; }
            x[i] = sacc;
        }
        WSYNC();
        LQ bf16_t* Ti = (LQ bf16_t*)wl;
#pragma unroll
        for (int i = 0; i < 64; ++i) Ti[i * 64 + lane] = f2bf(x[i]);
        WSYNC();
        bf16_t* Tg = v.T + (size_t)item * 4096;
#pragma unroll
        for (int j = 0; j < 8; ++j) { const int piece = lane + 64 * j; *(U4*)(Tg + piece * 8) = ld16l(wl + piece * 16); }
        WSYNC();
    }
}

constexpr int SC_KB = 0, SC_QB = 17408, SC_TB = 34816, SC_PB = 44032, SC_VB = 53248, SC_SC = 62464, SC_BUF = 63744;
template <int MIX, int DIR, int PF = 0> DEVI void scan_chain(const Ctx& cx, const Params& p, const Views& v, LQ unsigned char* lds, int layer, int b, int h, int half) {
    const int tid = cx.tid, wave = RFL(tid >> 6), lane = tid & 63, q = lane >> 4, c = lane & 15;
    const bool helper = wave >= 4; const int ht = tid - 256;
    const bf16_t* QKV = MIX == 0 ? v.AQKV : v.CQKV; bf16_t* PARK = MIX == 0 ? v.PA : v.PC;
    const float lgam = MIX == 1 ? -softplusf_(-p.c_decay[layer * 8 + DIR * 4 + h]) : 0.f;
    U4 kreg[4], qreg[4], treg[2], vreg[2]; float breg = 1.f, greg = 0.f, bsc = 1.f;
    auto hload = [&](int n) {
        const size_t m0 = (size_t)chain_row0(b, DIR, n);
        const bf16_t* base = QKV + m0 * 1536 + h * 128;
#pragma unroll
        for (int j = 0; j < 4; ++j) { const int piece = ht + 256 * j, row = piece >> 4, c16 = piece & 15; const int off = (DIR ? 63 - row : row) * 1536 + c16 * 8;
            kreg[j] = *(const U4*)(base + 512 + off); qreg[j] = *(const U4*)(base + off); }
        if (MIX == 0) { const bf16_t* Tg = v.T + ((size_t)(m0 / 64) * 8 + h * 2 + DIR) * 4096;
#pragma unroll
            for (int j = 0; j < 2; ++j) treg[j] = *(const U4*)(Tg + (ht + 256 * j) * 8); }
#pragma unroll
        for (int j = 0; j < 2; ++j) { const int piece = ht + 256 * j, row = piece >> 3, c8 = piece & 7; vreg[j] = *(const U4*)(base + 1024 + 64 * half + (DIR ? 63 - row : row) * 1536 + c8 * 8); }
        if (MIX == 0 && wave == 4) { const size_t m = m0 + (DIR ? 63 - ht : ht); greg = v.GC[m * 8 + DIR * 4 + h]; breg = v.BETA[m * 8 + DIR * 4 + h]; bsc = v.GC[(m0 + (DIR ? 0 : 63)) * 8 + DIR * 4 + h]; }
    };
    auto hwrite = [&](int bufi) {
        LQ unsigned char* B = lds + bufi * SC_BUF;
#pragma unroll
        for (int j = 0; j < 4; ++j) { const int piece = ht + 256 * j, row = piece >> 4, c16 = piece & 15;
            st16l(B + SC_KB + row * 272 + c16 * 16, kreg[j]); st16l(B + SC_QB + row * 272 + c16 * 16, qreg[j]); }
#pragma unroll
        for (int j = 0; j < 2; ++j) { const int piece = ht + 256 * j, row = piece >> 3, c8 = piece & 7;
            if (MIX == 0) st16l(B + SC_TB + row * 144 + c8 * 16, treg[j]);
            st16l(B + SC_VB + row * 144 + c8 * 16, vreg[j]); }
        if (wave == 4) { LQ float* sc = (LQ float*)(B + SC_SC);
            float Gc, g63;
            if (MIX == 0) { Gc = greg; g63 = bsc; } else { Gc = (float)(ht + 1) * lgam; g63 = 64.f * lgam; }
            const float Gam = FEXP(Gc);
            sc[ht] = -breg * Gam; sc[64 + ht] = Gam; sc[128 + ht] = FEXP(g63 - Gc); sc[192 + ht] = Gc; sc[256 + ht] = breg; }
    };
    auto ptile = [&](LQ unsigned char* B, int it, int jt, bool zr) {
        LQ const float* sc = (LQ const float*)(B + SC_SC);
        f32x4 acc = {0.f, 0.f, 0.f, 0.f};
#pragma unroll
        for (int s2 = 0; s2 < 4; ++s2) acc = MFMA16(ld8l(B + SC_QB + (16 * it + c) * 272 + (32 * s2 + 8 * q) * 2), ld8l(B + SC_KB + (16 * jt + c) * 272 + (32 * s2 + 8 * q) * 2), acc);
        const int col = 16 * jt + c; const float gcol = sc[192 + col];
        const f32x4 grow = ld4fl(B + SC_SC + (192 + 16 * it + 4 * q) * 4);
#pragma unroll
        for (int r = 0; r < 4; ++r) { const int row = 16 * it + 4 * q + r;
            *(LQ bf16_t*)(B + SC_PB + row * 144 + col * 2) = f2bf(row >= col ? acc[r] * FEXP(grow[r] - gcol) : 0.f);
            if (zr) *(LQ bf16_t*)(B + SC_PB + row * 144 + (col + 16) * 2) = 0; }
    };
    auto hscore = [&](int bufi) {
        LQ unsigned char* B = lds + bufi * SC_BUF;
        if (wave == 4) { ptile(B, 0, 0, true); ptile(B, 1, 1, false); }
        else if (wave == 5) { ptile(B, 1, 0, false); ptile(B, 2, 2, true); ptile(B, 3, 3, false); }
        else if (wave == 6) { ptile(B, 2, 0, false); ptile(B, 2, 1, false); ptile(B, 3, 2, false); }
        else { ptile(B, 3, 0, false); ptile(B, 3, 1, false); }
    };
    if (helper) {
        hload(0); hwrite(0); if (NSTEP > 1) hload(1);
        LSYNC();
        for (int n = 0; n < NSTEP; ++n) {
            if (!(PF & 4)) hscore(n & 1);
            LSYNC();
            if (n + 1 < NSTEP && !(PF & 16)) hwrite((n + 1) & 1);
            if (n + 2 < NSTEP && !(PF & 1)) hload(n + 2);
            LSYNC();
        }
    } else {
        f32x4 St[8];
#pragma unroll
        for (int t = 0; t < 8; ++t) St[t] = (f32x4){0.f, 0.f, 0.f, 0.f};
        const int arow = 8 * (c >> 2) + (c & 3);
        LSYNC();
        for (int n = 0; n < NSTEP; ++n) {
            LQ unsigned char* B = lds + (n & 1) * SC_BUF; LQ const float* sc = (LQ const float*)(B + SC_SC);
            f32x4 o[4], vn[4];
            if (PF & 8) { LSYNC(); LSYNC(); continue; }
            {
                bf16x8 Sb[4];
#pragma unroll
                for (int s2 = 0; s2 < 4; ++s2) Sb[s2] = packb(St[2 * s2], St[2 * s2 + 1]);
                f32x4 R[4];
                bf16x8 fq[2][4], fk[2][4];
#pragma unroll
                for (int s2 = 0; s2 < 4; ++s2) { const int off = arow * 272 + (32 * s2 + 8 * q) * 2; fq[0][s2] = ld8l(B + SC_QB + off); if (MIX == 0) fk[0][s2] = ld8l(B + SC_KB + off); }
#pragma unroll
                for (int i = 0; i < 4; ++i) {
                    if (i < 3) {
#pragma unroll
                        for (int s2 = 0; s2 < 4; ++s2) { const int off = (32 * ((i + 1) >> 1) + 4 * ((i + 1) & 1) + arow) * 272 + (32 * s2 + 8 * q) * 2; fq[(i + 1) & 1][s2] = ld8l(B + SC_QB + off); if (MIX == 0) fk[(i + 1) & 1][s2] = ld8l(B + SC_KB + off); } }
                    const int r0 = 32 * (i >> 1) + 8 * q + 4 * (i & 1);
                    const f32x4 Gm = ld4fl(B + SC_SC + (64 + r0) * 4);
                    const s16x4 vraw = trread(B + SC_VB + (r0 + (c >> 2)) * 144 + (16 * wave + 4 * (c & 3)) * 2);
                    f32x4 Vt; Vt[0] = bf2f((bf16_t)vraw[0]); Vt[1] = bf2f((bf16_t)vraw[1]); Vt[2] = bf2f((bf16_t)vraw[2]); Vt[3] = bf2f((bf16_t)vraw[3]);
                    f32x4 a4 = {0.f, 0.f, 0.f, 0.f}; if (MIX == 0) { a4 = ld4fl(B + SC_SC + r0 * 4); Vt = Vt * ld4fl(B + SC_SC + (256 + r0) * 4); }
                    f32x4 aK = {0.f, 0.f, 0.f, 0.f}, aQ = {0.f, 0.f, 0.f, 0.f};
                    SCHEDB();
#pragma unroll
                    for (int s2 = 0; s2 < 4; ++s2) { aQ = MFMA16(fq[i & 1][s2], Sb[s2], aQ); if (MIX == 0) aK = MFMA16(fk[i & 1][s2], Sb[s2], aK); }
                    SCHEDB();
                    o[i] = Gm * aQ;
                    if (MIX == 0) R[i] = Vt + a4 * aK; else vn[i] = Vt;
                }
                if (MIX == 0) {
                    bf16x8 Rb[2]; Rb[0] = packb(R[0], R[1]); Rb[1] = packb(R[2], R[3]);
                    bf16x8 tf[6];
                    tf[0] = ld8l(B + SC_TB + arow * 144 + (8 * q) * 2); tf[1] = ld8l(B + SC_TB + (4 + arow) * 144 + (8 * q) * 2);
                    tf[2] = ld8l(B + SC_TB + (32 + arow) * 144 + (8 * q) * 2); tf[3] = ld8l(B + SC_TB + (32 + arow) * 144 + (32 + 8 * q) * 2);
                    tf[4] = ld8l(B + SC_TB + (36 + arow) * 144 + (8 * q) * 2); tf[5] = ld8l(B + SC_TB + (36 + arow) * 144 + (32 + 8 * q) * 2);
                    const f32x4 z4 = {0.f, 0.f, 0.f, 0.f};
                    SCHEDB();
                    vn[0] = MFMA16(tf[0], Rb[0], z4); vn[1] = MFMA16(tf[1], Rb[0], z4);
                    vn[2] = MFMA16(tf[3], Rb[1], MFMA16(tf[2], Rb[0], z4)); vn[3] = MFMA16(tf[5], Rb[1], MFMA16(tf[4], Rb[0], z4));
                }
            }
            LSYNC();
            {
                bf16x8 vnb[2], veb[2];
                vnb[0] = packb(vn[0], vn[1]); vnb[1] = packb(vn[2], vn[3]);
                { f32x4 ve[4];
#pragma unroll
                  for (int i = 0; i < 4; ++i) ve[i] = ld4fl(B + SC_SC + (128 + 32 * (i >> 1) + 8 * q + 4 * (i & 1)) * 4) * vn[i];
                  veb[0] = packb(ve[0], ve[1]); veb[1] = packb(ve[2], ve[3]); }
                { bf16x8 pf[6];
                  pf[0] = ld8l(B + SC_PB + arow * 144 + (8 * q) * 2); pf[1] = ld8l(B + SC_PB + (4 + arow) * 144 + (8 * q) * 2);
                  pf[2] = ld8l(B + SC_PB + (32 + arow) * 144 + (8 * q) * 2); pf[3] = ld8l(B + SC_PB + (32 + arow) * 144 + (32 + 8 * q) * 2);
                  pf[4] = ld8l(B + SC_PB + (36 + arow) * 144 + (8 * q) * 2); pf[5] = ld8l(B + SC_PB + (36 + arow) * 144 + (32 + 8 * q) * 2);
                  SCHEDB();
                  o[0] = MFMA16(pf[0], vnb[0], o[0]); o[1] = MFMA16(pf[1], vnb[0], o[1]);
                  o[2] = MFMA16(pf[3], vnb[1], MFMA16(pf[2], vnb[0], o[2])); o[3] = MFMA16(pf[5], vnb[1], MFMA16(pf[4], vnb[0], o[3])); }
                const float g63 = sc[64 + 63];
#pragma unroll
                for (int tp = 0; tp < 8; tp += 4) {
                    s16x4 lo[4][2], hi[4][2];
#pragma unroll
                    for (int t = 0; t < 4; ++t)
#pragma unroll
                        for (int s2 = 0; s2 < 2; ++s2) { const int colb = (32 * ((tp + t) >> 1) + 8 * (c & 3) + 4 * ((tp + t) & 1)) * 2;
                            lo[t][s2] = trread(B + SC_KB + (32 * s2 + 8 * q + (c >> 2)) * 272 + colb);
                            hi[t][s2] = trread(B + SC_KB + (32 * s2 + 8 * q + 4 + (c >> 2)) * 272 + colb); }
                    SCHEDB();
#pragma unroll
                    for (int t = 0; t < 4; ++t) { f32x4 acc = St[tp + t] * g63;
#pragma unroll
                        for (int s2 = 0; s2 < 2; ++s2) { bf16x8 kt; kt[0] = lo[t][s2][0]; kt[1] = lo[t][s2][1]; kt[2] = lo[t][s2][2]; kt[3] = lo[t][s2][3]; kt[4] = hi[t][s2][0]; kt[5] = hi[t][s2][1]; kt[6] = hi[t][s2][2]; kt[7] = hi[t][s2][3];
                            acc = MFMA16(kt, veb[s2], acc); }
                        St[tp + t] = acc; }
                }
                const size_t m0 = (size_t)chain_row0(b, DIR, n);
#pragma unroll
                for (int i = 0; i < 4; ++i)
#pragma unroll
                    for (int r = 0; r < 4; ++r) { const int row = 32 * (i >> 1) + 8 * q + 4 * (i & 1) + r; const size_t m = m0 + (DIR ? 63 - row : row);
                        bf16_t* pp = PARK + m * 512 + h * 128 + 64 * half + 16 * wave + c;
                        if (!(PF & 2)) *pp = f2bf(DIR == 0 ? o[i][r] : bf2f(*pp) + o[i][r]); else if (o[i][r] == 12345.678f) *pp = 0; }
            }
            LSYNC();
        }
    }
}
template <int DIR, int PF = 0> DEVI void phase_scan(const Ctx& cx, const Params& p, LQ unsigned char* lds, int layer) {
    const Views v = make_views(p.ws);
    const int nitem = NB * 4 * 2;
    for (int item = cx.bid; item < nitem; item += cx.nblk) scan_chain<0, DIR, PF>(cx, p, v, lds, layer, item >> 3, (item >> 1) & 3, item & 1);
    CFENCE();
    for (int item = (cx.bid + cx.nblk - (nitem % cx.nblk)) % cx.nblk; item < nitem; item += cx.nblk) scan_chain<1, DIR, PF>(cx, p, v, lds, layer, item >> 3, (item >> 1) & 3, item & 1);
}

constexpr int AT_V = 9216, AT_BUF = 18432;
template <bool CTXQ, int PRB = 0> DEVI void attn_unit(const Ctx& cx, const Params& p, const Views& v, LQ unsigned char* lds, int layer, int b, int hkv, int blk) {
    const int tid = cx.tid, wave = RFL(tid >> 6), lane = tid & 63, q = lane >> 4, c = lane & 15;
    const int g = wave >> 1, rh = wave & 1, hq = 4 * hkv + g;
    const size_t mq0 = (CTXQ ? (size_t)ML + (size_t)b * CTXL : (size_t)b * SEQ) + 64 * blk + 32 * rh;
    bf16x8 qf[2][2];
#pragma unroll
    for (int i = 0; i < 2; ++i)
#pragma unroll
        for (int s2 = 0; s2 < 2; ++s2) qf[i][s2] = ld8g(v.BQ + (mq0 + 16 * i + c) * 512 + hq * 64 + 32 * s2 + 8 * q);
    const int wlo = CTXQ ? 0 : (2 - blk > 0 ? 2 - blk : 0), whi = CTXQ ? 0 : (NCH_L + 2 - blk < 5 ? NCH_L + 2 - blk : 5);
    const int ntile = NCH_C + (whi - wlo);
    const int lrow = tid >> 3, lpc = tid & 7;
    auto tile_row0 = [&](int j, int& tstart) -> size_t { if (j < NCH_C) { tstart = -100000; return (size_t)ML + (size_t)b * CTXL + 64 * j; } tstart = 64 * (blk - 2 + wlo + (j - NCH_C)); return (size_t)b * SEQ + tstart; };
    U4 kreg, vreg;
    auto tload = [&](int j) { int ts; const size_t r0 = tile_row0(j, ts); const bf16_t* src = v.BKV + (r0 + lrow) * 256 + hkv * 64 + lpc * 8; kreg = *(const U4*)src; vreg = *(const U4*)(src + 128); };
    auto twrite = [&](int bufi) { LQ unsigned char* B = lds + bufi * AT_BUF; st16l(B + lrow * 144 + lpc * 16, kreg); st16l(B + AT_V + lrow * 144 + lpc * 16, vreg); };
    float mrun[2], lrun[2]; f32x4 ot[4][2];
    mrun[0] = mrun[1] = p.b_sink[layer * 8 + hq]; lrun[0] = lrun[1] = 1.0f;
#pragma unroll
    for (int dt = 0; dt < 4; ++dt) { ot[dt][0] = (f32x4){0.f, 0.f, 0.f, 0.f}; ot[dt][1] = (f32x4){0.f, 0.f, 0.f, 0.f}; }
    SYNC();
    tload(0); twrite(0);
    SYNC();
    for (int j = 0; j < ntile; ++j) {
        LQ unsigned char* B = lds + (j & 1) * AT_BUF;
        if (j + 1 < ntile) tload(j + 1);
        int tstart; (void)tile_row0(j, tstart);
        f32x4 st[4][2];
#pragma unroll
        for (int kt = 0; kt < 4; ++kt) {
            const bf16x8 k0 = ld8l(B + (16 * kt + c) * 144 + (8 * q) * 2), k1 = ld8l(B + (16 * kt + c) * 144 + (32 + 8 * q) * 2);
#pragma unroll
            for (int i = 0; i < 2; ++i) { f32x4 acc = {0.f, 0.f, 0.f, 0.f}; acc = MFMA16(k0, qf[i][0], acc); acc = MFMA16(k1, qf[i][1], acc); st[kt][i] = acc * 0.125f; }
        }
        if (j >= NCH_C) {
#pragma unroll
            for (int i = 0; i < 2; ++i) { const int tq = 64 * blk + 32 * rh + 16 * i + c;
#pragma unroll
                for (int kt = 0; kt < 4; ++kt)
#pragma unroll
                    for (int r = 0; r < 4; ++r) { const int d = tstart + 16 * kt + 4 * q + r - tq; if (d > 128 || d < -128) st[kt][i][r] = -INFINITY; } }
        }
        bf16x8 pb[2][2];
#pragma unroll
        for (int i = 0; i < 2; ++i) {
            float mx = st[0][i][0];
#pragma unroll
            for (int kt = 0; kt < 4; ++kt)
#pragma unroll
                for (int r = 0; r < 4; ++r) mx = fmaxf(mx, st[kt][i][r]);
            mx = fmaxf(mx, shfl_f(mx, lane ^ 16)); mx = fmaxf(mx, shfl_f(mx, lane ^ 32));
            const float mnew = fmaxf(mrun[i], mx), alpha = FEXP(mrun[i] - mnew);
            float ls = 0.f;
#pragma unroll
            for (int kt = 0; kt < 4; ++kt)
#pragma unroll
                for (int r = 0; r < 4; ++r) { const float e = FEXP(st[kt][i][r] - mnew); st[kt][i][r] = e; ls += e; }
            ls += shfl_f(ls, lane ^ 16); ls += shfl_f(ls, lane ^ 32);
            lrun[i] = lrun[i] * alpha + ls; mrun[i] = mnew;
#pragma unroll
            for (int dt = 0; dt < 4; ++dt) ot[dt][i] = ot[dt][i] * alpha;
            pb[i][0] = packb(st[0][i], st[1][i]); pb[i][1] = packb(st[2][i], st[3][i]);
        }
#pragma unroll
        for (int dt = 0; dt < 4; ++dt)
#pragma unroll
            for (int ks = 0; ks < 2; ++ks) {
                const s16x4 lo = trread(B + AT_V + (32 * ks + 4 * q + (c >> 2)) * 144 + (16 * dt + 4 * (c & 3)) * 2);
                const s16x4 hi = trread(B + AT_V + (32 * ks + 16 + 4 * q + (c >> 2)) * 144 + (16 * dt + 4 * (c & 3)) * 2);
                bf16x8 vt; vt[0] = lo[0]; vt[1] = lo[1]; vt[2] = lo[2]; vt[3] = lo[3]; vt[4] = hi[0]; vt[5] = hi[1]; vt[6] = hi[2]; vt[7] = hi[3];
                ot[dt][0] = MFMA16(vt, pb[0][ks], ot[dt][0]); ot[dt][1] = MFMA16(vt, pb[1][ks], ot[dt][1]);
            }
        if (j + 1 < ntile) twrite((j + 1) & 1);
        SYNC();
    }
#pragma unroll
    for (int i = 0; i < 2; ++i) { const float il = 1.0f / lrun[i];
#pragma unroll
        for (int dt = 0; dt < 4; ++dt) { const f32x4 o4 = ot[dt][i] * il;
            unsigned long long w = (unsigned long long)pk2(o4[0], o4[1]) | ((unsigned long long)pk2(o4[2], o4[3]) << 32);
            *(unsigned long long*)((PRB ? v.PA : v.BQ) + (mq0 + 16 * i + c) * 512 + hq * 64 + 16 * dt + 4 * q) = w; } }
}
template <int PRB = 0> DEVI void phase_attn(const Ctx& cx, const Params& p, LQ unsigned char* lds, int layer) {
    const Views v = make_views(p.ws);
    const int nlat = NB * 2 * NCH_L, nctx = layer == 0 ? NB * 2 * NCH_C : 0;
    for (int item = cx.bid; item < nlat + nctx; item += cx.nblk) {
        if (item < nlat) attn_unit<false, PRB>(cx, p, v, lds, layer, item / (2 * NCH_L), (item / NCH_L) & 1, item % NCH_L);
        else { const int it = item - nlat; attn_unit<true, PRB>(cx, p, v, lds, layer, it / (2 * NCH_C), (it / NCH_C) & 1, it % NCH_C); }
    }
}

struct StG1 { bf16_t *AQKV, *BQ, *BKV, *CQKV, *HALO;
    DEVI void st8(int row, int col, const float* a) const {
        bf16_t* dst = col < 1536 ? AQKV + (size_t)row * 1536 + col : (col < 2048 ? BQ + (size_t)row * 512 + (col - 1536) : (col < 2304 ? BKV + (size_t)row * 256 + (col - 2048) : CQKV + (size_t)row * 1536 + (col - 2304)));
        const U4 w = pack8(a); *(U4*)dst = w;
        const int r64 = row & 63;
        if (col < 1536 && (r64 < 2 || r64 >= 62)) *(U4*)(HALO + ((size_t)(row >> 6) * 4 + (r64 < 2 ? r64 : r64 - 60)) * 1536 + col) = w; } };
struct StPlain { bf16_t* O; int ld;
    DEVI void st8(int row, int col, const float* a) const { *(U4*)(O + (size_t)row * ld + col) = pack8(a); } };
struct StMerge { const bf16_t* L; bf16_t* MRG; int br;
    DEVI void st8(int row, int col, const float* a) const {
        float lg[8], o[8]; unpack8(*(const U4*)(L + (size_t)row * NMG + br * 1024 + col), lg);
        if (br) unpack8(*(const U4*)(MRG + (size_t)row * DM + col), o); else { for (int e = 0; e < 8; ++e) o[e] = 0.f; }
        for (int e = 0; e < 8; ++e) o[e] += sigmoidf_(lg[e]) * a[e];
        *(U4*)(MRG + (size_t)row * DM + col) = pack8(o); }
    static constexpr bool HAS_LD = true;
    DEVI void ld8(int row, int col, U4& x0, U4& x1) const { x0 = *(const U4*)(L + (size_t)row * NMG + br * 1024 + col); if (br) x1 = *(const U4*)(MRG + (size_t)row * DM + col); else x1 = U4{0u, 0u, 0u, 0u}; }
    DEVI void fin8(int row, int col, const float* a, const U4& x0, const U4& x1) const {
        float lg[8], o[8]; unpack8(x0, lg); unpack8(x1, o);
        for (int e = 0; e < 8; ++e) o[e] += a[e] / (1.0f + FEXP(-lg[e]));
        *(U4*)(MRG + (size_t)row * DM + col) = pack8(o); } };
struct StMerge3 { const bf16_t* L; bf16_t* MRG;
    DEVI void st8(int row, int col, const float* a) const { const int br = col >> 10; StMerge{L, MRG, br}.st8(row - br * MT, col & 1023, a); }
    DEVI void ld8(int row, int col, U4& x0, U4& x1) const { const int br = col >> 10, r = row - br * MT, c = col & 1023; x0 = *(const U4*)(L + (size_t)r * NMG + br * 1024 + c); if (br) x1 = *(const U4*)(MRG + (size_t)r * DM + c); else x1 = U4{0u, 0u, 0u, 0u}; }
    DEVI void fin8(int row, int col, const float* a, const U4& x0, const U4& x1) const { const int br = col >> 10; StMerge{L, MRG, br}.fin8(row - br * MT, col & 1023, a, x0, x1); } };
struct StResid { const float *xlat, *xctx; float *olat, *octx; const float* mod;
    DEVI void st4(int row, int col, const float* a) const {
        const float* xi = row < ML ? xlat + (size_t)row * DM + col : xctx + (size_t)(row - ML) * DM + col;
        float* xo = row < ML ? olat + (size_t)row * DM + col : octx + (size_t)(row - ML) * DM + col;
        const int b = row < ML ? row / SEQ : NB; const float* g = mod + (size_t)b * 3072 + 2048 + col;
        for (int e = 0; e < 4; ++e) xo[e] = xi[e] + g[e] * a[e]; }
    DEVI f32x4 ldx(int row, int col) const { return ldg4(row < ML ? xlat + (size_t)row * DM + col : xctx + (size_t)(row - ML) * DM + col); }
    DEVI f32x4 ldgate(int row, int col) const { const int b = row < ML ? row / SEQ : NB; return ldg4(mod + (size_t)b * 3072 + 2048 + col); }
    DEVI void fin4(int row, int col, const f32x4& acc, const f32x4& x, const f32x4& g) const { stg4(row < ML ? olat + (size_t)row * DM + col : octx + (size_t)(row - ML) * DM + col, x + g * acc); } };

#ifndef CPU_EMU
namespace pg8 {
#define PG8_LAS __attribute__((address_space(3)))
typedef short bf16x8 __attribute__((ext_vector_type(8)));
typedef float f32x4 __attribute__((ext_vector_type(4)));
constexpr int BM = 256, BK = 64, HALF = 128, HTB = HALF * BK * 2, STAGE_BYTES = 8 * HTB, NXCD = 8, WGM = 8;
__host__ __device__ __forceinline__ int lds_byte(int r, int c) { const int st = (r >> 4) * 2 + (c >> 5), rr = r & 15, cc = c & 31, ob = rr * 64 + cc * 2; return st * 1024 + (ob ^ (((ob >> 9) & 1) << 5)); }
__host__ __device__ __forceinline__ void stage_rc(int b, int& R, int& C) { const int st = b / 1024, sb = b % 1024, swz = sb ^ (((sb >> 9) & 1) << 5); R = (st >> 1) * 16 + swz / 64; C = (st & 1) * 32 + (swz % 64) / 2; }
__host__ __device__ __forceinline__ int perm32(int rho) { const int n = rho >> 4, i = rho & 15; return 8 * (i >> 2) + 4 * n + (i & 3); }
struct Unit { int pm, pn; };
struct Gemm { const bf16_t* A; const bf16_t* Bt; int M, N, K; };
struct StaticOrder {
    int nM, nN, nwg, G, c;
    __host__ __device__ void init(int M, int N, int G_, int c_) { nM = M / BM; nN = N / BM; nwg = nM * nN; G = G_; c = c_; }
    __host__ __device__ bool next(int i, Unit& u) const {
        const long L = (long)i * G + c; if (L >= nwg) return false;
        int wgid = (int)L; { const int q = nwg / NXCD, r = nwg % NXCD, xcd = wgid % NXCD, off = wgid / NXCD; wgid = (xcd < r ? xcd * (q + 1) : r * (q + 1) + (xcd - r) * q) + off; }
        const int nig = WGM * nN, gid = wgid / nig, fm = gid * WGM, gsz = (nM - fm) < WGM ? (nM - fm) : WGM;
        u.pm = fm + ((wgid % nig) % gsz); u.pn = (wgid % nig) / gsz; return true;
    }
    __device__ __forceinline__ void a_ready(const Unit&) const {}
    __device__ __forceinline__ void done(const Unit&) const {}
};
struct BranchOrder {
    StaticOrder so;
    __host__ __device__ void init(int M, int G_, int c_) { so.init(M, 1024, G_, c_); }
    __host__ __device__ bool next(int i, Unit& u) const { Unit t; if (!so.next(i / 3, t)) return false; const int br = i % 3; u.pm = br * (MT / 256) + t.pm; u.pn = br * 4 + t.pn; return true; }
    __device__ __forceinline__ void a_ready(const Unit&) const {}
    __device__ __forceinline__ void done(const Unit&) const {}
};
template <class F> struct Epi8 {
    static constexpr bool PERM = true, AFTER_DRAIN = false; F f;
    __device__ __forceinline__ void operator()(const f32x4 (&acc)[2][2][4][2], const Unit& u, int wr, int wc, int fr, int fq) const {
        const int row0 = u.pm * BM + wr * 64 + fr, col0 = u.pn * BM + wc * 32 + 8 * fq;
#pragma unroll
        for (int ai = 0; ai < 2; ++ai)
#pragma unroll
            for (int m = 0; m < 4; ++m)
#pragma unroll
                for (int bj = 0; bj < 2; ++bj) { const f32x4 v0 = acc[ai][bj][m][0], v1 = acc[ai][bj][m][1];
                    const float a[8] = {v0[0], v0[1], v0[2], v0[3], v1[0], v1[1], v1[2], v1[3]};
                    f.st8(row0 + ai * HALF + m * 16, col0 + bj * HALF, a); }
    }
};
template <class F> struct Epi8L {
    static constexpr bool PERM = true, AFTER_DRAIN = false; F f;
    __device__ __forceinline__ void operator()(const f32x4 (&acc)[2][2][4][2], const Unit& u, int wr, int wc, int fr, int fq) const {
        const int row0 = u.pm * BM + wr * 64 + fr, col0 = u.pn * BM + wc * 32 + 8 * fq;
#pragma unroll
        for (int ai = 0; ai < 2; ++ai) {
            U4 x0[4][2], x1[4][2];
#pragma unroll
            for (int m = 0; m < 4; ++m)
#pragma unroll
                for (int bj = 0; bj < 2; ++bj) f.ld8(row0 + ai * HALF + m * 16, col0 + bj * HALF, x0[m][bj], x1[m][bj]);
#pragma unroll
            for (int m = 0; m < 4; ++m)
#pragma unroll
                for (int bj = 0; bj < 2; ++bj) { const f32x4 v0 = acc[ai][bj][m][0], v1 = acc[ai][bj][m][1];
                    const float a[8] = {v0[0], v0[1], v0[2], v0[3], v1[0], v1[1], v1[2], v1[3]};
                    f.fin8(row0 + ai * HALF + m * 16, col0 + bj * HALF, a, x0[m][bj], x1[m][bj]); }
        }
    }
};
struct SigTileStore { bf16_t* LT;
    __device__ __forceinline__ void st(const Unit& u, int slot, const float* a) const {
        float o[8];
#pragma unroll
        for (int e = 0; e < 8; ++e) o[e] = 1.0f / (1.0f + __expf(-a[e]));
        *(U4*)(LT + (((size_t)(u.pm * 12 + u.pn) * 8192 + slot) << 3)) = pack8(o); } };
template <class F> struct Epi8T {
    static constexpr bool PERM = true, AFTER_DRAIN = false; F f;
    __device__ __forceinline__ void operator()(const f32x4 (&acc)[2][2][4][2], const Unit& u, int wr, int wc, int fr, int fq) const {
        int wl = (wr * 4 + wc) * 64 + fq * 16 + fr; asm volatile("" : "+v"(wl));
#pragma unroll
        for (int ai = 0; ai < 2; ++ai)
#pragma unroll
            for (int m = 0; m < 4; ++m)
#pragma unroll
                for (int bj = 0; bj < 2; ++bj) { const f32x4 v0 = acc[ai][bj][m][0], v1 = acc[ai][bj][m][1];
                    const float a[8] = {v0[0], v0[1], v0[2], v0[3], v1[0], v1[1], v1[2], v1[3]};
                    f.st(u, ((ai * 4 + m) * 2 + bj) * 512 + wl, a); }
    }
};
struct MergeTile { const bf16_t* LT; bf16_t* SCR; bf16_t* MRG; };
struct Epi8M {
    static constexpr bool PERM = true, AFTER_DRAIN = false; MergeTile f;
    __device__ __forceinline__ void operator()(const f32x4 (&acc)[2][2][4][2], const Unit& u, int wr, int wc, int fr, int fq) const {
        const int br = u.pn >> 2, pm = u.pm - br * (MT / 256), pn = u.pn & 3;
        int wl = (wr * 4 + wc) * 64 + fq * 16 + fr; asm volatile("" : "+v"(wl));
        int row0 = pm * BM + wr * 64 + fr, col0 = pn * BM + wc * 32 + 8 * fq; asm volatile("" : "+v"(row0), "+v"(col0));
        const bf16_t* lt = f.LT + (((size_t)(pm * 12 + u.pn) * 8192) << 3);
#pragma unroll
        for (int ai = 0; ai < 2; ++ai) {
            U4 x0[4][2], x1[4][2];
#pragma unroll
            for (int m = 0; m < 4; ++m)
#pragma unroll
                for (int bj = 0; bj < 2; ++bj) { const int slot = ((ai * 4 + m) * 2 + bj) * 512 + wl;
                    x0[m][bj] = *(const U4*)(lt + ((size_t)slot << 3));
                    if (br) x1[m][bj] = *(const U4*)(f.SCR + ((size_t)slot << 3)); else x1[m][bj] = U4{0u, 0u, 0u, 0u}; }
#pragma unroll
            for (int m = 0; m < 4; ++m)
#pragma unroll
                for (int bj = 0; bj < 2; ++bj) { const f32x4 v0 = acc[ai][bj][m][0], v1 = acc[ai][bj][m][1];
                    const float a[8] = {v0[0], v0[1], v0[2], v0[3], v1[0], v1[1], v1[2], v1[3]};
                    float g[8], o[8]; unpack8(x0[m][bj], g); unpack8(x1[m][bj], o);
#pragma unroll
                    for (int e = 0; e < 8; ++e) o[e] += g[e] * a[e];
                    const int slot = ((ai * 4 + m) * 2 + bj) * 512 + wl;
                    if (br < 2) *(U4*)(f.SCR + ((size_t)slot << 3)) = pack8(o);
                    else *(U4*)(f.MRG + (size_t)(row0 + ai * HALF + m * 16) * DM + col0 + bj * HALF) = pack8(o); }
        }
    }
};
template <class F> struct Epi4L {
    static constexpr bool PERM = false, AFTER_DRAIN = false; F f;
    __device__ __forceinline__ void operator()(const f32x4 (&acc)[2][2][4][2], const Unit& u, int wr, int wc, int fr, int fq) const {
        const int row0 = u.pm * BM + wr * 64 + fr, col0 = u.pn * BM + wc * 32 + 4 * fq;
        f32x4 g[2][2];
#pragma unroll
        for (int bj = 0; bj < 2; ++bj)
#pragma unroll
            for (int n = 0; n < 2; ++n) g[bj][n] = f.ldgate(u.pm * BM, col0 + bj * HALF + n * 16);
#pragma unroll
        for (int ai = 0; ai < 2; ++ai) {
            f32x4 xr[4][2][2];
#pragma unroll
            for (int m = 0; m < 4; ++m)
#pragma unroll
                for (int bj = 0; bj < 2; ++bj)
#pragma unroll
                    for (int n = 0; n < 2; ++n) xr[m][bj][n] = f.ldx(row0 + ai * HALF + m * 16, col0 + bj * HALF + n * 16);
#pragma unroll
            for (int m = 0; m < 4; ++m)
#pragma unroll
                for (int bj = 0; bj < 2; ++bj)
#pragma unroll
                    for (int n = 0; n < 2; ++n) f.fin4(row0 + ai * HALF + m * 16, col0 + bj * HALF + n * 16, acc[ai][bj][m][n], xr[m][bj][n], g[bj][n]);
        }
    }
};
template <class F> struct Epi4 {
    static constexpr bool PERM = false, AFTER_DRAIN = false; F f;
    __device__ __forceinline__ void operator()(const f32x4 (&acc)[2][2][4][2], const Unit& u, int wr, int wc, int fr, int fq) const {
        const int row0 = u.pm * BM + wr * 64 + fr, col0 = u.pn * BM + wc * 32 + 4 * fq;
#pragma unroll
        for (int ai = 0; ai < 2; ++ai)
#pragma unroll
            for (int m = 0; m < 4; ++m)
#pragma unroll
                for (int bj = 0; bj < 2; ++bj)
#pragma unroll
                    for (int n = 0; n < 2; ++n) { const f32x4 v0 = acc[ai][bj][m][n]; const float a[4] = {v0[0], v0[1], v0[2], v0[3]};
                        f.st4(row0 + ai * HALF + m * 16, col0 + bj * HALF + n * 16, a); }
    }
};

template <class Epi, class Sched, bool ALIGN_EPI = false, bool SP2 = false>
__device__ __forceinline__ void gemm_phase(PG8_LAS unsigned char* lds, const int tid, const Gemm g, const Sched& S, const Epi& E) {
    const int wid = __builtin_amdgcn_readfirstlane(tid >> 6), lane = tid & 63, wr = wid >> 2, wc = wid & 3, fr = lane & 15, fq = lane >> 4;
    const int K = g.K, nt = K / BK;
    unsigned voffA[2], voffB[2];
#pragma unroll
    for (int i = 0; i < 2; ++i) { int R, C; stage_rc(tid * 16 + i * 8192, R, C); const int Rb = Epi::PERM ? ((R & ~31) + perm32(R & 31)) : R;
        voffA[i] = (unsigned)(R * K + C) * 2u; voffB[i] = (unsigned)(Rb * K + C) * 2u; }
    const size_t kstep = (size_t)(BK * 2);
    const size_t hstep = (size_t)HALF * K * 2;
    const size_t tstep = 2 * hstep;
    const unsigned ldsw = (unsigned)wid * 1024u;
    const int aoff = lds_byte(wr * 64 + fr, fq * 8), boff = lds_byte(wc * 32 + fr, fq * 8);
#define PG8_SA(b, h) (((b) * 2 + (h)) * HTB)
#define PG8_SB(b, h) ((4 + (b) * 2 + (h)) * HTB)
#define PG8_STAGE(bufoff, gbase, voff) do { _Pragma("unroll") for (int _i = 0; _i < 2; ++_i) \
        __builtin_amdgcn_global_load_lds((const unsigned*)((const char*)(gbase) + (voff)[_i]), (PG8_LAS unsigned*)(lds + (bufoff) + ldsw + _i * 8192), 16, 0, 0); } while (0)
#define PG8_LDA(dst, b, h) do { _Pragma("unroll") for (int m = 0; m < 4; ++m) _Pragma("unroll") for (int k = 0; k < 2; ++k) dst[m][k] = *(const PG8_LAS bf16x8*)(lds + PG8_SA(b, h) + aoff + m * 2048 + k * 1024); } while (0)
#define PG8_LDB(dst, b, h) do { _Pragma("unroll") for (int n = 0; n < 2; ++n) _Pragma("unroll") for (int k = 0; k < 2; ++k) dst[n][k] = *(const PG8_LAS bf16x8*)(lds + PG8_SB(b, h) + boff + n * 2048 + k * 1024); } while (0)
#define PG8_MMA(ai, bj, At, Bt) do { __builtin_amdgcn_s_setprio(1); _Pragma("unroll") for (int m = 0; m < 4; ++m) _Pragma("unroll") for (int n = 0; n < 2; ++n) _Pragma("unroll") for (int k = 0; k < 2; ++k) \
        acc[ai][bj][m][n] = __builtin_amdgcn_mfma_f32_16x16x32_bf16(Bt[n][k], At[m][k], acc[ai][bj][m][n], 0, 0, 0); __builtin_amdgcn_s_setprio(0); } while (0)
#define PG8_WAIT_V(n) asm volatile("s_waitcnt vmcnt(" #n ")" ::: "memory")
#define PG8_WAIT_L(n) asm volatile("s_waitcnt lgkmcnt(" #n ")" ::: "memory")
#define PG8_BAR __builtin_amdgcn_s_barrier()
#define PG8_SCHED __builtin_amdgcn_sched_barrier(0)
    Unit cur, nxt; int ui = 0;
    if (!S.next(0, cur)) return;
    f32x4 acc[2][2][4][2];
#pragma unroll
    for (int a = 0; a < 2; ++a)
#pragma unroll
        for (int b = 0; b < 2; ++b)
#pragma unroll
            for (int m = 0; m < 4; ++m)
#pragma unroll
                for (int n = 0; n < 2; ++n) acc[a][b][m][n] = (f32x4){0.f, 0.f, 0.f, 0.f};
    bf16x8 At[4][2], B0[2][2], B1[2][2];
    const char* cA = (const char*)g.A + (size_t)cur.pm * tstep; const char* cB = (const char*)g.Bt + (size_t)cur.pn * tstep;
    S.a_ready(cur);
    if constexpr (SP2) {
        PG8_STAGE(PG8_SB(0, 0), cB, voffB); PG8_STAGE(PG8_SB(0, 1), cB + hstep, voffB); PG8_STAGE(PG8_SA(0, 0), cA, voffA); PG8_STAGE(PG8_SA(0, 1), cA + hstep, voffA);
        if (wr == 1) PG8_BAR;
        PG8_WAIT_V(2); PG8_BAR;
        PG8_STAGE(PG8_SB(1, 0), cB + kstep, voffB); PG8_STAGE(PG8_SA(1, 0), cA + kstep, voffA); PG8_STAGE(PG8_SB(1, 1), cB + hstep + kstep, voffB);
        PG8_WAIT_V(6); PG8_BAR;
    } else {
        PG8_STAGE(PG8_SB(0, 0), cB, voffB); PG8_STAGE(PG8_SA(0, 0), cA, voffA); PG8_STAGE(PG8_SB(0, 1), cB + hstep, voffB); PG8_STAGE(PG8_SA(0, 1), cA + hstep, voffA);
        if (wr == 1) PG8_BAR;
        PG8_WAIT_V(4); PG8_BAR;
        PG8_STAGE(PG8_SB(1, 0), cB + kstep, voffB); PG8_STAGE(PG8_SA(1, 0), cA + kstep, voffA); PG8_STAGE(PG8_SB(1, 1), cB + hstep + kstep, voffB);
        PG8_WAIT_V(6); PG8_BAR;
    }
    for (;;) {
        const bool has_next = S.next(ui + 1, nxt);
        const char* nA = has_next ? (const char*)g.A + (size_t)nxt.pm * tstep : cA; const char* nB = has_next ? (const char*)g.Bt + (size_t)nxt.pn * tstep : cB;
        for (int t = 0; t < nt; t += 2) {
            const bool last = (t == nt - 2);
            const char* a1 = cA + (size_t)(t + 1) * kstep;
            const char* a2 = last ? nA : cA + (size_t)(t + 2) * kstep; const char* b2 = last ? nB : cB + (size_t)(t + 2) * kstep;
            const char* a3 = a2 + kstep; const char* b3 = b2 + kstep;
            if (last && has_next) S.a_ready(nxt);
            if constexpr (SP2) {
            PG8_LDB(B0, 0, 0); PG8_LDB(B1, 0, 1); PG8_SCHED; PG8_LDA(At, 0, 0); PG8_STAGE(PG8_SA(1, 1), a1 + hstep, voffA);
            PG8_WAIT_V(8); PG8_WAIT_L(0); PG8_BAR; PG8_MMA(0, 0, At, B0); PG8_MMA(0, 1, At, B1); PG8_BAR; PG8_SCHED;
            PG8_LDA(At, 0, 1); PG8_STAGE(PG8_SB(0, 0), b2, voffB); PG8_STAGE(PG8_SB(0, 1), b2 + hstep, voffB); PG8_STAGE(PG8_SA(0, 0), a2, voffA);
            PG8_WAIT_V(8); PG8_WAIT_L(0); PG8_BAR; PG8_MMA(1, 0, At, B0); PG8_MMA(1, 1, At, B1); PG8_BAR; PG8_SCHED;
            PG8_LDB(B0, 1, 0); PG8_LDB(B1, 1, 1); PG8_SCHED; PG8_LDA(At, 1, 0); PG8_STAGE(PG8_SA(0, 1), a2 + hstep, voffA);
            PG8_WAIT_V(8); PG8_WAIT_L(0); PG8_BAR; PG8_MMA(0, 0, At, B0); PG8_MMA(0, 1, At, B1); PG8_BAR; PG8_SCHED;
            PG8_LDA(At, 1, 1); PG8_STAGE(PG8_SB(1, 0), b3, voffB); PG8_STAGE(PG8_SB(1, 1), b3 + hstep, voffB); PG8_STAGE(PG8_SA(1, 0), a3, voffA);
            PG8_WAIT_V(8); PG8_WAIT_L(0); PG8_BAR; PG8_MMA(1, 0, At, B0); PG8_MMA(1, 1, At, B1); PG8_BAR; PG8_SCHED;
            } else {
            PG8_LDB(B0, 0, 0); PG8_SCHED; PG8_LDA(At, 0, 0); PG8_STAGE(PG8_SA(1, 1), a1 + hstep, voffA);
            PG8_WAIT_L(8); PG8_BAR; PG8_WAIT_L(0); PG8_MMA(0, 0, At, B0); PG8_BAR; PG8_SCHED;
            PG8_LDB(B1, 0, 1); PG8_STAGE(PG8_SB(0, 0), b2, voffB);
            PG8_BAR; PG8_WAIT_L(0); PG8_MMA(0, 1, At, B1); PG8_BAR;
            PG8_LDA(At, 0, 1); PG8_STAGE(PG8_SA(0, 0), a2, voffA);
            PG8_BAR; PG8_WAIT_L(0); PG8_MMA(1, 0, At, B0); PG8_BAR; PG8_SCHED;
            PG8_STAGE(PG8_SB(0, 1), b2 + hstep, voffB);
            PG8_WAIT_V(6); PG8_BAR; PG8_MMA(1, 1, At, B1); PG8_BAR;
            PG8_LDB(B0, 1, 0); PG8_SCHED; PG8_LDA(At, 1, 0); PG8_STAGE(PG8_SA(0, 1), a2 + hstep, voffA);
            PG8_WAIT_L(8); PG8_BAR; PG8_WAIT_L(0); PG8_MMA(0, 0, At, B0); PG8_BAR; PG8_SCHED;
            PG8_LDB(B1, 1, 1); PG8_STAGE(PG8_SB(1, 0), b3, voffB);
            PG8_BAR; PG8_WAIT_L(0); PG8_MMA(0, 1, At, B1); PG8_BAR;
            PG8_LDA(At, 1, 1); PG8_STAGE(PG8_SA(1, 0), a3, voffA);
            PG8_BAR; PG8_WAIT_L(0); PG8_MMA(1, 0, At, B0); PG8_BAR; PG8_SCHED;
            PG8_STAGE(PG8_SB(1, 1), b3 + hstep, voffB);
            PG8_WAIT_V(6); PG8_BAR; PG8_MMA(1, 1, At, B1); PG8_BAR;
            }
        }
        if constexpr (ALIGN_EPI) { if (wr == 0) PG8_BAR; }
        if constexpr (!Epi::AFTER_DRAIN) { E(acc, cur, wr, wc, fr, fq); S.done(cur); }
        if (!has_next) break;
#pragma unroll
        for (int a = 0; a < 2; ++a)
#pragma unroll
            for (int b = 0; b < 2; ++b)
#pragma unroll
                for (int m = 0; m < 4; ++m)
#pragma unroll
                    for (int n = 0; n < 2; ++n) acc[a][b][m][n] = (f32x4){0.f, 0.f, 0.f, 0.f};
        cur = nxt; cA = nA; cB = nB; ++ui;
        if constexpr (ALIGN_EPI) { if (wr == 1) PG8_BAR; }
    }
    PG8_WAIT_V(0);
    if constexpr (!ALIGN_EPI) { if (wr == 0) PG8_BAR; }
    PG8_BAR;
#undef PG8_SA
#undef PG8_SB
#undef PG8_STAGE
#undef PG8_LDA
#undef PG8_LDB
#undef PG8_MMA
#undef PG8_WAIT_V
#undef PG8_WAIT_L
#undef PG8_BAR
#undef PG8_SCHED
}
}

template <class F> __device__ __forceinline__ void run_gemm8(PG8_LAS unsigned char* lds, const Ctx& cx, const bf16_t* A, const bf16_t* Bt, int M, int N, int K, const F& f) {
    pg8::Gemm g{A, Bt, M, N, K}; pg8::StaticOrder S; S.init(M, N, cx.nblk, cx.bid);
    pg8::Epi8<F> E{f};
    pg8::gemm_phase<pg8::Epi8<F>, pg8::StaticOrder, true, true>(lds, cx.tid, g, S, E);
}
template <class F> __device__ __forceinline__ void run_gemm4(PG8_LAS unsigned char* lds, const Ctx& cx, const bf16_t* A, const bf16_t* Bt, int M, int N, int K, const F& f) {
    pg8::Gemm g{A, Bt, M, N, K}; pg8::StaticOrder S; S.init(M, N, cx.nblk, cx.bid);
    pg8::Epi4L<F> E{f};
    pg8::gemm_phase<pg8::Epi4L<F>, pg8::StaticOrder, true, true>(lds, cx.tid, g, S, E);
}
__device__ __forceinline__ void run_gemm_branches(PG8_LAS unsigned char* lds, const Ctx& cx, const bf16_t* Y, const bf16_t* WBl, int mrows, const StMerge3& f, bf16_t* scratch) {
    pg8::Gemm g{Y, WBl, 3 * MT, 3 * 1024, 512}; pg8::BranchOrder S; S.init(mrows, cx.nblk, cx.bid);
    pg8::Epi8M E{pg8::MergeTile{f.L, scratch + (size_t)cx.bid * 65536, f.MRG}};
    pg8::gemm_phase<pg8::Epi8M, pg8::BranchOrder, true, true>(lds, cx.tid, g, S, E);
}
__device__ __forceinline__ void run_gemm_logits(PG8_LAS unsigned char* lds, const Ctx& cx, const bf16_t* A, const bf16_t* Bt, int M, bf16_t* LT) {
    pg8::Gemm g{A, Bt, M, NMG, DM}; pg8::StaticOrder S; S.init(M, NMG, cx.nblk, cx.bid);
    pg8::Epi8T<pg8::SigTileStore> E{pg8::SigTileStore{LT}};
    pg8::gemm_phase<pg8::Epi8T<pg8::SigTileStore>, pg8::StaticOrder, true, true>(lds, cx.tid, g, S, E);
}
template <class F> __device__ __forceinline__ void run_gemm8L(PG8_LAS unsigned char* lds, const Ctx& cx, const bf16_t* A, const bf16_t* Bt, int M, int N, int K, const F& f) {
    pg8::Gemm g{A, Bt, M, N, K}; pg8::StaticOrder S; S.init(M, N, cx.nblk, cx.bid);
    pg8::Epi8L<F> E{f};
    pg8::gemm_phase<pg8::Epi8L<F>, pg8::StaticOrder, true, true>(lds, cx.tid, g, S, E);
}
#else
template <class F> void run_gemm8(unsigned char*, const Ctx&, const bf16_t* A, const bf16_t* Bt, int M, int N, int K, const F& f) {
#pragma omp parallel for schedule(dynamic, 8)
    for (int r = 0; r < M; ++r) for (int c0 = 0; c0 < N; c0 += 8) { float a[8];
        for (int e = 0; e < 8; ++e) { float s = 0.f; const bf16_t* ar = A + (size_t)r * K; const bf16_t* br = Bt + (size_t)(c0 + e) * K; for (int k = 0; k < K; ++k) s += bf2f(ar[k]) * bf2f(br[k]); a[e] = s; }
        f.st8(r, c0, a); }
}
inline void run_gemm_logits(unsigned char* l, const Ctx& c, const bf16_t* A, const bf16_t* Bt, int M, bf16_t* L) { run_gemm8(l, c, A, Bt, M, NMG, DM, StPlain{L, NMG}); }
inline void run_gemm_branches(unsigned char* l, const Ctx& c, const bf16_t* Y, const bf16_t* WBl, int mrows, const StMerge3& f, bf16_t*) {
    for (int br = 0; br < 3; ++br) run_gemm8(l, c, Y + (size_t)br * MT * 512, WBl + (size_t)br * DM * 512, mrows, DM, 512, StMerge{f.L, f.MRG, br}); }
template <class F> void run_gemm8L(unsigned char* l, const Ctx& c, const bf16_t* A, const bf16_t* Bt, int M, int N, int K, const F& f) { run_gemm8(l, c, A, Bt, M, N, K, f); }
template <class F> void run_gemm4(unsigned char*, const Ctx&, const bf16_t* A, const bf16_t* Bt, int M, int N, int K, const F& f) {
#pragma omp parallel for schedule(dynamic, 8)
    for (int r = 0; r < M; ++r) for (int c0 = 0; c0 < N; c0 += 4) { float a[4];
        for (int e = 0; e < 4; ++e) { float s = 0.f; const bf16_t* ar = A + (size_t)r * K; const bf16_t* br = Bt + (size_t)(c0 + e) * K; for (int k = 0; k < K; ++k) s += bf2f(ar[k]) * bf2f(br[k]); a[e] = s; }
        f.st4(r, c0, a); }
}
#endif

#ifndef PROBE_S
#define PROBE_S -1
#endif
constexpr int PPL = 12;
constexpr int NPHASE = 2 + PPL * NLAYER;
template <int PH> DEVI void run_phase_t(LQ unsigned char* lds, const Ctx& cx, const Params& p) {
    const Views v = make_views(p.ws);
    if constexpr (PH >= 100) { constexpr int layer = (PH - 100) / 10, kind = (PH - 100) % 10;
        if constexpr (kind == 0) phase_conv<0>(cx, p, layer); else if constexpr (kind == 1) phase_prep2(cx, p, layer); else phase_tmat(cx, p, lds, layer); }
    else if constexpr (PH == 0) { phase_prep(cx, p, lds); if (PROBE_S == 100) { SYNC(); phase_prep(cx, p, lds); } }
    else if constexpr (PH == NPHASE - 1) { phase_final(cx, p); }
    else {
        constexpr int layer = (PH - 1) / PPL, s = (PH - 1) % PPL;
        constexpr int mrows = layer == NLAYER - 1 ? ML : MT;
        if constexpr (s == 0) { phase_norm(cx, p, layer); if (PROBE_S == 0) phase_norm(cx, p, layer); }
        else if constexpr (s == 1) { run_gemm8(lds, cx, v.XN, v.W1 + (size_t)layer * N1 * DM, MT, N1, DM, StG1{v.AQKV, v.BQ, v.BKV, v.CQKV, v.HALO}); if (PROBE_S == 1) run_gemm8(lds, cx, v.XN, v.W1 + (size_t)layer * N1 * DM, MT, N1, DM, StG1{v.AQKV, v.BQ, v.BKV, v.CQKV, v.HALO}); }
        else if constexpr (s == 2) { if (PROBE_S == 2) phase_conv<1>(cx, p, layer); phase_conv<0>(cx, p, layer); }
        else if constexpr (s == 3) phase_prep2(cx, p, layer);
        else if constexpr (s == 4) { phase_tmat(cx, p, lds, layer); if (PROBE_S == 41) { SYNC(); phase_tmat(cx, p, lds, layer); } if (PROBE_S == 42) { phase_attn<1>(cx, p, lds, layer); SYNC(); } phase_attn<0>(cx, p, lds, layer); }
        else if constexpr (s == 5) { if (PROBE_S == 51) { phase_scan<0, 3>(cx, p, lds, layer); SYNC(); } if (PROBE_S == 52) { phase_scan<0, 2>(cx, p, lds, layer); SYNC(); } if (PROBE_S == 53) { phase_scan<0, 7>(cx, p, lds, layer); SYNC(); } if (PROBE_S == 54) { phase_scan<0, 11>(cx, p, lds, layer); SYNC(); } if (PROBE_S == 55) { phase_scan<0, 31>(cx, p, lds, layer); SYNC(); } phase_scan<0>(cx, p, lds, layer); if (PROBE_S == 5) { SYNC(); phase_scan<0>(cx, p, lds, layer); } }
        else if constexpr (s == 6) phase_scan<1>(cx, p, lds, layer);
        else if constexpr (s == 7) run_gemm8(lds, cx, v.XN, v.WZ + (size_t)layer * NZ * DM, mrows, NZ, DM, StPlain{v.Z, NZ});
        else if constexpr (s == 8) { phase_y(cx, p, layer); if (PROBE_S == 8) phase_y(cx, p, layer); }
        else if constexpr (s == 9) run_gemm_logits(lds, cx, v.XN, v.WM + (size_t)layer * NMG * DM, mrows, v.L);
        else if constexpr (s == 10) run_gemm_branches(lds, cx, v.Y, v.WB + (size_t)layer * 3 * DM * 512, mrows, StMerge3{v.L, v.MRG}, v.T);
        else run_gemm4(lds, cx, v.MRG, v.WO + (size_t)layer * DM * DM, mrows, DM, DM,
                       StResid{layer == 0 ? p.x : p.out, layer == 0 ? p.ctx : v.CTX1, p.out, v.CTX1, v.MOD + (size_t)layer * (NB + 1) * 3072});
    }
}
HD bool phase_is_gemm(int ph) { if (ph == 0 || ph == NPHASE - 1) return false; const int s = (ph - 1) % PPL; return s == 1 || s == 7 || s >= 9; }
#if PROBE_S == 200
#define PRB1 X(100)
#define PRB2 X(110)
#elif PROBE_S == 201
#define PRB1 X(101)
#define PRB2 X(111)
#elif PROBE_S == 202
#define PRB1 X(102)
#define PRB2 X(112)
#else
#define PRB1
#define PRB2
#endif
#if PROBE_S == 203
#define PZ1 X(8)
#define PZ2 X(20)
#else
#define PZ1
#define PZ2
#endif
#if PROBE_S == 204
#define PM1 X(11)
#define PM2 X(23)
#else
#define PM1
#define PM2
#endif
#if PROBE_S == 205
#define PO1 X(12)
#else
#define PO1
#endif
#if PROBE_S == 206
#define PG1 X(2)
#define PG2 X(14)
#else
#define PG1
#define PG2
#endif
#define MK_PHASE_LIST(X) X(0) X(1) PRB1 X(2) PG1 X(3) X(4) X(5) X(6) X(7) X(8) PZ1 X(9) X(10) X(11) PM1 X(12) PO1 X(13) PRB2 X(14) PG2 X(15) X(16) X(17) X(18) X(19) X(20) PZ2 X(21) X(22) X(23) PM2 X(24) X(25)
static_assert(NPHASE == 26, "phase list");
#ifdef CPU_EMU
inline void run_phase(unsigned char* lds, const Ctx& cx, const Params& p, int ph) {
    switch (ph) {
#define X(k) case k: run_phase_t<k>(lds, cx, p); break;
        MK_PHASE_LIST(X)
#undef X
    }
}
#endif

#ifndef CPU_EMU
constexpr int LDS_BYTES = 147456;
constexpr int LDS_BARST = 147392;
#define XB_TMO      128
#define XB_XCNT(j)  (256  + 64 * (j))
#define XB_XSUB(j)  (1280 + 64 * (j))
#define XB_XGEN(j)  (2304 + 64 * (j))
#define XB_TOP      3328
#define XB_TOPGEN   3392
#define XCD_BAR_WORDS 3456
#define XB_SPIN_CAP (1u << 22)
__device__ __forceinline__ unsigned xb_ld(unsigned* p)              { return __hip_atomic_load(p, __ATOMIC_RELAXED, __HIP_MEMORY_SCOPE_AGENT); }
__device__ __forceinline__ unsigned xb_add(unsigned* p, unsigned v) { return __hip_atomic_fetch_add(p, v, __ATOMIC_RELAXED, __HIP_MEMORY_SCOPE_AGENT); }
__device__ __forceinline__ unsigned xb_xcc_id() { return (unsigned)__builtin_amdgcn_s_getreg((3 << 11) | 20) & 0xFu; }
#define XB_SPIN(cond, bar) do { unsigned _sp = 0; while (cond) { __builtin_amdgcn_s_sleep(1); \
    if ((++_sp & 255u) == 0u) { if (xb_ld(&(bar)[XB_TMO])) break; if (_sp > XB_SPIN_CAP) { atomicAdd(&(bar)[XB_TMO], 1u); break; } } } } while (0)
struct XcdBarrier { unsigned* bar; unsigned x; volatile PG8_LAS unsigned* st; };
__device__ __forceinline__ void xcd_barrier_complete(unsigned* bar, unsigned x, unsigned G, unsigned& nloc, unsigned& nx) {
    unsigned sum, cnt, mine, sp = 0u;
    for (;;) {
        sum = 0u; cnt = 0u; mine = 0u;
#pragma unroll
        for (unsigned j = 0; j < 16; ++j) { const unsigned c = xb_ld(&bar[XB_XCNT(j)]); sum += c; cnt += (c > 0u) ? 1u : 0u; mine = (j == x) ? c : mine; }
        if (sum == G) break;
        __builtin_amdgcn_s_sleep(1);
        if ((++sp & 255u) == 0u) { if (xb_ld(&bar[XB_TMO])) break; if (sp > XB_SPIN_CAP) { atomicAdd(&bar[XB_TMO], 1u); break; } }
    }
    nloc = mine > 0u ? mine : 1u; nx = cnt > 0u ? cnt : 1u;
}
__device__ __forceinline__ void xcd_barrier(const XcdBarrier& b, int tid, unsigned G) {
    asm volatile("s_waitcnt vmcnt(0)" ::: "memory");
    __syncthreads();
    if (tid == 0) {
        unsigned* bar = b.bar;
        __builtin_amdgcn_s_waitcnt(0);
        unsigned nloc = b.st[0], nx = b.st[1];
        if (nloc == 0u) { xcd_barrier_complete(bar, b.x, G, nloc, nx); b.st[0] = nloc; b.st[1] = nx; }
        const unsigned old = xb_add(&bar[XB_XSUB(b.x)], 1u);
        const unsigned gen = old / nloc;
        if (old + 1u == (gen + 1u) * nloc) {
            __builtin_amdgcn_fence(__ATOMIC_RELEASE, "agent");
            asm volatile("s_waitcnt vmcnt(0)" ::: "memory");
            const unsigned og = xb_add(&bar[XB_TOP], 1u);
            const unsigned tg = og / nx;
            if (og + 1u == (tg + 1u) * nx) xb_add(&bar[XB_TOPGEN], 1u);
            else XB_SPIN(xb_ld(&bar[XB_TOPGEN]) == tg, bar);
            __builtin_amdgcn_fence(__ATOMIC_ACQUIRE, "agent");
            xb_add(&bar[XB_XGEN(b.x)], 1u);
            asm volatile("s_waitcnt vmcnt(0)" ::: "memory");
        } else {
            XB_SPIN(xb_ld(&bar[XB_XGEN(b.x)]) == gen, bar);
            __builtin_amdgcn_fence(__ATOMIC_ACQUIRE, "agent");
            asm volatile("s_waitcnt vmcnt(0)" ::: "memory");
        }
    }
    __syncthreads();
}

__global__ void __launch_bounds__(512, 2) mk_fwd(Params p) {
    extern __shared__ __attribute__((aligned(16))) unsigned char lds_raw[];
    PG8_LAS unsigned char* lds = (PG8_LAS unsigned char*)lds_raw;
    cg::grid_group grid = cg::this_grid();
    const int ph_lo = p.ph_lo, ph_hi = p.ph_hi;
    const int wave_s = __builtin_amdgcn_readfirstlane((int)threadIdx.x >> 6);
    volatile PG8_LAS unsigned* bst = (volatile PG8_LAS unsigned*)(lds + LDS_BARST);
    if (threadIdx.x < 2) bst[threadIdx.x] = 0u;
    __syncthreads();
    XcdBarrier bar; bar.bar = (unsigned*)p.ws; bar.x = xb_xcc_id(); bar.st = bst;
    if (threadIdx.x == 0) (void)xb_add(&bar.bar[XB_XCNT(bar.x)], 1u);
#define X(k) if (k >= 100 || (ph_lo <= k && k < ph_hi)) { \
        const Params* q = (const Params*)__builtin_amdgcn_kernarg_segment_ptr(); asm volatile("" : "+s"(q) :: "memory"); \
        unsigned zl = 0u; asm volatile("" : "+v"(zl)); Ctx cx; cx.tid = wave_s * 64 + (int)__builtin_amdgcn_mbcnt_hi(~0u, __builtin_amdgcn_mbcnt_lo(~0u, zl)); cx.bid = (int)blockIdx.x; cx.nblk = (int)gridDim.x; \
        asm volatile("" : "+v"(cx.tid)); asm volatile("" : "+s"(cx.bid), "+s"(cx.nblk)); \
        run_phase_t<k>(lds, cx, *q); \
        if (k >= 100 || k + 1 < ph_hi) { if (k == 0) grid.sync(); else { unsigned z0 = 0u; asm volatile("" : "+v"(z0)); const int t2 = wave_s * 64 + (int)__builtin_amdgcn_mbcnt_hi(~0u, __builtin_amdgcn_mbcnt_lo(~0u, z0)); xcd_barrier(bar, t2, gridDim.x); } } }
    MK_PHASE_LIST(X)
#undef X
}

#ifndef MK_SINGLE
#define MK_SINGLE 1
#endif
extern "C" void kernel_launch(void* const* d_in, const int* in_sizes, int n_in, void* d_out, int out_size, void* d_ws, size_t ws_size, hipStream_t stream) {
    static int grid = 0;
    if (grid == 0) {
        if (n_in != 18 || in_sizes[0] != ML * DM || out_size != ML * DM || ws_size < WS_END) { fprintf(stderr, "kernel_launch: unexpected shapes (n_in %d, in0 %d, out %d, ws %zu < %zu)\n", n_in, n_in > 0 ? in_sizes[0] : -1, out_size, ws_size, (size_t)WS_END); grid = -1; return; }
        int dev = 0, cus = 0, per_cu = 0;
        if (hipGetDevice(&dev) != hipSuccess || hipDeviceGetAttribute(&cus, hipDeviceAttributeMultiprocessorCount, dev) != hipSuccess) { grid = -1; return; }
        if (hipFuncSetAttribute((const void*)mk_fwd, hipFuncAttributeMaxDynamicSharedMemorySize, LDS_BYTES) != hipSuccess) { fprintf(stderr, "kernel_launch: hipFuncSetAttribute failed\n"); grid = -1; return; }
        if (hipOccupancyMaxActiveBlocksPerMultiprocessor(&per_cu, (const void*)mk_fwd, 512, LDS_BYTES) != hipSuccess || per_cu < 1) { fprintf(stderr, "kernel_launch: occupancy query says %d\n", per_cu); (void)hipGetLastError(); grid = -1; return; }
        grid = cus;
    }
    if (grid < 0) return;
    if (hipMemsetAsync(d_ws, 0, 16384, stream) != hipSuccess) { fprintf(stderr, "kernel_launch: memset failed\n"); return; }
    Params p{};
    const float** pp = (const float**)&p;
    for (int i = 0; i < 18; ++i) pp[i] = (const float*)d_in[i];
    p.out = (float*)d_out; p.ws = (unsigned char*)d_ws;
#if MK_SINGLE
    p.ph_lo = 0; p.ph_hi = NPHASE;
    { void* args[] = {&p}; hipError_t e = hipLaunchCooperativeKernel((const void*)mk_fwd, dim3(grid), dim3(512), args, LDS_BYTES, stream);
      if (e != hipSuccess) fprintf(stderr, "cooperative launch failed: %s\n", hipGetErrorString(e)); }
#else
    for (int ph = 0; ph < NPHASE; ++ph) {
        p.ph_lo = ph; p.ph_hi = ph + 1;
        void* args[] = {&p}; hipError_t e = hipLaunchCooperativeKernel((const void*)mk_fwd, dim3(grid), dim3(512), args, LDS_BYTES, stream);
        if (e != hipSuccess) { fprintf(stderr, "cooperative launch %d failed: %s\n", ph, hipGetErrorString(e)); break; }
    }
#endif
}
#endif
```

```cpp
#ifndef CPU_EMU
#include <hip/hip_runtime.h>
#include <hip/hip_cooperative_groups.h>
#include <cstdio>
#include <cstdint>
namespace cg = cooperative_groups;
#define DEVI __device__ __forceinline__
#define HD __host__ __device__ __forceinline__
#define CFENCE() asm volatile("" ::: "memory")
#define LAUNDER(x) asm volatile("" : "+v"(x))
#define SCHEDB() __builtin_amdgcn_sched_barrier(0)
#else
#define CFENCE() do {} while (0)
#define LAUNDER(x) do {} while (0)
#define SCHEDB() do {} while (0)
#include <cstring>
#include <cmath>
#include <cstdio>
#include <cstdint>
#include <cstddef>
#define DEVI inline
#define HD inline
#endif

#ifndef CPU_EMU
#define LQ __attribute__((address_space(3)))
typedef short bf16x8 __attribute__((ext_vector_type(8)));
typedef float f32x4 __attribute__((ext_vector_type(4)));
typedef short s16x4 __attribute__((ext_vector_type(4)));
typedef long long i64x2 __attribute__((ext_vector_type(2)));
typedef unsigned u32x4 __attribute__((ext_vector_type(4)));
#define MFMA16(a, b, c) __builtin_amdgcn_mfma_f32_16x16x32_bf16(a, b, c, 0, 0, 0)
#define SYNC() __syncthreads()
#define LSYNC() do { asm volatile("s_waitcnt lgkmcnt(0)" ::: "memory"); __builtin_amdgcn_s_barrier(); asm volatile("" ::: "memory"); } while (0)
#define WSYNC() __builtin_amdgcn_wave_barrier()
__device__ __forceinline__ s16x4 trread(LQ const unsigned char* p) { return __builtin_bit_cast(s16x4, __builtin_amdgcn_ds_read_tr16_b64_v4i16((LQ s16x4*)p)); }
__device__ __forceinline__ float shfl_f(float v, int src) { return __shfl(v, src, 64); }
#define RFL(x) __builtin_amdgcn_readfirstlane(x)
#define SPIN_YIELD() __builtin_amdgcn_s_sleep(1)
#define LDSWAIT() asm volatile("s_waitcnt lgkmcnt(0)" ::: "memory")
__device__ __forceinline__ void lds_inc(LQ unsigned* p) { (void)__hip_atomic_fetch_add(p, 1u, __ATOMIC_RELAXED, __HIP_MEMORY_SCOPE_WORKGROUP); }
__device__ __forceinline__ unsigned lds_peek(LQ unsigned* p) { return __hip_atomic_load(p, __ATOMIC_RELAXED, __HIP_MEMORY_SCOPE_WORKGROUP); }
#define FEXP(x) __expf(x)
#else
#define LQ
using simt::bf16x8; using simt::f32x4; using simt::s16x4;
typedef long long i64x2 __attribute__((vector_size(16)));
typedef unsigned u32x4 __attribute__((vector_size(16)));
#define MFMA16(a, b, c) simt::mfma16(a, b, c)
#define SYNC() simt::syncthreads()
#define LSYNC() simt::syncthreads()
#define WSYNC() ((void)simt::shfl(0.f, 0))
inline s16x4 trread(const unsigned char* p) { return simt::tr16_b64(p); }
inline float shfl_f(float v, int src) { return simt::shfl(v, src); }
#define RFL(x) (x)
#define SPIN_YIELD() simt::yield_()
#define LDSWAIT() do {} while (0)
inline void lds_inc(unsigned* p) { *(volatile unsigned*)p += 1u; }
inline unsigned lds_peek(unsigned* p) { return *(volatile unsigned*)p; }
#define FEXP(x) expf(x)
#endif

#ifndef NB
#define NB 8
#endif
#ifndef SEQ
#define SEQ 4096
#endif
#ifndef CTXL
#define CTXL 256
#endif
constexpr int DM = 1024, INW = 8464, GRIDW = 64;
constexpr int ML = NB * SEQ, MC = NB * CTXL, MT = ML + MC;
constexpr int N1 = 3840;
constexpr int NZ = 1536;
constexpr int NMG = 3072;
constexpr float EPSF = 1e-6f;
constexpr int NLAYER = 2;
static_assert(MT % 256 == 0 && ML % 256 == 0, "row tiles");
constexpr int NCH_C = CTXL / 64, NCH_L = SEQ / 64, NSTEP = NCH_C + NCH_L;

typedef unsigned short bf16_t;
struct alignas(16) U4 { unsigned x, y, z, w; };
DEVI void st16l(LQ unsigned char* p, const U4& w) { u32x4 t; t[0] = w.x; t[1] = w.y; t[2] = w.z; t[3] = w.w; *(LQ u32x4*)p = t; }
DEVI U4 ld16l(LQ const unsigned char* p) { const u32x4 t = *(LQ const u32x4*)p; U4 w; w.x = t[0]; w.y = t[1]; w.z = t[2]; w.w = t[3]; return w; }

constexpr size_t MiB = 1u << 20;
constexpr size_t al1(size_t x) { return (x + MiB - 1) & ~(MiB - 1); }
constexpr size_t WS_CTL = 0;
constexpr size_t WS_MOD = 256 * 1024;
constexpr size_t WS_WAB = 512 * 1024;
constexpr size_t WS_TAX = 640 * 1024;
constexpr size_t WS_W1 = 1 * MiB;
constexpr size_t WS_WZ = WS_W1 + al1((size_t)N1 * DM * 2);
constexpr size_t WS_WM = WS_WZ + al1((size_t)NZ * DM * 2);
constexpr size_t WS_WB = WS_WM + al1((size_t)NMG * DM * 2);
constexpr size_t WS_WO = WS_WB + al1((size_t)3 * DM * 512 * 2);
constexpr size_t WS_G = WS_WO + al1((size_t)DM * DM * 2);
constexpr size_t WS_BETA = WS_G + al1((size_t)MT * 8 * 4);
constexpr size_t WS_CTX1 = WS_BETA + al1((size_t)MT * 8 * 4);
constexpr size_t WS_XN = WS_CTX1 + al1((size_t)MC * DM * 4);
constexpr size_t WS_AQKV = WS_XN + al1((size_t)MT * DM * 2);
constexpr size_t WS_CQKV = WS_AQKV + al1((size_t)MT * 1536 * 2);
constexpr size_t WS_BQ = WS_CQKV + al1((size_t)MT * 1536 * 2);
constexpr size_t WS_PA = WS_BQ + al1((size_t)MT * 512 * 2);
constexpr size_t WS_PC = WS_PA + al1((size_t)MT * 512 * 2);
constexpr size_t WS_T = WS_PC + al1((size_t)MT * 512 * 2);
constexpr size_t WS_GC = WS_T + al1((size_t)(MT / 64) * 8 * 8192);
constexpr size_t WS_TRET = WS_GC + al1((size_t)MT * 8 * 4);
constexpr size_t WS_BKV = WS_TRET + al1((size_t)2 * SEQ * 64 * 4);
constexpr size_t WS_HALO = WS_BKV + al1((size_t)MT * 256 * 2);
constexpr size_t WS_END = WS_HALO + al1((size_t)(MT / 64) * 4 * 1536 * 2);
constexpr size_t WS_PB1 = WS_BKV;
static_assert(WS_PB1 + (size_t)2 * ML * 512 * 2 <= (size_t)512 * MiB, "layer-1 backward parks");
static_assert((size_t)2 * MT * 512 * 2 <= (size_t)ML * DM * 4, "layer-0 backward parks in d_out");
static_assert(WS_CQKV + (size_t)MT * NMG * 2 <= WS_T, "gate tile overlay");

static_assert(WS_END <= (size_t)512 * MiB, "workspace");

struct Params {
    const float *x, *c, *ctx, *c_ctx, *w_ada, *b_ada, *norm_w, *w_in, *a_conv_w, *a_log, *a_dt_bias, *a_norm_w, *b_sink, *c_decay, *c_norm_w, *w_branch, *w_out, *final_norm_w;
    float* out; unsigned char* ws;
    int ph_lo, ph_hi;
};

#ifdef CPU_EMU
inline float u2f(unsigned u) { float f; memcpy(&f, &u, 4); return f; }
inline unsigned f2u(float f) { unsigned u; memcpy(&u, &f, 4); return u; }
#else
DEVI float u2f(unsigned u) { return __uint_as_float(u); }
DEVI unsigned f2u(float f) { return __float_as_uint(f); }
#endif
DEVI float bf2f(bf16_t h) { return u2f((unsigned)h << 16); }
DEVI bf16_t f2bf(float f) { unsigned u = f2u(f); return (bf16_t)((u + 0x7fffu + ((u >> 16) & 1u)) >> 16); }
#ifndef CPU_EMU
typedef float f32x2_t __attribute__((ext_vector_type(2))); typedef __bf16 bf16x2_t __attribute__((ext_vector_type(2)));
__device__ __forceinline__ unsigned pk2(float lo, float hi) { const f32x2_t v = {lo, hi}; const bf16x2_t b = __builtin_convertvector(v, bf16x2_t); return __builtin_bit_cast(unsigned, b); }
#else
DEVI unsigned pk2(float lo, float hi) { return (unsigned)f2bf(lo) | ((unsigned)f2bf(hi) << 16); }
#endif
DEVI float lo16(unsigned w) { return u2f(w << 16); }
DEVI float hi16(unsigned w) { return u2f(w & 0xffff0000u); }
DEVI float sigmoidf_(float x) { return 1.0f / (1.0f + expf(-x)); }
DEVI float siluf_(float x) { return x / (1.0f + expf(-x)); }
DEVI float softplusf_(float x) { return x > 20.f ? x : log1pf(expf(x)); }
DEVI void unpack8(const U4& w, float* v) { v[0] = lo16(w.x); v[1] = hi16(w.x); v[2] = lo16(w.y); v[3] = hi16(w.y); v[4] = lo16(w.z); v[5] = hi16(w.z); v[6] = lo16(w.w); v[7] = hi16(w.w); }
DEVI U4 pack8(const float* v) { U4 w; w.x = pk2(v[0], v[1]); w.y = pk2(v[2], v[3]); w.z = pk2(v[4], v[5]); w.w = pk2(v[6], v[7]); return w; }

struct Ctx { int tid, bid, nblk; };
struct TI { long id, n; };
DEVI TI thread_info(const Ctx& c) {
    const int wave = c.tid >> 6, lane = c.tid & 63;
    return TI{((long)wave * c.nblk + c.bid) * 64 + lane, (long)c.nblk * 512};
}

struct Views {
    float *MOD, *WAB, *TAX, *TRET, *GC; bf16_t *W1, *WZ, *WM, *WB, *WO; float *G, *BETA, *CTX1; bf16_t *XN, *AQKV, *CQKV, *BQ, *BKV, *PA, *PC, *Y, *Z, *L, *MRG, *T, *HALO;
    bf16_t *PAb[2], *PCb[2];
};
DEVI Views make_views(unsigned char* ws, float* outbuf = nullptr) {
    Views v;
    v.MOD = (float*)(ws + WS_MOD); v.WAB = (float*)(ws + WS_WAB); v.TAX = (float*)(ws + WS_TAX); v.TRET = (float*)(ws + WS_TRET); v.GC = (float*)(ws + WS_GC); v.W1 = (bf16_t*)(ws + WS_W1); v.WZ = (bf16_t*)(ws + WS_WZ); v.WM = (bf16_t*)(ws + WS_WM); v.WB = (bf16_t*)(ws + WS_WB); v.WO = (bf16_t*)(ws + WS_WO);
    v.G = (float*)(ws + WS_G); v.BETA = (float*)(ws + WS_BETA); v.CTX1 = (float*)(ws + WS_CTX1);
    v.XN = (bf16_t*)(ws + WS_XN); v.AQKV = (bf16_t*)(ws + WS_AQKV); v.CQKV = (bf16_t*)(ws + WS_CQKV); v.BQ = (bf16_t*)(ws + WS_BQ); v.BKV = (bf16_t*)(ws + WS_BKV);
    v.PA = (bf16_t*)(ws + WS_PA); v.PC = (bf16_t*)(ws + WS_PC); v.Y = v.AQKV; v.Z = v.CQKV; v.L = v.CQKV; v.MRG = v.XN; v.T = (bf16_t*)(ws + WS_T); v.HALO = (bf16_t*)(ws + WS_HALO);
    v.PAb[0] = (bf16_t*)outbuf; v.PCb[0] = (bf16_t*)outbuf + (size_t)MT * 512; v.PAb[1] = (bf16_t*)(ws + WS_PB1); v.PCb[1] = (bf16_t*)(ws + WS_PB1) + (size_t)ML * 512;
    return v;
}

HD int map_g1(int n) { return n < 1536 ? n : (n < 2048 ? 2064 + (n - 1536) : (n < 2304 ? 2576 + (n - 2048) : 3344 + (n - 2304))); }
HD int map_z(int n) { return n < 512 ? 1536 + n : (n < 1024 ? 2832 + (n - 512) : 4880 + (n - 1024)); }

DEVI float wave_sum(float v, int lane) {
#pragma unroll
    for (int o = 32; o >= 1; o >>= 1) v += shfl_f(v, lane ^ o);
    return v;
}
template <int W> DEVI float grp_sum(float v, int lane) {
#pragma unroll
    for (int o = W / 2; o >= 1; o >>= 1) v += shfl_f(v, lane ^ o);
    return v;
}
DEVI f32x4 ldg4(const float* p) { f32x4 v; __builtin_memcpy(&v, p, 16); return v; }
DEVI void stg4(float* p, const f32x4& v) { __builtin_memcpy(p, &v, 16); }

DEVI void prep_tile(const Ctx& cx, LQ unsigned char* lds, const float* src, int ld, int srccol0, int k0, bf16_t* dst, int K, int n0) {
    LQ float* tl = (LQ float*)lds; const int tid = cx.tid;
    { const int r = tid >> 4, c4 = (tid & 15) * 4;
#pragma unroll
      for (int rr = 0; rr < 64; rr += 32) { const f32x4 w = ldg4(src + (size_t)(k0 + r + rr) * ld + srccol0 + c4);
#pragma unroll
          for (int e = 0; e < 4; ++e) tl[(r + rr) * 65 + c4 + e] = w[e]; } }
    SYNC();
    { const int n = tid >> 3, kc = (tid & 7) * 8; float a[8];
#pragma unroll
      for (int e = 0; e < 8; ++e) a[e] = tl[(kc + e) * 65 + n];
      *(U4*)(dst + (size_t)(n0 + n) * K + k0 + kc) = pack8(a); }
    SYNC();
}
DEVI void phase_prep_w(const Ctx& cx, const Params& p, LQ unsigned char* lds, int l) {
    const Views v = make_views(p.ws);
    constexpr int T1 = (N1 / 64) * 16, TZ = (NZ / 64) * 16, TM = (NMG / 64) * 16, TB = 3 * 16 * 8, TO = 16 * 16, TL = T1 + TZ + TM + TB + TO;
    for (int t = cx.bid; t < TL; t += cx.nblk) {
        int r = t;
        const float* win = p.w_in + (size_t)l * DM * INW;
        if (r < T1) { const int nt = r / 16, kt = r % 16; prep_tile(cx, lds, win, INW, map_g1(nt * 64), kt * 64, v.W1, DM, nt * 64); continue; } r -= T1;
        if (r < TZ) { const int nt = r / 16, kt = r % 16; prep_tile(cx, lds, win, INW, map_z(nt * 64), kt * 64, v.WZ, DM, nt * 64); continue; } r -= TZ;
        if (r < TM) { const int nt = r / 16, kt = r % 16; prep_tile(cx, lds, win, INW, 5392 + nt * 64, kt * 64, v.WM, DM, nt * 64); continue; } r -= TM;
        if (r < TB) { const int br = r / 128, r2 = r % 128, nt = r2 / 8, kt = r2 % 8; prep_tile(cx, lds, p.w_branch + ((size_t)l * 3 + br) * 512 * DM, DM, nt * 64, kt * 64, v.WB + (size_t)br * DM * 512, 512, nt * 64); continue; } r -= TB;
        { const int nt = r / 16, kt = r % 16; prep_tile(cx, lds, p.w_out + (size_t)l * DM * DM, DM, nt * 64, kt * 64, v.WO, DM, nt * 64); }
    }
}
DEVI void phase_prep(const Ctx& cx, const Params& p, LQ unsigned char* lds) {
    const Views v = make_views(p.ws); const TI ti = thread_info(cx);
    phase_prep_w(cx, p, lds, 0);
    long tb = ti.id; LAUNDER(tb);
    for (long i = tb; i < (long)NLAYER * 16 * DM; i += ti.n) { const int l = (int)(i / (16 * DM)), j = (int)((i / DM) % 16), k = (int)(i % DM); v.WAB[i] = p.w_in[((size_t)l * DM + k) * INW + 2048 + j]; }
    LAUNDER(tb);
    for (long i = tb; i < 64 * 16; i += ti.n) { const int pos = (int)(i >> 4), f = (int)(i & 15); const float ang = (float)pos * powf(10000.0f, -(float)f / 16.0f); v.TAX[i] = cosf(ang); v.TAX[1024 + i] = sinf(ang); }
    LAUNDER(tb);
    for (long i = tb; i < (long)SEQ * 64; i += ti.n) { const int pos = (int)(i >> 6), f = (int)(i & 63); const float ang = (float)pos * powf(10000.0f, -(float)f / 64.0f); v.TRET[i] = cosf(ang); v.TRET[(size_t)SEQ * 64 + i] = sinf(ang); }
    const long nmod = (long)NLAYER * (NB + 1) * 3072;
    LAUNDER(tb);
    for (long i = tb; i < nmod; i += ti.n) {
        const int l = (int)(i / ((NB + 1) * 3072)), rem = (int)(i % ((NB + 1) * 3072)), b = rem / 3072, n = rem % 3072;
        const float* cv = b < NB ? p.c + (size_t)b * DM : p.c_ctx;
        const float* w = p.w_ada + (size_t)l * DM * 3072 + n;
        float acc = 0.f;
#pragma unroll 8
        for (int k = 0; k < DM; ++k) { const float cvk = cv[k]; acc += (cvk / (1.0f + FEXP(-cvk))) * w[(size_t)k * 3072]; }
        v.MOD[i] = acc + p.b_ada[l * 3072 + n];
    }
}

DEVI const float* xrow_in(const Params& p, const Views& v, int layer, int m) {
    if (layer == 0) return m < ML ? p.x + (size_t)m * DM : p.ctx + (size_t)(m - ML) * DM;
    return m < ML ? p.out + (size_t)m * DM : v.CTX1 + (size_t)(m - ML) * DM;
}
DEVI void phase_norm(const Ctx& cx, const Params& p, int layer) {
    const Views v = make_views(p.ws);
    const int wave = RFL(cx.tid >> 6), lane = cx.tid & 63;
    const float* nw = p.norm_w + layer * DM; const float* wab = v.WAB + (size_t)layer * 16 * DM;
    for (int qd = wave * cx.nblk + cx.bid; qd < MT / 4; qd += 8 * cx.nblk) {
        f32x4 xv[4][4];
#pragma unroll
        for (int r = 0; r < 4; ++r) { const int m = 4 * qd + r; const float* xr = xrow_in(p, v, layer, m); float ss = 0.f;
#pragma unroll
            for (int j = 0; j < 4; ++j) { xv[r][j] = ldg4(xr + 256 * j + 4 * lane); ss += xv[r][j][0] * xv[r][j][0] + xv[r][j][1] * xv[r][j][1] + xv[r][j][2] * xv[r][j][2] + xv[r][j][3] * xv[r][j][3]; }
            ss = wave_sum(ss, lane);
            const float rr = 1.0f / sqrtf(ss * (1.0f / DM) + EPSF);
            const int b = m < ML ? m / SEQ : NB; const float* mod = v.MOD + ((size_t)layer * (NB + 1) + b) * 3072;
#pragma unroll
            for (int j = 0; j < 4; ++j) { const int k0 = 256 * j + 4 * lane; const f32x4 n4 = ldg4(nw + k0), s4 = ldg4(mod + 1024 + k0), h4 = ldg4(mod + k0);
#pragma unroll
                for (int e = 0; e < 4; ++e) xv[r][j][e] = xv[r][j][e] * rr * n4[e] * (1.0f + s4[e]) + h4[e];
                unsigned long long w = (unsigned long long)pk2(xv[r][j][0], xv[r][j][1]) | ((unsigned long long)pk2(xv[r][j][2], xv[r][j][3]) << 32);
                *(unsigned long long*)(v.XN + (size_t)m * DM + k0) = w; } }
        float mine[4] = {0.f, 0.f, 0.f, 0.f};
#pragma unroll 2
        for (int jj = 0; jj < 16; ++jj) { float a[4] = {0.f, 0.f, 0.f, 0.f};
#pragma unroll
            for (int j = 0; j < 4; ++j) { const f32x4 w4 = ldg4(wab + jj * DM + 256 * j + 4 * lane);
#pragma unroll
                for (int r = 0; r < 4; ++r) a[r] += xv[r][j][0] * w4[0] + xv[r][j][1] * w4[1] + xv[r][j][2] * w4[2] + xv[r][j][3] * w4[3]; }
#pragma unroll
            for (int r = 0; r < 4; ++r) { a[r] = wave_sum(a[r], lane); if (lane == jj) mine[r] = a[r]; } }
#pragma unroll
        for (int r = 0; r < 4; ++r) { const size_t m = (size_t)4 * qd + r;
            if (lane < 8) v.BETA[m * 8 + lane] = sigmoidf_(mine[r]);
            else if (lane < 16) v.G[m * 8 + lane - 8] = -expf(p.a_log[layer * 8 + lane - 8]) * softplusf_(mine[r] + p.a_dt_bias[layer * 8 + lane - 8]); }
    }
}

template <int PRB = 0> DEVI void phase_conv(const Ctx& cx, const Params& p, int layer) {
    const Views v = make_views(p.ws); const TI ti = thread_info(cx);
    const float* cw = p.a_conv_w + (size_t)layer * 5 * 1536;
    for (long it = ti.id; it < (long)(MT / 64) * 1536; it += ti.n) {
        const int gch = (int)(it / 1536), c = (int)(it % 1536);
        const bool lat = gch < ML / 64; const int ci = lat ? gch % NCH_L : (gch - ML / 64) % NCH_C; const bool first = ci == 0, last = ci == (lat ? NCH_L : NCH_C) - 1;
        bf16_t* col = v.AQKV + (size_t)gch * 64 * 1536 + c;
        const float w0 = cw[c], w1 = cw[1536 + c], w2 = cw[2 * 1536 + c], w3 = cw[3 * 1536 + c], w4 = cw[4 * 1536 + c];
        float xv[68];
        xv[0] = first ? 0.f : bf2f(v.HALO[((size_t)(gch - 1) * 4 + 2) * 1536 + c]); xv[1] = first ? 0.f : bf2f(v.HALO[((size_t)(gch - 1) * 4 + 3) * 1536 + c]);
        xv[66] = last ? 0.f : bf2f(v.HALO[((size_t)(gch + 1) * 4 + 0) * 1536 + c]); xv[67] = last ? 0.f : bf2f(v.HALO[((size_t)(gch + 1) * 4 + 1) * 1536 + c]);
#pragma unroll
        for (int t = 0; t < 64; ++t) xv[2 + t] = bf2f(col[(size_t)t * 1536]);
#pragma unroll
        for (int t = 0; t < 64; ++t) { const float y = w0 * xv[t] + w1 * xv[t + 1] + w2 * xv[t + 2] + w3 * xv[t + 3] + w4 * xv[t + 4];
            if (PRB) v.PA[((size_t)gch * 64 + t) * 512 + (c & 511)] = f2bf(y / (1.0f + FEXP(-y))); else col[(size_t)t * 1536] = f2bf(y / (1.0f + FEXP(-y))); }
    }
}

DEVI void phase_prep2(const Ctx& cx, const Params& p, int layer) {
    const Views v = make_views(p.ws);
    const int wave = RFL(cx.tid >> 6), lane = cx.tid & 63;
    for (int m = wave * cx.nblk + cx.bid; m < MT; m += 8 * cx.nblk) {
        {
            bf16_t* ptr = v.AQKV + (size_t)m * 1536 + 16 * lane; float f[16]; unpack8(*(const U4*)ptr, f); unpack8(*(const U4*)(ptr + 8), f + 8);
            float ss = 0.f;
#pragma unroll
            for (int e = 0; e < 16; ++e) ss += f[e] * f[e];
            ss = grp_sum<8>(ss, lane);
            const float sc = (1.0f / sqrtf(ss + EPSF)) * (lane < 32 ? 0.08838834764831845f : 1.0f);
#pragma unroll
            for (int e = 0; e < 16; ++e) f[e] *= sc;
            *(U4*)ptr = pack8(f); *(U4*)(ptr + 8) = pack8(f + 8);
        }
        if (m < ML && lane < 40) {
            const int t = m % SEQ, hh = lane >> 2, pu = lane & 3, half = pu >> 1, ch = pu & 1; const int pos = half == 0 ? t / GRIDW : t % GRIDW;
            bf16_t* ptr = (hh < 8 ? v.BQ + (size_t)m * 512 + hh * 64 : v.BKV + (size_t)m * 256 + (hh - 8) * 64) + half * 32 + ch * 8;
            float x1[8], x2[8]; unpack8(*(const U4*)ptr, x1); unpack8(*(const U4*)(ptr + 16), x2);
            const float* cs = v.TAX + pos * 16 + ch * 8; const float* sn = cs + 1024;
#pragma unroll
            for (int e = 0; e < 8; ++e) { const float a = x1[e], bb = x2[e]; x1[e] = a * cs[e] - bb * sn[e]; x2[e] = a * sn[e] + bb * cs[e]; }
            *(U4*)ptr = pack8(x1); *(U4*)(ptr + 16) = pack8(x2);
        }
        {
            const int which = lane >> 5, h = (lane >> 3) & 3, pu = lane & 7;
            bf16_t* ptr = v.CQKV + (size_t)m * 1536 + which * 512 + h * 128 + pu * 8;
            const float sc = which == 1 ? 0.08838834764831845f : 1.0f;
            if (m < ML) {
                float x1[8], x2[8]; unpack8(*(const U4*)ptr, x1); unpack8(*(const U4*)(ptr + 64), x2);
                const float* cs = v.TRET + (size_t)(m % SEQ) * 64 + pu * 8; const float* sn = cs + (size_t)SEQ * 64;
#pragma unroll
                for (int e = 0; e < 8; ++e) { const float a = x1[e] * sc, bb = x2[e] * sc; x1[e] = a * cs[e] - bb * sn[e]; x2[e] = a * sn[e] + bb * cs[e]; }
                *(U4*)ptr = pack8(x1); *(U4*)(ptr + 64) = pack8(x2);
            } else if (which == 1) {
                float x1[8], x2[8]; unpack8(*(const U4*)ptr, x1); unpack8(*(const U4*)(ptr + 64), x2);
#pragma unroll
                for (int e = 0; e < 8; ++e) { x1[e] *= sc; x2[e] *= sc; }
                *(U4*)ptr = pack8(x1); *(U4*)(ptr + 64) = pack8(x2);
            }
        }
    }
}

DEVI void phase_y(const Ctx& cx, const Params& p, int layer) {
    const Views v = make_views(p.ws, p.out);
    const int wave = RFL(cx.tid >> 6), lane = cx.tid & 63;
    const int mrows = layer == 0 ? MT : ML;
    for (int m = wave * cx.nblk + cx.bid; m < mrows; m += 8 * cx.nblk) {
        const int c0 = 8 * lane; float o[8], z[8], y[8];
        {   unpack8(*(const U4*)(v.PA + (size_t)m * 512 + c0), o); unpack8(*(const U4*)(v.PAb[layer] + (size_t)m * 512 + c0), z);
#pragma unroll
            for (int e = 0; e < 8; ++e) o[e] += z[e];
            unpack8(*(const U4*)(v.Z + (size_t)m * 1536 + c0), z);
            float ss = 0.f;
#pragma unroll
            for (int e = 0; e < 8; ++e) ss += o[e] * o[e];
            ss = grp_sum<16>(ss, lane); const float rs = 1.0f / sqrtf(ss * (1.0f / 128.0f) + EPSF);
            const float* w = p.a_norm_w + layer * 128 + (c0 & 127);
#pragma unroll
            for (int e = 0; e < 8; ++e) y[e] = o[e] * rs * w[e] * (z[e] / (1.0f + FEXP(-z[e])));
            *(U4*)(v.Y + (size_t)m * 512 + c0) = pack8(y); }
        {   unpack8(*(const U4*)(v.BQ + (size_t)m * 512 + c0), o); unpack8(*(const U4*)(v.Z + (size_t)m * 1536 + 512 + c0), z);
#pragma unroll
            for (int e = 0; e < 8; ++e) y[e] = o[e] * (z[e] / (1.0f + FEXP(-z[e])));
            *(U4*)(v.Y + ((size_t)MT + m) * 512 + c0) = pack8(y); }
        {   unpack8(*(const U4*)(v.PC + (size_t)m * 512 + c0), o); unpack8(*(const U4*)(v.PCb[layer] + (size_t)m * 512 + c0), z);
#pragma unroll
            for (int e = 0; e < 8; ++e) o[e] += z[e];
            unpack8(*(const U4*)(v.Z + (size_t)m * 1536 + 1024 + c0), z);
            float sm = 0.f;
#pragma unroll
            for (int e = 0; e < 8; ++e) sm += o[e];
            const float mu = grp_sum<16>(sm, lane) * (1.0f / 128.0f); float qv = 0.f;
#pragma unroll
            for (int e = 0; e < 8; ++e) { o[e] -= mu; qv += o[e] * o[e]; }
            const float rs = 1.0f / sqrtf(grp_sum<16>(qv, lane) * (1.0f / 128.0f) + EPSF);
            const float* w = p.c_norm_w + layer * 512 + c0;
#pragma unroll
            for (int e = 0; e < 8; ++e) y[e] = o[e] * rs * w[e] * (z[e] / (1.0f + FEXP(-z[e])));
            *(U4*)(v.Y + ((size_t)2 * MT + m) * 512 + c0) = pack8(y); }
    }
}

DEVI void phase_final(const Ctx& cx, const Params& p) {
    const int wave = RFL(cx.tid >> 6), lane = cx.tid & 63;
    for (int m = wave * cx.nblk + cx.bid; m < ML; m += 8 * cx.nblk) {
        float* xr = p.out + (size_t)m * DM; f32x4 xv[4]; float ss = 0.f;
#pragma unroll
        for (int j = 0; j < 4; ++j) { xv[j] = ldg4(xr + 256 * j + 4 * lane); ss += xv[j][0] * xv[j][0] + xv[j][1] * xv[j][1] + xv[j][2] * xv[j][2] + xv[j][3] * xv[j][3]; }
        ss = wave_sum(ss, lane);
        const float r = 1.0f / sqrtf(ss * (1.0f / DM) + EPSF);
#pragma unroll
        for (int j = 0; j < 4; ++j) { const f32x4 w4 = ldg4(p.final_norm_w + 256 * j + 4 * lane); f32x4 o4;
#pragma unroll
            for (int e = 0; e < 4; ++e) o4[e] = xv[j][e] * r * w4[e];
            stg4(xr + 256 * j + 4 * lane, o4); }
    }
}

DEVI bf16x8 ld8g(const bf16_t* p) { bf16x8 v; __builtin_memcpy(&v, p, 16); return v; }
DEVI bf16x8 ld8l(LQ const unsigned char* p) { return *(LQ const bf16x8*)p; }
DEVI bf16x8 ld44l(LQ const unsigned char* p) { i64x2 t; t[0] = *(LQ const long long*)p; t[1] = *(LQ const long long*)(p + 32); return __builtin_bit_cast(bf16x8, t); }
DEVI f32x4 ld4fl(LQ const unsigned char* p) { return *(LQ const f32x4*)p; }
DEVI bf16x8 packb(const f32x4& x0, const f32x4& x1) { u32x4 t; t[0] = pk2(x0[0], x0[1]); t[1] = pk2(x0[2], x0[3]); t[2] = pk2(x1[0], x1[1]); t[3] = pk2(x1[2], x1[3]); return __builtin_bit_cast(bf16x8, t); }
DEVI float wave_incl_scan(float v, int lane) {
#pragma unroll
    for (int d = 1; d < 64; d <<= 1) { const float t = shfl_f(v, lane - d < 0 ? 0 : lane - d); if (lane >= d) v += t; }
    return v;
}
DEVI int chain_row0(int b, int dir, int n) {
    if (n < NCH_C) { const int c = dir ? NCH_C - 1 - n : n; return ML + b * CTXL + 64 * c; }
    int c = n - NCH_C; if (dir) c = NCH_L - 1 - c; return b * SEQ + 64 * c;
}

constexpr int TM_WAVE_BYTES = 16384 + 512;
DEVI void phase_tmat(const Ctx& cx, const Params& p, LQ unsigned char* lds, int layer) {
    const Views v = make_views(p.ws);
    const int wave = RFL(cx.tid >> 6), lane = cx.tid & 63, q = lane >> 4, c = lane & 15;
    LQ unsigned char* wl = lds + wave * TM_WAVE_BYTES;
    LQ float* Am = (LQ float*)wl; LQ float* tab = (LQ float*)(wl + 16384);
    const int nitem = (MT / 64) * 8;
    for (int item = wave * cx.nblk + cx.bid; item < nitem; item += 8 * cx.nblk) {
        const int gchunk = item >> 3, h = (item >> 1) & 3, dir = item & 1; const size_t m0 = (size_t)gchunk * 64;
        { const size_t m = m0 + (dir ? 63 - lane : lane); const float g = v.G[m * 8 + dir * 4 + h], be = v.BETA[m * 8 + dir * 4 + h];
          const float gc = wave_incl_scan(g, lane); tab[lane] = gc; tab[64 + lane] = be; v.GC[m * 8 + dir * 4 + h] = gc; }
        bf16x8 fr[4][4];
#pragma unroll
        for (int t = 0; t < 4; ++t) { const int row = 16 * t + c; const size_t m = m0 + (dir ? 63 - row : row);
#pragma unroll
            for (int s2 = 0; s2 < 4; ++s2) fr[t][s2] = ld8g(v.AQKV + m * 1536 + 512 + h * 128 + 32 * s2 + 8 * q); }
        WSYNC();
#pragma unroll
        for (int it = 0; it < 4; ++it)
#pragma unroll
            for (int jt = 0; jt <= it; ++jt) {
                f32x4 acc = {0.f, 0.f, 0.f, 0.f};
#pragma unroll
                for (int s2 = 0; s2 < 4; ++s2) acc = MFMA16(fr[it][s2], fr[jt][s2], acc);
                const int col = 16 * jt + c; const float gcol = tab[col];
#pragma unroll
                for (int r = 0; r < 4; ++r) { const int row = 16 * it + 4 * q + r;
                    Am[row * 64 + col] = row > col ? tab[64 + row] * acc[r] * FEXP(tab[row] - gcol) : 0.f; }
            }
        WSYNC();
        float x[64];
#pragma unroll
        for (int i = 0; i < 64; ++i) {
            float sacc = (i == lane) ? 1.f : 0.f;
#pragma unroll
            for (int j4 = 0; j4 < (i + 3) / 4; ++j4) { const f32x4 a4 = ld4fl((LQ const unsigned char*)(Am + i * 64 + j4 * 4));
#pragma unroll
                for (int e = 0; e < 4; ++e) if (4 * j4 + e < i) sacc -= a4[e] * x[4 * j4 + e]; }
            x[i] = sacc;
        }
        WSYNC();
        LQ bf16_t* Ti = (LQ bf16_t*)wl;
#pragma unroll
        for (int i = 0; i < 64; ++i) Ti[i * 64 + lane] = f2bf(x[i]);
        WSYNC();
        bf16_t* Tg = v.T + (size_t)item * 4096;
#pragma unroll
        for (int j = 0; j < 8; ++j) { const int piece = lane + 64 * j; *(U4*)(Tg + piece * 8) = ld16l(wl + piece * 16); }
        WSYNC();
    }
}

constexpr int SC_KB = 0, SC_QB = 17408, SC_TB = 34816, SC_PB = 44032, SC_VB = 53248, SC_SC = 62464, SC_BUF = 63744;
template <int MIX, int PF = 0> DEVI void scan_chain(const Ctx& cx, const Params& p, const Views& v, LQ unsigned char* lds, int layer, const int DIR, int b, int h, int half) {
    const int tid = cx.tid, wave = RFL(tid >> 6), lane = tid & 63, q = lane >> 4, c = lane & 15;
    const bool helper = wave >= 4; const int ht = tid - 256;
    const bf16_t* QKV = MIX == 0 ? v.AQKV : v.CQKV; bf16_t* PARK = DIR == 0 ? (MIX == 0 ? v.PA : v.PC) : (MIX == 0 ? v.PAb[layer] : v.PCb[layer]);
    const int rx = DIR ? 63 : 0;
    const float lgam = MIX == 1 ? -softplusf_(-p.c_decay[layer * 8 + DIR * 4 + h]) : 0.f;
    U4 kreg[4], qreg[4], treg[2], vreg[2]; float breg = 1.f, greg = 0.f, bsc = 1.f;
    auto hload = [&](int n) {
        const size_t m0 = (size_t)chain_row0(b, DIR, n);
        const bf16_t* base = QKV + m0 * 1536 + h * 128;
#pragma unroll
        for (int j = 0; j < 4; ++j) { const int piece = ht + 256 * j, row = piece >> 4, c16 = piece & 15; const int off = (row ^ rx) * 1536 + c16 * 8;
            kreg[j] = *(const U4*)(base + 512 + off); qreg[j] = *(const U4*)(base + off); }
        if (MIX == 0) { const bf16_t* Tg = v.T + ((size_t)(m0 / 64) * 8 + h * 2 + DIR) * 4096;
#pragma unroll
            for (int j = 0; j < 2; ++j) treg[j] = *(const U4*)(Tg + (ht + 256 * j) * 8); }
#pragma unroll
        for (int j = 0; j < 2; ++j) { const int piece = ht + 256 * j, row = piece >> 3, c8 = piece & 7; vreg[j] = *(const U4*)(base + 1024 + 64 * half + (row ^ rx) * 1536 + c8 * 8); }
        if (MIX == 0 && wave == 4) { const size_t m = m0 + (ht ^ rx); greg = v.GC[m * 8 + DIR * 4 + h]; breg = v.BETA[m * 8 + DIR * 4 + h]; bsc = v.GC[(m0 + (63 ^ rx)) * 8 + DIR * 4 + h]; }
    };
    auto hwrite = [&](int bufi) {
        LQ unsigned char* B = lds + bufi * SC_BUF;
#pragma unroll
        for (int j = 0; j < 4; ++j) { const int piece = ht + 256 * j, row = piece >> 4, c16 = piece & 15;
            st16l(B + SC_KB + row * 272 + c16 * 16, kreg[j]); st16l(B + SC_QB + row * 272 + c16 * 16, qreg[j]); }
#pragma unroll
        for (int j = 0; j < 2; ++j) { const int piece = ht + 256 * j, row = piece >> 3, c8 = piece & 7;
            if (MIX == 0) st16l(B + SC_TB + row * 144 + c8 * 16, treg[j]);
            st16l(B + SC_VB + row * 144 + c8 * 16, vreg[j]); }
        if (wave == 4) { LQ float* sc = (LQ float*)(B + SC_SC);
            float Gc, g63;
            if (MIX == 0) { Gc = greg; g63 = bsc; } else { Gc = (float)(ht + 1) * lgam; g63 = 64.f * lgam; }
            const float Gam = FEXP(Gc);
            sc[ht] = -breg * Gam; sc[64 + ht] = Gam; sc[128 + ht] = FEXP(g63 - Gc); sc[192 + ht] = Gc; sc[256 + ht] = breg; }
    };
    auto ptile = [&](LQ unsigned char* B, int it, int jt, bool zr) {
        LQ const float* sc = (LQ const float*)(B + SC_SC);
        f32x4 acc = {0.f, 0.f, 0.f, 0.f};
#pragma unroll
        for (int s2 = 0; s2 < 4; ++s2) acc = MFMA16(ld8l(B + SC_QB + (16 * it + c) * 272 + (32 * s2 + 8 * q) * 2), ld8l(B + SC_KB + (16 * jt + c) * 272 + (32 * s2 + 8 * q) * 2), acc);
        const int col = 16 * jt + c; const float gcol = sc[192 + col];
        const f32x4 grow = ld4fl(B + SC_SC + (192 + 16 * it + 4 * q) * 4);
#pragma unroll
        for (int r = 0; r < 4; ++r) { const int row = 16 * it + 4 * q + r;
            *(LQ bf16_t*)(B + SC_PB + row * 144 + col * 2) = f2bf(row >= col ? acc[r] * FEXP(grow[r] - gcol) : 0.f);
            if (zr) *(LQ bf16_t*)(B + SC_PB + row * 144 + (col + 16) * 2) = 0; }
    };
    auto hscore = [&](int bufi) {
        LQ unsigned char* B = lds + bufi * SC_BUF;
        if (wave == 4) { ptile(B, 0, 0, true); ptile(B, 1, 1, false); }
        else if (wave == 5) { ptile(B, 1, 0, false); ptile(B, 2, 2, true); ptile(B, 3, 3, false); }
        else if (wave == 6) { ptile(B, 2, 0, false); ptile(B, 2, 1, false); ptile(B, 3, 2, false); }
        else { ptile(B, 3, 0, false); ptile(B, 3, 1, false); }
    };
    LQ unsigned* hcnt = (LQ unsigned*)(lds + 2 * SC_BUF);
    if (tid == 256) *hcnt = 0u;
    LSYNC();
    if (helper) {
        unsigned htarget = 0u;
        auto hmeet = [&]() { LDSWAIT(); WSYNC(); htarget += 4u; if (lane == 0) lds_inc(hcnt); while (lds_peek(hcnt) < htarget) SPIN_YIELD(); CFENCE(); };
        hload(0); hwrite(0); hmeet(); hscore(0); if (NSTEP > 1) hload(1);
        LSYNC();
        for (int n = 0; n < NSTEP; ++n) {
            if (n + 1 < NSTEP) { hwrite((n + 1) & 1); hmeet(); hscore((n + 1) & 1); }
            if (n + 2 < NSTEP && !(PF & 1)) hload(n + 2);
            LSYNC();
        }
    } else {
        f32x4 St[8];
#pragma unroll
        for (int t = 0; t < 8; ++t) St[t] = (f32x4){0.f, 0.f, 0.f, 0.f};
        const int arow = 8 * (c >> 2) + (c & 3);
        LSYNC();
        for (int n = 0; n < NSTEP; ++n) {
            LQ unsigned char* B = lds + (n & 1) * SC_BUF; LQ const float* sc = (LQ const float*)(B + SC_SC);
            f32x4 o[4], vn[4];
            if (PF & 8) { LSYNC(); continue; }
            {
                bf16x8 Sb[4];
#pragma unroll
                for (int s2 = 0; s2 < 4; ++s2) Sb[s2] = packb(St[2 * s2], St[2 * s2 + 1]);
                f32x4 R[4];
                bf16x8 fq[2][4], fk[2][4];
#pragma unroll
                for (int s2 = 0; s2 < 4; ++s2) { const int off = arow * 272 + (32 * s2 + 8 * q) * 2; fq[0][s2] = ld8l(B + SC_QB + off); if (MIX == 0) fk[0][s2] = ld8l(B + SC_KB + off); }
#pragma unroll
                for (int i = 0; i < 4; ++i) {
                    if (i < 3) {
#pragma unroll
                        for (int s2 = 0; s2 < 4; ++s2) { const int off = (32 * ((i + 1) >> 1) + 4 * ((i + 1) & 1) + arow) * 272 + (32 * s2 + 8 * q) * 2; fq[(i + 1) & 1][s2] = ld8l(B + SC_QB + off); if (MIX == 0) fk[(i + 1) & 1][s2] = ld8l(B + SC_KB + off); } }
                    const int r0 = 32 * (i >> 1) + 8 * q + 4 * (i & 1);
                    const f32x4 Gm = ld4fl(B + SC_SC + (64 + r0) * 4);
                    const s16x4 vraw = trread(B + SC_VB + (r0 + (c >> 2)) * 144 + (16 * wave + 4 * (c & 3)) * 2);
                    f32x4 Vt; Vt[0] = bf2f((bf16_t)vraw[0]); Vt[1] = bf2f((bf16_t)vraw[1]); Vt[2] = bf2f((bf16_t)vraw[2]); Vt[3] = bf2f((bf16_t)vraw[3]);
                    f32x4 a4 = {0.f, 0.f, 0.f, 0.f}; if (MIX == 0) { a4 = ld4fl(B + SC_SC + r0 * 4); Vt = Vt * ld4fl(B + SC_SC + (256 + r0) * 4); }
                    f32x4 aK = {0.f, 0.f, 0.f, 0.f}, aQ = {0.f, 0.f, 0.f, 0.f};
                    SCHEDB();
#pragma unroll
                    for (int s2 = 0; s2 < 4; ++s2) { aQ = MFMA16(fq[i & 1][s2], Sb[s2], aQ); if (MIX == 0) aK = MFMA16(fk[i & 1][s2], Sb[s2], aK); }
                    SCHEDB();
                    o[i] = Gm * aQ;
                    if (MIX == 0) R[i] = Vt + a4 * aK; else vn[i] = Vt;
                }
                if (MIX == 0) {
                    bf16x8 Rb[2]; Rb[0] = packb(R[0], R[1]); Rb[1] = packb(R[2], R[3]);
                    bf16x8 tf[6];
                    tf[0] = ld8l(B + SC_TB + arow * 144 + (8 * q) * 2); tf[1] = ld8l(B + SC_TB + (4 + arow) * 144 + (8 * q) * 2);
                    tf[2] = ld8l(B + SC_TB + (32 + arow) * 144 + (8 * q) * 2); tf[3] = ld8l(B + SC_TB + (32 + arow) * 144 + (32 + 8 * q) * 2);
                    tf[4] = ld8l(B + SC_TB + (36 + arow) * 144 + (8 * q) * 2); tf[5] = ld8l(B + SC_TB + (36 + arow) * 144 + (32 + 8 * q) * 2);
                    const f32x4 z4 = {0.f, 0.f, 0.f, 0.f};
                    SCHEDB();
                    vn[0] = MFMA16(tf[0], Rb[0], z4); vn[1] = MFMA16(tf[1], Rb[0], z4);
                    vn[2] = MFMA16(tf[3], Rb[1], MFMA16(tf[2], Rb[0], z4)); vn[3] = MFMA16(tf[5], Rb[1], MFMA16(tf[4], Rb[0], z4));
                }
            }
            {
                bf16x8 vnb[2], veb[2];
                vnb[0] = packb(vn[0], vn[1]); vnb[1] = packb(vn[2], vn[3]);
                { f32x4 ve[4];
#pragma unroll
                  for (int i = 0; i < 4; ++i) ve[i] = ld4fl(B + SC_SC + (128 + 32 * (i >> 1) + 8 * q + 4 * (i & 1)) * 4) * vn[i];
                  veb[0] = packb(ve[0], ve[1]); veb[1] = packb(ve[2], ve[3]); }
                { bf16x8 pf[6];
                  pf[0] = ld8l(B + SC_PB + arow * 144 + (8 * q) * 2); pf[1] = ld8l(B + SC_PB + (4 + arow) * 144 + (8 * q) * 2);
                  pf[2] = ld8l(B + SC_PB + (32 + arow) * 144 + (8 * q) * 2); pf[3] = ld8l(B + SC_PB + (32 + arow) * 144 + (32 + 8 * q) * 2);
                  pf[4] = ld8l(B + SC_PB + (36 + arow) * 144 + (8 * q) * 2); pf[5] = ld8l(B + SC_PB + (36 + arow) * 144 + (32 + 8 * q) * 2);
                  SCHEDB();
                  o[0] = MFMA16(pf[0], vnb[0], o[0]); o[1] = MFMA16(pf[1], vnb[0], o[1]);
                  o[2] = MFMA16(pf[3], vnb[1], MFMA16(pf[2], vnb[0], o[2])); o[3] = MFMA16(pf[5], vnb[1], MFMA16(pf[4], vnb[0], o[3])); }
                const float g63 = sc[64 + 63];
#pragma unroll
                for (int tp = 0; tp < 8; tp += 4) {
                    s16x4 lo[4][2], hi[4][2];
#pragma unroll
                    for (int t = 0; t < 4; ++t)
#pragma unroll
                        for (int s2 = 0; s2 < 2; ++s2) { const int colb = (32 * ((tp + t) >> 1) + 8 * (c & 3) + 4 * ((tp + t) & 1)) * 2;
                            lo[t][s2] = trread(B + SC_KB + (32 * s2 + 8 * q + (c >> 2)) * 272 + colb);
                            hi[t][s2] = trread(B + SC_KB + (32 * s2 + 8 * q + 4 + (c >> 2)) * 272 + colb); }
                    SCHEDB();
#pragma unroll
                    for (int t = 0; t < 4; ++t) { f32x4 acc = St[tp + t] * g63;
#pragma unroll
                        for (int s2 = 0; s2 < 2; ++s2) { bf16x8 kt; kt[0] = lo[t][s2][0]; kt[1] = lo[t][s2][1]; kt[2] = lo[t][s2][2]; kt[3] = lo[t][s2][3]; kt[4] = hi[t][s2][0]; kt[5] = hi[t][s2][1]; kt[6] = hi[t][s2][2]; kt[7] = hi[t][s2][3];
                            acc = MFMA16(kt, veb[s2], acc); }
                        St[tp + t] = acc; }
                }
                const size_t m0 = (size_t)chain_row0(b, DIR, n);
                if (!(DIR == 1 && layer == NLAYER - 1 && n < NCH_C))
#pragma unroll
                for (int i = 0; i < 4; ++i)
#pragma unroll
                    for (int r = 0; r < 4; ++r) { const int row = 32 * (i >> 1) + 8 * q + 4 * (i & 1) + r; const size_t m = m0 + (row ^ rx);
                        bf16_t* pp = PARK + m * 512 + h * 128 + 64 * half + 16 * wave + c;
                        if (!(PF & 2)) *pp = f2bf(o[i][r]); else if (o[i][r] == 12345.678f) *pp = 0; }
            }
            LSYNC();
        }
    }
}
template <int PF = 0> DEVI void phase_scan(const Ctx& cx, const Params& p, LQ unsigned char* lds, int layer) {
    const Views v = make_views(p.ws, p.out);
    const int nitem = 2 * NB * 4 * 2;
    for (int item = cx.bid; item < nitem; item += cx.nblk) scan_chain<0, PF>(cx, p, v, lds, layer, item / (8 * NB), (item >> 3) % NB, (item >> 1) & 3, item & 1);
    CFENCE();
    for (int item = (cx.bid + cx.nblk - (nitem % cx.nblk)) % cx.nblk; item < nitem; item += cx.nblk) scan_chain<1, PF>(cx, p, v, lds, layer, item / (8 * NB), (item >> 3) % NB, (item >> 1) & 3, item & 1);
}

constexpr int AT_V = 9216, AT_BUF = 18432;
template <bool CTXQ, int PRB = 0> DEVI void attn_unit(const Ctx& cx, const Params& p, const Views& v, LQ unsigned char* lds, int layer, int b, int hkv, int blk) {
    const int tid = cx.tid, wave = RFL(tid >> 6), lane = tid & 63, q = lane >> 4, c = lane & 15;
    const int g = wave >> 1, rh = wave & 1, hq = 4 * hkv + g;
    const size_t mq0 = (CTXQ ? (size_t)ML + (size_t)b * CTXL : (size_t)b * SEQ) + 64 * blk + 32 * rh;
    bf16x8 qf[2][2];
#pragma unroll
    for (int i = 0; i < 2; ++i)
#pragma unroll
        for (int s2 = 0; s2 < 2; ++s2) qf[i][s2] = ld8g(v.BQ + (mq0 + 16 * i + c) * 512 + hq * 64 + 32 * s2 + 8 * q);
    const int wlo = CTXQ ? 0 : (2 - blk > 0 ? 2 - blk : 0), whi = CTXQ ? 0 : (NCH_L + 2 - blk < 5 ? NCH_L + 2 - blk : 5);
    const int ntile = NCH_C + (whi - wlo);
    const int lrow = tid >> 3, lpc = tid & 7;
    auto tile_row0 = [&](int j, int& tstart) -> size_t { if (j < NCH_C) { tstart = -100000; return (size_t)ML + (size_t)b * CTXL + 64 * j; } tstart = 64 * (blk - 2 + wlo + (j - NCH_C)); return (size_t)b * SEQ + tstart; };
    U4 kreg, vreg;
    auto tload = [&](int j) { int ts; const size_t r0 = tile_row0(j, ts); const bf16_t* src = v.BKV + (r0 + lrow) * 256 + hkv * 64 + lpc * 8; kreg = *(const U4*)src; vreg = *(const U4*)(src + 128); };
    auto twrite = [&](int bufi) { LQ unsigned char* B = lds + bufi * AT_BUF; st16l(B + lrow * 144 + lpc * 16, kreg); st16l(B + AT_V + lrow * 144 + lpc * 16, vreg); };
    float mrun[2], lrun[2]; f32x4 ot[4][2];
    mrun[0] = mrun[1] = p.b_sink[layer * 8 + hq]; lrun[0] = lrun[1] = 1.0f;
#pragma unroll
    for (int dt = 0; dt < 4; ++dt) { ot[dt][0] = (f32x4){0.f, 0.f, 0.f, 0.f}; ot[dt][1] = (f32x4){0.f, 0.f, 0.f, 0.f}; }
    SYNC();
    tload(0); twrite(0);
    SYNC();
    for (int j = 0; j < ntile; ++j) {
        LQ unsigned char* B = lds + (j & 1) * AT_BUF;
        if (j + 1 < ntile) tload(j + 1);
        int tstart; (void)tile_row0(j, tstart);
        f32x4 st[4][2];
#pragma unroll
        for (int kt = 0; kt < 4; ++kt) {
            const bf16x8 k0 = ld8l(B + (16 * kt + c) * 144 + (8 * q) * 2), k1 = ld8l(B + (16 * kt + c) * 144 + (32 + 8 * q) * 2);
#pragma unroll
            for (int i = 0; i < 2; ++i) { f32x4 acc = {0.f, 0.f, 0.f, 0.f}; acc = MFMA16(k0, qf[i][0], acc); acc = MFMA16(k1, qf[i][1], acc); st[kt][i] = acc * 0.125f; }
        }
        if (j >= NCH_C) {
#pragma unroll
            for (int i = 0; i < 2; ++i) { const int tq = 64 * blk + 32 * rh + 16 * i + c;
#pragma unroll
                for (int kt = 0; kt < 4; ++kt)
#pragma unroll
                    for (int r = 0; r < 4; ++r) { const int d = tstart + 16 * kt + 4 * q + r - tq; if (d > 128 || d < -128) st[kt][i][r] = -INFINITY; } }
        }
        bf16x8 pb[2][2];
#pragma unroll
        for (int i = 0; i < 2; ++i) {
            float mx = st[0][i][0];
#pragma unroll
            for (int kt = 0; kt < 4; ++kt)
#pragma unroll
                for (int r = 0; r < 4; ++r) mx = fmaxf(mx, st[kt][i][r]);
            mx = fmaxf(mx, shfl_f(mx, lane ^ 16)); mx = fmaxf(mx, shfl_f(mx, lane ^ 32));
            const float mnew = fmaxf(mrun[i], mx), alpha = FEXP(mrun[i] - mnew);
            float ls = 0.f;
#pragma unroll
            for (int kt = 0; kt < 4; ++kt)
#pragma unroll
                for (int r = 0; r < 4; ++r) { const float e = FEXP(st[kt][i][r] - mnew); st[kt][i][r] = e; ls += e; }
            ls += shfl_f(ls, lane ^ 16); ls += shfl_f(ls, lane ^ 32);
            lrun[i] = lrun[i] * alpha + ls; mrun[i] = mnew;
#pragma unroll
            for (int dt = 0; dt < 4; ++dt) ot[dt][i] = ot[dt][i] * alpha;
            pb[i][0] = packb(st[0][i], st[1][i]); pb[i][1] = packb(st[2][i], st[3][i]);
        }
#pragma unroll
        for (int dt = 0; dt < 4; ++dt)
#pragma unroll
            for (int ks = 0; ks < 2; ++ks) {
                const s16x4 lo = trread(B + AT_V + (32 * ks + 4 * q + (c >> 2)) * 144 + (16 * dt + 4 * (c & 3)) * 2);
                const s16x4 hi = trread(B + AT_V + (32 * ks + 16 + 4 * q + (c >> 2)) * 144 + (16 * dt + 4 * (c & 3)) * 2);
                bf16x8 vt; vt[0] = lo[0]; vt[1] = lo[1]; vt[2] = lo[2]; vt[3] = lo[3]; vt[4] = hi[0]; vt[5] = hi[1]; vt[6] = hi[2]; vt[7] = hi[3];
                ot[dt][0] = MFMA16(vt, pb[0][ks], ot[dt][0]); ot[dt][1] = MFMA16(vt, pb[1][ks], ot[dt][1]);
            }
        if (j + 1 < ntile) twrite((j + 1) & 1);
        SYNC();
    }
#pragma unroll
    for (int i = 0; i < 2; ++i) { const float il = 1.0f / lrun[i];
#pragma unroll
        for (int dt = 0; dt < 4; ++dt) { const f32x4 o4 = ot[dt][i] * il;
            unsigned long long w = (unsigned long long)pk2(o4[0], o4[1]) | ((unsigned long long)pk2(o4[2], o4[3]) << 32);
            *(unsigned long long*)((PRB ? v.PA : v.BQ) + (mq0 + 16 * i + c) * 512 + hq * 64 + 16 * dt + 4 * q) = w; } }
}
template <int PRB = 0> DEVI void phase_attn(const Ctx& cx, const Params& p, LQ unsigned char* lds, int layer) {
    const Views v = make_views(p.ws);
    const int nlat = NB * 2 * NCH_L, nctx = layer == 0 ? NB * 2 * NCH_C : 0;
    for (int item = cx.bid; item < nlat + nctx; item += cx.nblk) {
        if (item < nlat) attn_unit<false, PRB>(cx, p, v, lds, layer, item / (2 * NCH_L), (item / NCH_L) & 1, item % NCH_L);
        else { const int it = item - nlat; attn_unit<true, PRB>(cx, p, v, lds, layer, it / (2 * NCH_C), (it / NCH_C) & 1, it % NCH_C); }
    }
}

struct StG1 { bf16_t *AQKV, *BQ, *BKV, *CQKV, *HALO;
    DEVI void st8(int row, int col, const float* a) const {
        bf16_t* dst = col < 1536 ? AQKV + (size_t)row * 1536 + col : (col < 2048 ? BQ + (size_t)row * 512 + (col - 1536) : (col < 2304 ? BKV + (size_t)row * 256 + (col - 2048) : CQKV + (size_t)row * 1536 + (col - 2304)));
        const U4 w = pack8(a); *(U4*)dst = w;
        const int r64 = row & 63;
        if (col < 1536 && (r64 < 2 || r64 >= 62)) *(U4*)(HALO + ((size_t)(row >> 6) * 4 + (r64 < 2 ? r64 : r64 - 60)) * 1536 + col) = w; } };
struct StPlain { bf16_t* O; int ld;
    DEVI void st8(int row, int col, const float* a) const { *(U4*)(O + (size_t)row * ld + col) = pack8(a); } };
struct StMerge { const bf16_t* L; bf16_t* MRG; int br;
    DEVI void st8(int row, int col, const float* a) const {
        float lg[8], o[8]; unpack8(*(const U4*)(L + (size_t)row * NMG + br * 1024 + col), lg);
        if (br) unpack8(*(const U4*)(MRG + (size_t)row * DM + col), o); else { for (int e = 0; e < 8; ++e) o[e] = 0.f; }
        for (int e = 0; e < 8; ++e) o[e] += sigmoidf_(lg[e]) * a[e];
        *(U4*)(MRG + (size_t)row * DM + col) = pack8(o); }
    static constexpr bool HAS_LD = true;
    DEVI void ld8(int row, int col, U4& x0, U4& x1) const { x0 = *(const U4*)(L + (size_t)row * NMG + br * 1024 + col); if (br) x1 = *(const U4*)(MRG + (size_t)row * DM + col); else x1 = U4{0u, 0u, 0u, 0u}; }
    DEVI void fin8(int row, int col, const float* a, const U4& x0, const U4& x1) const {
        float lg[8], o[8]; unpack8(x0, lg); unpack8(x1, o);
        for (int e = 0; e < 8; ++e) o[e] += a[e] / (1.0f + FEXP(-lg[e]));
        *(U4*)(MRG + (size_t)row * DM + col) = pack8(o); } };
struct StMerge3 { const bf16_t* L; bf16_t* MRG;
    DEVI void st8(int row, int col, const float* a) const { const int br = col >> 10; StMerge{L, MRG, br}.st8(row - br * MT, col & 1023, a); }
    DEVI void ld8(int row, int col, U4& x0, U4& x1) const { const int br = col >> 10, r = row - br * MT, c = col & 1023; x0 = *(const U4*)(L + (size_t)r * NMG + br * 1024 + c); if (br) x1 = *(const U4*)(MRG + (size_t)r * DM + c); else x1 = U4{0u, 0u, 0u, 0u}; }
    DEVI void fin8(int row, int col, const float* a, const U4& x0, const U4& x1) const { const int br = col >> 10; StMerge{L, MRG, br}.fin8(row - br * MT, col & 1023, a, x0, x1); } };
struct StResid { const float *xlat, *xctx; float *olat, *octx; const float* mod;
    DEVI void st4(int row, int col, const float* a) const {
        const float* xi = row < ML ? xlat + (size_t)row * DM + col : xctx + (size_t)(row - ML) * DM + col;
        float* xo = row < ML ? olat + (size_t)row * DM + col : octx + (size_t)(row - ML) * DM + col;
        const int b = row < ML ? row / SEQ : NB; const float* g = mod + (size_t)b * 3072 + 2048 + col;
        for (int e = 0; e < 4; ++e) xo[e] = xi[e] + g[e] * a[e]; }
    DEVI f32x4 ldx(int row, int col) const { return ldg4(row < ML ? xlat + (size_t)row * DM + col : xctx + (size_t)(row - ML) * DM + col); }
    DEVI f32x4 ldgate(int row, int col) const { const int b = row < ML ? row / SEQ : NB; return ldg4(mod + (size_t)b * 3072 + 2048 + col); }
    DEVI void fin4(int row, int col, const f32x4& acc, const f32x4& x, const f32x4& g) const { stg4(row < ML ? olat + (size_t)row * DM + col : octx + (size_t)(row - ML) * DM + col, x + g * acc); } };

#ifndef CPU_EMU
namespace pg8 {
#define PG8_LAS __attribute__((address_space(3)))
typedef short bf16x8 __attribute__((ext_vector_type(8)));
typedef float f32x4 __attribute__((ext_vector_type(4)));
constexpr int BM = 256, BK = 64, HALF = 128, HTB = HALF * BK * 2, STAGE_BYTES = 8 * HTB, NXCD = 8, WGM = 8;
__host__ __device__ __forceinline__ int lds_byte(int r, int c) { const int st = (r >> 4) * 2 + (c >> 5), rr = r & 15, cc = c & 31, ob = rr * 64 + cc * 2; return st * 1024 + (ob ^ (((ob >> 9) & 1) << 5)); }
__host__ __device__ __forceinline__ void stage_rc(int b, int& R, int& C) { const int st = b / 1024, sb = b % 1024, swz = sb ^ (((sb >> 9) & 1) << 5); R = (st >> 1) * 16 + swz / 64; C = (st & 1) * 32 + (swz % 64) / 2; }
__host__ __device__ __forceinline__ int perm32(int rho) { const int n = rho >> 4, i = rho & 15; return 8 * (i >> 2) + 4 * n + (i & 3); }
struct Unit { int pm, pn; };
struct Gemm { const bf16_t* A; const bf16_t* Bt; int M, N, K; };
struct StaticOrder {
    int nM, nN, nwg, G, c;
    __host__ __device__ void init(int M, int N, int G_, int c_) { nM = M / BM; nN = N / BM; nwg = nM * nN; G = G_; c = c_; }
    __host__ __device__ bool next(int i, Unit& u) const {
        const long L = (long)i * G + c; if (L >= nwg) return false;
        int wgid = (int)L; { const int q = nwg / NXCD, r = nwg % NXCD, xcd = wgid % NXCD, off = wgid / NXCD; wgid = (xcd < r ? xcd * (q + 1) : r * (q + 1) + (xcd - r) * q) + off; }
        const int nig = WGM * nN, gid = wgid / nig, fm = gid * WGM, gsz = (nM - fm) < WGM ? (nM - fm) : WGM;
        u.pm = fm + ((wgid % nig) % gsz); u.pn = (wgid % nig) / gsz; return true;
    }
    __device__ __forceinline__ void a_ready(const Unit&) const {}
    __device__ __forceinline__ void done(const Unit&) const {}
};
struct BranchOrder {
    StaticOrder so;
    __host__ __device__ void init(int M, int G_, int c_) { so.init(M, 1024, G_, c_); }
    __host__ __device__ bool next(int i, Unit& u) const { Unit t; if (!so.next(i / 3, t)) return false; const int br = i % 3; u.pm = br * (MT / 256) + t.pm; u.pn = br * 4 + t.pn; return true; }
    __device__ __forceinline__ void a_ready(const Unit&) const {}
    __device__ __forceinline__ void done(const Unit&) const {}
};
template <class F> struct Epi8 {
    static constexpr bool PERM = true, AFTER_DRAIN = false; F f;
    __device__ __forceinline__ void operator()(const f32x4 (&acc)[2][2][4][2], const Unit& u, int wr, int wc, int fr, int fq) const {
        const int row0 = u.pm * BM + wr * 64 + fr, col0 = u.pn * BM + wc * 32 + 8 * fq;
#pragma unroll
        for (int ai = 0; ai < 2; ++ai)
#pragma unroll
            for (int m = 0; m < 4; ++m)
#pragma unroll
                for (int bj = 0; bj < 2; ++bj) { const f32x4 v0 = acc[ai][bj][m][0], v1 = acc[ai][bj][m][1];
                    const float a[8] = {v0[0], v0[1], v0[2], v0[3], v1[0], v1[1], v1[2], v1[3]};
                    f.st8(row0 + ai * HALF + m * 16, col0 + bj * HALF, a); }
    }
};
template <class F> struct Epi8L {
    static constexpr bool PERM = true, AFTER_DRAIN = false; F f;
    __device__ __forceinline__ void operator()(const f32x4 (&acc)[2][2][4][2], const Unit& u, int wr, int wc, int fr, int fq) const {
        const int row0 = u.pm * BM + wr * 64 + fr, col0 = u.pn * BM + wc * 32 + 8 * fq;
#pragma unroll
        for (int ai = 0; ai < 2; ++ai) {
            U4 x0[4][2], x1[4][2];
#pragma unroll
            for (int m = 0; m < 4; ++m)
#pragma unroll
                for (int bj = 0; bj < 2; ++bj) f.ld8(row0 + ai * HALF + m * 16, col0 + bj * HALF, x0[m][bj], x1[m][bj]);
#pragma unroll
            for (int m = 0; m < 4; ++m)
#pragma unroll
                for (int bj = 0; bj < 2; ++bj) { const f32x4 v0 = acc[ai][bj][m][0], v1 = acc[ai][bj][m][1];
                    const float a[8] = {v0[0], v0[1], v0[2], v0[3], v1[0], v1[1], v1[2], v1[3]};
                    f.fin8(row0 + ai * HALF + m * 16, col0 + bj * HALF, a, x0[m][bj], x1[m][bj]); }
        }
    }
};
struct SigTileStore { bf16_t* LT;
    __device__ __forceinline__ void st(const Unit& u, int slot, const float* a) const {
        float o[8];
#pragma unroll
        for (int e = 0; e < 8; ++e) o[e] = 1.0f / (1.0f + __expf(-a[e]));
        *(U4*)(LT + (((size_t)(u.pm * 12 + u.pn) * 8192 + slot) << 3)) = pack8(o); } };
template <class F> struct Epi8T {
    static constexpr bool PERM = true, AFTER_DRAIN = false; F f;
    __device__ __forceinline__ void operator()(const f32x4 (&acc)[2][2][4][2], const Unit& u, int wr, int wc, int fr, int fq) const {
        int wl = (wr * 4 + wc) * 64 + fq * 16 + fr; asm volatile("" : "+v"(wl));
#pragma unroll
        for (int ai = 0; ai < 2; ++ai)
#pragma unroll
            for (int m = 0; m < 4; ++m)
#pragma unroll
                for (int bj = 0; bj < 2; ++bj) { const f32x4 v0 = acc[ai][bj][m][0], v1 = acc[ai][bj][m][1];
                    const float a[8] = {v0[0], v0[1], v0[2], v0[3], v1[0], v1[1], v1[2], v1[3]};
                    f.st(u, ((ai * 4 + m) * 2 + bj) * 512 + wl, a); }
    }
};
struct MergeTile { const bf16_t* LT; bf16_t* SCR; bf16_t* MRG; };
struct Epi8M {
    static constexpr bool PERM = true, AFTER_DRAIN = false; MergeTile f;
    __device__ __forceinline__ void operator()(const f32x4 (&acc)[2][2][4][2], const Unit& u, int wr, int wc, int fr, int fq) const {
        const int br = u.pn >> 2, pm = u.pm - br * (MT / 256), pn = u.pn & 3;
        int wl = (wr * 4 + wc) * 64 + fq * 16 + fr; asm volatile("" : "+v"(wl));
        int row0 = pm * BM + wr * 64 + fr, col0 = pn * BM + wc * 32 + 8 * fq; asm volatile("" : "+v"(row0), "+v"(col0));
        const bf16_t* lt = f.LT + (((size_t)(pm * 12 + u.pn) * 8192) << 3);
#pragma unroll
        for (int ai = 0; ai < 2; ++ai) {
            U4 x0[4][2], x1[4][2];
#pragma unroll
            for (int m = 0; m < 4; ++m)
#pragma unroll
                for (int bj = 0; bj < 2; ++bj) { const int slot = ((ai * 4 + m) * 2 + bj) * 512 + wl;
                    x0[m][bj] = *(const U4*)(lt + ((size_t)slot << 3));
                    if (br) x1[m][bj] = *(const U4*)(f.SCR + ((size_t)slot << 3)); else x1[m][bj] = U4{0u, 0u, 0u, 0u}; }
#pragma unroll
            for (int m = 0; m < 4; ++m)
#pragma unroll
                for (int bj = 0; bj < 2; ++bj) { const f32x4 v0 = acc[ai][bj][m][0], v1 = acc[ai][bj][m][1];
                    const float a[8] = {v0[0], v0[1], v0[2], v0[3], v1[0], v1[1], v1[2], v1[3]};
                    float g[8], o[8]; unpack8(x0[m][bj], g); unpack8(x1[m][bj], o);
#pragma unroll
                    for (int e = 0; e < 8; ++e) o[e] += g[e] * a[e];
                    const int slot = ((ai * 4 + m) * 2 + bj) * 512 + wl;
                    if (br < 2) *(U4*)(f.SCR + ((size_t)slot << 3)) = pack8(o);
                    else *(U4*)(f.MRG + (size_t)(row0 + ai * HALF + m * 16) * DM + col0 + bj * HALF) = pack8(o); }
        }
    }
};
template <class F> struct Epi4L {
    static constexpr bool PERM = false, AFTER_DRAIN = false; F f;
    __device__ __forceinline__ void operator()(const f32x4 (&acc)[2][2][4][2], const Unit& u, int wr, int wc, int fr, int fq) const {
        const int row0 = u.pm * BM + wr * 64 + fr, col0 = u.pn * BM + wc * 32 + 4 * fq;
        f32x4 g[2][2];
#pragma unroll
        for (int bj = 0; bj < 2; ++bj)
#pragma unroll
            for (int n = 0; n < 2; ++n) g[bj][n] = f.ldgate(u.pm * BM, col0 + bj * HALF + n * 16);
#pragma unroll
        for (int ai = 0; ai < 2; ++ai) {
            f32x4 xr[4][2][2];
#pragma unroll
            for (int m = 0; m < 4; ++m)
#pragma unroll
                for (int bj = 0; bj < 2; ++bj)
#pragma unroll
                    for (int n = 0; n < 2; ++n) xr[m][bj][n] = f.ldx(row0 + ai * HALF + m * 16, col0 + bj * HALF + n * 16);
#pragma unroll
            for (int m = 0; m < 4; ++m)
#pragma unroll
                for (int bj = 0; bj < 2; ++bj)
#pragma unroll
                    for (int n = 0; n < 2; ++n) f.fin4(row0 + ai * HALF + m * 16, col0 + bj * HALF + n * 16, acc[ai][bj][m][n], xr[m][bj][n], g[bj][n]);
        }
    }
};
template <class F> struct Epi4 {
    static constexpr bool PERM = false, AFTER_DRAIN = false; F f;
    __device__ __forceinline__ void operator()(const f32x4 (&acc)[2][2][4][2], const Unit& u, int wr, int wc, int fr, int fq) const {
        const int row0 = u.pm * BM + wr * 64 + fr, col0 = u.pn * BM + wc * 32 + 4 * fq;
#pragma unroll
        for (int ai = 0; ai < 2; ++ai)
#pragma unroll
            for (int m = 0; m < 4; ++m)
#pragma unroll
                for (int bj = 0; bj < 2; ++bj)
#pragma unroll
                    for (int n = 0; n < 2; ++n) { const f32x4 v0 = acc[ai][bj][m][n]; const float a[4] = {v0[0], v0[1], v0[2], v0[3]};
                        f.st4(row0 + ai * HALF + m * 16, col0 + bj * HALF + n * 16, a); }
    }
};

template <class Epi, class Sched, bool ALIGN_EPI = false, bool SP2 = false>
__device__ __forceinline__ void gemm_phase(PG8_LAS unsigned char* lds, const int tid, const Gemm g, const Sched& S, const Epi& E) {
    const int wid = __builtin_amdgcn_readfirstlane(tid >> 6), lane = tid & 63, wr = wid >> 2, wc = wid & 3, fr = lane & 15, fq = lane >> 4;
    const int K = g.K, nt = K / BK;
    unsigned voffA[2], voffB[2];
#pragma unroll
    for (int i = 0; i < 2; ++i) { int R, C; stage_rc(tid * 16 + i * 8192, R, C); const int Rb = Epi::PERM ? ((R & ~31) + perm32(R & 31)) : R;
        voffA[i] = (unsigned)(R * K + C) * 2u; voffB[i] = (unsigned)(Rb * K + C) * 2u; }
    const size_t kstep = (size_t)(BK * 2);
    const size_t hstep = (size_t)HALF * K * 2;
    const size_t tstep = 2 * hstep;
    const unsigned ldsw = (unsigned)wid * 1024u;
    const int aoff = lds_byte(wr * 64 + fr, fq * 8), boff = lds_byte(wc * 32 + fr, fq * 8);
#define PG8_SA(b, h) (((b) * 2 + (h)) * HTB)
#define PG8_SB(b, h) ((4 + (b) * 2 + (h)) * HTB)
#define PG8_STAGE(bufoff, gbase, voff) do { _Pragma("unroll") for (int _i = 0; _i < 2; ++_i) \
        __builtin_amdgcn_global_load_lds((const unsigned*)((const char*)(gbase) + (voff)[_i]), (PG8_LAS unsigned*)(lds + (bufoff) + ldsw + _i * 8192), 16, 0, 0); } while (0)
#define PG8_LDA(dst, b, h) do { _Pragma("unroll") for (int m = 0; m < 4; ++m) _Pragma("unroll") for (int k = 0; k < 2; ++k) dst[m][k] = *(const PG8_LAS bf16x8*)(lds + PG8_SA(b, h) + aoff + m * 2048 + k * 1024); } while (0)
#define PG8_LDB(dst, b, h) do { _Pragma("unroll") for (int n = 0; n < 2; ++n) _Pragma("unroll") for (int k = 0; k < 2; ++k) dst[n][k] = *(const PG8_LAS bf16x8*)(lds + PG8_SB(b, h) + boff + n * 2048 + k * 1024); } while (0)
#define PG8_MMA(ai, bj, At, Bt) do { __builtin_amdgcn_s_setprio(1); _Pragma("unroll") for (int m = 0; m < 4; ++m) _Pragma("unroll") for (int n = 0; n < 2; ++n) _Pragma("unroll") for (int k = 0; k < 2; ++k) \
        acc[ai][bj][m][n] = __builtin_amdgcn_mfma_f32_16x16x32_bf16(Bt[n][k], At[m][k], acc[ai][bj][m][n], 0, 0, 0); __builtin_amdgcn_s_setprio(0); } while (0)
#define PG8_WAIT_V(n) asm volatile("s_waitcnt vmcnt(" #n ")" ::: "memory")
#define PG8_WAIT_L(n) asm volatile("s_waitcnt lgkmcnt(" #n ")" ::: "memory")
#define PG8_BAR __builtin_amdgcn_s_barrier()
#define PG8_SCHED __builtin_amdgcn_sched_barrier(0)
    Unit cur, nxt; int ui = 0;
    if (!S.next(0, cur)) return;
    f32x4 acc[2][2][4][2];
#pragma unroll
    for (int a = 0; a < 2; ++a)
#pragma unroll
        for (int b = 0; b < 2; ++b)
#pragma unroll
            for (int m = 0; m < 4; ++m)
#pragma unroll
                for (int n = 0; n < 2; ++n) acc[a][b][m][n] = (f32x4){0.f, 0.f, 0.f, 0.f};
    bf16x8 At[4][2], B0[2][2], B1[2][2];
    const char* cA = (const char*)g.A + (size_t)cur.pm * tstep; const char* cB = (const char*)g.Bt + (size_t)cur.pn * tstep;
    S.a_ready(cur);
    if constexpr (SP2) {
        PG8_STAGE(PG8_SB(0, 0), cB, voffB); PG8_STAGE(PG8_SB(0, 1), cB + hstep, voffB); PG8_STAGE(PG8_SA(0, 0), cA, voffA); PG8_STAGE(PG8_SA(0, 1), cA + hstep, voffA);
        if (wr == 1) PG8_BAR;
        PG8_WAIT_V(2); PG8_BAR;
        PG8_STAGE(PG8_SB(1, 0), cB + kstep, voffB); PG8_STAGE(PG8_SA(1, 0), cA + kstep, voffA); PG8_STAGE(PG8_SB(1, 1), cB + hstep + kstep, voffB);
        PG8_WAIT_V(6); PG8_BAR;
    } else {
        PG8_STAGE(PG8_SB(0, 0), cB, voffB); PG8_STAGE(PG8_SA(0, 0), cA, voffA); PG8_STAGE(PG8_SB(0, 1), cB + hstep, voffB); PG8_STAGE(PG8_SA(0, 1), cA + hstep, voffA);
        if (wr == 1) PG8_BAR;
        PG8_WAIT_V(4); PG8_BAR;
        PG8_STAGE(PG8_SB(1, 0), cB + kstep, voffB); PG8_STAGE(PG8_SA(1, 0), cA + kstep, voffA); PG8_STAGE(PG8_SB(1, 1), cB + hstep + kstep, voffB);
        PG8_WAIT_V(6); PG8_BAR;
    }
    for (;;) {
        const bool has_next = S.next(ui + 1, nxt);
        const char* nA = has_next ? (const char*)g.A + (size_t)nxt.pm * tstep : cA; const char* nB = has_next ? (const char*)g.Bt + (size_t)nxt.pn * tstep : cB;
        for (int t = 0; t < nt; t += 2) {
            const bool last = (t == nt - 2);
            const char* a1 = cA + (size_t)(t + 1) * kstep;
            const char* a2 = last ? nA : cA + (size_t)(t + 2) * kstep; const char* b2 = last ? nB : cB + (size_t)(t + 2) * kstep;
            const char* a3 = a2 + kstep; const char* b3 = b2 + kstep;
            if (last && has_next) S.a_ready(nxt);
            if constexpr (SP2) {
            PG8_LDB(B0, 0, 0); PG8_LDB(B1, 0, 1); PG8_SCHED; PG8_LDA(At, 0, 0); PG8_STAGE(PG8_SA(1, 1), a1 + hstep, voffA);
            PG8_WAIT_V(8); PG8_WAIT_L(0); PG8_BAR; PG8_MMA(0, 0, At, B0); PG8_MMA(0, 1, At, B1); PG8_BAR; PG8_SCHED;
            PG8_LDA(At, 0, 1); PG8_STAGE(PG8_SB(0, 0), b2, voffB); PG8_STAGE(PG8_SB(0, 1), b2 + hstep, voffB); PG8_STAGE(PG8_SA(0, 0), a2, voffA);
            PG8_WAIT_V(8); PG8_WAIT_L(0); PG8_BAR; PG8_MMA(1, 0, At, B0); PG8_MMA(1, 1, At, B1); PG8_BAR; PG8_SCHED;
            PG8_LDB(B0, 1, 0); PG8_LDB(B1, 1, 1); PG8_SCHED; PG8_LDA(At, 1, 0); PG8_STAGE(PG8_SA(0, 1), a2 + hstep, voffA);
            PG8_WAIT_V(8); PG8_WAIT_L(0); PG8_BAR; PG8_MMA(0, 0, At, B0); PG8_MMA(0, 1, At, B1); PG8_BAR; PG8_SCHED;
            PG8_LDA(At, 1, 1); PG8_STAGE(PG8_SB(1, 0), b3, voffB); PG8_STAGE(PG8_SB(1, 1), b3 + hstep, voffB); PG8_STAGE(PG8_SA(1, 0), a3, voffA);
            PG8_WAIT_V(8); PG8_WAIT_L(0); PG8_BAR; PG8_MMA(1, 0, At, B0); PG8_MMA(1, 1, At, B1); PG8_BAR; PG8_SCHED;
            } else {
            PG8_LDB(B0, 0, 0); PG8_SCHED; PG8_LDA(At, 0, 0); PG8_STAGE(PG8_SA(1, 1), a1 + hstep, voffA);
            PG8_WAIT_L(8); PG8_BAR; PG8_WAIT_L(0); PG8_MMA(0, 0, At, B0); PG8_BAR; PG8_SCHED;
            PG8_LDB(B1, 0, 1); PG8_STAGE(PG8_SB(0, 0), b2, voffB);
            PG8_BAR; PG8_WAIT_L(0); PG8_MMA(0, 1, At, B1); PG8_BAR;
            PG8_LDA(At, 0, 1); PG8_STAGE(PG8_SA(0, 0), a2, voffA);
            PG8_BAR; PG8_WAIT_L(0); PG8_MMA(1, 0, At, B0); PG8_BAR; PG8_SCHED;
            PG8_STAGE(PG8_SB(0, 1), b2 + hstep, voffB);
            PG8_WAIT_V(6); PG8_BAR; PG8_MMA(1, 1, At, B1); PG8_BAR;
            PG8_LDB(B0, 1, 0); PG8_SCHED; PG8_LDA(At, 1, 0); PG8_STAGE(PG8_SA(0, 1), a2 + hstep, voffA);
            PG8_WAIT_L(8); PG8_BAR; PG8_WAIT_L(0); PG8_MMA(0, 0, At, B0); PG8_BAR; PG8_SCHED;
            PG8_LDB(B1, 1, 1); PG8_STAGE(PG8_SB(1, 0), b3, voffB);
            PG8_BAR; PG8_WAIT_L(0); PG8_MMA(0, 1, At, B1); PG8_BAR;
            PG8_LDA(At, 1, 1); PG8_STAGE(PG8_SA(1, 0), a3, voffA);
            PG8_BAR; PG8_WAIT_L(0); PG8_MMA(1, 0, At, B0); PG8_BAR; PG8_SCHED;
            PG8_STAGE(PG8_SB(1, 1), b3 + hstep, voffB);
            PG8_WAIT_V(6); PG8_BAR; PG8_MMA(1, 1, At, B1); PG8_BAR;
            }
        }
        if constexpr (ALIGN_EPI) { if (wr == 0) PG8_BAR; }
        if constexpr (!Epi::AFTER_DRAIN) { E(acc, cur, wr, wc, fr, fq); S.done(cur); }
        if (!has_next) break;
#pragma unroll
        for (int a = 0; a < 2; ++a)
#pragma unroll
            for (int b = 0; b < 2; ++b)
#pragma unroll
                for (int m = 0; m < 4; ++m)
#pragma unroll
                    for (int n = 0; n < 2; ++n) acc[a][b][m][n] = (f32x4){0.f, 0.f, 0.f, 0.f};
        cur = nxt; cA = nA; cB = nB; ++ui;
        if constexpr (ALIGN_EPI) { if (wr == 1) PG8_BAR; }
    }
    PG8_WAIT_V(0);
    if constexpr (!ALIGN_EPI) { if (wr == 0) PG8_BAR; }
    PG8_BAR;
#undef PG8_SA
#undef PG8_SB
#undef PG8_STAGE
#undef PG8_LDA
#undef PG8_LDB
#undef PG8_MMA
#undef PG8_WAIT_V
#undef PG8_WAIT_L
#undef PG8_BAR
#undef PG8_SCHED
}
}

template <class F> __device__ __forceinline__ void run_gemm8(PG8_LAS unsigned char* lds, const Ctx& cx, const bf16_t* A, const bf16_t* Bt, int M, int N, int K, const F& f) {
    pg8::Gemm g{A, Bt, M, N, K}; pg8::StaticOrder S; S.init(M, N, cx.nblk, cx.bid);
    pg8::Epi8<F> E{f};
    pg8::gemm_phase<pg8::Epi8<F>, pg8::StaticOrder, true, true>(lds, cx.tid, g, S, E);
}
template <class F> __device__ __forceinline__ void run_gemm4(PG8_LAS unsigned char* lds, const Ctx& cx, const bf16_t* A, const bf16_t* Bt, int M, int N, int K, const F& f) {
    pg8::Gemm g{A, Bt, M, N, K}; pg8::StaticOrder S; S.init(M, N, cx.nblk, cx.bid);
    pg8::Epi4L<F> E{f};
    pg8::gemm_phase<pg8::Epi4L<F>, pg8::StaticOrder, true, true>(lds, cx.tid, g, S, E);
}
__device__ __forceinline__ void run_gemm_branches(PG8_LAS unsigned char* lds, const Ctx& cx, const bf16_t* Y, const bf16_t* WBl, int mrows, const StMerge3& f, bf16_t* scratch) {
    pg8::Gemm g{Y, WBl, 3 * MT, 3 * 1024, 512}; pg8::BranchOrder S; S.init(mrows, cx.nblk, cx.bid);
    pg8::Epi8M E{pg8::MergeTile{f.L, scratch + (size_t)cx.bid * 65536, f.MRG}};
    pg8::gemm_phase<pg8::Epi8M, pg8::BranchOrder, true, true>(lds, cx.tid, g, S, E);
}
__device__ __forceinline__ void run_gemm_logits(PG8_LAS unsigned char* lds, const Ctx& cx, const bf16_t* A, const bf16_t* Bt, int M, bf16_t* LT) {
    pg8::Gemm g{A, Bt, M, NMG, DM}; pg8::StaticOrder S; S.init(M, NMG, cx.nblk, cx.bid);
    pg8::Epi8T<pg8::SigTileStore> E{pg8::SigTileStore{LT}};
    pg8::gemm_phase<pg8::Epi8T<pg8::SigTileStore>, pg8::StaticOrder, true, true>(lds, cx.tid, g, S, E);
}
template <class F> __device__ __forceinline__ void run_gemm8L(PG8_LAS unsigned char* lds, const Ctx& cx, const bf16_t* A, const bf16_t* Bt, int M, int N, int K, const F& f) {
    pg8::Gemm g{A, Bt, M, N, K}; pg8::StaticOrder S; S.init(M, N, cx.nblk, cx.bid);
    pg8::Epi8L<F> E{f};
    pg8::gemm_phase<pg8::Epi8L<F>, pg8::StaticOrder, true, true>(lds, cx.tid, g, S, E);
}
#else
template <class F> void run_gemm8(unsigned char*, const Ctx&, const bf16_t* A, const bf16_t* Bt, int M, int N, int K, const F& f) {
#pragma omp parallel for schedule(dynamic, 8)
    for (int r = 0; r < M; ++r) for (int c0 = 0; c0 < N; c0 += 8) { float a[8];
        for (int e = 0; e < 8; ++e) { float s = 0.f; const bf16_t* ar = A + (size_t)r * K; const bf16_t* br = Bt + (size_t)(c0 + e) * K; for (int k = 0; k < K; ++k) s += bf2f(ar[k]) * bf2f(br[k]); a[e] = s; }
        f.st8(r, c0, a); }
}
inline void run_gemm_logits(unsigned char* l, const Ctx& c, const bf16_t* A, const bf16_t* Bt, int M, bf16_t* L) { run_gemm8(l, c, A, Bt, M, NMG, DM, StPlain{L, NMG}); }
inline void run_gemm_branches(unsigned char* l, const Ctx& c, const bf16_t* Y, const bf16_t* WBl, int mrows, const StMerge3& f, bf16_t*) {
    for (int br = 0; br < 3; ++br) run_gemm8(l, c, Y + (size_t)br * MT * 512, WBl + (size_t)br * DM * 512, mrows, DM, 512, StMerge{f.L, f.MRG, br}); }
template <class F> void run_gemm8L(unsigned char* l, const Ctx& c, const bf16_t* A, const bf16_t* Bt, int M, int N, int K, const F& f) { run_gemm8(l, c, A, Bt, M, N, K, f); }
template <class F> void run_gemm4(unsigned char*, const Ctx&, const bf16_t* A, const bf16_t* Bt, int M, int N, int K, const F& f) {
#pragma omp parallel for schedule(dynamic, 8)
    for (int r = 0; r < M; ++r) for (int c0 = 0; c0 < N; c0 += 4) { float a[4];
        for (int e = 0; e < 4; ++e) { float s = 0.f; const bf16_t* ar = A + (size_t)r * K; const bf16_t* br = Bt + (size_t)(c0 + e) * K; for (int k = 0; k < K; ++k) s += bf2f(ar[k]) * bf2f(br[k]); a[e] = s; }
        f.st4(r, c0, a); }
}
#endif

#ifndef PROBE_S
#define PROBE_S -1
#endif
constexpr int PPL = 11;
constexpr int NPHASE = 2 + PPL * NLAYER;
template <int PH> DEVI void run_phase_t(LQ unsigned char* lds, const Ctx& cx, const Params& p) {
    const Views v = make_views(p.ws, p.out);
    if constexpr (PH >= 100) { constexpr int layer = (PH - 100) / 10, kind = (PH - 100) % 10;
        if constexpr (kind == 0) phase_conv<0>(cx, p, layer); else if constexpr (kind == 1) phase_prep2(cx, p, layer); else phase_tmat(cx, p, lds, layer); }
    else if constexpr (PH == 0) { phase_prep(cx, p, lds); }
    else if constexpr (PH == NPHASE - 1) { phase_final(cx, p); }
    else {
        constexpr int layer = (PH - 1) / PPL, s = (PH - 1) % PPL;
        constexpr int mrows = layer == NLAYER - 1 ? ML : MT;
        if constexpr (s == 0) { phase_norm(cx, p, layer); if constexpr (layer > 0) { SYNC(); phase_prep_w(cx, p, lds, layer); } }
        else if constexpr (s == 1) run_gemm8(lds, cx, v.XN, v.W1, MT, N1, DM, StG1{v.AQKV, v.BQ, v.BKV, v.CQKV, v.HALO});
        else if constexpr (s == 2) phase_conv<0>(cx, p, layer);
        else if constexpr (s == 3) phase_prep2(cx, p, layer);
        else if constexpr (s == 4) { phase_tmat(cx, p, lds, layer); phase_attn<0>(cx, p, lds, layer); }
        else if constexpr (s == 5) phase_scan<0>(cx, p, lds, layer);
        else if constexpr (s == 6) run_gemm8(lds, cx, v.XN, v.WZ, mrows, NZ, DM, StPlain{v.Z, NZ});
        else if constexpr (s == 7) phase_y(cx, p, layer);
        else if constexpr (s == 8) run_gemm_logits(lds, cx, v.XN, v.WM, mrows, v.L);
        else if constexpr (s == 9) run_gemm_branches(lds, cx, v.Y, v.WB, mrows, StMerge3{v.L, v.MRG}, v.T);
        else run_gemm4(lds, cx, v.MRG, v.WO, mrows, DM, DM,
                       StResid{layer == 0 ? p.x : p.out, layer == 0 ? p.ctx : v.CTX1, p.out, v.CTX1, v.MOD + (size_t)layer * (NB + 1) * 3072});
    }
}
HD bool phase_is_gemm(int ph) { if (ph == 0 || ph == NPHASE - 1) return false; const int s = (ph - 1) % PPL; return s == 1 || s == 6 || s >= 8; }
#define MK_PHASE_LIST(X) X(0) X(1) X(2) X(3) X(4) X(5) X(6) X(7) X(8) X(9) X(10) X(11) X(12) X(13) X(14) X(15) X(16) X(17) X(18) X(19) X(20) X(21) X(22) X(23)
static_assert(NPHASE == 24, "phase list");
#ifdef CPU_EMU
inline void run_phase(unsigned char* lds, const Ctx& cx, const Params& p, int ph) {
    switch (ph) {
#define X(k) case k: run_phase_t<k>(lds, cx, p); break;
        MK_PHASE_LIST(X)
#undef X
    }
}
#endif

#ifndef CPU_EMU
constexpr int LDS_BYTES = 147456;
constexpr int LDS_BARST = 147392;
#define XB_TMO      128
#define XB_XCNT(j)  (256  + 64 * (j))
#define XB_XSUB(j)  (1280 + 64 * (j))
#define XB_XGEN(j)  (2304 + 64 * (j))
#define XB_TOP      3328
#define XB_TOPGEN   3392
#define XCD_BAR_WORDS 3456
#define XB_SPIN_CAP (1u << 22)
__device__ __forceinline__ unsigned xb_ld(unsigned* p)              { return __hip_atomic_load(p, __ATOMIC_RELAXED, __HIP_MEMORY_SCOPE_AGENT); }
__device__ __forceinline__ unsigned xb_add(unsigned* p, unsigned v) { return __hip_atomic_fetch_add(p, v, __ATOMIC_RELAXED, __HIP_MEMORY_SCOPE_AGENT); }
__device__ __forceinline__ unsigned xb_xcc_id() { return (unsigned)__builtin_amdgcn_s_getreg((3 << 11) | 20) & 0xFu; }
#define XB_SPIN(cond, bar) do { unsigned _sp = 0; while (cond) { __builtin_amdgcn_s_sleep(1); \
    if ((++_sp & 255u) == 0u) { if (xb_ld(&(bar)[XB_TMO])) break; if (_sp > XB_SPIN_CAP) { atomicAdd(&(bar)[XB_TMO], 1u); break; } } } } while (0)
struct XcdBarrier { unsigned* bar; unsigned x; volatile PG8_LAS unsigned* st; };
__device__ __forceinline__ void xcd_barrier_complete(unsigned* bar, unsigned x, unsigned G, unsigned& nloc, unsigned& nx) {
    unsigned sum, cnt, mine, sp = 0u;
    for (;;) {
        sum = 0u; cnt = 0u; mine = 0u;
#pragma unroll
        for (unsigned j = 0; j < 16; ++j) { const unsigned c = xb_ld(&bar[XB_XCNT(j)]); sum += c; cnt += (c > 0u) ? 1u : 0u; mine = (j == x) ? c : mine; }
        if (sum == G) break;
        __builtin_amdgcn_s_sleep(1);
        if ((++sp & 255u) == 0u) { if (xb_ld(&bar[XB_TMO])) break; if (sp > XB_SPIN_CAP) { atomicAdd(&bar[XB_TMO], 1u); break; } }
    }
    nloc = mine > 0u ? mine : 1u; nx = cnt > 0u ? cnt : 1u;
}
__device__ __forceinline__ void xcd_barrier(const XcdBarrier& b, int tid, unsigned G) {
    asm volatile("s_waitcnt vmcnt(0)" ::: "memory");
    __syncthreads();
    if (tid == 0) {
        unsigned* bar = b.bar;
        __builtin_amdgcn_s_waitcnt(0);
        unsigned nloc = b.st[0], nx = b.st[1];
        if (nloc == 0u) { xcd_barrier_complete(bar, b.x, G, nloc, nx); b.st[0] = nloc; b.st[1] = nx; }
        const unsigned old = xb_add(&bar[XB_XSUB(b.x)], 1u);
        const unsigned gen = old / nloc;
        if (old + 1u == (gen + 1u) * nloc) {
            __builtin_amdgcn_fence(__ATOMIC_RELEASE, "agent");
            asm volatile("s_waitcnt vmcnt(0)" ::: "memory");
            const unsigned og = xb_add(&bar[XB_TOP], 1u);
            const unsigned tg = og / nx;
            if (og + 1u == (tg + 1u) * nx) xb_add(&bar[XB_TOPGEN], 1u);
            else XB_SPIN(xb_ld(&bar[XB_TOPGEN]) == tg, bar);
            __builtin_amdgcn_fence(__ATOMIC_ACQUIRE, "agent");
            xb_add(&bar[XB_XGEN(b.x)], 1u);
            asm volatile("s_waitcnt vmcnt(0)" ::: "memory");
        } else {
            XB_SPIN(xb_ld(&bar[XB_XGEN(b.x)]) == gen, bar);
            __builtin_amdgcn_fence(__ATOMIC_ACQUIRE, "agent");
            asm volatile("s_waitcnt vmcnt(0)" ::: "memory");
        }
    }
    __syncthreads();
}

__device__ __forceinline__ void load_args(Params& pl, const Params& p) {
#if defined(__HIP_DEVICE_COMPILE__)
    const __attribute__((address_space(4))) unsigned long long* q4 = (const __attribute__((address_space(4))) unsigned long long*)__builtin_amdgcn_kernarg_segment_ptr();
    asm volatile("" : "+s"(q4) :: "memory");
    unsigned long long w[sizeof(Params) / 8];
#pragma unroll
    for (int i = 0; i < (int)(sizeof(Params) / 8); ++i) w[i] = q4[i];
    __builtin_memcpy(&pl, w, sizeof(Params));
#else
    pl = p;
#endif
}
__global__ void __launch_bounds__(512, 2) mk_fwd(Params p) {
    extern __shared__ __attribute__((aligned(16))) unsigned char lds_raw[];
    PG8_LAS unsigned char* lds = (PG8_LAS unsigned char*)lds_raw;
    cg::grid_group grid = cg::this_grid();
    const int ph_lo = p.ph_lo, ph_hi = p.ph_hi;
    const int wave_s = __builtin_amdgcn_readfirstlane((int)threadIdx.x >> 6);
    volatile PG8_LAS unsigned* bst = (volatile PG8_LAS unsigned*)(lds + LDS_BARST);
    if (threadIdx.x < 2) bst[threadIdx.x] = 0u;
    __syncthreads();
    XcdBarrier bar; bar.bar = (unsigned*)p.ws; bar.x = xb_xcc_id(); bar.st = bst;
    if (threadIdx.x == 0) (void)xb_add(&bar.bar[XB_XCNT(bar.x)], 1u);
#define X(k) if (k >= 100 || (ph_lo <= k && k < ph_hi)) { \
        Params pl; load_args(pl, p); \
        unsigned zl = 0u; asm volatile("" : "+v"(zl)); Ctx cx; cx.tid = wave_s * 64 + (int)__builtin_amdgcn_mbcnt_hi(~0u, __builtin_amdgcn_mbcnt_lo(~0u, zl)); cx.bid = (int)blockIdx.x; cx.nblk = (int)gridDim.x; \
        asm volatile("" : "+v"(cx.tid)); asm volatile("" : "+s"(cx.bid), "+s"(cx.nblk)); \
        run_phase_t<k>(lds, cx, pl); \
        if (k >= 100 || k + 1 < ph_hi) { if (k == 0) grid.sync(); else { unsigned z0 = 0u; asm volatile("" : "+v"(z0)); const int t2 = wave_s * 64 + (int)__builtin_amdgcn_mbcnt_hi(~0u, __builtin_amdgcn_mbcnt_lo(~0u, z0)); xcd_barrier(bar, t2, gridDim.x); } } }
    MK_PHASE_LIST(X)
#undef X
}

#ifndef MK_SINGLE
#define MK_SINGLE 1
#endif
extern "C" void kernel_launch(void* const* d_in, const int* in_sizes, int n_in, void* d_out, int out_size, void* d_ws, size_t ws_size, hipStream_t stream) {
    static int grid = 0;
    if (grid == 0) {
        if (n_in != 18 || in_sizes[0] != ML * DM || out_size != ML * DM || ws_size < (size_t)512 * MiB) { fprintf(stderr, "kernel_launch: unexpected shapes (n_in %d, in0 %d, out %d, ws %zu < %zu)\n", n_in, n_in > 0 ? in_sizes[0] : -1, out_size, ws_size, (size_t)WS_END); grid = -1; return; }
        int dev = 0, cus = 0, per_cu = 0;
        if (hipGetDevice(&dev) != hipSuccess || hipDeviceGetAttribute(&cus, hipDeviceAttributeMultiprocessorCount, dev) != hipSuccess) { grid = -1; return; }
        if (hipFuncSetAttribute((const void*)mk_fwd, hipFuncAttributeMaxDynamicSharedMemorySize, LDS_BYTES) != hipSuccess) { fprintf(stderr, "kernel_launch: hipFuncSetAttribute failed\n"); grid = -1; return; }
        if (hipOccupancyMaxActiveBlocksPerMultiprocessor(&per_cu, (const void*)mk_fwd, 512, LDS_BYTES) != hipSuccess || per_cu < 1) { fprintf(stderr, "kernel_launch: occupancy query says %d\n", per_cu); (void)hipGetLastError(); grid = -1; return; }
        grid = cus;
    }
    if (grid < 0) return;
    if (hipMemsetAsync(d_ws, 0, 16384, stream) != hipSuccess) { fprintf(stderr, "kernel_launch: memset failed\n"); return; }
    Params p{};
    const float** pp = (const float**)&p;
    for (int i = 0; i < 18; ++i) pp[i] = (const float*)d_in[i];
    p.out = (float*)d_out; p.ws = (unsigned char*)d_ws;
#if MK_SINGLE
    p.ph_lo = 0; p.ph_hi = NPHASE;
    { void* args[] = {&p}; hipError_t e = hipLaunchCooperativeKernel((const void*)mk_fwd, dim3(grid), dim3(512), args, LDS_BYTES, stream);
      if (e != hipSuccess) fprintf(stderr, "cooperative launch failed: %s\n", hipGetErrorString(e)); }
#else
    for (int ph = 0; ph < NPHASE; ++ph) {
        p.ph_lo = ph; p.ph_hi = ph + 1;
        void* args[] = {&p}; hipError_t e = hipLaunchCooperativeKernel((const void*)mk_fwd, dim3(grid), dim3(512), args, LDS_BYTES, stream);
        if (e != hipSuccess) { fprintf(stderr, "cooperative launch %d failed: %s\n", ph, hipGetErrorString(e)); break; }
    }
#endif
}
#endif
```

```cpp
#ifndef CPU_EMU
#include <hip/hip_runtime.h>
#include <hip/hip_cooperative_groups.h>
#include <cstdio>
#include <cstdint>
namespace cg = cooperative_groups;
#define DEVI __device__ __forceinline__
#define HD __host__ __device__ __forceinline__
#define CFENCE() asm volatile("" ::: "memory")
#define LAUNDER(x) asm volatile("" : "+v"(x))
#define SCHEDB() __builtin_amdgcn_sched_barrier(0)
#else
#define CFENCE() do {} while (0)
#define LAUNDER(x) do {} while (0)
#define SCHEDB() do {} while (0)
#include <cstring>
#include <cmath>
#include <cstdio>
#include <cstdint>
#include <cstddef>
#define DEVI inline
#define HD inline
#endif

#ifndef CPU_EMU
#define LQ __attribute__((address_space(3)))
typedef short bf16x8 __attribute__((ext_vector_type(8)));
typedef float f32x4 __attribute__((ext_vector_type(4)));
typedef short s16x4 __attribute__((ext_vector_type(4)));
typedef long long i64x2 __attribute__((ext_vector_type(2)));
typedef unsigned u32x4 __attribute__((ext_vector_type(4)));
#define MFMA16(a, b, c) __builtin_amdgcn_mfma_f32_16x16x32_bf16(a, b, c, 0, 0, 0)
#define SYNC() __syncthreads()
#define LSYNC() do { asm volatile("s_waitcnt lgkmcnt(0)" ::: "memory"); __builtin_amdgcn_s_barrier(); asm volatile("" ::: "memory"); } while (0)
#define WSYNC() __builtin_amdgcn_wave_barrier()
__device__ __forceinline__ s16x4 trread(LQ const unsigned char* p) { return __builtin_bit_cast(s16x4, __builtin_amdgcn_ds_read_tr16_b64_v4i16((LQ s16x4*)p)); }
__device__ __forceinline__ float shfl_f(float v, int src) { return __shfl(v, src, 64); }
#define RFL(x) __builtin_amdgcn_readfirstlane(x)
#define SPIN_YIELD() __builtin_amdgcn_s_sleep(1)
#define LDSWAIT() asm volatile("s_waitcnt lgkmcnt(0)" ::: "memory")
__device__ __forceinline__ void lds_inc(LQ unsigned* p) { (void)__hip_atomic_fetch_add(p, 1u, __ATOMIC_RELAXED, __HIP_MEMORY_SCOPE_WORKGROUP); }
__device__ __forceinline__ unsigned lds_peek(LQ unsigned* p) { return __hip_atomic_load(p, __ATOMIC_RELAXED, __HIP_MEMORY_SCOPE_WORKGROUP); }
#define FEXP(x) __expf(x)
#else
#define LQ
using simt::bf16x8; using simt::f32x4; using simt::s16x4;
typedef long long i64x2 __attribute__((vector_size(16)));
typedef unsigned u32x4 __attribute__((vector_size(16)));
#define MFMA16(a, b, c) simt::mfma16(a, b, c)
#define SYNC() simt::syncthreads()
#define LSYNC() simt::syncthreads()
#define WSYNC() ((void)simt::shfl(0.f, 0))
inline s16x4 trread(const unsigned char* p) { return simt::tr16_b64(p); }
inline float shfl_f(float v, int src) { return simt::shfl(v, src); }
#define RFL(x) (x)
#define SPIN_YIELD() simt::yield_()
#define LDSWAIT() do {} while (0)
inline void lds_inc(unsigned* p) { *(volatile unsigned*)p += 1u; }
inline unsigned lds_peek(unsigned* p) { return *(volatile unsigned*)p; }
#define FEXP(x) expf(x)
#endif

#ifndef NB
#define NB 8
#endif
#ifndef SEQ
#define SEQ 4096
#endif
#ifndef CTXL
#define CTXL 256
#endif
constexpr int DM = 1024, INW = 8464, GRIDW = 64;
constexpr int ML = NB * SEQ, MC = NB * CTXL, MT = ML + MC;
constexpr int N1 = 3840;
constexpr int NZ = 1536;
constexpr int NMG = 3072;
constexpr float EPSF = 1e-6f;
constexpr int NLAYER = 2;
static_assert(MT % 256 == 0 && ML % 256 == 0, "row tiles");
constexpr int NCH_C = CTXL / 64, NCH_L = SEQ / 64, NSTEP = NCH_C + NCH_L;

typedef unsigned short bf16_t;
struct alignas(16) U4 { unsigned x, y, z, w; };
DEVI void st16l(LQ unsigned char* p, const U4& w) { u32x4 t; t[0] = w.x; t[1] = w.y; t[2] = w.z; t[3] = w.w; *(LQ u32x4*)p = t; }
DEVI U4 ld16l(LQ const unsigned char* p) { const u32x4 t = *(LQ const u32x4*)p; U4 w; w.x = t[0]; w.y = t[1]; w.z = t[2]; w.w = t[3]; return w; }

constexpr size_t MiB = 1u << 20;
constexpr size_t al1(size_t x) { return (x + MiB - 1) & ~(MiB - 1); }
constexpr size_t WS_CTL = 0;
constexpr size_t WS_MOD = 256 * 1024;
constexpr size_t WS_WAB = 512 * 1024;
constexpr size_t WS_TAX = 640 * 1024;
constexpr size_t WS_W1 = 1 * MiB;
constexpr size_t WS_WZ = WS_W1 + al1((size_t)N1 * DM * 2);
constexpr size_t WS_WM = WS_WZ + al1((size_t)NZ * DM * 2);
constexpr size_t WS_WB = WS_WM + al1((size_t)NMG * DM * 2);
constexpr size_t WS_WO = WS_WB + al1((size_t)3 * DM * 512 * 2);
constexpr size_t WS_G = WS_WO + al1((size_t)DM * DM * 2);
constexpr size_t WS_BETA = WS_G + al1((size_t)MT * 8 * 4);
constexpr size_t WS_CTX1 = WS_BETA + al1((size_t)MT * 8 * 4);
constexpr size_t WS_XN = WS_CTX1 + al1((size_t)MC * DM * 4);
constexpr size_t WS_AQKV = WS_XN + al1((size_t)MT * DM * 2);
constexpr size_t WS_CQKV = WS_AQKV + al1((size_t)MT * 1536 * 2);
constexpr size_t WS_BQ = WS_CQKV + al1((size_t)MT * 1536 * 2);
constexpr size_t WS_PA = WS_BQ + al1((size_t)MT * 512 * 2);
constexpr size_t WS_PC = WS_PA + al1((size_t)MT * 512 * 2);
constexpr size_t WS_T = WS_PC + al1((size_t)MT * 512 * 2);
constexpr size_t WS_GC = WS_T + al1((size_t)(MT / 64) * 8 * 8192);
constexpr size_t WS_TRET = WS_GC + al1((size_t)MT * 8 * 4);
constexpr size_t WS_BKV = WS_TRET + al1((size_t)2 * SEQ * 64 * 4);
constexpr size_t WS_HALO = WS_BKV + al1((size_t)MT * 256 * 2);
constexpr size_t WS_END = WS_HALO + al1((size_t)(MT / 64) * 4 * 1536 * 2);
constexpr size_t WS_PB1 = WS_BKV;
static_assert(WS_PB1 + (size_t)2 * ML * 512 * 2 <= (size_t)512 * MiB, "layer-1 backward parks");
static_assert((size_t)2 * MT * 512 * 2 <= (size_t)ML * DM * 4, "layer-0 backward parks in d_out");
static_assert(WS_CQKV + (size_t)MT * NMG * 2 <= WS_T, "gate tile overlay");

static_assert(WS_END <= (size_t)512 * MiB, "workspace");

struct Params {
    const float *x, *c, *ctx, *c_ctx, *w_ada, *b_ada, *norm_w, *w_in, *a_conv_w, *a_log, *a_dt_bias, *a_norm_w, *b_sink, *c_decay, *c_norm_w, *w_branch, *w_out, *final_norm_w;
    float* out; unsigned char* ws;
    int ph_lo, ph_hi;
};

#ifdef CPU_EMU
inline float u2f(unsigned u) { float f; memcpy(&f, &u, 4); return f; }
inline unsigned f2u(float f) { unsigned u; memcpy(&u, &f, 4); return u; }
#else
DEVI float u2f(unsigned u) { return __uint_as_float(u); }
DEVI unsigned f2u(float f) { return __float_as_uint(f); }
#endif
DEVI float bf2f(bf16_t h) { return u2f((unsigned)h << 16); }
DEVI bf16_t f2bf(float f) { unsigned u = f2u(f); return (bf16_t)((u + 0x7fffu + ((u >> 16) & 1u)) >> 16); }
#ifndef CPU_EMU
typedef float f32x2_t __attribute__((ext_vector_type(2))); typedef __bf16 bf16x2_t __attribute__((ext_vector_type(2)));
__device__ __forceinline__ unsigned pk2(float lo, float hi) { const f32x2_t v = {lo, hi}; const bf16x2_t b = __builtin_convertvector(v, bf16x2_t); return __builtin_bit_cast(unsigned, b); }
#else
DEVI unsigned pk2(float lo, float hi) { return (unsigned)f2bf(lo) | ((unsigned)f2bf(hi) << 16); }
#endif
DEVI float lo16(unsigned w) { return u2f(w << 16); }
DEVI float hi16(unsigned w) { return u2f(w & 0xffff0000u); }
DEVI float sigmoidf_(float x) { return 1.0f / (1.0f + expf(-x)); }
DEVI float siluf_(float x) { return x / (1.0f + expf(-x)); }
DEVI float softplusf_(float x) { return x > 20.f ? x : log1pf(expf(x)); }
DEVI void unpack8(const U4& w, float* v) { v[0] = lo16(w.x); v[1] = hi16(w.x); v[2] = lo16(w.y); v[3] = hi16(w.y); v[4] = lo16(w.z); v[5] = hi16(w.z); v[6] = lo16(w.w); v[7] = hi16(w.w); }
DEVI U4 pack8(const float* v) { U4 w; w.x = pk2(v[0], v[1]); w.y = pk2(v[2], v[3]); w.z = pk2(v[4], v[5]); w.w = pk2(v[6], v[7]); return w; }

struct Ctx { int tid, bid, nblk; };
struct TI { long id, n; };
DEVI TI thread_info(const Ctx& c) {
    const int wave = c.tid >> 6, lane = c.tid & 63;
    return TI{((long)wave * c.nblk + c.bid) * 64 + lane, (long)c.nblk * 512};
}

struct Views {
    float *MOD, *WAB, *TAX, *TRET, *GC; bf16_t *W1, *WZ, *WM, *WB, *WO; float *G, *BETA, *CTX1; bf16_t *XN, *AQKV, *CQKV, *BQ, *BKV, *PA, *PC, *Y, *Z, *L, *MRG, *T, *HALO;
    bf16_t *PAb[2], *PCb[2];
};
DEVI Views make_views(unsigned char* ws, float* outbuf = nullptr) {
    Views v;
    v.MOD = (float*)(ws + WS_MOD); v.WAB = (float*)(ws + WS_WAB); v.TAX = (float*)(ws + WS_TAX); v.TRET = (float*)(ws + WS_TRET); v.GC = (float*)(ws + WS_GC); v.W1 = (bf16_t*)(ws + WS_W1); v.WZ = (bf16_t*)(ws + WS_WZ); v.WM = (bf16_t*)(ws + WS_WM); v.WB = (bf16_t*)(ws + WS_WB); v.WO = (bf16_t*)(ws + WS_WO);
    v.G = (float*)(ws + WS_G); v.BETA = (float*)(ws + WS_BETA); v.CTX1 = (float*)(ws + WS_CTX1);
    v.XN = (bf16_t*)(ws + WS_XN); v.AQKV = (bf16_t*)(ws + WS_AQKV); v.CQKV = (bf16_t*)(ws + WS_CQKV); v.BQ = (bf16_t*)(ws + WS_BQ); v.BKV = (bf16_t*)(ws + WS_BKV);
    v.PA = (bf16_t*)(ws + WS_PA); v.PC = (bf16_t*)(ws + WS_PC); v.Y = v.AQKV; v.Z = v.CQKV; v.L = v.CQKV; v.MRG = v.XN; v.T = (bf16_t*)(ws + WS_T); v.HALO = (bf16_t*)(ws + WS_HALO);
    v.PAb[0] = (bf16_t*)outbuf; v.PCb[0] = (bf16_t*)outbuf + (size_t)MT * 512; v.PAb[1] = (bf16_t*)(ws + WS_PB1); v.PCb[1] = (bf16_t*)(ws + WS_PB1) + (size_t)ML * 512;
    return v;
}

HD int map_g1(int n) { return n < 1536 ? n : (n < 2048 ? 2064 + (n - 1536) : (n < 2304 ? 2576 + (n - 2048) : 3344 + (n - 2304))); }
HD int map_z(int n) { return n < 512 ? 1536 + n : (n < 1024 ? 2832 + (n - 512) : 4880 + (n - 1024)); }

DEVI float wave_sum(float v, int lane) {
#pragma unroll
    for (int o = 32; o >= 1; o >>= 1) v += shfl_f(v, lane ^ o);
    return v;
}
template <int W> DEVI float grp_sum(float v, int lane) {
#pragma unroll
    for (int o = W / 2; o >= 1; o >>= 1) v += shfl_f(v, lane ^ o);
    return v;
}
DEVI f32x4 ldg4(const float* p) { f32x4 v; __builtin_memcpy(&v, p, 16); return v; }
DEVI void stg4(float* p, const f32x4& v) { __builtin_memcpy(p, &v, 16); }

DEVI void prep_tile(const Ctx& cx, LQ unsigned char* lds, const float* src, int ld, int srccol0, int k0, bf16_t* dst, int K, int n0) {
    const int wave = RFL(cx.tid >> 6), lane = cx.tid & 63;
    LQ float* tl = (LQ float*)(lds + wave * 16640);
    { const int r = lane >> 4, c4 = (lane & 15) * 4; f32x4 w[16];
#pragma unroll
      for (int i = 0; i < 16; ++i) w[i] = ldg4(src + (size_t)(k0 + r + 4 * i) * ld + srccol0 + c4);
#pragma unroll
      for (int i = 0; i < 16; ++i)
#pragma unroll
          for (int e = 0; e < 4; ++e) tl[(r + 4 * i) * 65 + c4 + e] = w[i][e]; }
    WSYNC();
    { const int kc = (lane & 7) * 8;
#pragma unroll
      for (int i = 0; i < 8; ++i) { const int n = (lane >> 3) + 8 * i; float a[8];
#pragma unroll
          for (int e = 0; e < 8; ++e) a[e] = tl[(kc + e) * 65 + n];
          *(U4*)(dst + (size_t)(n0 + n) * K + k0 + kc) = pack8(a); } }
    WSYNC();
}
DEVI void phase_prep_w(const Ctx& cx, const Params& p, LQ unsigned char* lds, int l) {
    const Views v = make_views(p.ws);
    constexpr int T1 = (N1 / 64) * 16, TZ = (NZ / 64) * 16, TM = (NMG / 64) * 16, TB = 3 * 16 * 8, TO = 16 * 16, TL = T1 + TZ + TM + TB + TO;
    for (int t = RFL(cx.tid >> 6) * cx.nblk + cx.bid; t < TL; t += 8 * cx.nblk) {
        int r = t;
        const float* win = p.w_in + (size_t)l * DM * INW;
        if (r < T1) { const int nt = r / 16, kt = r % 16; prep_tile(cx, lds, win, INW, map_g1(nt * 64), kt * 64, v.W1, DM, nt * 64); continue; } r -= T1;
        if (r < TZ) { const int nt = r / 16, kt = r % 16; prep_tile(cx, lds, win, INW, map_z(nt * 64), kt * 64, v.WZ, DM, nt * 64); continue; } r -= TZ;
        if (r < TM) { const int nt = r / 16, kt = r % 16; prep_tile(cx, lds, win, INW, 5392 + nt * 64, kt * 64, v.WM, DM, nt * 64); continue; } r -= TM;
        if (r < TB) { const int br = r / 128, r2 = r % 128, nt = r2 / 8, kt = r2 % 8; prep_tile(cx, lds, p.w_branch + ((size_t)l * 3 + br) * 512 * DM, DM, nt * 64, kt * 64, v.WB + (size_t)br * DM * 512, 512, nt * 64); continue; } r -= TB;
        { const int nt = r / 16, kt = r % 16; prep_tile(cx, lds, p.w_out + (size_t)l * DM * DM, DM, nt * 64, kt * 64, v.WO, DM, nt * 64); }
    }
}
DEVI void phase_prep(const Ctx& cx, const Params& p, LQ unsigned char* lds) {
    const Views v = make_views(p.ws); const TI ti = thread_info(cx);
    phase_prep_w(cx, p, lds, 0);
    long tb = ti.id; LAUNDER(tb);
    for (long i = tb; i < (long)NLAYER * 16 * DM; i += ti.n) { const int l = (int)(i / (16 * DM)), j = (int)((i / DM) % 16), k = (int)(i % DM); v.WAB[i] = p.w_in[((size_t)l * DM + k) * INW + 2048 + j]; }
    LAUNDER(tb);
    for (long i = tb; i < 64 * 16; i += ti.n) { const int pos = (int)(i >> 4), f = (int)(i & 15); const float ang = (float)pos * powf(10000.0f, -(float)f / 16.0f); v.TAX[i] = cosf(ang); v.TAX[1024 + i] = sinf(ang); }
    LAUNDER(tb);
    for (long i = tb; i < (long)SEQ * 64; i += ti.n) { const int pos = (int)(i >> 6), f = (int)(i & 63); const float ang = (float)pos * powf(10000.0f, -(float)f / 64.0f); v.TRET[i] = cosf(ang); v.TRET[(size_t)SEQ * 64 + i] = sinf(ang); }
    {
        const int wave = RFL(cx.tid >> 6), lane = cx.tid & 63, nl = lane & 7, ks = lane >> 3;
        for (int it = wave * cx.nblk + cx.bid; it < NLAYER * (NB + 1) * 384; it += 8 * cx.nblk) {
            const int l = it / ((NB + 1) * 384), rem = it % ((NB + 1) * 384), b = rem / 384, n = (rem % 384) * 8 + nl;
            const float* cv = (b < NB ? p.c + (size_t)b * DM : p.c_ctx) + ks * 128;
            const float* w = p.w_ada + (size_t)l * DM * 3072 + (size_t)ks * 128 * 3072 + n;
            float acc = 0.f;
#pragma unroll 8
            for (int k = 0; k < 128; ++k) { const float cvk = cv[k]; acc += (cvk / (1.0f + FEXP(-cvk))) * w[(size_t)k * 3072]; }
            acc += shfl_f(acc, lane ^ 8); acc += shfl_f(acc, lane ^ 16); acc += shfl_f(acc, lane ^ 32);
            if (ks == 0) v.MOD[((size_t)l * (NB + 1) + b) * 3072 + n] = acc + p.b_ada[l * 3072 + n];
        }
    }
}

DEVI const float* xrow_in(const Params& p, const Views& v, int layer, int m) {
    if (layer == 0) return m < ML ? p.x + (size_t)m * DM : p.ctx + (size_t)(m - ML) * DM;
    return m < ML ? p.out + (size_t)m * DM : v.CTX1 + (size_t)(m - ML) * DM;
}
DEVI void phase_norm(const Ctx& cx, const Params& p, int layer) {
    const Views v = make_views(p.ws);
    const int wave = RFL(cx.tid >> 6), lane = cx.tid & 63;
    const float* nw = p.norm_w + layer * DM; const float* wab = v.WAB + (size_t)layer * 16 * DM;
    for (int qd = wave * cx.nblk + cx.bid; qd < MT / 4; qd += 8 * cx.nblk) {
        f32x4 xv[4][4];
#pragma unroll
        for (int r = 0; r < 4; ++r) { const int m = 4 * qd + r; const float* xr = xrow_in(p, v, layer, m); float ss = 0.f;
#pragma unroll
            for (int j = 0; j < 4; ++j) { xv[r][j] = ldg4(xr + 256 * j + 4 * lane); ss += xv[r][j][0] * xv[r][j][0] + xv[r][j][1] * xv[r][j][1] + xv[r][j][2] * xv[r][j][2] + xv[r][j][3] * xv[r][j][3]; }
            ss = wave_sum(ss, lane);
            const float rr = 1.0f / sqrtf(ss * (1.0f / DM) + EPSF);
            const int b = m < ML ? m / SEQ : NB; const float* mod = v.MOD + ((size_t)layer * (NB + 1) + b) * 3072;
#pragma unroll
            for (int j = 0; j < 4; ++j) { const int k0 = 256 * j + 4 * lane; const f32x4 n4 = ldg4(nw + k0), s4 = ldg4(mod + 1024 + k0), h4 = ldg4(mod + k0);
#pragma unroll
                for (int e = 0; e < 4; ++e) xv[r][j][e] = xv[r][j][e] * rr * n4[e] * (1.0f + s4[e]) + h4[e];
                unsigned long long w = (unsigned long long)pk2(xv[r][j][0], xv[r][j][1]) | ((unsigned long long)pk2(xv[r][j][2], xv[r][j][3]) << 32);
                *(unsigned long long*)(v.XN + (size_t)m * DM + k0) = w; } }
        float mine[4] = {0.f, 0.f, 0.f, 0.f};
#pragma unroll 2
        for (int jj = 0; jj < 16; ++jj) { float a[4] = {0.f, 0.f, 0.f, 0.f};
#pragma unroll
            for (int j = 0; j < 4; ++j) { const f32x4 w4 = ldg4(wab + jj * DM + 256 * j + 4 * lane);
#pragma unroll
                for (int r = 0; r < 4; ++r) a[r] += xv[r][j][0] * w4[0] + xv[r][j][1] * w4[1] + xv[r][j][2] * w4[2] + xv[r][j][3] * w4[3]; }
#pragma unroll
            for (int r = 0; r < 4; ++r) { a[r] = wave_sum(a[r], lane); if (lane == jj) mine[r] = a[r]; } }
#pragma unroll
        for (int r = 0; r < 4; ++r) { const size_t m = (size_t)4 * qd + r;
            if (lane < 8) v.BETA[m * 8 + lane] = sigmoidf_(mine[r]);
            else if (lane < 16) v.G[m * 8 + lane - 8] = -expf(p.a_log[layer * 8 + lane - 8]) * softplusf_(mine[r] + p.a_dt_bias[layer * 8 + lane - 8]); }
    }
}

template <int PRB = 0> DEVI void phase_conv(const Ctx& cx, const Params& p, int layer) {
    const Views v = make_views(p.ws); const TI ti = thread_info(cx);
    const float* cw = p.a_conv_w + (size_t)layer * 5 * 1536;
    for (long it = ti.id; it < (long)(MT / 64) * 768; it += ti.n) {
        const int gch = (int)(it / 768), c = 2 * (int)(it % 768);
        const bool lat = gch < ML / 64; const int ci = lat ? gch % NCH_L : (gch - ML / 64) % NCH_C; const bool first = ci == 0, last = ci == (lat ? NCH_L : NCH_C) - 1;
        bf16_t* col = v.AQKV + (size_t)gch * 64 * 1536 + c;
        float wa[5], wb[5];
#pragma unroll
        for (int j = 0; j < 5; ++j) { wa[j] = cw[j * 1536 + c]; wb[j] = cw[j * 1536 + c + 1]; }
        unsigned xw[68];
        xw[0] = first ? 0u : *(const unsigned*)(v.HALO + ((size_t)(gch - 1) * 4 + 2) * 1536 + c); xw[1] = first ? 0u : *(const unsigned*)(v.HALO + ((size_t)(gch - 1) * 4 + 3) * 1536 + c);
        xw[66] = last ? 0u : *(const unsigned*)(v.HALO + ((size_t)(gch + 1) * 4 + 0) * 1536 + c); xw[67] = last ? 0u : *(const unsigned*)(v.HALO + ((size_t)(gch + 1) * 4 + 1) * 1536 + c);
#pragma unroll
        for (int t = 0; t < 64; ++t) xw[2 + t] = *(const unsigned*)(col + (size_t)t * 1536);
#pragma unroll
        for (int t = 0; t < 64; ++t) {
            float ya = 0.f, yb = 0.f;
#pragma unroll
            for (int j = 0; j < 5; ++j) { ya += wa[j] * lo16(xw[t + j]); yb += wb[j] * hi16(xw[t + j]); }
            *(unsigned*)(col + (size_t)t * 1536) = pk2(ya / (1.0f + FEXP(-ya)), yb / (1.0f + FEXP(-yb))); }
    }
}

DEVI void phase_prep2(const Ctx& cx, const Params& p, int layer) {
    const Views v = make_views(p.ws);
    const int wave = RFL(cx.tid >> 6), lane = cx.tid & 63;
    for (int m = wave * cx.nblk + cx.bid; m < MT; m += 8 * cx.nblk) {
        {
            bf16_t* ptr = v.AQKV + (size_t)m * 1536 + 16 * lane; float f[16]; unpack8(*(const U4*)ptr, f); unpack8(*(const U4*)(ptr + 8), f + 8);
            float ss = 0.f;
#pragma unroll
            for (int e = 0; e < 16; ++e) ss += f[e] * f[e];
            ss = grp_sum<8>(ss, lane);
            const float sc = (1.0f / sqrtf(ss + EPSF)) * (lane < 32 ? 0.08838834764831845f : 1.0f);
#pragma unroll
            for (int e = 0; e < 16; ++e) f[e] *= sc;
            *(U4*)ptr = pack8(f); *(U4*)(ptr + 8) = pack8(f + 8);
        }
        if (m < ML && lane < 40) {
            const int t = m % SEQ, hh = lane >> 2, pu = lane & 3, half = pu >> 1, ch = pu & 1; const int pos = half == 0 ? t / GRIDW : t % GRIDW;
            bf16_t* ptr = (hh < 8 ? v.BQ + (size_t)m * 512 + hh * 64 : v.BKV + (size_t)m * 256 + (hh - 8) * 64) + half * 32 + ch * 8;
            float x1[8], x2[8]; unpack8(*(const U4*)ptr, x1); unpack8(*(const U4*)(ptr + 16), x2);
            const float* cs = v.TAX + pos * 16 + ch * 8; const float* sn = cs + 1024;
#pragma unroll
            for (int e = 0; e < 8; ++e) { const float a = x1[e], bb = x2[e]; x1[e] = a * cs[e] - bb * sn[e]; x2[e] = a * sn[e] + bb * cs[e]; }
            *(U4*)ptr = pack8(x1); *(U4*)(ptr + 16) = pack8(x2);
        }
        {
            const int which = lane >> 5, h = (lane >> 3) & 3, pu = lane & 7;
            bf16_t* ptr = v.CQKV + (size_t)m * 1536 + which * 512 + h * 128 + pu * 8;
            const float sc = which == 1 ? 0.08838834764831845f : 1.0f;
            if (m < ML) {
                float x1[8], x2[8]; unpack8(*(const U4*)ptr, x1); unpack8(*(const U4*)(ptr + 64), x2);
                const float* cs = v.TRET + (size_t)(m % SEQ) * 64 + pu * 8; const float* sn = cs + (size_t)SEQ * 64;
#pragma unroll
                for (int e = 0; e < 8; ++e) { const float a = x1[e] * sc, bb = x2[e] * sc; x1[e] = a * cs[e] - bb * sn[e]; x2[e] = a * sn[e] + bb * cs[e]; }
                *(U4*)ptr = pack8(x1); *(U4*)(ptr + 64) = pack8(x2);
            } else if (which == 1) {
                float x1[8], x2[8]; unpack8(*(const U4*)ptr, x1); unpack8(*(const U4*)(ptr + 64), x2);
#pragma unroll
                for (int e = 0; e < 8; ++e) { x1[e] *= sc; x2[e] *= sc; }
                *(U4*)ptr = pack8(x1); *(U4*)(ptr + 64) = pack8(x2);
            }
        }
    }
}

DEVI void phase_y(const Ctx& cx, const Params& p, int layer) {
    const Views v = make_views(p.ws, p.out);
    const int wave = RFL(cx.tid >> 6), lane = cx.tid & 63;
    const int mrows = layer == 0 ? MT : ML;
    for (int m = wave * cx.nblk + cx.bid; m < mrows; m += 8 * cx.nblk) {
        const int c0 = 8 * lane; float o[8], z[8], y[8];
        {   unpack8(*(const U4*)(v.PA + (size_t)m * 512 + c0), o); unpack8(*(const U4*)(v.PAb[layer] + (size_t)m * 512 + c0), z);
#pragma unroll
            for (int e = 0; e < 8; ++e) o[e] += z[e];
            unpack8(*(const U4*)(v.Z + (size_t)m * 1536 + c0), z);
            float ss = 0.f;
#pragma unroll
            for (int e = 0; e < 8; ++e) ss += o[e] * o[e];
            ss = grp_sum<16>(ss, lane); const float rs = 1.0f / sqrtf(ss * (1.0f / 128.0f) + EPSF);
            const float* w = p.a_norm_w + layer * 128 + (c0 & 127);
#pragma unroll
            for (int e = 0; e < 8; ++e) y[e] = o[e] * rs * w[e] * (z[e] / (1.0f + FEXP(-z[e])));
            *(U4*)(v.Y + (size_t)m * 512 + c0) = pack8(y); }
        {   unpack8(*(const U4*)(v.BQ + (size_t)m * 512 + c0), o); unpack8(*(const U4*)(v.Z + (size_t)m * 1536 + 512 + c0), z);
#pragma unroll
            for (int e = 0; e < 8; ++e) y[e] = o[e] * (z[e] / (1.0f + FEXP(-z[e])));
            *(U4*)(v.Y + ((size_t)MT + m) * 512 + c0) = pack8(y); }
        {   unpack8(*(const U4*)(v.PC + (size_t)m * 512 + c0), o); unpack8(*(const U4*)(v.PCb[layer] + (size_t)m * 512 + c0), z);
#pragma unroll
            for (int e = 0; e < 8; ++e) o[e] += z[e];
            unpack8(*(const U4*)(v.Z + (size_t)m * 1536 + 1024 + c0), z);
            float sm = 0.f;
#pragma unroll
            for (int e = 0; e < 8; ++e) sm += o[e];
            const float mu = grp_sum<16>(sm, lane) * (1.0f / 128.0f); float qv = 0.f;
#pragma unroll
            for (int e = 0; e < 8; ++e) { o[e] -= mu; qv += o[e] * o[e]; }
            const float rs = 1.0f / sqrtf(grp_sum<16>(qv, lane) * (1.0f / 128.0f) + EPSF);
            const float* w = p.c_norm_w + layer * 512 + c0;
#pragma unroll
            for (int e = 0; e < 8; ++e) y[e] = o[e] * rs * w[e] * (z[e] / (1.0f + FEXP(-z[e])));
            *(U4*)(v.Y + ((size_t)2 * MT + m) * 512 + c0) = pack8(y); }
    }
}

DEVI void phase_final(const Ctx& cx, const Params& p) {
    const int wave = RFL(cx.tid >> 6), lane = cx.tid & 63;
    for (int m = wave * cx.nblk + cx.bid; m < ML; m += 8 * cx.nblk) {
        float* xr = p.out + (size_t)m * DM; f32x4 xv[4]; float ss = 0.f;
#pragma unroll
        for (int j = 0; j < 4; ++j) { xv[j] = ldg4(xr + 256 * j + 4 * lane); ss += xv[j][0] * xv[j][0] + xv[j][1] * xv[j][1] + xv[j][2] * xv[j][2] + xv[j][3] * xv[j][3]; }
        ss = wave_sum(ss, lane);
        const float r = 1.0f / sqrtf(ss * (1.0f / DM) + EPSF);
#pragma unroll
        for (int j = 0; j < 4; ++j) { const f32x4 w4 = ldg4(p.final_norm_w + 256 * j + 4 * lane); f32x4 o4;
#pragma unroll
            for (int e = 0; e < 4; ++e) o4[e] = xv[j][e] * r * w4[e];
            stg4(xr + 256 * j + 4 * lane, o4); }
    }
}

DEVI bf16x8 ld8g(const bf16_t* p) { bf16x8 v; __builtin_memcpy(&v, p, 16); return v; }
DEVI bf16x8 ld8l(LQ const unsigned char* p) { return *(LQ const bf16x8*)p; }
DEVI bf16x8 ld44l(LQ const unsigned char* p) { i64x2 t; t[0] = *(LQ const long long*)p; t[1] = *(LQ const long long*)(p + 32); return __builtin_bit_cast(bf16x8, t); }
DEVI f32x4 ld4fl(LQ const unsigned char* p) { return *(LQ const f32x4*)p; }
DEVI bf16x8 packb(const f32x4& x0, const f32x4& x1) { u32x4 t; t[0] = pk2(x0[0], x0[1]); t[1] = pk2(x0[2], x0[3]); t[2] = pk2(x1[0], x1[1]); t[3] = pk2(x1[2], x1[3]); return __builtin_bit_cast(bf16x8, t); }
DEVI float wave_incl_scan(float v, int lane) {
#pragma unroll
    for (int d = 1; d < 64; d <<= 1) { const float t = shfl_f(v, lane - d < 0 ? 0 : lane - d); if (lane >= d) v += t; }
    return v;
}
DEVI int chain_row0(int b, int dir, int n) {
    if (n < NCH_C) { const int c = dir ? NCH_C - 1 - n : n; return ML + b * CTXL + 64 * c; }
    int c = n - NCH_C; if (dir) c = NCH_L - 1 - c; return b * SEQ + 64 * c;
}

constexpr int TM_WAVE_BYTES = 16384 + 512;
DEVI void phase_tmat(const Ctx& cx, const Params& p, LQ unsigned char* lds, int layer) {
    const Views v = make_views(p.ws);
    const int wave = RFL(cx.tid >> 6), lane = cx.tid & 63, q = lane >> 4, c = lane & 15;
    LQ unsigned char* wl = lds + wave * TM_WAVE_BYTES;
    LQ float* Am = (LQ float*)wl; LQ float* tab = (LQ float*)(wl + 16384);
    const int nitem = (MT / 64) * 8;
    for (int item = wave * cx.nblk + cx.bid; item < nitem; item += 8 * cx.nblk) {
        const int gchunk = item >> 3, h = (item >> 1) & 3, dir = item & 1; const size_t m0 = (size_t)gchunk * 64;
        { const size_t m = m0 + (dir ? 63 - lane : lane); const float g = v.G[m * 8 + dir * 4 + h], be = v.BETA[m * 8 + dir * 4 + h];
          const float gc = wave_incl_scan(g, lane); tab[lane] = gc; tab[64 + lane] = be; v.GC[m * 8 + dir * 4 + h] = gc; }
        bf16x8 fr[4][4];
#pragma unroll
        for (int t = 0; t < 4; ++t) { const int row = 16 * t + c; const size_t m = m0 + (dir ? 63 - row : row);
#pragma unroll
            for (int s2 = 0; s2 < 4; ++s2) fr[t][s2] = ld8g(v.AQKV + m * 1536 + 512 + h * 128 + 32 * s2 + 8 * q); }
        WSYNC();
#pragma unroll
        for (int it = 0; it < 4; ++it)
#pragma unroll
            for (int jt = 0; jt <= it; ++jt) {
                f32x4 acc = {0.f, 0.f, 0.f, 0.f};
#pragma unroll
                for (int s2 = 0; s2 < 4; ++s2) acc = MFMA16(fr[it][s2], fr[jt][s2], acc);
                const int col = 16 * jt + c; const float gcol = tab[col];
#pragma unroll
                for (int r = 0; r < 4; ++r) { const int row = 16 * it + 4 * q + r;
                    Am[row * 64 + col] = row > col ? tab[64 + row] * acc[r] * FEXP(tab[row] - gcol) : 0.f; }
            }
        WSYNC();
        float x[64];
#pragma unroll
        for (int i = 0; i < 64; ++i) {
            float sacc = (i == lane) ? 1.f : 0.f;
#pragma unroll
            for (int j4 = 0; j4 < (i + 3) / 4; ++j4) { const f32x4 a4 = ld4fl((LQ const unsigned char*)(Am + i * 64 + j4 * 4));
#pragma unroll
                for (int e = 0; e < 4; ++e) if (4 * j4 + e < i) sacc -= a4[e] * x[4 * j4 + e]; }
            x[i] = sacc;
        }
        WSYNC();
        LQ bf16_t* Ti = (LQ bf16_t*)wl;
#pragma unroll
        for (int i = 0; i < 64; ++i) Ti[i * 64 + lane] = f2bf(x[i]);
        WSYNC();
        bf16_t* Tg = v.T + (size_t)item * 4096;
#pragma unroll
        for (int j = 0; j < 8; ++j) { const int piece = lane + 64 * j; *(U4*)(Tg + piece * 8) = ld16l(wl + piece * 16); }
        WSYNC();
    }
}

constexpr int SC_KB = 0, SC_QB = 17408, SC_TB = 34816, SC_PB = 44032, SC_VB = 53248, SC_SC = 62464, SC_BUF = 63744;
template <int MIX, int PF = 0> DEVI void scan_chain(const Ctx& cx, const Params& p, const Views& v, LQ unsigned char* lds, int layer, const int DIR, int b, int h, int half) {
    const int tid = cx.tid, wave = RFL(tid >> 6), lane = tid & 63, q = lane >> 4, c = lane & 15;
    const bool helper = wave >= 4; const int ht = tid - 256;
    const bf16_t* QKV = MIX == 0 ? v.AQKV : v.CQKV; bf16_t* PARK = DIR == 0 ? (MIX == 0 ? v.PA : v.PC) : (MIX == 0 ? v.PAb[layer] : v.PCb[layer]);
    const int rx = DIR ? 63 : 0;
    const float lgam = MIX == 1 ? -softplusf_(-p.c_decay[layer * 8 + DIR * 4 + h]) : 0.f;
    U4 kreg[4], qreg[4], treg[2], vreg[2]; float breg = 1.f, greg = 0.f, bsc = 1.f;
    auto hload = [&](int n) {
        const size_t m0 = (size_t)chain_row0(b, DIR, n);
        const bf16_t* base = QKV + m0 * 1536 + h * 128;
#pragma unroll
        for (int j = 0; j < 4; ++j) { const int piece = ht + 256 * j, row = piece >> 4, c16 = piece & 15; const int off = (row ^ rx) * 1536 + c16 * 8;
            kreg[j] = *(const U4*)(base + 512 + off); qreg[j] = *(const U4*)(base + off); }
        if (MIX == 0) { const bf16_t* Tg = v.T + ((size_t)(m0 / 64) * 8 + h * 2 + DIR) * 4096;
#pragma unroll
            for (int j = 0; j < 2; ++j) treg[j] = *(const U4*)(Tg + (ht + 256 * j) * 8); }
#pragma unroll
        for (int j = 0; j < 2; ++j) { const int piece = ht + 256 * j, row = piece >> 3, c8 = piece & 7; vreg[j] = *(const U4*)(base + 1024 + 64 * half + (row ^ rx) * 1536 + c8 * 8); }
        if (MIX == 0 && wave == 4) { const size_t m = m0 + (ht ^ rx); greg = v.GC[m * 8 + DIR * 4 + h]; breg = v.BETA[m * 8 + DIR * 4 + h]; bsc = v.GC[(m0 + (63 ^ rx)) * 8 + DIR * 4 + h]; }
    };
    auto hwrite = [&](int bufi) {
        LQ unsigned char* B = lds + bufi * SC_BUF;
#pragma unroll
        for (int j = 0; j < 4; ++j) { const int piece = ht + 256 * j, row = piece >> 4, c16 = piece & 15;
            st16l(B + SC_KB + row * 272 + c16 * 16, kreg[j]); st16l(B + SC_QB + row * 272 + c16 * 16, qreg[j]); }
#pragma unroll
        for (int j = 0; j < 2; ++j) { const int piece = ht + 256 * j, row = piece >> 3, c8 = piece & 7;
            if (MIX == 0) st16l(B + SC_TB + row * 144 + c8 * 16, treg[j]);
            st16l(B + SC_VB + row * 144 + c8 * 16, vreg[j]); }
        if (wave == 4) { LQ float* sc = (LQ float*)(B + SC_SC);
            float Gc, g63;
            if (MIX == 0) { Gc = greg; g63 = bsc; } else { Gc = (float)(ht + 1) * lgam; g63 = 64.f * lgam; }
            const float Gam = FEXP(Gc);
            sc[ht] = -breg * Gam; sc[64 + ht] = Gam; sc[128 + ht] = FEXP(g63 - Gc); sc[192 + ht] = Gc; sc[256 + ht] = breg; }
    };
    auto ptile = [&](LQ unsigned char* B, int it, int jt, bool zr) {
        LQ const float* sc = (LQ const float*)(B + SC_SC);
        f32x4 acc = {0.f, 0.f, 0.f, 0.f};
#pragma unroll
        for (int s2 = 0; s2 < 4; ++s2) acc = MFMA16(ld8l(B + SC_QB + (16 * it + c) * 272 + (32 * s2 + 8 * q) * 2), ld8l(B + SC_KB + (16 * jt + c) * 272 + (32 * s2 + 8 * q) * 2), acc);
        const int col = 16 * jt + c; const float gcol = sc[192 + col];
        const f32x4 grow = ld4fl(B + SC_SC + (192 + 16 * it + 4 * q) * 4);
#pragma unroll
        for (int r = 0; r < 4; ++r) { const int row = 16 * it + 4 * q + r;
            *(LQ bf16_t*)(B + SC_PB + row * 144 + col * 2) = f2bf(row >= col ? acc[r] * FEXP(grow[r] - gcol) : 0.f);
            if (zr) *(LQ bf16_t*)(B + SC_PB + row * 144 + (col + 16) * 2) = 0; }
    };
    auto hscore = [&](int bufi) {
        LQ unsigned char* B = lds + bufi * SC_BUF;
        if (wave == 4) { ptile(B, 0, 0, true); ptile(B, 1, 1, false); }
        else if (wave == 5) { ptile(B, 1, 0, false); ptile(B, 2, 2, true); ptile(B, 3, 3, false); }
        else if (wave == 6) { ptile(B, 2, 0, false); ptile(B, 2, 1, false); ptile(B, 3, 2, false); }
        else { ptile(B, 3, 0, false); ptile(B, 3, 1, false); }
    };
    LQ unsigned* hcnt = (LQ unsigned*)(lds + 2 * SC_BUF);
    if (tid == 256) *hcnt = 0u;
    LSYNC();
    if (helper) {
        unsigned htarget = 0u;
        auto hmeet = [&]() { LDSWAIT(); WSYNC(); htarget += 4u; if (lane == 0) lds_inc(hcnt); while (lds_peek(hcnt) < htarget) SPIN_YIELD(); CFENCE(); };
        hload(0); hwrite(0); hmeet(); hscore(0); if (NSTEP > 1) hload(1);
        LSYNC();
        for (int n = 0; n < NSTEP; ++n) {
            if (n + 1 < NSTEP) { hwrite((n + 1) & 1); hmeet(); hscore((n + 1) & 1); }
            if (n + 2 < NSTEP && !(PF & 1)) hload(n + 2);
            LSYNC();
        }
    } else {
        f32x4 St[8];
#pragma unroll
        for (int t = 0; t < 8; ++t) St[t] = (f32x4){0.f, 0.f, 0.f, 0.f};
        const int arow = 8 * (c >> 2) + (c & 3);
        LSYNC();
        for (int n = 0; n < NSTEP; ++n) {
            LQ unsigned char* B = lds + (n & 1) * SC_BUF; LQ const float* sc = (LQ const float*)(B + SC_SC);
            f32x4 o[4], vn[4];
            if (PF & 8) { LSYNC(); continue; }
            {
                bf16x8 Sb[4];
#pragma unroll
                for (int s2 = 0; s2 < 4; ++s2) Sb[s2] = packb(St[2 * s2], St[2 * s2 + 1]);
                f32x4 R[4];
                bf16x8 fq[2][4], fk[2][4];
#pragma unroll
                for (int s2 = 0; s2 < 4; ++s2) { const int off = arow * 272 + (32 * s2 + 8 * q) * 2; fq[0][s2] = ld8l(B + SC_QB + off); if (MIX == 0) fk[0][s2] = ld8l(B + SC_KB + off); }
#pragma unroll
                for (int i = 0; i < 4; ++i) {
                    if (i < 3) {
#pragma unroll
                        for (int s2 = 0; s2 < 4; ++s2) { const int off = (32 * ((i + 1) >> 1) + 4 * ((i + 1) & 1) + arow) * 272 + (32 * s2 + 8 * q) * 2; fq[(i + 1) & 1][s2] = ld8l(B + SC_QB + off); if (MIX == 0) fk[(i + 1) & 1][s2] = ld8l(B + SC_KB + off); } }
                    const int r0 = 32 * (i >> 1) + 8 * q + 4 * (i & 1);
                    const f32x4 Gm = ld4fl(B + SC_SC + (64 + r0) * 4);
                    const s16x4 vraw = trread(B + SC_VB + (r0 + (c >> 2)) * 144 + (16 * wave + 4 * (c & 3)) * 2);
                    f32x4 Vt; Vt[0] = bf2f((bf16_t)vraw[0]); Vt[1] = bf2f((bf16_t)vraw[1]); Vt[2] = bf2f((bf16_t)vraw[2]); Vt[3] = bf2f((bf16_t)vraw[3]);
                    f32x4 a4 = {0.f, 0.f, 0.f, 0.f}; if (MIX == 0) { a4 = ld4fl(B + SC_SC + r0 * 4); Vt = Vt * ld4fl(B + SC_SC + (256 + r0) * 4); }
                    f32x4 aK = {0.f, 0.f, 0.f, 0.f}, aQ = {0.f, 0.f, 0.f, 0.f};
                    SCHEDB();
#pragma unroll
                    for (int s2 = 0; s2 < 4; ++s2) { aQ = MFMA16(fq[i & 1][s2], Sb[s2], aQ); if (MIX == 0) aK = MFMA16(fk[i & 1][s2], Sb[s2], aK); }
                    SCHEDB();
                    o[i] = Gm * aQ;
                    if (MIX == 0) R[i] = Vt + a4 * aK; else vn[i] = Vt;
                }
                if (MIX == 0) {
                    bf16x8 Rb[2]; Rb[0] = packb(R[0], R[1]); Rb[1] = packb(R[2], R[3]);
                    bf16x8 tf[6];
                    tf[0] = ld8l(B + SC_TB + arow * 144 + (8 * q) * 2); tf[1] = ld8l(B + SC_TB + (4 + arow) * 144 + (8 * q) * 2);
                    tf[2] = ld8l(B + SC_TB + (32 + arow) * 144 + (8 * q) * 2); tf[3] = ld8l(B + SC_TB + (32 + arow) * 144 + (32 + 8 * q) * 2);
                    tf[4] = ld8l(B + SC_TB + (36 + arow) * 144 + (8 * q) * 2); tf[5] = ld8l(B + SC_TB + (36 + arow) * 144 + (32 + 8 * q) * 2);
                    const f32x4 z4 = {0.f, 0.f, 0.f, 0.f};
                    SCHEDB();
                    vn[0] = MFMA16(tf[0], Rb[0], z4); vn[1] = MFMA16(tf[1], Rb[0], z4);
                    vn[2] = MFMA16(tf[3], Rb[1], MFMA16(tf[2], Rb[0], z4)); vn[3] = MFMA16(tf[5], Rb[1], MFMA16(tf[4], Rb[0], z4));
                }
            }
            {
                bf16x8 vnb[2], veb[2];
                vnb[0] = packb(vn[0], vn[1]); vnb[1] = packb(vn[2], vn[3]);
                { f32x4 ve[4];
#pragma unroll
                  for (int i = 0; i < 4; ++i) ve[i] = ld4fl(B + SC_SC + (128 + 32 * (i >> 1) + 8 * q + 4 * (i & 1)) * 4) * vn[i];
                  veb[0] = packb(ve[0], ve[1]); veb[1] = packb(ve[2], ve[3]); }
                { bf16x8 pf[6];
                  pf[0] = ld8l(B + SC_PB + arow * 144 + (8 * q) * 2); pf[1] = ld8l(B + SC_PB + (4 + arow) * 144 + (8 * q) * 2);
                  pf[2] = ld8l(B + SC_PB + (32 + arow) * 144 + (8 * q) * 2); pf[3] = ld8l(B + SC_PB + (32 + arow) * 144 + (32 + 8 * q) * 2);
                  pf[4] = ld8l(B + SC_PB + (36 + arow) * 144 + (8 * q) * 2); pf[5] = ld8l(B + SC_PB + (36 + arow) * 144 + (32 + 8 * q) * 2);
                  SCHEDB();
                  o[0] = MFMA16(pf[0], vnb[0], o[0]); o[1] = MFMA16(pf[1], vnb[0], o[1]);
                  o[2] = MFMA16(pf[3], vnb[1], MFMA16(pf[2], vnb[0], o[2])); o[3] = MFMA16(pf[5], vnb[1], MFMA16(pf[4], vnb[0], o[3])); }
                const float g63 = sc[64 + 63];
#pragma unroll
                for (int tp = 0; tp < 8; tp += 4) {
                    s16x4 lo[4][2], hi[4][2];
#pragma unroll
                    for (int t = 0; t < 4; ++t)
#pragma unroll
                        for (int s2 = 0; s2 < 2; ++s2) { const int colb = (32 * ((tp + t) >> 1) + 8 * (c & 3) + 4 * ((tp + t) & 1)) * 2;
                            lo[t][s2] = trread(B + SC_KB + (32 * s2 + 8 * q + (c >> 2)) * 272 + colb);
                            hi[t][s2] = trread(B + SC_KB + (32 * s2 + 8 * q + 4 + (c >> 2)) * 272 + colb); }
                    SCHEDB();
#pragma unroll
                    for (int t = 0; t < 4; ++t) { f32x4 acc = St[tp + t] * g63;
#pragma unroll
                        for (int s2 = 0; s2 < 2; ++s2) { bf16x8 kt; kt[0] = lo[t][s2][0]; kt[1] = lo[t][s2][1]; kt[2] = lo[t][s2][2]; kt[3] = lo[t][s2][3]; kt[4] = hi[t][s2][0]; kt[5] = hi[t][s2][1]; kt[6] = hi[t][s2][2]; kt[7] = hi[t][s2][3];
                            acc = MFMA16(kt, veb[s2], acc); }
                        St[tp + t] = acc; }
                }
                const size_t m0 = (size_t)chain_row0(b, DIR, n);
                if (!(DIR == 1 && layer == NLAYER - 1 && n < NCH_C))
#pragma unroll
                for (int i = 0; i < 4; ++i)
#pragma unroll
                    for (int r = 0; r < 4; ++r) { const int row = 32 * (i >> 1) + 8 * q + 4 * (i & 1) + r; const size_t m = m0 + (row ^ rx);
                        bf16_t* pp = PARK + m * 512 + h * 128 + 64 * half + 16 * wave + c;
                        if (!(PF & 2)) *pp = f2bf(o[i][r]); else if (o[i][r] == 12345.678f) *pp = 0; }
            }
            LSYNC();
        }
    }
}
template <int PF = 0> DEVI void phase_scan(const Ctx& cx, const Params& p, LQ unsigned char* lds, int layer) {
    const Views v = make_views(p.ws, p.out);
    const int nitem = 2 * NB * 4 * 2;
    for (int item = cx.bid; item < nitem; item += cx.nblk) scan_chain<0, PF>(cx, p, v, lds, layer, item / (8 * NB), (item >> 3) % NB, (item >> 1) & 3, item & 1);
    CFENCE();
    for (int item = (cx.bid + cx.nblk - (nitem % cx.nblk)) % cx.nblk; item < nitem; item += cx.nblk) scan_chain<1, PF>(cx, p, v, lds, layer, item / (8 * NB), (item >> 3) % NB, (item >> 1) & 3, item & 1);
}

constexpr int AT_V = 9216, AT_BUF = 18432;
template <bool CTXQ, int PRB = 0> DEVI void attn_unit(const Ctx& cx, const Params& p, const Views& v, LQ unsigned char* lds, int layer, int b, int hkv, int blk) {
    const int tid = cx.tid, wave = RFL(tid >> 6), lane = tid & 63, q = lane >> 4, c = lane & 15;
    const int g = wave >> 1, rh = wave & 1, hq = 4 * hkv + g;
    const size_t mq0 = (CTXQ ? (size_t)ML + (size_t)b * CTXL : (size_t)b * SEQ) + 64 * blk + 32 * rh;
    bf16x8 qf[2][2];
#pragma unroll
    for (int i = 0; i < 2; ++i)
#pragma unroll
        for (int s2 = 0; s2 < 2; ++s2) qf[i][s2] = ld8g(v.BQ + (mq0 + 16 * i + c) * 512 + hq * 64 + 32 * s2 + 8 * q);
    const int wlo = CTXQ ? 0 : (2 - blk > 0 ? 2 - blk : 0), whi = CTXQ ? 0 : (NCH_L + 2 - blk < 5 ? NCH_L + 2 - blk : 5);
    const int ntile = NCH_C + (whi - wlo);
    const int lrow = tid >> 3, lpc = tid & 7;
    auto tile_row0 = [&](int j, int& tstart) -> size_t { if (j < NCH_C) { tstart = -100000; return (size_t)ML + (size_t)b * CTXL + 64 * j; } tstart = 64 * (blk - 2 + wlo + (j - NCH_C)); return (size_t)b * SEQ + tstart; };
    U4 kr0, vr0, kr1, vr1;
    auto tload = [&](int j, U4& kr, U4& vr) { int ts; const size_t r0 = tile_row0(j, ts); const bf16_t* src = v.BKV + (r0 + lrow) * 256 + hkv * 64 + lpc * 8; kr = *(const U4*)src; vr = *(const U4*)(src + 128); };
    auto twrite = [&](int bufi, const U4& kr, const U4& vr) { LQ unsigned char* B = lds + bufi * AT_BUF; st16l(B + lrow * 144 + lpc * 16, kr); st16l(B + AT_V + lrow * 144 + lpc * 16, vr); };
    float mrun[2], lrun[2]; f32x4 ot[4][2];
    mrun[0] = mrun[1] = p.b_sink[layer * 8 + hq]; lrun[0] = lrun[1] = 1.0f;
#pragma unroll
    for (int dt = 0; dt < 4; ++dt) { ot[dt][0] = (f32x4){0.f, 0.f, 0.f, 0.f}; ot[dt][1] = (f32x4){0.f, 0.f, 0.f, 0.f}; }
    SYNC();
    tload(0, kr0, vr0); twrite(0, kr0, vr0); if (ntile > 1) tload(1, kr1, vr1);
    SYNC();
    auto tile_step = [&](int j, U4& kl, U4& vl, const U4& kw, const U4& vw) {
        LQ unsigned char* B = lds + (j & 1) * AT_BUF;
        if (j + 2 < ntile) tload(j + 2, kl, vl);
        int tstart; (void)tile_row0(j, tstart);
        f32x4 st[4][2];
#pragma unroll
        for (int kt = 0; kt < 4; ++kt) {
            const bf16x8 k0 = ld8l(B + (16 * kt + c) * 144 + (8 * q) * 2), k1 = ld8l(B + (16 * kt + c) * 144 + (32 + 8 * q) * 2);
#pragma unroll
            for (int i = 0; i < 2; ++i) { f32x4 acc = {0.f, 0.f, 0.f, 0.f}; acc = MFMA16(k0, qf[i][0], acc); acc = MFMA16(k1, qf[i][1], acc); st[kt][i] = acc * 0.125f; }
        }
        if (j >= NCH_C) {
#pragma unroll
            for (int i = 0; i < 2; ++i) { const int tq = 64 * blk + 32 * rh + 16 * i + c;
#pragma unroll
                for (int kt = 0; kt < 4; ++kt)
#pragma unroll
                    for (int r = 0; r < 4; ++r) { const int d = tstart + 16 * kt + 4 * q + r - tq; if (d > 128 || d < -128) st[kt][i][r] = -INFINITY; } }
        }
        bf16x8 pb[2][2];
#pragma unroll
        for (int i = 0; i < 2; ++i) {
            float mx = st[0][i][0];
#pragma unroll
            for (int kt = 0; kt < 4; ++kt)
#pragma unroll
                for (int r = 0; r < 4; ++r) mx = fmaxf(mx, st[kt][i][r]);
            mx = fmaxf(mx, shfl_f(mx, lane ^ 16)); mx = fmaxf(mx, shfl_f(mx, lane ^ 32));
            const float mnew = fmaxf(mrun[i], mx), alpha = FEXP(mrun[i] - mnew);
            float ls = 0.f;
#pragma unroll
            for (int kt = 0; kt < 4; ++kt)
#pragma unroll
                for (int r = 0; r < 4; ++r) { const float e = FEXP(st[kt][i][r] - mnew); st[kt][i][r] = e; ls += e; }
            ls += shfl_f(ls, lane ^ 16); ls += shfl_f(ls, lane ^ 32);
            lrun[i] = lrun[i] * alpha + ls; mrun[i] = mnew;
#pragma unroll
            for (int dt = 0; dt < 4; ++dt) ot[dt][i] = ot[dt][i] * alpha;
            pb[i][0] = packb(st[0][i], st[1][i]); pb[i][1] = packb(st[2][i], st[3][i]);
        }
#pragma unroll
        for (int dt = 0; dt < 4; ++dt)
#pragma unroll
            for (int ks = 0; ks < 2; ++ks) {
                const s16x4 lo = trread(B + AT_V + (32 * ks + 4 * q + (c >> 2)) * 144 + (16 * dt + 4 * (c & 3)) * 2);
                const s16x4 hi = trread(B + AT_V + (32 * ks + 16 + 4 * q + (c >> 2)) * 144 + (16 * dt + 4 * (c & 3)) * 2);
                bf16x8 vt; vt[0] = lo[0]; vt[1] = lo[1]; vt[2] = lo[2]; vt[3] = lo[3]; vt[4] = hi[0]; vt[5] = hi[1]; vt[6] = hi[2]; vt[7] = hi[3];
                ot[dt][0] = MFMA16(vt, pb[0][ks], ot[dt][0]); ot[dt][1] = MFMA16(vt, pb[1][ks], ot[dt][1]);
            }
        if (j + 1 < ntile) twrite((j + 1) & 1, kw, vw);
        SYNC();
    };
    for (int j = 0; j < ntile; j += 2) { tile_step(j, kr0, vr0, kr1, vr1); if (j + 1 < ntile) tile_step(j + 1, kr1, vr1, kr0, vr0); }
#pragma unroll
    for (int i = 0; i < 2; ++i) { const float il = 1.0f / lrun[i];
#pragma unroll
        for (int dt = 0; dt < 4; ++dt) { const f32x4 o4 = ot[dt][i] * il;
            unsigned long long w = (unsigned long long)pk2(o4[0], o4[1]) | ((unsigned long long)pk2(o4[2], o4[3]) << 32);
            *(unsigned long long*)((PRB ? v.PA : v.BQ) + (mq0 + 16 * i + c) * 512 + hq * 64 + 16 * dt + 4 * q) = w; } }
}
template <int PRB = 0> DEVI void phase_attn(const Ctx& cx, const Params& p, LQ unsigned char* lds, int layer) {
    const Views v = make_views(p.ws);
    const int nlat = NB * 2 * NCH_L, nctx = layer == 0 ? NB * 2 * NCH_C : 0;
    for (int item = cx.bid; item < nlat + nctx; item += cx.nblk) {
        if (item < nlat) attn_unit<false, PRB>(cx, p, v, lds, layer, item / (2 * NCH_L), (item / NCH_L) & 1, item % NCH_L);
        else { const int it = item - nlat; attn_unit<true, PRB>(cx, p, v, lds, layer, it / (2 * NCH_C), (it / NCH_C) & 1, it % NCH_C); }
    }
}

struct StG1 { bf16_t *AQKV, *BQ, *BKV, *CQKV, *HALO;
    DEVI void st8(int row, int col, const float* a) const {
        bf16_t* dst = col < 1536 ? AQKV + (size_t)row * 1536 + col : (col < 2048 ? BQ + (size_t)row * 512 + (col - 1536) : (col < 2304 ? BKV + (size_t)row * 256 + (col - 2048) : CQKV + (size_t)row * 1536 + (col - 2304)));
        const U4 w = pack8(a); *(U4*)dst = w;
        const int r64 = row & 63;
        if (col < 1536 && (r64 < 2 || r64 >= 62)) *(U4*)(HALO + ((size_t)(row >> 6) * 4 + (r64 < 2 ? r64 : r64 - 60)) * 1536 + col) = w; } };
struct StPlain { bf16_t* O; int ld;
    DEVI void st8(int row, int col, const float* a) const { *(U4*)(O + (size_t)row * ld + col) = pack8(a); } };
struct StMerge { const bf16_t* L; bf16_t* MRG; int br;
    DEVI void st8(int row, int col, const float* a) const {
        float lg[8], o[8]; unpack8(*(const U4*)(L + (size_t)row * NMG + br * 1024 + col), lg);
        if (br) unpack8(*(const U4*)(MRG + (size_t)row * DM + col), o); else { for (int e = 0; e < 8; ++e) o[e] = 0.f; }
        for (int e = 0; e < 8; ++e) o[e] += sigmoidf_(lg[e]) * a[e];
        *(U4*)(MRG + (size_t)row * DM + col) = pack8(o); }
    static constexpr bool HAS_LD = true;
    DEVI void ld8(int row, int col, U4& x0, U4& x1) const { x0 = *(const U4*)(L + (size_t)row * NMG + br * 1024 + col); if (br) x1 = *(const U4*)(MRG + (size_t)row * DM + col); else x1 = U4{0u, 0u, 0u, 0u}; }
    DEVI void fin8(int row, int col, const float* a, const U4& x0, const U4& x1) const {
        float lg[8], o[8]; unpack8(x0, lg); unpack8(x1, o);
        for (int e = 0; e < 8; ++e) o[e] += a[e] / (1.0f + FEXP(-lg[e]));
        *(U4*)(MRG + (size_t)row * DM + col) = pack8(o); } };
struct StMerge3 { const bf16_t* L; bf16_t* MRG;
    DEVI void st8(int row, int col, const float* a) const { const int br = col >> 10; StMerge{L, MRG, br}.st8(row - br * MT, col & 1023, a); }
    DEVI void ld8(int row, int col, U4& x0, U4& x1) const { const int br = col >> 10, r = row - br * MT, c = col & 1023; x0 = *(const U4*)(L + (size_t)r * NMG + br * 1024 + c); if (br) x1 = *(const U4*)(MRG + (size_t)r * DM + c); else x1 = U4{0u, 0u, 0u, 0u}; }
    DEVI void fin8(int row, int col, const float* a, const U4& x0, const U4& x1) const { const int br = col >> 10; StMerge{L, MRG, br}.fin8(row - br * MT, col & 1023, a, x0, x1); } };
struct StResid { const float *xlat, *xctx; float *olat, *octx; const float* mod;
    DEVI void st4(int row, int col, const float* a) const {
        const float* xi = row < ML ? xlat + (size_t)row * DM + col : xctx + (size_t)(row - ML) * DM + col;
        float* xo = row < ML ? olat + (size_t)row * DM + col : octx + (size_t)(row - ML) * DM + col;
        const int b = row < ML ? row / SEQ : NB; const float* g = mod + (size_t)b * 3072 + 2048 + col;
        for (int e = 0; e < 4; ++e) xo[e] = xi[e] + g[e] * a[e]; }
    DEVI f32x4 ldx(int row, int col) const { return ldg4(row < ML ? xlat + (size_t)row * DM + col : xctx + (size_t)(row - ML) * DM + col); }
    DEVI f32x4 ldgate(int row, int col) const { const int b = row < ML ? row / SEQ : NB; return ldg4(mod + (size_t)b * 3072 + 2048 + col); }
    DEVI void fin4(int row, int col, const f32x4& acc, const f32x4& x, const f32x4& g) const { stg4(row < ML ? olat + (size_t)row * DM + col : octx + (size_t)(row - ML) * DM + col, x + g * acc); } };

#ifndef CPU_EMU
namespace pg8 {
#define PG8_LAS __attribute__((address_space(3)))
typedef short bf16x8 __attribute__((ext_vector_type(8)));
typedef float f32x4 __attribute__((ext_vector_type(4)));
constexpr int BM = 256, BK = 64, HALF = 128, HTB = HALF * BK * 2, STAGE_BYTES = 8 * HTB, NXCD = 8, WGM = 8;
__host__ __device__ __forceinline__ int lds_byte(int r, int c) { const int st = (r >> 4) * 2 + (c >> 5), rr = r & 15, cc = c & 31, ob = rr * 64 + cc * 2; return st * 1024 + (ob ^ (((ob >> 9) & 1) << 5)); }
__host__ __device__ __forceinline__ void stage_rc(int b, int& R, int& C) { const int st = b / 1024, sb = b % 1024, swz = sb ^ (((sb >> 9) & 1) << 5); R = (st >> 1) * 16 + swz / 64; C = (st & 1) * 32 + (swz % 64) / 2; }
__host__ __device__ __forceinline__ int perm32(int rho) { const int n = rho >> 4, i = rho & 15; return 8 * (i >> 2) + 4 * n + (i & 3); }
struct Unit { int pm, pn; };
struct Gemm { const bf16_t* A; const bf16_t* Bt; int M, N, K; };
struct StaticOrder {
    int nM, nN, nwg, G, c;
    __host__ __device__ void init(int M, int N, int G_, int c_) { nM = M / BM; nN = N / BM; nwg = nM * nN; G = G_; c = c_; }
    __host__ __device__ bool next(int i, Unit& u) const {
        const long L = (long)i * G + c; if (L >= nwg) return false;
        int wgid = (int)L; { const int q = nwg / NXCD, r = nwg % NXCD, xcd = wgid % NXCD, off = wgid / NXCD; wgid = (xcd < r ? xcd * (q + 1) : r * (q + 1) + (xcd - r) * q) + off; }
        const int nig = WGM * nN, gid = wgid / nig, fm = gid * WGM, gsz = (nM - fm) < WGM ? (nM - fm) : WGM;
        u.pm = fm + ((wgid % nig) % gsz); u.pn = (wgid % nig) / gsz; return true;
    }
    __device__ __forceinline__ void a_ready(const Unit&) const {}
    __device__ __forceinline__ void done(const Unit&) const {}
};
struct BranchOrder {
    StaticOrder so;
    __host__ __device__ void init(int M, int G_, int c_) { so.init(M, 1024, G_, c_); }
    __host__ __device__ bool next(int i, Unit& u) const { Unit t; if (!so.next(i / 3, t)) return false; const int br = i % 3; u.pm = br * (MT / 256) + t.pm; u.pn = br * 4 + t.pn; return true; }
    __device__ __forceinline__ void a_ready(const Unit&) const {}
    __device__ __forceinline__ void done(const Unit&) const {}
};
template <class F> struct Epi8 {
    static constexpr bool PERM = true, AFTER_DRAIN = false; F f;
    __device__ __forceinline__ void operator()(const f32x4 (&acc)[2][2][4][2], const Unit& u, int wr, int wc, int fr, int fq) const {
        const int row0 = u.pm * BM + wr * 64 + fr, col0 = u.pn * BM + wc * 32 + 8 * fq;
#pragma unroll
        for (int ai = 0; ai < 2; ++ai)
#pragma unroll
            for (int m = 0; m < 4; ++m)
#pragma unroll
                for (int bj = 0; bj < 2; ++bj) { const f32x4 v0 = acc[ai][bj][m][0], v1 = acc[ai][bj][m][1];
                    const float a[8] = {v0[0], v0[1], v0[2], v0[3], v1[0], v1[1], v1[2], v1[3]};
                    f.st8(row0 + ai * HALF + m * 16, col0 + bj * HALF, a); }
    }
};
template <class F> struct Epi8L {
    static constexpr bool PERM = true, AFTER_DRAIN = false; F f;
    __device__ __forceinline__ void operator()(const f32x4 (&acc)[2][2][4][2], const Unit& u, int wr, int wc, int fr, int fq) const {
        const int row0 = u.pm * BM + wr * 64 + fr, col0 = u.pn * BM + wc * 32 + 8 * fq;
#pragma unroll
        for (int ai = 0; ai < 2; ++ai) {
            U4 x0[4][2], x1[4][2];
#pragma unroll
            for (int m = 0; m < 4; ++m)
#pragma unroll
                for (int bj = 0; bj < 2; ++bj) f.ld8(row0 + ai * HALF + m * 16, col0 + bj * HALF, x0[m][bj], x1[m][bj]);
#pragma unroll
            for (int m = 0; m < 4; ++m)
#pragma unroll
                for (int bj = 0; bj < 2; ++bj) { const f32x4 v0 = acc[ai][bj][m][0], v1 = acc[ai][bj][m][1];
                    const float a[8] = {v0[0], v0[1], v0[2], v0[3], v1[0], v1[1], v1[2], v1[3]};
                    f.fin8(row0 + ai * HALF + m * 16, col0 + bj * HALF, a, x0[m][bj], x1[m][bj]); }
        }
    }
};
struct SigTileStore { bf16_t* LT;
    __device__ __forceinline__ void st(const Unit& u, int slot, const float* a) const {
        float o[8];
#pragma unroll
        for (int e = 0; e < 8; ++e) o[e] = 1.0f / (1.0f + __expf(-a[e]));
        *(U4*)(LT + (((size_t)(u.pm * 12 + u.pn) * 8192 + slot) << 3)) = pack8(o); } };
template <class F> struct Epi8T {
    static constexpr bool PERM = true, AFTER_DRAIN = false; F f;
    __device__ __forceinline__ void operator()(const f32x4 (&acc)[2][2][4][2], const Unit& u, int wr, int wc, int fr, int fq) const {
        int wl = (wr * 4 + wc) * 64 + fq * 16 + fr; asm volatile("" : "+v"(wl));
#pragma unroll
        for (int ai = 0; ai < 2; ++ai)
#pragma unroll
            for (int m = 0; m < 4; ++m)
#pragma unroll
                for (int bj = 0; bj < 2; ++bj) { const f32x4 v0 = acc[ai][bj][m][0], v1 = acc[ai][bj][m][1];
                    const float a[8] = {v0[0], v0[1], v0[2], v0[3], v1[0], v1[1], v1[2], v1[3]};
                    f.st(u, ((ai * 4 + m) * 2 + bj) * 512 + wl, a); }
    }
};
struct MergeTile { const bf16_t* LT; bf16_t* SCR; bf16_t* MRG; };
struct Epi8M {
    static constexpr bool PERM = true, AFTER_DRAIN = false; MergeTile f;
    __device__ __forceinline__ void operator()(const f32x4 (&acc)[2][2][4][2], const Unit& u, int wr, int wc, int fr, int fq) const {
        const int br = u.pn >> 2, pm = u.pm - br * (MT / 256), pn = u.pn & 3;
        int wl = (wr * 4 + wc) * 64 + fq * 16 + fr; asm volatile("" : "+v"(wl));
        int row0 = pm * BM + wr * 64 + fr, col0 = pn * BM + wc * 32 + 8 * fq; asm volatile("" : "+v"(row0), "+v"(col0));
        const bf16_t* lt = f.LT + (((size_t)(pm * 12 + u.pn) * 8192) << 3);
#pragma unroll
        for (int ai = 0; ai < 2; ++ai) {
            U4 x0[4][2], x1[4][2];
#pragma unroll
            for (int m = 0; m < 4; ++m)
#pragma unroll
                for (int bj = 0; bj < 2; ++bj) { const int slot = ((ai * 4 + m) * 2 + bj) * 512 + wl;
                    x0[m][bj] = *(const U4*)(lt + ((size_t)slot << 3));
                    if (br) x1[m][bj] = *(const U4*)(f.SCR + ((size_t)slot << 3)); else x1[m][bj] = U4{0u, 0u, 0u, 0u}; }
#pragma unroll
            for (int m = 0; m < 4; ++m)
#pragma unroll
                for (int bj = 0; bj < 2; ++bj) { const f32x4 v0 = acc[ai][bj][m][0], v1 = acc[ai][bj][m][1];
                    const float a[8] = {v0[0], v0[1], v0[2], v0[3], v1[0], v1[1], v1[2], v1[3]};
                    float g[8], o[8]; unpack8(x0[m][bj], g); unpack8(x1[m][bj], o);
#pragma unroll
                    for (int e = 0; e < 8; ++e) o[e] += g[e] * a[e];
                    const int slot = ((ai * 4 + m) * 2 + bj) * 512 + wl;
                    if (br < 2) *(U4*)(f.SCR + ((size_t)slot << 3)) = pack8(o);
                    else *(U4*)(f.MRG + (size_t)(row0 + ai * HALF + m * 16) * DM + col0 + bj * HALF) = pack8(o); }
        }
    }
};
template <class F> struct Epi4L {
    static constexpr bool PERM = false, AFTER_DRAIN = false; F f;
    __device__ __forceinline__ void operator()(const f32x4 (&acc)[2][2][4][2], const Unit& u, int wr, int wc, int fr, int fq) const {
        const int row0 = u.pm * BM + wr * 64 + fr, col0 = u.pn * BM + wc * 32 + 4 * fq;
        f32x4 g[2][2];
#pragma unroll
        for (int bj = 0; bj < 2; ++bj)
#pragma unroll
            for (int n = 0; n < 2; ++n) g[bj][n] = f.ldgate(u.pm * BM, col0 + bj * HALF + n * 16);
#pragma unroll
        for (int ai = 0; ai < 2; ++ai) {
            f32x4 xr[4][2][2];
#pragma unroll
            for (int m = 0; m < 4; ++m)
#pragma unroll
                for (int bj = 0; bj < 2; ++bj)
#pragma unroll
                    for (int n = 0; n < 2; ++n) xr[m][bj][n] = f.ldx(row0 + ai * HALF + m * 16, col0 + bj * HALF + n * 16);
#pragma unroll
            for (int m = 0; m < 4; ++m)
#pragma unroll
                for (int bj = 0; bj < 2; ++bj)
#pragma unroll
                    for (int n = 0; n < 2; ++n) f.fin4(row0 + ai * HALF + m * 16, col0 + bj * HALF + n * 16, acc[ai][bj][m][n], xr[m][bj][n], g[bj][n]);
        }
    }
};
template <class F> struct Epi4 {
    static constexpr bool PERM = false, AFTER_DRAIN = false; F f;
    __device__ __forceinline__ void operator()(const f32x4 (&acc)[2][2][4][2], const Unit& u, int wr, int wc, int fr, int fq) const {
        const int row0 = u.pm * BM + wr * 64 + fr, col0 = u.pn * BM + wc * 32 + 4 * fq;
#pragma unroll
        for (int ai = 0; ai < 2; ++ai)
#pragma unroll
            for (int m = 0; m < 4; ++m)
#pragma unroll
                for (int bj = 0; bj < 2; ++bj)
#pragma unroll
                    for (int n = 0; n < 2; ++n) { const f32x4 v0 = acc[ai][bj][m][n]; const float a[4] = {v0[0], v0[1], v0[2], v0[3]};
                        f.st4(row0 + ai * HALF + m * 16, col0 + bj * HALF + n * 16, a); }
    }
};

template <class Epi, class Sched, bool ALIGN_EPI = false, bool SP2 = false>
__device__ __forceinline__ void gemm_phase(PG8_LAS unsigned char* lds, const int tid, const Gemm g, const Sched& S, const Epi& E) {
    const int wid = __builtin_amdgcn_readfirstlane(tid >> 6), lane = tid & 63, wr = wid >> 2, wc = wid & 3, fr = lane & 15, fq = lane >> 4;
    const int K = g.K, nt = K / BK;
    unsigned voffA[2], voffB[2];
#pragma unroll
    for (int i = 0; i < 2; ++i) { int R, C; stage_rc(tid * 16 + i * 8192, R, C); const int Rb = Epi::PERM ? ((R & ~31) + perm32(R & 31)) : R;
        voffA[i] = (unsigned)(R * K + C) * 2u; voffB[i] = (unsigned)(Rb * K + C) * 2u; }
    const size_t kstep = (size_t)(BK * 2);
    const size_t hstep = (size_t)HALF * K * 2;
    const size_t tstep = 2 * hstep;
    const unsigned ldsw = (unsigned)wid * 1024u;
    const int aoff = lds_byte(wr * 64 + fr, fq * 8), boff = lds_byte(wc * 32 + fr, fq * 8);
#define PG8_SA(b, h) (((b) * 2 + (h)) * HTB)
#define PG8_SB(b, h) ((4 + (b) * 2 + (h)) * HTB)
#define PG8_STAGE(bufoff, gbase, voff) do { _Pragma("unroll") for (int _i = 0; _i < 2; ++_i) \
        __builtin_amdgcn_global_load_lds((const unsigned*)((const char*)(gbase) + (voff)[_i]), (PG8_LAS unsigned*)(lds + (bufoff) + ldsw + _i * 8192), 16, 0, 0); } while (0)
#define PG8_LDA(dst, b, h) do { _Pragma("unroll") for (int m = 0; m < 4; ++m) _Pragma("unroll") for (int k = 0; k < 2; ++k) dst[m][k] = *(const PG8_LAS bf16x8*)(lds + PG8_SA(b, h) + aoff + m * 2048 + k * 1024); } while (0)
#define PG8_LDB(dst, b, h) do { _Pragma("unroll") for (int n = 0; n < 2; ++n) _Pragma("unroll") for (int k = 0; k < 2; ++k) dst[n][k] = *(const PG8_LAS bf16x8*)(lds + PG8_SB(b, h) + boff + n * 2048 + k * 1024); } while (0)
#define PG8_MMA(ai, bj, At, Bt) do { __builtin_amdgcn_s_setprio(1); _Pragma("unroll") for (int m = 0; m < 4; ++m) _Pragma("unroll") for (int n = 0; n < 2; ++n) _Pragma("unroll") for (int k = 0; k < 2; ++k) \
        acc[ai][bj][m][n] = __builtin_amdgcn_mfma_f32_16x16x32_bf16(Bt[n][k], At[m][k], acc[ai][bj][m][n], 0, 0, 0); __builtin_amdgcn_s_setprio(0); } while (0)
#define PG8_WAIT_V(n) asm volatile("s_waitcnt vmcnt(" #n ")" ::: "memory")
#define PG8_WAIT_L(n) asm volatile("s_waitcnt lgkmcnt(" #n ")" ::: "memory")
#define PG8_BAR __builtin_amdgcn_s_barrier()
#define PG8_SCHED __builtin_amdgcn_sched_barrier(0)
    Unit cur, nxt; int ui = 0;
    if (!S.next(0, cur)) return;
    f32x4 acc[2][2][4][2];
#pragma unroll
    for (int a = 0; a < 2; ++a)
#pragma unroll
        for (int b = 0; b < 2; ++b)
#pragma unroll
            for (int m = 0; m < 4; ++m)
#pragma unroll
                for (int n = 0; n < 2; ++n) acc[a][b][m][n] = (f32x4){0.f, 0.f, 0.f, 0.f};
    bf16x8 At[4][2], B0[2][2], B1[2][2];
    const char* cA = (const char*)g.A + (size_t)cur.pm * tstep; const char* cB = (const char*)g.Bt + (size_t)cur.pn * tstep;
    S.a_ready(cur);
    if constexpr (SP2) {
        PG8_STAGE(PG8_SB(0, 0), cB, voffB); PG8_STAGE(PG8_SB(0, 1), cB + hstep, voffB); PG8_STAGE(PG8_SA(0, 0), cA, voffA); PG8_STAGE(PG8_SA(0, 1), cA + hstep, voffA);
        if (wr == 1) PG8_BAR;
        PG8_WAIT_V(2); PG8_BAR;
        PG8_STAGE(PG8_SB(1, 0), cB + kstep, voffB); PG8_STAGE(PG8_SA(1, 0), cA + kstep, voffA); PG8_STAGE(PG8_SB(1, 1), cB + hstep + kstep, voffB);
        PG8_WAIT_V(6); PG8_BAR;
    } else {
        PG8_STAGE(PG8_SB(0, 0), cB, voffB); PG8_STAGE(PG8_SA(0, 0), cA, voffA); PG8_STAGE(PG8_SB(0, 1), cB + hstep, voffB); PG8_STAGE(PG8_SA(0, 1), cA + hstep, voffA);
        if (wr == 1) PG8_BAR;
        PG8_WAIT_V(4); PG8_BAR;
        PG8_STAGE(PG8_SB(1, 0), cB + kstep, voffB); PG8_STAGE(PG8_SA(1, 0), cA + kstep, voffA); PG8_STAGE(PG8_SB(1, 1), cB + hstep + kstep, voffB);
        PG8_WAIT_V(6); PG8_BAR;
    }
    for (;;) {
        const bool has_next = S.next(ui + 1, nxt);
        const char* nA = has_next ? (const char*)g.A + (size_t)nxt.pm * tstep : cA; const char* nB = has_next ? (const char*)g.Bt + (size_t)nxt.pn * tstep : cB;
        for (int t = 0; t < nt; t += 2) {
            const bool last = (t == nt - 2);
            const char* a1 = cA + (size_t)(t + 1) * kstep;
            const char* a2 = last ? nA : cA + (size_t)(t + 2) * kstep; const char* b2 = last ? nB : cB + (size_t)(t + 2) * kstep;
            const char* a3 = a2 + kstep; const char* b3 = b2 + kstep;
            if (last && has_next) S.a_ready(nxt);
            if constexpr (SP2) {
            PG8_LDB(B0, 0, 0); PG8_LDB(B1, 0, 1); PG8_SCHED; PG8_LDA(At, 0, 0); PG8_STAGE(PG8_SA(1, 1), a1 + hstep, voffA);
            PG8_WAIT_V(8); PG8_WAIT_L(0); PG8_BAR; PG8_MMA(0, 0, At, B0); PG8_MMA(0, 1, At, B1); PG8_BAR; PG8_SCHED;
            PG8_LDA(At, 0, 1); PG8_STAGE(PG8_SB(0, 0), b2, voffB); PG8_STAGE(PG8_SB(0, 1), b2 + hstep, voffB); PG8_STAGE(PG8_SA(0, 0), a2, voffA);
            PG8_WAIT_V(8); PG8_WAIT_L(0); PG8_BAR; PG8_MMA(1, 0, At, B0); PG8_MMA(1, 1, At, B1); PG8_BAR; PG8_SCHED;
            PG8_LDB(B0, 1, 0); PG8_LDB(B1, 1, 1); PG8_SCHED; PG8_LDA(At, 1, 0); PG8_STAGE(PG8_SA(0, 1), a2 + hstep, voffA);
            PG8_WAIT_V(8); PG8_WAIT_L(0); PG8_BAR; PG8_MMA(0, 0, At, B0); PG8_MMA(0, 1, At, B1); PG8_BAR; PG8_SCHED;
            PG8_LDA(At, 1, 1); PG8_STAGE(PG8_SB(1, 0), b3, voffB); PG8_STAGE(PG8_SB(1, 1), b3 + hstep, voffB); PG8_STAGE(PG8_SA(1, 0), a3, voffA);
            PG8_WAIT_V(8); PG8_WAIT_L(0); PG8_BAR; PG8_MMA(1, 0, At, B0); PG8_MMA(1, 1, At, B1); PG8_BAR; PG8_SCHED;
            } else {
            PG8_LDB(B0, 0, 0); PG8_SCHED; PG8_LDA(At, 0, 0); PG8_STAGE(PG8_SA(1, 1), a1 + hstep, voffA);
            PG8_WAIT_L(8); PG8_BAR; PG8_WAIT_L(0); PG8_MMA(0, 0, At, B0); PG8_BAR; PG8_SCHED;
            PG8_LDB(B1, 0, 1); PG8_STAGE(PG8_SB(0, 0), b2, voffB);
            PG8_BAR; PG8_WAIT_L(0); PG8_MMA(0, 1, At, B1); PG8_BAR;
            PG8_LDA(At, 0, 1); PG8_STAGE(PG8_SA(0, 0), a2, voffA);
            PG8_BAR; PG8_WAIT_L(0); PG8_MMA(1, 0, At, B0); PG8_BAR; PG8_SCHED;
            PG8_STAGE(PG8_SB(0, 1), b2 + hstep, voffB);
            PG8_WAIT_V(6); PG8_BAR; PG8_MMA(1, 1, At, B1); PG8_BAR;
            PG8_LDB(B0, 1, 0); PG8_SCHED; PG8_LDA(At, 1, 0); PG8_STAGE(PG8_SA(0, 1), a2 + hstep, voffA);
            PG8_WAIT_L(8); PG8_BAR; PG8_WAIT_L(0); PG8_MMA(0, 0, At, B0); PG8_BAR; PG8_SCHED;
            PG8_LDB(B1, 1, 1); PG8_STAGE(PG8_SB(1, 0), b3, voffB);
            PG8_BAR; PG8_WAIT_L(0); PG8_MMA(0, 1, At, B1); PG8_BAR;
            PG8_LDA(At, 1, 1); PG8_STAGE(PG8_SA(1, 0), a3, voffA);
            PG8_BAR; PG8_WAIT_L(0); PG8_MMA(1, 0, At, B0); PG8_BAR; PG8_SCHED;
            PG8_STAGE(PG8_SB(1, 1), b3 + hstep, voffB);
            PG8_WAIT_V(6); PG8_BAR; PG8_MMA(1, 1, At, B1); PG8_BAR;
            }
        }
        if constexpr (ALIGN_EPI) { if (wr == 0) PG8_BAR; }
        if constexpr (!Epi::AFTER_DRAIN) { E(acc, cur, wr, wc, fr, fq); S.done(cur); }
        if (!has_next) break;
#pragma unroll
        for (int a = 0; a < 2; ++a)
#pragma unroll
            for (int b = 0; b < 2; ++b)
#pragma unroll
                for (int m = 0; m < 4; ++m)
#pragma unroll
                    for (int n = 0; n < 2; ++n) acc[a][b][m][n] = (f32x4){0.f, 0.f, 0.f, 0.f};
        cur = nxt; cA = nA; cB = nB; ++ui;
        if constexpr (ALIGN_EPI) { if (wr == 1) PG8_BAR; }
    }
    PG8_WAIT_V(0);
    if constexpr (!ALIGN_EPI) { if (wr == 0) PG8_BAR; }
    PG8_BAR;
#undef PG8_SA
#undef PG8_SB
#undef PG8_STAGE
#undef PG8_LDA
#undef PG8_LDB
#undef PG8_MMA
#undef PG8_WAIT_V
#undef PG8_WAIT_L
#undef PG8_BAR
#undef PG8_SCHED
}
}

template <class F> __device__ __forceinline__ void run_gemm8(PG8_LAS unsigned char* lds, const Ctx& cx, const bf16_t* A, const bf16_t* Bt, int M, int N, int K, const F& f) {
    pg8::Gemm g{A, Bt, M, N, K}; pg8::StaticOrder S; S.init(M, N, cx.nblk, cx.bid);
    pg8::Epi8<F> E{f};
    pg8::gemm_phase<pg8::Epi8<F>, pg8::StaticOrder, true, true>(lds, cx.tid, g, S, E);
}
template <class F> __device__ __forceinline__ void run_gemm4(PG8_LAS unsigned char* lds, const Ctx& cx, const bf16_t* A, const bf16_t* Bt, int M, int N, int K, const F& f) {
    pg8::Gemm g{A, Bt, M, N, K}; pg8::StaticOrder S; S.init(M, N, cx.nblk, cx.bid);
    pg8::Epi4L<F> E{f};
    pg8::gemm_phase<pg8::Epi4L<F>, pg8::StaticOrder, true, true>(lds, cx.tid, g, S, E);
}
__device__ __forceinline__ void run_gemm_branches(PG8_LAS unsigned char* lds, const Ctx& cx, const bf16_t* Y, const bf16_t* WBl, int mrows, const StMerge3& f, bf16_t* scratch) {
    pg8::Gemm g{Y, WBl, 3 * MT, 3 * 1024, 512}; pg8::BranchOrder S; S.init(mrows, cx.nblk, cx.bid);
    pg8::Epi8M E{pg8::MergeTile{f.L, scratch + (size_t)cx.bid * 65536, f.MRG}};
    pg8::gemm_phase<pg8::Epi8M, pg8::BranchOrder, true, true>(lds, cx.tid, g, S, E);
}
__device__ __forceinline__ void run_gemm_logits(PG8_LAS unsigned char* lds, const Ctx& cx, const bf16_t* A, const bf16_t* Bt, int M, bf16_t* LT) {
    pg8::Gemm g{A, Bt, M, NMG, DM}; pg8::StaticOrder S; S.init(M, NMG, cx.nblk, cx.bid);
    pg8::Epi8T<pg8::SigTileStore> E{pg8::SigTileStore{LT}};
    pg8::gemm_phase<pg8::Epi8T<pg8::SigTileStore>, pg8::StaticOrder, true, true>(lds, cx.tid, g, S, E);
}
template <class F> __device__ __forceinline__ void run_gemm8L(PG8_LAS unsigned char* lds, const Ctx& cx, const bf16_t* A, const bf16_t* Bt, int M, int N, int K, const F& f) {
    pg8::Gemm g{A, Bt, M, N, K}; pg8::StaticOrder S; S.init(M, N, cx.nblk, cx.bid);
    pg8::Epi8L<F> E{f};
    pg8::gemm_phase<pg8::Epi8L<F>, pg8::StaticOrder, true, true>(lds, cx.tid, g, S, E);
}
#else
template <class F> void run_gemm8(unsigned char*, const Ctx&, const bf16_t* A, const bf16_t* Bt, int M, int N, int K, const F& f) {
#pragma omp parallel for schedule(dynamic, 8)
    for (int r = 0; r < M; ++r) for (int c0 = 0; c0 < N; c0 += 8) { float a[8];
        for (int e = 0; e < 8; ++e) { float s = 0.f; const bf16_t* ar = A + (size_t)r * K; const bf16_t* br = Bt + (size_t)(c0 + e) * K; for (int k = 0; k < K; ++k) s += bf2f(ar[k]) * bf2f(br[k]); a[e] = s; }
        f.st8(r, c0, a); }
}
inline void run_gemm_logits(unsigned char* l, const Ctx& c, const bf16_t* A, const bf16_t* Bt, int M, bf16_t* L) { run_gemm8(l, c, A, Bt, M, NMG, DM, StPlain{L, NMG}); }
inline void run_gemm_branches(unsigned char* l, const Ctx& c, const bf16_t* Y, const bf16_t* WBl, int mrows, const StMerge3& f, bf16_t*) {
    for (int br = 0; br < 3; ++br) run_gemm8(l, c, Y + (size_t)br * MT * 512, WBl + (size_t)br * DM * 512, mrows, DM, 512, StMerge{f.L, f.MRG, br}); }
template <class F> void run_gemm8L(unsigned char* l, const Ctx& c, const bf16_t* A, const bf16_t* Bt, int M, int N, int K, const F& f) { run_gemm8(l, c, A, Bt, M, N, K, f); }
template <class F> void run_gemm4(unsigned char*, const Ctx&, const bf16_t* A, const bf16_t* Bt, int M, int N, int K, const F& f) {
#pragma omp parallel for schedule(dynamic, 8)
    for (int r = 0; r < M; ++r) for (int c0 = 0; c0 < N; c0 += 4) { float a[4];
        for (int e = 0; e < 4; ++e) { float s = 0.f; const bf16_t* ar = A + (size_t)r * K; const bf16_t* br = Bt + (size_t)(c0 + e) * K; for (int k = 0; k < K; ++k) s += bf2f(ar[k]) * bf2f(br[k]); a[e] = s; }
        f.st4(r, c0, a); }
}
#endif

#ifndef PROBE_S
#define PROBE_S -1
#endif
constexpr int PPL = 11;
constexpr int NPHASE = 2 + PPL * NLAYER;
template <int PH> DEVI void run_phase_t(LQ unsigned char* lds, const Ctx& cx, const Params& p) {
    const Views v = make_views(p.ws, p.out);
    if constexpr (PH >= 100) { constexpr int layer = (PH - 100) / 10, kind = (PH - 100) % 10;
        if constexpr (kind == 0) phase_conv<0>(cx, p, layer); else if constexpr (kind == 1) phase_prep2(cx, p, layer); else phase_tmat(cx, p, lds, layer); }
    else if constexpr (PH == 0) { phase_prep(cx, p, lds); }
    else if constexpr (PH == NPHASE - 1) { phase_final(cx, p); }
    else {
        constexpr int layer = (PH - 1) / PPL, s = (PH - 1) % PPL;
        constexpr int mrows = layer == NLAYER - 1 ? ML : MT;
        if constexpr (s == 0) { phase_norm(cx, p, layer); if constexpr (layer > 0) { SYNC(); phase_prep_w(cx, p, lds, layer); } }
        else if constexpr (s == 1) run_gemm8(lds, cx, v.XN, v.W1, MT, N1, DM, StG1{v.AQKV, v.BQ, v.BKV, v.CQKV, v.HALO});
        else if constexpr (s == 2) phase_conv<0>(cx, p, layer);
        else if constexpr (s == 3) phase_prep2(cx, p, layer);
        else if constexpr (s == 4) { phase_tmat(cx, p, lds, layer); phase_attn<0>(cx, p, lds, layer); }
        else if constexpr (s == 5) phase_scan<0>(cx, p, lds, layer);
        else if constexpr (s == 6) run_gemm8(lds, cx, v.XN, v.WZ, mrows, NZ, DM, StPlain{v.Z, NZ});
        else if constexpr (s == 7) phase_y(cx, p, layer);
        else if constexpr (s == 8) run_gemm_logits(lds, cx, v.XN, v.WM, mrows, v.L);
        else if constexpr (s == 9) run_gemm_branches(lds, cx, v.Y, v.WB, mrows, StMerge3{v.L, v.MRG}, v.T);
        else run_gemm4(lds, cx, v.MRG, v.WO, mrows, DM, DM,
                       StResid{layer == 0 ? p.x : p.out, layer == 0 ? p.ctx : v.CTX1, p.out, v.CTX1, v.MOD + (size_t)layer * (NB + 1) * 3072});
    }
}
HD bool phase_is_gemm(int ph) { if (ph == 0 || ph == NPHASE - 1) return false; const int s = (ph - 1) % PPL; return s == 1 || s == 6 || s >= 8; }
#define MK_PHASE_LIST(X) X(0) X(1) X(2) X(3) X(4) X(5) X(6) X(7) X(8) X(9) X(10) X(11) X(12) X(13) X(14) X(15) X(16) X(17) X(18) X(19) X(20) X(21) X(22) X(23)
static_assert(NPHASE == 24, "phase list");
#ifdef CPU_EMU
inline void run_phase(unsigned char* lds, const Ctx& cx, const Params& p, int ph) {
    switch (ph) {
#define X(k) case k: run_phase_t<k>(lds, cx, p); break;
        MK_PHASE_LIST(X)
#undef X
    }
}
#endif

#ifndef CPU_EMU
constexpr int LDS_BYTES = 147456;
constexpr int LDS_BARST = 147392;
#define XB_TMO      128
#define XB_XCNT(j)  (256  + 64 * (j))
#define XB_XSUB(j)  (1280 + 64 * (j))
#define XB_XGEN(j)  (2304 + 64 * (j))
#define XB_TOP      3328
#define XB_TOPGEN   3392
#define XCD_BAR_WORDS 3456
#define XB_SPIN_CAP (1u << 22)
__device__ __forceinline__ unsigned xb_ld(unsigned* p)              { return __hip_atomic_load(p, __ATOMIC_RELAXED, __HIP_MEMORY_SCOPE_AGENT); }
__device__ __forceinline__ unsigned xb_add(unsigned* p, unsigned v) { return __hip_atomic_fetch_add(p, v, __ATOMIC_RELAXED, __HIP_MEMORY_SCOPE_AGENT); }
__device__ __forceinline__ unsigned xb_xcc_id() { return (unsigned)__builtin_amdgcn_s_getreg((3 << 11) | 20) & 0xFu; }
#define XB_SPIN(cond, bar) do { unsigned _sp = 0; while (cond) { __builtin_amdgcn_s_sleep(1); \
    if ((++_sp & 255u) == 0u) { if (xb_ld(&(bar)[XB_TMO])) break; if (_sp > XB_SPIN_CAP) { atomicAdd(&(bar)[XB_TMO], 1u); break; } } } } while (0)
struct XcdBarrier { unsigned* bar; unsigned x; volatile PG8_LAS unsigned* st; };
__device__ __forceinline__ void xcd_barrier_complete(unsigned* bar, unsigned x, unsigned G, unsigned& nloc, unsigned& nx) {
    unsigned sum, cnt, mine, sp = 0u;
    for (;;) {
        sum = 0u; cnt = 0u; mine = 0u;
#pragma unroll
        for (unsigned j = 0; j < 16; ++j) { const unsigned c = xb_ld(&bar[XB_XCNT(j)]); sum += c; cnt += (c > 0u) ? 1u : 0u; mine = (j == x) ? c : mine; }
        if (sum == G) break;
        __builtin_amdgcn_s_sleep(1);
        if ((++sp & 255u) == 0u) { if (xb_ld(&bar[XB_TMO])) break; if (sp > XB_SPIN_CAP) { atomicAdd(&bar[XB_TMO], 1u); break; } }
    }
    nloc = mine > 0u ? mine : 1u; nx = cnt > 0u ? cnt : 1u;
}
__device__ __forceinline__ void xcd_barrier(const XcdBarrier& b, int tid, unsigned G) {
    asm volatile("s_waitcnt vmcnt(0)" ::: "memory");
    __syncthreads();
    if (tid == 0) {
        unsigned* bar = b.bar;
        __builtin_amdgcn_s_waitcnt(0);
        unsigned nloc = b.st[0], nx = b.st[1];
        if (nloc == 0u) { xcd_barrier_complete(bar, b.x, G, nloc, nx); b.st[0] = nloc; b.st[1] = nx; }
        const unsigned old = xb_add(&bar[XB_XSUB(b.x)], 1u);
        const unsigned gen = old / nloc;
        if (old + 1u == (gen + 1u) * nloc) {
            __builtin_amdgcn_fence(__ATOMIC_RELEASE, "agent");
            asm volatile("s_waitcnt vmcnt(0)" ::: "memory");
            const unsigned og = xb_add(&bar[XB_TOP], 1u);
            const unsigned tg = og / nx;
            if (og + 1u == (tg + 1u) * nx) xb_add(&bar[XB_TOPGEN], 1u);
            else XB_SPIN(xb_ld(&bar[XB_TOPGEN]) == tg, bar);
            __builtin_amdgcn_fence(__ATOMIC_ACQUIRE, "agent");
            xb_add(&bar[XB_XGEN(b.x)], 1u);
            asm volatile("s_waitcnt vmcnt(0)" ::: "memory");
        } else {
            XB_SPIN(xb_ld(&bar[XB_XGEN(b.x)]) == gen, bar);
            __builtin_amdgcn_fence(__ATOMIC_ACQUIRE, "agent");
            asm volatile("s_waitcnt vmcnt(0)" ::: "memory");
        }
    }
    __syncthreads();
}

__device__ __forceinline__ void load_args(Params& pl, const Params& p) {
#if defined(__HIP_DEVICE_COMPILE__)
    const __attribute__((address_space(4))) unsigned long long* q4 = (const __attribute__((address_space(4))) unsigned long long*)__builtin_amdgcn_kernarg_segment_ptr();
    asm volatile("" : "+s"(q4) :: "memory");
    unsigned long long w[sizeof(Params) / 8];
#pragma unroll
    for (int i = 0; i < (int)(sizeof(Params) / 8); ++i) w[i] = q4[i];
    __builtin_memcpy(&pl, w, sizeof(Params));
#else
    pl = p;
#endif
}
__global__ void __launch_bounds__(512, 2) mk_fwd(Params p) {
    extern __shared__ __attribute__((aligned(16))) unsigned char lds_raw[];
    PG8_LAS unsigned char* lds = (PG8_LAS unsigned char*)lds_raw;
    cg::grid_group grid = cg::this_grid();
    const int ph_lo = p.ph_lo, ph_hi = p.ph_hi;
    const int wave_s = __builtin_amdgcn_readfirstlane((int)threadIdx.x >> 6);
    volatile PG8_LAS unsigned* bst = (volatile PG8_LAS unsigned*)(lds + LDS_BARST);
    if (threadIdx.x < 2) bst[threadIdx.x] = 0u;
    __syncthreads();
    XcdBarrier bar; bar.bar = (unsigned*)p.ws; bar.x = xb_xcc_id(); bar.st = bst;
    if (threadIdx.x == 0) (void)xb_add(&bar.bar[XB_XCNT(bar.x)], 1u);
#define X(k) if (k >= 100 || (ph_lo <= k && k < ph_hi)) { \
        Params pl; load_args(pl, p); \
        unsigned zl = 0u; asm volatile("" : "+v"(zl)); Ctx cx; cx.tid = wave_s * 64 + (int)__builtin_amdgcn_mbcnt_hi(~0u, __builtin_amdgcn_mbcnt_lo(~0u, zl)); cx.bid = (int)blockIdx.x; cx.nblk = (int)gridDim.x; \
        asm volatile("" : "+v"(cx.tid)); asm volatile("" : "+s"(cx.bid), "+s"(cx.nblk)); \
        run_phase_t<k>(lds, cx, pl); \
        if (k >= 100 || k + 1 < ph_hi) { if (k == 0) grid.sync(); else { unsigned z0 = 0u; asm volatile("" : "+v"(z0)); const int t2 = wave_s * 64 + (int)__builtin_amdgcn_mbcnt_hi(~0u, __builtin_amdgcn_mbcnt_lo(~0u, z0)); xcd_barrier(bar, t2, gridDim.x); } } }
    MK_PHASE_LIST(X)
#undef X
}

#ifndef MK_SINGLE
#define MK_SINGLE 1
#endif
extern "C" void kernel_launch(void* const* d_in, const int* in_sizes, int n_in, void* d_out, int out_size, void* d_ws, size_t ws_size, hipStream_t stream) {
    static int grid = 0;
    if (grid == 0) {
        if (n_in != 18 || in_sizes[0] != ML * DM || out_size != ML * DM || ws_size < (size_t)512 * MiB) { fprintf(stderr, "kernel_launch: unexpected shapes (n_in %d, in0 %d, out %d, ws %zu < %zu)\n", n_in, n_in > 0 ? in_sizes[0] : -1, out_size, ws_size, (size_t)WS_END); grid = -1; return; }
        int dev = 0, cus = 0, per_cu = 0;
        if (hipGetDevice(&dev) != hipSuccess || hipDeviceGetAttribute(&cus, hipDeviceAttributeMultiprocessorCount, dev) != hipSuccess) { grid = -1; return; }
        if (hipFuncSetAttribute((const void*)mk_fwd, hipFuncAttributeMaxDynamicSharedMemorySize, LDS_BYTES) != hipSuccess) { fprintf(stderr, "kernel_launch: hipFuncSetAttribute failed\n"); grid = -1; return; }
        if (hipOccupancyMaxActiveBlocksPerMultiprocessor(&per_cu, (const void*)mk_fwd, 512, LDS_BYTES) != hipSuccess || per_cu < 1) { fprintf(stderr, "kernel_launch: occupancy query says %d\n", per_cu); (void)hipGetLastError(); grid = -1; return; }
        grid = cus;
    }
    if (grid < 0) return;
    if (hipMemsetAsync(d_ws, 0, 16384, stream) != hipSuccess) { fprintf(stderr, "kernel_launch: memset failed\n"); return; }
    Params p{};
    const float** pp = (const float**)&p;
    for (int i = 0; i < 18; ++i) pp[i] = (const float*)d_in[i];
    p.out = (float*)d_out; p.ws = (unsigned char*)d_ws;
#if MK_SINGLE
    p.ph_lo = 0; p.ph_hi = NPHASE;
    { void* args[] = {&p}; hipError_t e = hipLaunchCooperativeKernel((const void*)mk_fwd, dim3(grid), dim3(512), args, LDS_BYTES, stream);
      if (e != hipSuccess) fprintf(stderr, "cooperative launch failed: %s\n", hipGetErrorString(e)); }
#else
    for (int ph = 0; ph < NPHASE; ++ph) {
        p.ph_lo = ph; p.ph_hi = ph + 1;
        void* args[] = {&p}; hipError_t e = hipLaunchCooperativeKernel((const void*)mk_fwd, dim3(grid), dim3(512), args, LDS_BYTES, stream);
        if (e != hipSuccess) { fprintf(stderr, "cooperative launch %d failed: %s\n", ph, hipGetErrorString(e)); break; }
    }
#endif
}
#endif
```

```cpp
#ifndef CPU_EMU
#include <hip/hip_runtime.h>
#include <hip/hip_cooperative_groups.h>
#include <cstdio>
#include <cstdint>
namespace cg = cooperative_groups;
#define DEVI __device__ __forceinline__
#define HD __host__ __device__ __forceinline__
#define CFENCE() asm volatile("" ::: "memory")
#define LAUNDER(x) asm volatile("" : "+v"(x))
#define SCHEDB() __builtin_amdgcn_sched_barrier(0)
#else
#define CFENCE() do {} while (0)
#define LAUNDER(x) do {} while (0)
#define SCHEDB() do {} while (0)
#include <cstring>
#include <cmath>
#include <cstdio>
#include <cstdint>
#include <cstddef>
#define DEVI inline
#define HD inline
#endif

#ifndef CPU_EMU
#define LQ __attribute__((address_space(3)))
typedef short bf16x8 __attribute__((ext_vector_type(8)));
typedef float f32x4 __attribute__((ext_vector_type(4)));
typedef short s16x4 __attribute__((ext_vector_type(4)));
typedef long long i64x2 __attribute__((ext_vector_type(2)));
typedef unsigned u32x4 __attribute__((ext_vector_type(4)));
#define MFMA16(a, b, c) __builtin_amdgcn_mfma_f32_16x16x32_bf16(a, b, c, 0, 0, 0)
#define SYNC() __syncthreads()
#define LSYNC() do { asm volatile("s_waitcnt lgkmcnt(0)" ::: "memory"); __builtin_amdgcn_s_barrier(); asm volatile("" ::: "memory"); } while (0)
#define WSYNC() __builtin_amdgcn_wave_barrier()
__device__ __forceinline__ s16x4 trread(LQ const unsigned char* p) { return __builtin_bit_cast(s16x4, __builtin_amdgcn_ds_read_tr16_b64_v4i16((LQ s16x4*)p)); }
__device__ __forceinline__ float shfl_f(float v, int src) { return __shfl(v, src, 64); }
#define RFL(x) __builtin_amdgcn_readfirstlane(x)
#define SPIN_YIELD() __builtin_amdgcn_s_sleep(1)
#define LDSWAIT() asm volatile("s_waitcnt lgkmcnt(0)" ::: "memory")
__device__ __forceinline__ void lds_inc(LQ unsigned* p) { (void)__hip_atomic_fetch_add(p, 1u, __ATOMIC_RELAXED, __HIP_MEMORY_SCOPE_WORKGROUP); }
__device__ __forceinline__ unsigned lds_peek(LQ unsigned* p) { return __hip_atomic_load(p, __ATOMIC_RELAXED, __HIP_MEMORY_SCOPE_WORKGROUP); }
#define FEXP(x) __expf(x)
#else
#define LQ
using simt::bf16x8; using simt::f32x4; using simt::s16x4;
typedef long long i64x2 __attribute__((vector_size(16)));
typedef unsigned u32x4 __attribute__((vector_size(16)));
#define MFMA16(a, b, c) simt::mfma16(a, b, c)
#define SYNC() simt::syncthreads()
#define LSYNC() simt::syncthreads()
#define WSYNC() ((void)simt::shfl(0.f, 0))
inline s16x4 trread(const unsigned char* p) { return simt::tr16_b64(p); }
inline float shfl_f(float v, int src) { return simt::shfl(v, src); }
#define RFL(x) (x)
#define SPIN_YIELD() simt::yield_()
#define LDSWAIT() do {} while (0)
inline void lds_inc(unsigned* p) { *(volatile unsigned*)p += 1u; }
inline unsigned lds_peek(unsigned* p) { return *(volatile unsigned*)p; }
#define FEXP(x) expf(x)
#endif

#ifndef NB
#define NB 8
#endif
#ifndef SEQ
#define SEQ 4096
#endif
#ifndef CTXL
#define CTXL 256
#endif
constexpr int DM = 1024, INW = 8464, GRIDW = 64;
constexpr int ML = NB * SEQ, MC = NB * CTXL, MT = ML + MC;
constexpr int N1 = 3840;
constexpr int NZ = 1536;
constexpr int NMG = 3072;
constexpr float EPSF = 1e-6f;
constexpr int NLAYER = 2;
static_assert(MT % 256 == 0 && ML % 256 == 0, "row tiles");
constexpr int NCH_C = CTXL / 64, NCH_L = SEQ / 64, NSTEP = NCH_C + NCH_L;

typedef unsigned short bf16_t;
struct alignas(16) U4 { unsigned x, y, z, w; };
DEVI void st16l(LQ unsigned char* p, const U4& w) { u32x4 t; t[0] = w.x; t[1] = w.y; t[2] = w.z; t[3] = w.w; *(LQ u32x4*)p = t; }
DEVI U4 ld16l(LQ const unsigned char* p) { const u32x4 t = *(LQ const u32x4*)p; U4 w; w.x = t[0]; w.y = t[1]; w.z = t[2]; w.w = t[3]; return w; }

constexpr size_t MiB = 1u << 20;
constexpr size_t al1(size_t x) { return (x + MiB - 1) & ~(MiB - 1); }
constexpr size_t WS_CTL = 0;
constexpr size_t WS_MOD = 256 * 1024;
constexpr size_t WS_WAB = 512 * 1024;
constexpr size_t WS_TAX = 640 * 1024;
constexpr size_t WS_W1 = 1 * MiB;
constexpr size_t WS_WZ = WS_W1 + al1((size_t)N1 * DM * 2);
constexpr size_t WS_WM = WS_WZ + al1((size_t)NZ * DM * 2);
constexpr size_t WS_WB = WS_WM + al1((size_t)NMG * DM * 2);
constexpr size_t WS_WO = WS_WB + al1((size_t)3 * DM * 512 * 2);
constexpr size_t WS_G = WS_WO + al1((size_t)DM * DM * 2);
constexpr size_t WS_BETA = WS_G + al1((size_t)MT * 8 * 4);
constexpr size_t WS_CTX1 = WS_BETA + al1((size_t)MT * 8 * 4);
constexpr size_t WS_XN = WS_CTX1 + al1((size_t)MC * DM * 4);
constexpr size_t WS_AQKV = WS_XN + al1((size_t)MT * DM * 2);
constexpr size_t WS_CQKV = WS_AQKV + al1((size_t)MT * 1536 * 2);
constexpr size_t WS_BQ = WS_CQKV + al1((size_t)MT * 1536 * 2);
constexpr size_t WS_PA = WS_BQ + al1((size_t)MT * 512 * 2);
constexpr size_t WS_PC = WS_PA + al1((size_t)MT * 512 * 2);
constexpr size_t WS_T = WS_PC + al1((size_t)MT * 512 * 2);
constexpr size_t WS_GC = WS_T + al1((size_t)(MT / 64) * 8 * 8192);
constexpr size_t WS_TRET = WS_GC + al1((size_t)MT * 8 * 4);
constexpr size_t WS_BKV = WS_TRET + al1((size_t)2 * SEQ * 64 * 4);
constexpr size_t WS_HALO = WS_BKV + al1((size_t)MT * 256 * 2);
constexpr size_t WS_END = WS_HALO + al1((size_t)(MT / 64) * 4 * 1536 * 2);
constexpr size_t WS_PB1 = WS_BKV;
static_assert(WS_PB1 + (size_t)2 * ML * 512 * 2 <= (size_t)512 * MiB, "layer-1 backward parks");
static_assert((size_t)2 * MT * 512 * 2 <= (size_t)ML * DM * 4, "layer-0 backward parks in d_out");
static_assert(WS_CQKV + (size_t)MT * NMG * 2 <= WS_T, "gate tile overlay");

static_assert(WS_END <= (size_t)512 * MiB, "workspace");

struct Params {
    const float *x, *c, *ctx, *c_ctx, *w_ada, *b_ada, *norm_w, *w_in, *a_conv_w, *a_log, *a_dt_bias, *a_norm_w, *b_sink, *c_decay, *c_norm_w, *w_branch, *w_out, *final_norm_w;
    float* out; unsigned char* ws;
    int ph_lo, ph_hi;
};

#ifdef CPU_EMU
inline float u2f(unsigned u) { float f; memcpy(&f, &u, 4); return f; }
inline unsigned f2u(float f) { unsigned u; memcpy(&u, &f, 4); return u; }
#else
DEVI float u2f(unsigned u) { return __uint_as_float(u); }
DEVI unsigned f2u(float f) { return __float_as_uint(f); }
#endif
DEVI float bf2f(bf16_t h) { return u2f((unsigned)h << 16); }
DEVI bf16_t f2bf(float f) { unsigned u = f2u(f); return (bf16_t)((u + 0x7fffu + ((u >> 16) & 1u)) >> 16); }
#ifndef CPU_EMU
typedef float f32x2_t __attribute__((ext_vector_type(2))); typedef __bf16 bf16x2_t __attribute__((ext_vector_type(2)));
__device__ __forceinline__ unsigned pk2(float lo, float hi) { const f32x2_t v = {lo, hi}; const bf16x2_t b = __builtin_convertvector(v, bf16x2_t); return __builtin_bit_cast(unsigned, b); }
#else
DEVI unsigned pk2(float lo, float hi) { return (unsigned)f2bf(lo) | ((unsigned)f2bf(hi) << 16); }
#endif
DEVI float lo16(unsigned w) { return u2f(w << 16); }
DEVI float hi16(unsigned w) { return u2f(w & 0xffff0000u); }
DEVI float sigmoidf_(float x) { return 1.0f / (1.0f + expf(-x)); }
DEVI float siluf_(float x) { return x / (1.0f + expf(-x)); }
DEVI float softplusf_(float x) { return x > 20.f ? x : log1pf(expf(x)); }
DEVI void unpack8(const U4& w, float* v) { v[0] = lo16(w.x); v[1] = hi16(w.x); v[2] = lo16(w.y); v[3] = hi16(w.y); v[4] = lo16(w.z); v[5] = hi16(w.z); v[6] = lo16(w.w); v[7] = hi16(w.w); }
DEVI U4 pack8(const float* v) { U4 w; w.x = pk2(v[0], v[1]); w.y = pk2(v[2], v[3]); w.z = pk2(v[4], v[5]); w.w = pk2(v[6], v[7]); return w; }

struct Ctx { int tid, bid, nblk; };
struct TI { long id, n; };
DEVI TI thread_info(const Ctx& c) {
    const int wave = c.tid >> 6, lane = c.tid & 63;
    return TI{((long)wave * c.nblk + c.bid) * 64 + lane, (long)c.nblk * 512};
}

struct Views {
    float *MOD, *WAB, *TAX, *TRET, *GC; bf16_t *W1, *WZ, *WM, *WB, *WO; float *G, *BETA, *CTX1; bf16_t *XN, *AQKV, *CQKV, *BQ, *BKV, *PA, *PC, *Y, *Z, *L, *MRG, *T, *HALO;
    bf16_t *PAb[2], *PCb[2];
};
DEVI Views make_views(unsigned char* ws, float* outbuf = nullptr) {
    Views v;
    v.MOD = (float*)(ws + WS_MOD); v.WAB = (float*)(ws + WS_WAB); v.TAX = (float*)(ws + WS_TAX); v.TRET = (float*)(ws + WS_TRET); v.GC = (float*)(ws + WS_GC); v.W1 = (bf16_t*)(ws + WS_W1); v.WZ = (bf16_t*)(ws + WS_WZ); v.WM = (bf16_t*)(ws + WS_WM); v.WB = (bf16_t*)(ws + WS_WB); v.WO = (bf16_t*)(ws + WS_WO);
    v.G = (float*)(ws + WS_G); v.BETA = (float*)(ws + WS_BETA); v.CTX1 = (float*)(ws + WS_CTX1);
    v.XN = (bf16_t*)(ws + WS_XN); v.AQKV = (bf16_t*)(ws + WS_AQKV); v.CQKV = (bf16_t*)(ws + WS_CQKV); v.BQ = (bf16_t*)(ws + WS_BQ); v.BKV = (bf16_t*)(ws + WS_BKV);
    v.PA = (bf16_t*)(ws + WS_PA); v.PC = (bf16_t*)(ws + WS_PC); v.Y = v.AQKV; v.Z = v.CQKV; v.L = v.CQKV; v.MRG = v.XN; v.T = (bf16_t*)(ws + WS_T); v.HALO = (bf16_t*)(ws + WS_HALO);
    v.PAb[0] = (bf16_t*)outbuf; v.PCb[0] = (bf16_t*)outbuf + (size_t)MT * 512; v.PAb[1] = (bf16_t*)(ws + WS_PB1); v.PCb[1] = (bf16_t*)(ws + WS_PB1) + (size_t)ML * 512;
    return v;
}

HD int map_g1(int n) { return n < 1536 ? n : (n < 2048 ? 2064 + (n - 1536) : (n < 2304 ? 2576 + (n - 2048) : 3344 + (n - 2304))); }
HD int map_z(int n) { return n < 512 ? 1536 + n : (n < 1024 ? 2832 + (n - 512) : 4880 + (n - 1024)); }

DEVI float wave_sum(float v, int lane) {
#pragma unroll
    for (int o = 32; o >= 1; o >>= 1) v += shfl_f(v, lane ^ o);
    return v;
}
template <int W> DEVI float grp_sum(float v, int lane) {
#pragma unroll
    for (int o = W / 2; o >= 1; o >>= 1) v += shfl_f(v, lane ^ o);
    return v;
}
DEVI f32x4 ldg4(const float* p) { f32x4 v; __builtin_memcpy(&v, p, 16); return v; }
DEVI void stg4(float* p, const f32x4& v) { __builtin_memcpy(p, &v, 16); }

DEVI void prep_tile(const Ctx& cx, LQ unsigned char* lds, const float* src, int ld, int srccol0, int k0, bf16_t* dst, int K, int n0) {
    const int wave = RFL(cx.tid >> 6), lane = cx.tid & 63;
    LQ float* tl = (LQ float*)(lds + wave * 16640);
    { const int r = lane >> 4, c4 = (lane & 15) * 4; f32x4 w[16];
#pragma unroll
      for (int i = 0; i < 16; ++i) w[i] = ldg4(src + (size_t)(k0 + r + 4 * i) * ld + srccol0 + c4);
#pragma unroll
      for (int i = 0; i < 16; ++i)
#pragma unroll
          for (int e = 0; e < 4; ++e) tl[(r + 4 * i) * 65 + c4 + e] = w[i][e]; }
    WSYNC();
    { const int kc = (lane & 7) * 8;
#pragma unroll
      for (int i = 0; i < 8; ++i) { const int n = (lane >> 3) + 8 * i; float a[8];
#pragma unroll
          for (int e = 0; e < 8; ++e) a[e] = tl[(kc + e) * 65 + n];
          *(U4*)(dst + (size_t)(n0 + n) * K + k0 + kc) = pack8(a); } }
    WSYNC();
}
DEVI void phase_prep_w(const Ctx& cx, const Params& p, LQ unsigned char* lds, int l) {
    const Views v = make_views(p.ws);
    constexpr int T1 = (N1 / 64) * 16, TZ = (NZ / 64) * 16, TM = (NMG / 64) * 16, TB = 3 * 16 * 8, TO = 16 * 16, TL = T1 + TZ + TM + TB + TO;
    for (int t = RFL(cx.tid >> 6) * cx.nblk + cx.bid; t < TL; t += 8 * cx.nblk) {
        int r = t;
        const float* win = p.w_in + (size_t)l * DM * INW;
        if (r < T1) { const int nt = r / 16, kt = r % 16; prep_tile(cx, lds, win, INW, map_g1(nt * 64), kt * 64, v.W1, DM, nt * 64); continue; } r -= T1;
        if (r < TZ) { const int nt = r / 16, kt = r % 16; prep_tile(cx, lds, win, INW, map_z(nt * 64), kt * 64, v.WZ, DM, nt * 64); continue; } r -= TZ;
        if (r < TM) { const int nt = r / 16, kt = r % 16; prep_tile(cx, lds, win, INW, 5392 + nt * 64, kt * 64, v.WM, DM, nt * 64); continue; } r -= TM;
        if (r < TB) { const int br = r / 128, r2 = r % 128, nt = r2 / 8, kt = r2 % 8; prep_tile(cx, lds, p.w_branch + ((size_t)l * 3 + br) * 512 * DM, DM, nt * 64, kt * 64, v.WB + (size_t)br * DM * 512, 512, nt * 64); continue; } r -= TB;
        { const int nt = r / 16, kt = r % 16; prep_tile(cx, lds, p.w_out + (size_t)l * DM * DM, DM, nt * 64, kt * 64, v.WO, DM, nt * 64); }
    }
}
DEVI void phase_prep(const Ctx& cx, const Params& p, LQ unsigned char* lds) {
    const Views v = make_views(p.ws); const TI ti = thread_info(cx);
    phase_prep_w(cx, p, lds, 0);
    long tb = ti.id; LAUNDER(tb);
    for (long i = tb; i < (long)NLAYER * 16 * DM; i += ti.n) { const int l = (int)(i / (16 * DM)), j = (int)((i / DM) % 16), k = (int)(i % DM); v.WAB[i] = p.w_in[((size_t)l * DM + k) * INW + 2048 + j]; }
    LAUNDER(tb);
    for (long i = tb; i < 64 * 16; i += ti.n) { const int pos = (int)(i >> 4), f = (int)(i & 15); const float ang = (float)pos * powf(10000.0f, -(float)f / 16.0f); v.TAX[i] = cosf(ang); v.TAX[1024 + i] = sinf(ang); }
    LAUNDER(tb);
    for (long i = tb; i < (long)SEQ * 64; i += ti.n) { const int pos = (int)(i >> 6), f = (int)(i & 63); const float ang = (float)pos * powf(10000.0f, -(float)f / 64.0f); v.TRET[i] = cosf(ang); v.TRET[(size_t)SEQ * 64 + i] = sinf(ang); }
    {
        const int wave = RFL(cx.tid >> 6), lane = cx.tid & 63, nl = lane & 7, ks = lane >> 3;
        for (int it = wave * cx.nblk + cx.bid; it < NLAYER * (NB + 1) * 384; it += 8 * cx.nblk) {
            const int l = it / ((NB + 1) * 384), rem = it % ((NB + 1) * 384), b = rem / 384, n = (rem % 384) * 8 + nl;
            const float* cv = (b < NB ? p.c + (size_t)b * DM : p.c_ctx) + ks * 128;
            const float* w = p.w_ada + (size_t)l * DM * 3072 + (size_t)ks * 128 * 3072 + n;
            float acc = 0.f;
#pragma unroll 8
            for (int k = 0; k < 128; ++k) { const float cvk = cv[k]; acc += (cvk / (1.0f + FEXP(-cvk))) * w[(size_t)k * 3072]; }
            acc += shfl_f(acc, lane ^ 8); acc += shfl_f(acc, lane ^ 16); acc += shfl_f(acc, lane ^ 32);
            if (ks == 0) v.MOD[((size_t)l * (NB + 1) + b) * 3072 + n] = acc + p.b_ada[l * 3072 + n];
        }
    }
}

DEVI const float* xrow_in(const Params& p, const Views& v, int layer, int m) {
    if (layer == 0) return m < ML ? p.x + (size_t)m * DM : p.ctx + (size_t)(m - ML) * DM;
    return m < ML ? p.out + (size_t)m * DM : v.CTX1 + (size_t)(m - ML) * DM;
}
DEVI void phase_norm(const Ctx& cx, const Params& p, int layer) {
    const Views v = make_views(p.ws);
    const int wave = RFL(cx.tid >> 6), lane = cx.tid & 63;
    const float* nw = p.norm_w + layer * DM; const float* wab = v.WAB + (size_t)layer * 16 * DM;
    for (int qd = wave * cx.nblk + cx.bid; qd < MT / 4; qd += 8 * cx.nblk) {
        f32x4 xv[4][4];
#pragma unroll
        for (int r = 0; r < 4; ++r) { const int m = 4 * qd + r; const float* xr = xrow_in(p, v, layer, m); float ss = 0.f;
#pragma unroll
            for (int j = 0; j < 4; ++j) { xv[r][j] = ldg4(xr + 256 * j + 4 * lane); ss += xv[r][j][0] * xv[r][j][0] + xv[r][j][1] * xv[r][j][1] + xv[r][j][2] * xv[r][j][2] + xv[r][j][3] * xv[r][j][3]; }
            ss = wave_sum(ss, lane);
            const float rr = 1.0f / sqrtf(ss * (1.0f / DM) + EPSF);
            const int b = m < ML ? m / SEQ : NB; const float* mod = v.MOD + ((size_t)layer * (NB + 1) + b) * 3072;
#pragma unroll
            for (int j = 0; j < 4; ++j) { const int k0 = 256 * j + 4 * lane; const f32x4 n4 = ldg4(nw + k0), s4 = ldg4(mod + 1024 + k0), h4 = ldg4(mod + k0);
#pragma unroll
                for (int e = 0; e < 4; ++e) xv[r][j][e] = xv[r][j][e] * rr * n4[e] * (1.0f + s4[e]) + h4[e];
                unsigned long long w = (unsigned long long)pk2(xv[r][j][0], xv[r][j][1]) | ((unsigned long long)pk2(xv[r][j][2], xv[r][j][3]) << 32);
                *(unsigned long long*)(v.XN + (size_t)m * DM + k0) = w; } }
        float mine[4] = {0.f, 0.f, 0.f, 0.f};
#pragma unroll 2
        for (int jj = 0; jj < 16; ++jj) { float a[4] = {0.f, 0.f, 0.f, 0.f};
#pragma unroll
            for (int j = 0; j < 4; ++j) { const f32x4 w4 = ldg4(wab + jj * DM + 256 * j + 4 * lane);
#pragma unroll
                for (int r = 0; r < 4; ++r) a[r] += xv[r][j][0] * w4[0] + xv[r][j][1] * w4[1] + xv[r][j][2] * w4[2] + xv[r][j][3] * w4[3]; }
#pragma unroll
            for (int r = 0; r < 4; ++r) { a[r] = wave_sum(a[r], lane); if (lane == jj) mine[r] = a[r]; } }
#pragma unroll
        for (int r = 0; r < 4; ++r) { const size_t m = (size_t)4 * qd + r;
            if (lane < 8) v.BETA[m * 8 + lane] = sigmoidf_(mine[r]);
            else if (lane < 16) v.G[m * 8 + lane - 8] = -expf(p.a_log[layer * 8 + lane - 8]) * softplusf_(mine[r] + p.a_dt_bias[layer * 8 + lane - 8]); }
    }
}

template <int PRB = 0> DEVI void phase_conv(const Ctx& cx, const Params& p, int layer) {
    const Views v = make_views(p.ws); const TI ti = thread_info(cx);
    const float* cw = p.a_conv_w + (size_t)layer * 5 * 1536;
    for (long it = ti.id; it < (long)(MT / 64) * 768; it += ti.n) {
        const int gch = (int)(it / 768), c = 2 * (int)(it % 768);
        const bool lat = gch < ML / 64; const int ci = lat ? gch % NCH_L : (gch - ML / 64) % NCH_C; const bool first = ci == 0, last = ci == (lat ? NCH_L : NCH_C) - 1;
        bf16_t* col = v.AQKV + (size_t)gch * 64 * 1536 + c;
        float wa[5], wb[5];
#pragma unroll
        for (int j = 0; j < 5; ++j) { wa[j] = cw[j * 1536 + c]; wb[j] = cw[j * 1536 + c + 1]; }
        unsigned xw[68];
        xw[0] = first ? 0u : *(const unsigned*)(v.HALO + ((size_t)(gch - 1) * 4 + 2) * 1536 + c); xw[1] = first ? 0u : *(const unsigned*)(v.HALO + ((size_t)(gch - 1) * 4 + 3) * 1536 + c);
        xw[66] = last ? 0u : *(const unsigned*)(v.HALO + ((size_t)(gch + 1) * 4 + 0) * 1536 + c); xw[67] = last ? 0u : *(const unsigned*)(v.HALO + ((size_t)(gch + 1) * 4 + 1) * 1536 + c);
#pragma unroll
        for (int t = 0; t < 64; ++t) xw[2 + t] = *(const unsigned*)(col + (size_t)t * 1536);
#pragma unroll
        for (int t = 0; t < 64; ++t) {
            float ya = 0.f, yb = 0.f;
#pragma unroll
            for (int j = 0; j < 5; ++j) { ya += wa[j] * lo16(xw[t + j]); yb += wb[j] * hi16(xw[t + j]); }
            *(unsigned*)(col + (size_t)t * 1536) = pk2(ya / (1.0f + FEXP(-ya)), yb / (1.0f + FEXP(-yb))); }
    }
}

DEVI void phase_prep2(const Ctx& cx, const Params& p, int layer) {
    const Views v = make_views(p.ws);
    const int wave = RFL(cx.tid >> 6), lane = cx.tid & 63;
    for (int m = wave * cx.nblk + cx.bid; m < MT; m += 8 * cx.nblk) {
        {
            bf16_t* ptr = v.AQKV + (size_t)m * 1536 + 16 * lane; float f[16]; unpack8(*(const U4*)ptr, f); unpack8(*(const U4*)(ptr + 8), f + 8);
            float ss = 0.f;
#pragma unroll
            for (int e = 0; e < 16; ++e) ss += f[e] * f[e];
            ss = grp_sum<8>(ss, lane);
            const float sc = (1.0f / sqrtf(ss + EPSF)) * (lane < 32 ? 0.08838834764831845f : 1.0f);
#pragma unroll
            for (int e = 0; e < 16; ++e) f[e] *= sc;
            *(U4*)ptr = pack8(f); *(U4*)(ptr + 8) = pack8(f + 8);
        }
        if (m < ML && lane < 40) {
            const int t = m % SEQ, hh = lane >> 2, pu = lane & 3, half = pu >> 1, ch = pu & 1; const int pos = half == 0 ? t / GRIDW : t % GRIDW;
            bf16_t* ptr = (hh < 8 ? v.BQ + (size_t)m * 512 + hh * 64 : v.BKV + (size_t)m * 256 + (hh - 8) * 64) + half * 32 + ch * 8;
            float x1[8], x2[8]; unpack8(*(const U4*)ptr, x1); unpack8(*(const U4*)(ptr + 16), x2);
            const float* cs = v.TAX + pos * 16 + ch * 8; const float* sn = cs + 1024;
#pragma unroll
            for (int e = 0; e < 8; ++e) { const float a = x1[e], bb = x2[e]; x1[e] = a * cs[e] - bb * sn[e]; x2[e] = a * sn[e] + bb * cs[e]; }
            *(U4*)ptr = pack8(x1); *(U4*)(ptr + 16) = pack8(x2);
        }
        {
            const int which = lane >> 5, h = (lane >> 3) & 3, pu = lane & 7;
            bf16_t* ptr = v.CQKV + (size_t)m * 1536 + which * 512 + h * 128 + pu * 8;
            const float sc = which == 1 ? 0.08838834764831845f : 1.0f;
            if (m < ML) {
                float x1[8], x2[8]; unpack8(*(const U4*)ptr, x1); unpack8(*(const U4*)(ptr + 64), x2);
                const float* cs = v.TRET + (size_t)(m % SEQ) * 64 + pu * 8; const float* sn = cs + (size_t)SEQ * 64;
#pragma unroll
                for (int e = 0; e < 8; ++e) { const float a = x1[e] * sc, bb = x2[e] * sc; x1[e] = a * cs[e] - bb * sn[e]; x2[e] = a * sn[e] + bb * cs[e]; }
                *(U4*)ptr = pack8(x1); *(U4*)(ptr + 64) = pack8(x2);
            } else if (which == 1) {
                float x1[8], x2[8]; unpack8(*(const U4*)ptr, x1); unpack8(*(const U4*)(ptr + 64), x2);
#pragma unroll
                for (int e = 0; e < 8; ++e) { x1[e] *= sc; x2[e] *= sc; }
                *(U4*)ptr = pack8(x1); *(U4*)(ptr + 64) = pack8(x2);
            }
        }
    }
}

DEVI void phase_y(const Ctx& cx, const Params& p, int layer) {
    const Views v = make_views(p.ws, p.out);
    const int wave = RFL(cx.tid >> 6), lane = cx.tid & 63;
    const int mrows = layer == 0 ? MT : ML;
    for (int m = wave * cx.nblk + cx.bid; m < mrows; m += 8 * cx.nblk) {
        const int c0 = 8 * lane; float o[8], z[8], y[8];
        {   unpack8(*(const U4*)(v.PA + (size_t)m * 512 + c0), o); unpack8(*(const U4*)(v.PAb[layer] + (size_t)m * 512 + c0), z);
#pragma unroll
            for (int e = 0; e < 8; ++e) o[e] += z[e];
            unpack8(*(const U4*)(v.Z + (size_t)m * 1536 + c0), z);
            float ss = 0.f;
#pragma unroll
            for (int e = 0; e < 8; ++e) ss += o[e] * o[e];
            ss = grp_sum<16>(ss, lane); const float rs = 1.0f / sqrtf(ss * (1.0f / 128.0f) + EPSF);
            const float* w = p.a_norm_w + layer * 128 + (c0 & 127);
#pragma unroll
            for (int e = 0; e < 8; ++e) y[e] = o[e] * rs * w[e] * (z[e] / (1.0f + FEXP(-z[e])));
            *(U4*)(v.Y + (size_t)m * 512 + c0) = pack8(y); }
        {   unpack8(*(const U4*)(v.BQ + (size_t)m * 512 + c0), o); unpack8(*(const U4*)(v.Z + (size_t)m * 1536 + 512 + c0), z);
#pragma unroll
            for (int e = 0; e < 8; ++e) y[e] = o[e] * (z[e] / (1.0f + FEXP(-z[e])));
            *(U4*)(v.Y + ((size_t)MT + m) * 512 + c0) = pack8(y); }
        {   unpack8(*(const U4*)(v.PC + (size_t)m * 512 + c0), o); unpack8(*(const U4*)(v.PCb[layer] + (size_t)m * 512 + c0), z);
#pragma unroll
            for (int e = 0; e < 8; ++e) o[e] += z[e];
            unpack8(*(const U4*)(v.Z + (size_t)m * 1536 + 1024 + c0), z);
            float sm = 0.f;
#pragma unroll
            for (int e = 0; e < 8; ++e) sm += o[e];
            const float mu = grp_sum<16>(sm, lane) * (1.0f / 128.0f); float qv = 0.f;
#pragma unroll
            for (int e = 0; e < 8; ++e) { o[e] -= mu; qv += o[e] * o[e]; }
            const float rs = 1.0f / sqrtf(grp_sum<16>(qv, lane) * (1.0f / 128.0f) + EPSF);
            const float* w = p.c_norm_w + layer * 512 + c0;
#pragma unroll
            for (int e = 0; e < 8; ++e) y[e] = o[e] * rs * w[e] * (z[e] / (1.0f + FEXP(-z[e])));
            *(U4*)(v.Y + ((size_t)2 * MT + m) * 512 + c0) = pack8(y); }
    }
}

DEVI void phase_final(const Ctx& cx, const Params& p) {
    const int wave = RFL(cx.tid >> 6), lane = cx.tid & 63;
    for (int m = wave * cx.nblk + cx.bid; m < ML; m += 8 * cx.nblk) {
        float* xr = p.out + (size_t)m * DM; f32x4 xv[4]; float ss = 0.f;
#pragma unroll
        for (int j = 0; j < 4; ++j) { xv[j] = ldg4(xr + 256 * j + 4 * lane); ss += xv[j][0] * xv[j][0] + xv[j][1] * xv[j][1] + xv[j][2] * xv[j][2] + xv[j][3] * xv[j][3]; }
        ss = wave_sum(ss, lane);
        const float r = 1.0f / sqrtf(ss * (1.0f / DM) + EPSF);
#pragma unroll
        for (int j = 0; j < 4; ++j) { const f32x4 w4 = ldg4(p.final_norm_w + 256 * j + 4 * lane); f32x4 o4;
#pragma unroll
            for (int e = 0; e < 4; ++e) o4[e] = xv[j][e] * r * w4[e];
            stg4(xr + 256 * j + 4 * lane, o4); }
    }
}

DEVI bf16x8 ld8g(const bf16_t* p) { bf16x8 v; __builtin_memcpy(&v, p, 16); return v; }
DEVI bf16x8 ld8l(LQ const unsigned char* p) { return *(LQ const bf16x8*)p; }
DEVI bf16x8 ld44l(LQ const unsigned char* p) { i64x2 t; t[0] = *(LQ const long long*)p; t[1] = *(LQ const long long*)(p + 32); return __builtin_bit_cast(bf16x8, t); }
DEVI f32x4 ld4fl(LQ const unsigned char* p) { return *(LQ const f32x4*)p; }
DEVI bf16x8 packb(const f32x4& x0, const f32x4& x1) { u32x4 t; t[0] = pk2(x0[0], x0[1]); t[1] = pk2(x0[2], x0[3]); t[2] = pk2(x1[0], x1[1]); t[3] = pk2(x1[2], x1[3]); return __builtin_bit_cast(bf16x8, t); }
DEVI float wave_incl_scan(float v, int lane) {
#pragma unroll
    for (int d = 1; d < 64; d <<= 1) { const float t = shfl_f(v, lane - d < 0 ? 0 : lane - d); if (lane >= d) v += t; }
    return v;
}
DEVI int chain_row0(int b, int dir, int n) {
    if (n < NCH_C) { const int c = dir ? NCH_C - 1 - n : n; return ML + b * CTXL + 64 * c; }
    int c = n - NCH_C; if (dir) c = NCH_L - 1 - c; return b * SEQ + 64 * c;
}

constexpr int TM_WAVE_BYTES = 16384 + 512;
DEVI void phase_tmat(const Ctx& cx, const Params& p, LQ unsigned char* lds, int layer) {
    const Views v = make_views(p.ws);
    const int wave = RFL(cx.tid >> 6), lane = cx.tid & 63, q = lane >> 4, c = lane & 15;
    LQ unsigned char* wl = lds + wave * TM_WAVE_BYTES;
    LQ float* Am = (LQ float*)wl; LQ float* tab = (LQ float*)(wl + 16384);
    const int nitem = (MT / 64) * 8;
    for (int item = wave * cx.nblk + cx.bid; item < nitem; item += 8 * cx.nblk) {
        const int gchunk = item >> 3, h = (item >> 1) & 3, dir = item & 1; const size_t m0 = (size_t)gchunk * 64;
        { const size_t m = m0 + (dir ? 63 - lane : lane); const float g = v.G[m * 8 + dir * 4 + h], be = v.BETA[m * 8 + dir * 4 + h];
          const float gc = wave_incl_scan(g, lane); tab[lane] = gc; tab[64 + lane] = be; v.GC[m * 8 + dir * 4 + h] = gc; }
        bf16x8 fr[4][4];
#pragma unroll
        for (int t = 0; t < 4; ++t) { const int row = 16 * t + c; const size_t m = m0 + (dir ? 63 - row : row);
#pragma unroll
            for (int s2 = 0; s2 < 4; ++s2) fr[t][s2] = ld8g(v.AQKV + m * 1536 + 512 + h * 128 + 32 * s2 + 8 * q); }
        WSYNC();
#pragma unroll
        for (int it = 0; it < 4; ++it)
#pragma unroll
            for (int jt = 0; jt <= it; ++jt) {
                f32x4 acc = {0.f, 0.f, 0.f, 0.f};
#pragma unroll
                for (int s2 = 0; s2 < 4; ++s2) acc = MFMA16(fr[it][s2], fr[jt][s2], acc);
                const int col = 16 * jt + c; const float gcol = tab[col];
#pragma unroll
                for (int r = 0; r < 4; ++r) { const int row = 16 * it + 4 * q + r;
                    Am[row * 64 + col] = row > col ? tab[64 + row] * acc[r] * FEXP(tab[row] - gcol) : 0.f; }
            }
        WSYNC();
        float x[64];
#pragma unroll
        for (int i = 0; i < 64; ++i) {
            float sacc = (i == lane) ? 1.f : 0.f;
#pragma unroll
            for (int j4 = 0; j4 < (i + 3) / 4; ++j4) { const f32x4 a4 = ld4fl((LQ const unsigned char*)(Am + i * 64 + j4 * 4));
#pragma unroll
                for (int e = 0; e < 4; ++e) if (4 * j4 + e < i) sacc -= a4[e] * x[4 * j4 + e]; }
            x[i] = sacc;
        }
        WSYNC();
        LQ bf16_t* Ti = (LQ bf16_t*)wl;
#pragma unroll
        for (int i = 0; i < 64; ++i) Ti[i * 64 + lane] = f2bf(x[i]);
        WSYNC();
        bf16_t* Tg = v.T + (size_t)item * 4096;
#pragma unroll
        for (int j = 0; j < 8; ++j) { const int piece = lane + 64 * j; *(U4*)(Tg + piece * 8) = ld16l(wl + piece * 16); }
        WSYNC();
    }
}

constexpr int SC_KB = 0, SC_QB = 17408, SC_TB = 34816, SC_PB = 44032, SC_VB = 53248, SC_SC = 62464, SC_BUF = 63744;
template <int MIX, int PF = 0> DEVI void scan_chain(const Ctx& cx, const Params& p, const Views& v, LQ unsigned char* lds, int layer, const int DIR, int b, int h, int half) {
    const int tid = cx.tid, wave = RFL(tid >> 6), lane = tid & 63, q = lane >> 4, c = lane & 15;
    const bool helper = wave >= 4; const int ht = tid - 256;
    const bf16_t* QKV = MIX == 0 ? v.AQKV : v.CQKV; bf16_t* PARK = DIR == 0 ? (MIX == 0 ? v.PA : v.PC) : (MIX == 0 ? v.PAb[layer] : v.PCb[layer]);
    const int rx = DIR ? 63 : 0;
    const float lgam = MIX == 1 ? -softplusf_(-p.c_decay[layer * 8 + DIR * 4 + h]) : 0.f;
    U4 kreg[4], qreg[4], treg[2], vreg[2]; float breg = 1.f, greg = 0.f, bsc = 1.f;
    auto hload = [&](int n) {
        const size_t m0 = (size_t)chain_row0(b, DIR, n);
        const bf16_t* base = QKV + m0 * 1536 + h * 128;
#pragma unroll
        for (int j = 0; j < 4; ++j) { const int piece = ht + 256 * j, row = piece >> 4, c16 = piece & 15; const int off = (row ^ rx) * 1536 + c16 * 8;
            kreg[j] = *(const U4*)(base + 512 + off); qreg[j] = *(const U4*)(base + off); }
        if (MIX == 0) { const bf16_t* Tg = v.T + ((size_t)(m0 / 64) * 8 + h * 2 + DIR) * 4096;
#pragma unroll
            for (int j = 0; j < 2; ++j) treg[j] = *(const U4*)(Tg + (ht + 256 * j) * 8); }
#pragma unroll
        for (int j = 0; j < 2; ++j) { const int piece = ht + 256 * j, row = piece >> 3, c8 = piece & 7; vreg[j] = *(const U4*)(base + 1024 + 64 * half + (row ^ rx) * 1536 + c8 * 8); }
        if (MIX == 0 && wave == 4) { const size_t m = m0 + (ht ^ rx); greg = v.GC[m * 8 + DIR * 4 + h]; breg = v.BETA[m * 8 + DIR * 4 + h]; bsc = v.GC[(m0 + (63 ^ rx)) * 8 + DIR * 4 + h]; }
    };
    auto hwrite = [&](int bufi) {
        LQ unsigned char* B = lds + bufi * SC_BUF;
#pragma unroll
        for (int j = 0; j < 4; ++j) { const int piece = ht + 256 * j, row = piece >> 4, c16 = piece & 15;
            st16l(B + SC_KB + row * 272 + c16 * 16, kreg[j]); st16l(B + SC_QB + row * 272 + c16 * 16, qreg[j]); }
#pragma unroll
        for (int j = 0; j < 2; ++j) { const int piece = ht + 256 * j, row = piece >> 3, c8 = piece & 7;
            if (MIX == 0) st16l(B + SC_TB + row * 144 + c8 * 16, treg[j]);
            st16l(B + SC_VB + row * 144 + c8 * 16, vreg[j]); }
        if (wave == 4) { LQ float* sc = (LQ float*)(B + SC_SC);
            float Gc, g63;
            if (MIX == 0) { Gc = greg; g63 = bsc; } else { Gc = (float)(ht + 1) * lgam; g63 = 64.f * lgam; }
            const float Gam = FEXP(Gc);
            sc[ht] = -breg * Gam; sc[64 + ht] = Gam; sc[128 + ht] = FEXP(g63 - Gc); sc[192 + ht] = Gc; sc[256 + ht] = breg; }
    };
    auto ptile = [&](LQ unsigned char* B, int it, int jt, bool zr) {
        LQ const float* sc = (LQ const float*)(B + SC_SC);
        f32x4 acc = {0.f, 0.f, 0.f, 0.f};
#pragma unroll
        for (int s2 = 0; s2 < 4; ++s2) acc = MFMA16(ld8l(B + SC_QB + (16 * it + c) * 272 + (32 * s2 + 8 * q) * 2), ld8l(B + SC_KB + (16 * jt + c) * 272 + (32 * s2 + 8 * q) * 2), acc);
        const int col = 16 * jt + c; const float gcol = sc[192 + col];
        const f32x4 grow = ld4fl(B + SC_SC + (192 + 16 * it + 4 * q) * 4);
#pragma unroll
        for (int r = 0; r < 4; ++r) { const int row = 16 * it + 4 * q + r;
            *(LQ bf16_t*)(B + SC_PB + row * 144 + col * 2) = f2bf(row >= col ? acc[r] * FEXP(grow[r] - gcol) : 0.f);
            if (zr) *(LQ bf16_t*)(B + SC_PB + row * 144 + (col + 16) * 2) = 0; }
    };
    auto hscore = [&](int bufi) {
        LQ unsigned char* B = lds + bufi * SC_BUF;
        if (wave == 4) { ptile(B, 0, 0, true); ptile(B, 1, 1, false); }
        else if (wave == 5) { ptile(B, 1, 0, false); ptile(B, 2, 2, true); ptile(B, 3, 3, false); }
        else if (wave == 6) { ptile(B, 2, 0, false); ptile(B, 2, 1, false); ptile(B, 3, 2, false); }
        else { ptile(B, 3, 0, false); ptile(B, 3, 1, false); }
    };
    LQ unsigned* hcnt = (LQ unsigned*)(lds + 2 * SC_BUF);
    if (tid == 256) *hcnt = 0u;
    LSYNC();
    if (helper) {
        unsigned htarget = 0u;
        auto hmeet = [&]() { LDSWAIT(); WSYNC(); htarget += 4u; if (lane == 0) lds_inc(hcnt); while (lds_peek(hcnt) < htarget) SPIN_YIELD(); CFENCE(); };
        hload(0); hwrite(0); hmeet(); hscore(0); if (NSTEP > 1) hload(1);
        LSYNC();
        for (int n = 0; n < NSTEP; ++n) {
            if (n + 1 < NSTEP) { hwrite((n + 1) & 1); hmeet(); hscore((n + 1) & 1); }
            if (n + 2 < NSTEP && !(PF & 1)) hload(n + 2);
            LSYNC();
        }
    } else {
        f32x4 St[8];
#pragma unroll
        for (int t = 0; t < 8; ++t) St[t] = (f32x4){0.f, 0.f, 0.f, 0.f};
        const int arow = 8 * (c >> 2) + (c & 3);
        LSYNC();
        for (int n = 0; n < NSTEP; ++n) {
            LQ unsigned char* B = lds + (n & 1) * SC_BUF; LQ const float* sc = (LQ const float*)(B + SC_SC);
            f32x4 o[4], vn[4];
            if (PF & 8) { LSYNC(); continue; }
            {
                bf16x8 Sb[4];
#pragma unroll
                for (int s2 = 0; s2 < 4; ++s2) Sb[s2] = packb(St[2 * s2], St[2 * s2 + 1]);
                f32x4 R[4];
                bf16x8 fq[2][4], fk[2][4];
#pragma unroll
                for (int s2 = 0; s2 < 4; ++s2) { const int off = arow * 272 + (32 * s2 + 8 * q) * 2; fq[0][s2] = ld8l(B + SC_QB + off); if (MIX == 0) fk[0][s2] = ld8l(B + SC_KB + off); }
#pragma unroll
                for (int i = 0; i < 4; ++i) {
                    if (i < 3) {
#pragma unroll
                        for (int s2 = 0; s2 < 4; ++s2) { const int off = (32 * ((i + 1) >> 1) + 4 * ((i + 1) & 1) + arow) * 272 + (32 * s2 + 8 * q) * 2; fq[(i + 1) & 1][s2] = ld8l(B + SC_QB + off); if (MIX == 0) fk[(i + 1) & 1][s2] = ld8l(B + SC_KB + off); } }
                    const int r0 = 32 * (i >> 1) + 8 * q + 4 * (i & 1);
                    const f32x4 Gm = ld4fl(B + SC_SC + (64 + r0) * 4);
                    const s16x4 vraw = trread(B + SC_VB + (r0 + (c >> 2)) * 144 + (16 * wave + 4 * (c & 3)) * 2);
                    f32x4 Vt; Vt[0] = bf2f((bf16_t)vraw[0]); Vt[1] = bf2f((bf16_t)vraw[1]); Vt[2] = bf2f((bf16_t)vraw[2]); Vt[3] = bf2f((bf16_t)vraw[3]);
                    f32x4 a4 = {0.f, 0.f, 0.f, 0.f}; if (MIX == 0) { a4 = ld4fl(B + SC_SC + r0 * 4); Vt = Vt * ld4fl(B + SC_SC + (256 + r0) * 4); }
                    f32x4 aK = {0.f, 0.f, 0.f, 0.f}, aQ = {0.f, 0.f, 0.f, 0.f};
                    SCHEDB();
#pragma unroll
                    for (int s2 = 0; s2 < 4; ++s2) { aQ = MFMA16(fq[i & 1][s2], Sb[s2], aQ); if (MIX == 0) aK = MFMA16(fk[i & 1][s2], Sb[s2], aK); }
                    SCHEDB();
                    o[i] = Gm * aQ;
                    if (MIX == 0) R[i] = Vt + a4 * aK; else vn[i] = Vt;
                }
                if (MIX == 0) {
                    bf16x8 Rb[2]; Rb[0] = packb(R[0], R[1]); Rb[1] = packb(R[2], R[3]);
                    bf16x8 tf[6];
                    tf[0] = ld8l(B + SC_TB + arow * 144 + (8 * q) * 2); tf[1] = ld8l(B + SC_TB + (4 + arow) * 144 + (8 * q) * 2);
                    tf[2] = ld8l(B + SC_TB + (32 + arow) * 144 + (8 * q) * 2); tf[3] = ld8l(B + SC_TB + (32 + arow) * 144 + (32 + 8 * q) * 2);
                    tf[4] = ld8l(B + SC_TB + (36 + arow) * 144 + (8 * q) * 2); tf[5] = ld8l(B + SC_TB + (36 + arow) * 144 + (32 + 8 * q) * 2);
                    const f32x4 z4 = {0.f, 0.f, 0.f, 0.f};
                    SCHEDB();
                    vn[0] = MFMA16(tf[0], Rb[0], z4); vn[1] = MFMA16(tf[1], Rb[0], z4);
                    vn[2] = MFMA16(tf[3], Rb[1], MFMA16(tf[2], Rb[0], z4)); vn[3] = MFMA16(tf[5], Rb[1], MFMA16(tf[4], Rb[0], z4));
                }
            }
            {
                bf16x8 vnb[2], veb[2];
                vnb[0] = packb(vn[0], vn[1]); vnb[1] = packb(vn[2], vn[3]);
                { f32x4 ve[4];
#pragma unroll
                  for (int i = 0; i < 4; ++i) ve[i] = ld4fl(B + SC_SC + (128 + 32 * (i >> 1) + 8 * q + 4 * (i & 1)) * 4) * vn[i];
                  veb[0] = packb(ve[0], ve[1]); veb[1] = packb(ve[2], ve[3]); }
                { bf16x8 pf[6];
                  pf[0] = ld8l(B + SC_PB + arow * 144 + (8 * q) * 2); pf[1] = ld8l(B + SC_PB + (4 + arow) * 144 + (8 * q) * 2);
                  pf[2] = ld8l(B + SC_PB + (32 + arow) * 144 + (8 * q) * 2); pf[3] = ld8l(B + SC_PB + (32 + arow) * 144 + (32 + 8 * q) * 2);
                  pf[4] = ld8l(B + SC_PB + (36 + arow) * 144 + (8 * q) * 2); pf[5] = ld8l(B + SC_PB + (36 + arow) * 144 + (32 + 8 * q) * 2);
                  SCHEDB();
                  o[0] = MFMA16(pf[0], vnb[0], o[0]); o[1] = MFMA16(pf[1], vnb[0], o[1]);
                  o[2] = MFMA16(pf[3], vnb[1], MFMA16(pf[2], vnb[0], o[2])); o[3] = MFMA16(pf[5], vnb[1], MFMA16(pf[4], vnb[0], o[3])); }
                const float g63 = sc[64 + 63];
#pragma unroll
                for (int tp = 0; tp < 8; tp += 4) {
                    s16x4 lo[4][2], hi[4][2];
#pragma unroll
                    for (int t = 0; t < 4; ++t)
#pragma unroll
                        for (int s2 = 0; s2 < 2; ++s2) { const int colb = (32 * ((tp + t) >> 1) + 8 * (c & 3) + 4 * ((tp + t) & 1)) * 2;
                            lo[t][s2] = trread(B + SC_KB + (32 * s2 + 8 * q + (c >> 2)) * 272 + colb);
                            hi[t][s2] = trread(B + SC_KB + (32 * s2 + 8 * q + 4 + (c >> 2)) * 272 + colb); }
                    SCHEDB();
#pragma unroll
                    for (int t = 0; t < 4; ++t) { f32x4 acc = St[tp + t] * g63;
#pragma unroll
                        for (int s2 = 0; s2 < 2; ++s2) { bf16x8 kt; kt[0] = lo[t][s2][0]; kt[1] = lo[t][s2][1]; kt[2] = lo[t][s2][2]; kt[3] = lo[t][s2][3]; kt[4] = hi[t][s2][0]; kt[5] = hi[t][s2][1]; kt[6] = hi[t][s2][2]; kt[7] = hi[t][s2][3];
                            acc = MFMA16(kt, veb[s2], acc); }
                        St[tp + t] = acc; }
                }
                const size_t m0 = (size_t)chain_row0(b, DIR, n);
                if (!(DIR == 1 && layer == NLAYER - 1 && n < NCH_C))
#pragma unroll
                for (int i = 0; i < 4; ++i)
#pragma unroll
                    for (int r = 0; r < 4; ++r) { const int row = 32 * (i >> 1) + 8 * q + 4 * (i & 1) + r; const size_t m = m0 + (row ^ rx);
                        bf16_t* pp = PARK + m * 512 + h * 128 + 64 * half + 16 * wave + c;
                        if (!(PF & 2)) *pp = f2bf(o[i][r]); else if (o[i][r] == 12345.678f) *pp = 0; }
            }
            LSYNC();
        }
    }
}
template <int PF = 0> DEVI void phase_scan(const Ctx& cx, const Params& p, LQ unsigned char* lds, int layer) {
    const Views v = make_views(p.ws, p.out);
    const int nitem = 2 * NB * 4 * 2;
    for (int item = cx.bid; item < nitem; item += cx.nblk) scan_chain<0, PF>(cx, p, v, lds, layer, item / (8 * NB), (item >> 3) % NB, (item >> 1) & 3, item & 1);
    CFENCE();
    for (int item = (cx.bid + cx.nblk - (nitem % cx.nblk)) % cx.nblk; item < nitem; item += cx.nblk) scan_chain<1, PF>(cx, p, v, lds, layer, item / (8 * NB), (item >> 3) % NB, (item >> 1) & 3, item & 1);
}

constexpr int AT_V = 9216, AT_BUF = 18432;
template <bool CTXQ, int PRB = 0> DEVI void attn_unit(const Ctx& cx, const Params& p, const Views& v, LQ unsigned char* lds, int layer, int b, int hkv, int blk) {
    const int tid = cx.tid, wave = RFL(tid >> 6), lane = tid & 63, q = lane >> 4, c = lane & 15;
    const int g = wave >> 1, rh = wave & 1, hq = 4 * hkv + g;
    const size_t mq0 = (CTXQ ? (size_t)ML + (size_t)b * CTXL : (size_t)b * SEQ) + 64 * blk + 32 * rh;
    bf16x8 qf[2][2];
#pragma unroll
    for (int i = 0; i < 2; ++i)
#pragma unroll
        for (int s2 = 0; s2 < 2; ++s2) qf[i][s2] = ld8g(v.BQ + (mq0 + 16 * i + c) * 512 + hq * 64 + 32 * s2 + 8 * q);
    const int wlo = CTXQ ? 0 : (2 - blk > 0 ? 2 - blk : 0), whi = CTXQ ? 0 : (NCH_L + 2 - blk < 5 ? NCH_L + 2 - blk : 5);
    const int ntile = NCH_C + (whi - wlo);
    const int lrow = tid >> 3, lpc = tid & 7;
    auto tile_row0 = [&](int j, int& tstart) -> size_t { if (j < NCH_C) { tstart = -100000; return (size_t)ML + (size_t)b * CTXL + 64 * j; } tstart = 64 * (blk - 2 + wlo + (j - NCH_C)); return (size_t)b * SEQ + tstart; };
    U4 kr0, vr0, kr1, vr1;
    auto tload = [&](int j, U4& kr, U4& vr) { int ts; const size_t r0 = tile_row0(j, ts); const bf16_t* src = v.BKV + (r0 + lrow) * 256 + hkv * 64 + lpc * 8; kr = *(const U4*)src; vr = *(const U4*)(src + 128); };
    auto twrite = [&](int bufi, const U4& kr, const U4& vr) { LQ unsigned char* B = lds + bufi * AT_BUF; st16l(B + lrow * 144 + lpc * 16, kr); st16l(B + AT_V + lrow * 144 + lpc * 16, vr); };
    float mrun[2], lrun[2]; f32x4 ot[4][2];
    mrun[0] = mrun[1] = p.b_sink[layer * 8 + hq]; lrun[0] = lrun[1] = 1.0f;
#pragma unroll
    for (int dt = 0; dt < 4; ++dt) { ot[dt][0] = (f32x4){0.f, 0.f, 0.f, 0.f}; ot[dt][1] = (f32x4){0.f, 0.f, 0.f, 0.f}; }
    SYNC();
    tload(0, kr0, vr0); twrite(0, kr0, vr0); if (ntile > 1) tload(1, kr1, vr1);
    SYNC();
    auto tile_step = [&](int j, U4& kl, U4& vl, const U4& kw, const U4& vw) {
        LQ unsigned char* B = lds + (j & 1) * AT_BUF;
        if (j + 2 < ntile) tload(j + 2, kl, vl);
        int tstart; (void)tile_row0(j, tstart);
        f32x4 st[4][2];
#pragma unroll
        for (int kt = 0; kt < 4; ++kt) {
            const bf16x8 k0 = ld8l(B + (16 * kt + c) * 144 + (8 * q) * 2), k1 = ld8l(B + (16 * kt + c) * 144 + (32 + 8 * q) * 2);
#pragma unroll
            for (int i = 0; i < 2; ++i) { f32x4 acc = {0.f, 0.f, 0.f, 0.f}; acc = MFMA16(k0, qf[i][0], acc); acc = MFMA16(k1, qf[i][1], acc); st[kt][i] = acc * 0.125f; }
        }
        if (j >= NCH_C) {
#pragma unroll
            for (int i = 0; i < 2; ++i) { const int tq = 64 * blk + 32 * rh + 16 * i + c;
#pragma unroll
                for (int kt = 0; kt < 4; ++kt)
#pragma unroll
                    for (int r = 0; r < 4; ++r) { const int d = tstart + 16 * kt + 4 * q + r - tq; if (d > 128 || d < -128) st[kt][i][r] = -INFINITY; } }
        }
        bf16x8 pb[2][2];
#pragma unroll
        for (int i = 0; i < 2; ++i) {
            float mx = st[0][i][0];
#pragma unroll
            for (int kt = 0; kt < 4; ++kt)
#pragma unroll
                for (int r = 0; r < 4; ++r) mx = fmaxf(mx, st[kt][i][r]);
            mx = fmaxf(mx, shfl_f(mx, lane ^ 16)); mx = fmaxf(mx, shfl_f(mx, lane ^ 32));
            const float mnew = fmaxf(mrun[i], mx), alpha = FEXP(mrun[i] - mnew);
            float ls = 0.f;
#pragma unroll
            for (int kt = 0; kt < 4; ++kt)
#pragma unroll
                for (int r = 0; r < 4; ++r) { const float e = FEXP(st[kt][i][r] - mnew); st[kt][i][r] = e; ls += e; }
            ls += shfl_f(ls, lane ^ 16); ls += shfl_f(ls, lane ^ 32);
            lrun[i] = lrun[i] * alpha + ls; mrun[i] = mnew;
#pragma unroll
            for (int dt = 0; dt < 4; ++dt) ot[dt][i] = ot[dt][i] * alpha;
            pb[i][0] = packb(st[0][i], st[1][i]); pb[i][1] = packb(st[2][i], st[3][i]);
        }
#pragma unroll
        for (int dt = 0; dt < 4; ++dt)
#pragma unroll
            for (int ks = 0; ks < 2; ++ks) {
                const s16x4 lo = trread(B + AT_V + (32 * ks + 4 * q + (c >> 2)) * 144 + (16 * dt + 4 * (c & 3)) * 2);
                const s16x4 hi = trread(B + AT_V + (32 * ks + 16 + 4 * q + (c >> 2)) * 144 + (16 * dt + 4 * (c & 3)) * 2);
                bf16x8 vt; vt[0] = lo[0]; vt[1] = lo[1]; vt[2] = lo[2]; vt[3] = lo[3]; vt[4] = hi[0]; vt[5] = hi[1]; vt[6] = hi[2]; vt[7] = hi[3];
                ot[dt][0] = MFMA16(vt, pb[0][ks], ot[dt][0]); ot[dt][1] = MFMA16(vt, pb[1][ks], ot[dt][1]);
            }
        if (j + 1 < ntile) twrite((j + 1) & 1, kw, vw);
        SYNC();
    };
    for (int j = 0; j < ntile; j += 2) { tile_step(j, kr0, vr0, kr1, vr1); if (j + 1 < ntile) tile_step(j + 1, kr1, vr1, kr0, vr0); }
#pragma unroll
    for (int i = 0; i < 2; ++i) { const float il = 1.0f / lrun[i];
#pragma unroll
        for (int dt = 0; dt < 4; ++dt) { const f32x4 o4 = ot[dt][i] * il;
            unsigned long long w = (unsigned long long)pk2(o4[0], o4[1]) | ((unsigned long long)pk2(o4[2], o4[3]) << 32);
            *(unsigned long long*)((PRB ? v.PA : v.BQ) + (mq0 + 16 * i + c) * 512 + hq * 64 + 16 * dt + 4 * q) = w; } }
}
template <int PRB = 0> DEVI void phase_attn(const Ctx& cx, const Params& p, LQ unsigned char* lds, int layer) {
    const Views v = make_views(p.ws);
    const int nlat = NB * 2 * NCH_L, nctx = layer == 0 ? NB * 2 * NCH_C : 0;
    for (int item = cx.bid; item < nlat + nctx; item += cx.nblk) {
        if (item < nlat) attn_unit<false, PRB>(cx, p, v, lds, layer, item / (2 * NCH_L), (item / NCH_L) & 1, item % NCH_L);
        else { const int it = item - nlat; attn_unit<true, PRB>(cx, p, v, lds, layer, it / (2 * NCH_C), (it / NCH_C) & 1, it % NCH_C); }
    }
}

struct StG1 { bf16_t *AQKV, *BQ, *BKV, *CQKV, *HALO;
    DEVI void st8(int row, int col, const float* a) const {
        bf16_t* dst = col < 1536 ? AQKV + (size_t)row * 1536 + col : (col < 2048 ? BQ + (size_t)row * 512 + (col - 1536) : (col < 2304 ? BKV + (size_t)row * 256 + (col - 2048) : CQKV + (size_t)row * 1536 + (col - 2304)));
        const U4 w = pack8(a); *(U4*)dst = w;
        const int r64 = row & 63;
        if (col < 1536 && (r64 < 2 || r64 >= 62)) *(U4*)(HALO + ((size_t)(row >> 6) * 4 + (r64 < 2 ? r64 : r64 - 60)) * 1536 + col) = w; } };
struct StPlain { bf16_t* O; int ld;
    DEVI void st8(int row, int col, const float* a) const { *(U4*)(O + (size_t)row * ld + col) = pack8(a); } };
struct StMerge { const bf16_t* L; bf16_t* MRG; int br;
    DEVI void st8(int row, int col, const float* a) const {
        float lg[8], o[8]; unpack8(*(const U4*)(L + (size_t)row * NMG + br * 1024 + col), lg);
        if (br) unpack8(*(const U4*)(MRG + (size_t)row * DM + col), o); else { for (int e = 0; e < 8; ++e) o[e] = 0.f; }
        for (int e = 0; e < 8; ++e) o[e] += sigmoidf_(lg[e]) * a[e];
        *(U4*)(MRG + (size_t)row * DM + col) = pack8(o); }
    static constexpr bool HAS_LD = true;
    DEVI void ld8(int row, int col, U4& x0, U4& x1) const { x0 = *(const U4*)(L + (size_t)row * NMG + br * 1024 + col); if (br) x1 = *(const U4*)(MRG + (size_t)row * DM + col); else x1 = U4{0u, 0u, 0u, 0u}; }
    DEVI void fin8(int row, int col, const float* a, const U4& x0, const U4& x1) const {
        float lg[8], o[8]; unpack8(x0, lg); unpack8(x1, o);
        for (int e = 0; e < 8; ++e) o[e] += a[e] / (1.0f + FEXP(-lg[e]));
        *(U4*)(MRG + (size_t)row * DM + col) = pack8(o); } };
struct StMerge3 { const bf16_t* L; bf16_t* MRG;
    DEVI void st8(int row, int col, const float* a) const { const int br = col >> 10; StMerge{L, MRG, br}.st8(row - br * MT, col & 1023, a); }
    DEVI void ld8(int row, int col, U4& x0, U4& x1) const { const int br = col >> 10, r = row - br * MT, c = col & 1023; x0 = *(const U4*)(L + (size_t)r * NMG + br * 1024 + c); if (br) x1 = *(const U4*)(MRG + (size_t)r * DM + c); else x1 = U4{0u, 0u, 0u, 0u}; }
    DEVI void fin8(int row, int col, const float* a, const U4& x0, const U4& x1) const { const int br = col >> 10; StMerge{L, MRG, br}.fin8(row - br * MT, col & 1023, a, x0, x1); } };
struct StResid { const float *xlat, *xctx; float *olat, *octx; const float* mod;
    DEVI void st4(int row, int col, const float* a) const {
        const float* xi = row < ML ? xlat + (size_t)row * DM + col : xctx + (size_t)(row - ML) * DM + col;
        float* xo = row < ML ? olat + (size_t)row * DM + col : octx + (size_t)(row - ML) * DM + col;
        const int b = row < ML ? row / SEQ : NB; const float* g = mod + (size_t)b * 3072 + 2048 + col;
        for (int e = 0; e < 4; ++e) xo[e] = xi[e] + g[e] * a[e]; }
    DEVI f32x4 ldx(int row, int col) const { return ldg4(row < ML ? xlat + (size_t)row * DM + col : xctx + (size_t)(row - ML) * DM + col); }
    DEVI f32x4 ldgate(int row, int col) const { const int b = row < ML ? row / SEQ : NB; return ldg4(mod + (size_t)b * 3072 + 2048 + col); }
    DEVI void fin4(int row, int col, const f32x4& acc, const f32x4& x, const f32x4& g) const { stg4(row < ML ? olat + (size_t)row * DM + col : octx + (size_t)(row - ML) * DM + col, x + g * acc); } };

#ifndef CPU_EMU
namespace pg8 {
#define PG8_LAS __attribute__((address_space(3)))
typedef short bf16x8 __attribute__((ext_vector_type(8)));
typedef float f32x4 __attribute__((ext_vector_type(4)));
constexpr int BM = 256, BK = 64, HALF = 128, HTB = HALF * BK * 2, STAGE_BYTES = 8 * HTB, NXCD = 8, WGM = 8;
__host__ __device__ __forceinline__ int lds_byte(int r, int c) { const int st = (r >> 4) * 2 + (c >> 5), rr = r & 15, cc = c & 31, ob = rr * 64 + cc * 2; return st * 1024 + (ob ^ (((ob >> 9) & 1) << 5)); }
__host__ __device__ __forceinline__ void stage_rc(int b, int& R, int& C) { const int st = b / 1024, sb = b % 1024, swz = sb ^ (((sb >> 9) & 1) << 5); R = (st >> 1) * 16 + swz / 64; C = (st & 1) * 32 + (swz % 64) / 2; }
__host__ __device__ __forceinline__ int perm32(int rho) { const int n = rho >> 4, i = rho & 15; return 8 * (i >> 2) + 4 * n + (i & 3); }
struct Unit { int pm, pn; };
struct Gemm { const bf16_t* A; const bf16_t* Bt; int M, N, K; };
struct StaticOrder {
    int nM, nN, nwg, G, c;
    __host__ __device__ void init(int M, int N, int G_, int c_) { nM = M / BM; nN = N / BM; nwg = nM * nN; G = G_; c = c_; }
    __host__ __device__ bool next(int i, Unit& u) const {
        const long L = (long)i * G + c; if (L >= nwg) return false;
        int wgid = (int)L; { const int q = nwg / NXCD, r = nwg % NXCD, xcd = wgid % NXCD, off = wgid / NXCD; wgid = (xcd < r ? xcd * (q + 1) : r * (q + 1) + (xcd - r) * q) + off; }
        const int nig = WGM * nN, gid = wgid / nig, fm = gid * WGM, gsz = (nM - fm) < WGM ? (nM - fm) : WGM;
        u.pm = fm + ((wgid % nig) % gsz); u.pn = (wgid % nig) / gsz; return true;
    }
    __device__ __forceinline__ void a_ready(const Unit&) const {}
    __device__ __forceinline__ void done(const Unit&) const {}
};
struct BranchOrder {
    StaticOrder so;
    __host__ __device__ void init(int M, int G_, int c_) { so.init(M, 1024, G_, c_); }
    __host__ __device__ bool next(int i, Unit& u) const { Unit t; if (!so.next(i / 3, t)) return false; const int br = i % 3; u.pm = br * (MT / 256) + t.pm; u.pn = br * 4 + t.pn; return true; }
    __device__ __forceinline__ void a_ready(const Unit&) const {}
    __device__ __forceinline__ void done(const Unit&) const {}
};
template <class F> struct Epi8 {
    static constexpr bool PERM = true, AFTER_DRAIN = false, CARRY = false; F f;
    __device__ __forceinline__ void operator()(const f32x4 (&acc)[2][2][4][2], const Unit& u, int wr, int wc, int fr, int fq) const {
        const int row0 = u.pm * BM + wr * 64 + fr, col0 = u.pn * BM + wc * 32 + 8 * fq;
#pragma unroll
        for (int ai = 0; ai < 2; ++ai)
#pragma unroll
            for (int m = 0; m < 4; ++m)
#pragma unroll
                for (int bj = 0; bj < 2; ++bj) { const f32x4 v0 = acc[ai][bj][m][0], v1 = acc[ai][bj][m][1];
                    const float a[8] = {v0[0], v0[1], v0[2], v0[3], v1[0], v1[1], v1[2], v1[3]};
                    f.st8(row0 + ai * HALF + m * 16, col0 + bj * HALF, a); }
    }
};
template <class F> struct Epi8L {
    static constexpr bool PERM = true, AFTER_DRAIN = false, CARRY = false; F f;
    __device__ __forceinline__ void operator()(const f32x4 (&acc)[2][2][4][2], const Unit& u, int wr, int wc, int fr, int fq) const {
        const int row0 = u.pm * BM + wr * 64 + fr, col0 = u.pn * BM + wc * 32 + 8 * fq;
#pragma unroll
        for (int ai = 0; ai < 2; ++ai) {
            U4 x0[4][2], x1[4][2];
#pragma unroll
            for (int m = 0; m < 4; ++m)
#pragma unroll
                for (int bj = 0; bj < 2; ++bj) f.ld8(row0 + ai * HALF + m * 16, col0 + bj * HALF, x0[m][bj], x1[m][bj]);
#pragma unroll
            for (int m = 0; m < 4; ++m)
#pragma unroll
                for (int bj = 0; bj < 2; ++bj) { const f32x4 v0 = acc[ai][bj][m][0], v1 = acc[ai][bj][m][1];
                    const float a[8] = {v0[0], v0[1], v0[2], v0[3], v1[0], v1[1], v1[2], v1[3]};
                    f.fin8(row0 + ai * HALF + m * 16, col0 + bj * HALF, a, x0[m][bj], x1[m][bj]); }
        }
    }
};
struct SigTileStore { bf16_t* LT;
    __device__ __forceinline__ void st(const Unit& u, int slot, const float* a) const {
        float o[8];
#pragma unroll
        for (int e = 0; e < 8; ++e) o[e] = 1.0f / (1.0f + __expf(-a[e]));
        *(U4*)(LT + (((size_t)(u.pm * 12 + u.pn) * 8192 + slot) << 3)) = pack8(o); } };
template <class F> struct Epi8T {
    static constexpr bool PERM = true, AFTER_DRAIN = false, CARRY = false; F f;
    __device__ __forceinline__ void operator()(const f32x4 (&acc)[2][2][4][2], const Unit& u, int wr, int wc, int fr, int fq) const {
        int wl = (wr * 4 + wc) * 64 + fq * 16 + fr; asm volatile("" : "+v"(wl));
#pragma unroll
        for (int ai = 0; ai < 2; ++ai)
#pragma unroll
            for (int m = 0; m < 4; ++m)
#pragma unroll
                for (int bj = 0; bj < 2; ++bj) { const f32x4 v0 = acc[ai][bj][m][0], v1 = acc[ai][bj][m][1];
                    const float a[8] = {v0[0], v0[1], v0[2], v0[3], v1[0], v1[1], v1[2], v1[3]};
                    f.st(u, ((ai * 4 + m) * 2 + bj) * 512 + wl, a); }
    }
};
struct MergeTile { const bf16_t* LT; bf16_t* SCR; bf16_t* MRG; };
struct Epi8M {
    static constexpr bool PERM = true, AFTER_DRAIN = false, CARRY = false; MergeTile f;
    __device__ __forceinline__ void operator()(const f32x4 (&acc)[2][2][4][2], const Unit& u, int wr, int wc, int fr, int fq) const {
        const int br = u.pn >> 2, pm = u.pm - br * (MT / 256), pn = u.pn & 3;
        int wl = (wr * 4 + wc) * 64 + fq * 16 + fr; asm volatile("" : "+v"(wl));
        int row0 = pm * BM + wr * 64 + fr, col0 = pn * BM + wc * 32 + 8 * fq; asm volatile("" : "+v"(row0), "+v"(col0));
        const bf16_t* lt = f.LT + (((size_t)(pm * 12 + u.pn) * 8192) << 3);
#pragma unroll
        for (int ai = 0; ai < 2; ++ai) {
            U4 x0[4][2], x1[4][2];
#pragma unroll
            for (int m = 0; m < 4; ++m)
#pragma unroll
                for (int bj = 0; bj < 2; ++bj) { const int slot = ((ai * 4 + m) * 2 + bj) * 512 + wl;
                    x0[m][bj] = *(const U4*)(lt + ((size_t)slot << 3));
                    if (br) x1[m][bj] = *(const U4*)(f.SCR + ((size_t)slot << 3)); else x1[m][bj] = U4{0u, 0u, 0u, 0u}; }
#pragma unroll
            for (int m = 0; m < 4; ++m)
#pragma unroll
                for (int bj = 0; bj < 2; ++bj) { const f32x4 v0 = acc[ai][bj][m][0], v1 = acc[ai][bj][m][1];
                    const float a[8] = {v0[0], v0[1], v0[2], v0[3], v1[0], v1[1], v1[2], v1[3]};
                    float g[8], o[8]; unpack8(x0[m][bj], g); unpack8(x1[m][bj], o);
#pragma unroll
                    for (int e = 0; e < 8; ++e) o[e] += g[e] * a[e];
                    const int slot = ((ai * 4 + m) * 2 + bj) * 512 + wl;
                    if (br < 2) *(U4*)(f.SCR + ((size_t)slot << 3)) = pack8(o);
                    else *(U4*)(f.MRG + (size_t)(row0 + ai * HALF + m * 16) * DM + col0 + bj * HALF) = pack8(o); }
        }
    }
};
__device__ __forceinline__ void gate_scale(f32x4 (&acc)[2][2][4][2], const bf16_t* lt, int wl, bool recip) {
#pragma unroll
    for (int ai = 0; ai < 2; ++ai) {
        U4 g[4][2];
#pragma unroll
        for (int m = 0; m < 4; ++m)
#pragma unroll
            for (int bj = 0; bj < 2; ++bj) g[m][bj] = *(const U4*)(lt + ((size_t)(((ai * 4 + m) * 2 + bj) * 512 + wl) << 3));
#pragma unroll
        for (int m = 0; m < 4; ++m)
#pragma unroll
            for (int bj = 0; bj < 2; ++bj) { float f[8]; unpack8(g[m][bj], f);
                if (recip) {
#pragma unroll
                    for (int e = 0; e < 8; ++e) f[e] = __builtin_amdgcn_rcpf(fmaxf(f[e], 1e-12f)); }
                acc[ai][bj][m][0] = acc[ai][bj][m][0] * (f32x4){f[0], f[1], f[2], f[3]}; acc[ai][bj][m][1] = acc[ai][bj][m][1] * (f32x4){f[4], f[5], f[6], f[7]}; }
    }
}
struct EpiMergeCarry {
    static constexpr bool PERM = true, AFTER_DRAIN = false, CARRY = true; const bf16_t* LT; bf16_t* MRG;
    __device__ __forceinline__ bool carry(const Unit& u) const { return (u.pn >> 2) < 2; }
    __device__ __forceinline__ void operator()(f32x4 (&acc)[2][2][4][2], const Unit& u, int wr, int wc, int fr, int fq) const {
        const int br = u.pn >> 2, pm = u.pm - br * (MT / 256), pn = u.pn & 3;
        int wl = (wr * 4 + wc) * 64 + fq * 16 + fr; asm volatile("" : "+v"(wl));
        const bf16_t* lt = LT + (((size_t)(pm * 12 + u.pn) * 8192) << 3);
        if (br < 2) { gate_scale(acc, lt, wl, false); gate_scale(acc, lt + ((size_t)4 * 8192 << 3), wl, true); return; }
        int row0 = pm * BM + wr * 64 + fr, col0 = pn * BM + wc * 32 + 8 * fq; asm volatile("" : "+v"(row0), "+v"(col0));
#pragma unroll
        for (int ai = 0; ai < 2; ++ai) {
            U4 g[4][2];
#pragma unroll
            for (int m = 0; m < 4; ++m)
#pragma unroll
                for (int bj = 0; bj < 2; ++bj) g[m][bj] = *(const U4*)(lt + ((size_t)(((ai * 4 + m) * 2 + bj) * 512 + wl) << 3));
#pragma unroll
            for (int m = 0; m < 4; ++m)
#pragma unroll
                for (int bj = 0; bj < 2; ++bj) { float f[8], o[8]; unpack8(g[m][bj], f); const f32x4 v0 = acc[ai][bj][m][0], v1 = acc[ai][bj][m][1];
                    o[0] = v0[0] * f[0]; o[1] = v0[1] * f[1]; o[2] = v0[2] * f[2]; o[3] = v0[3] * f[3]; o[4] = v1[0] * f[4]; o[5] = v1[1] * f[5]; o[6] = v1[2] * f[6]; o[7] = v1[3] * f[7];
                    *(U4*)(MRG + (size_t)(row0 + ai * HALF + m * 16) * DM + col0 + bj * HALF) = pack8(o); }
        }
    }
};
template <class F> struct Epi4L {
    static constexpr bool PERM = false, AFTER_DRAIN = false, CARRY = false; F f;
    __device__ __forceinline__ void operator()(const f32x4 (&acc)[2][2][4][2], const Unit& u, int wr, int wc, int fr, int fq) const {
        const int row0 = u.pm * BM + wr * 64 + fr, col0 = u.pn * BM + wc * 32 + 4 * fq;
        f32x4 g[2][2];
#pragma unroll
        for (int bj = 0; bj < 2; ++bj)
#pragma unroll
            for (int n = 0; n < 2; ++n) g[bj][n] = f.ldgate(u.pm * BM, col0 + bj * HALF + n * 16);
#pragma unroll
        for (int ai = 0; ai < 2; ++ai) {
            f32x4 xr[4][2][2];
#pragma unroll
            for (int m = 0; m < 4; ++m)
#pragma unroll
                for (int bj = 0; bj < 2; ++bj)
#pragma unroll
                    for (int n = 0; n < 2; ++n) xr[m][bj][n] = f.ldx(row0 + ai * HALF + m * 16, col0 + bj * HALF + n * 16);
#pragma unroll
            for (int m = 0; m < 4; ++m)
#pragma unroll
                for (int bj = 0; bj < 2; ++bj)
#pragma unroll
                    for (int n = 0; n < 2; ++n) f.fin4(row0 + ai * HALF + m * 16, col0 + bj * HALF + n * 16, acc[ai][bj][m][n], xr[m][bj][n], g[bj][n]);
        }
    }
};
template <class F> struct Epi4 {
    static constexpr bool PERM = false, AFTER_DRAIN = false, CARRY = false; F f;
    __device__ __forceinline__ void operator()(const f32x4 (&acc)[2][2][4][2], const Unit& u, int wr, int wc, int fr, int fq) const {
        const int row0 = u.pm * BM + wr * 64 + fr, col0 = u.pn * BM + wc * 32 + 4 * fq;
#pragma unroll
        for (int ai = 0; ai < 2; ++ai)
#pragma unroll
            for (int m = 0; m < 4; ++m)
#pragma unroll
                for (int bj = 0; bj < 2; ++bj)
#pragma unroll
                    for (int n = 0; n < 2; ++n) { const f32x4 v0 = acc[ai][bj][m][n]; const float a[4] = {v0[0], v0[1], v0[2], v0[3]};
                        f.st4(row0 + ai * HALF + m * 16, col0 + bj * HALF + n * 16, a); }
    }
};

template <class Epi, class Sched, bool ALIGN_EPI = false, bool SP2 = false>
__device__ __forceinline__ void gemm_phase(PG8_LAS unsigned char* lds, const int tid, const Gemm g, const Sched& S, const Epi& E) {
    const int wid = __builtin_amdgcn_readfirstlane(tid >> 6), lane = tid & 63, wr = wid >> 2, wc = wid & 3, fr = lane & 15, fq = lane >> 4;
    const int K = g.K, nt = K / BK;
    unsigned voffA[2], voffB[2];
#pragma unroll
    for (int i = 0; i < 2; ++i) { int R, C; stage_rc(tid * 16 + i * 8192, R, C); const int Rb = Epi::PERM ? ((R & ~31) + perm32(R & 31)) : R;
        voffA[i] = (unsigned)(R * K + C) * 2u; voffB[i] = (unsigned)(Rb * K + C) * 2u; }
    const size_t kstep = (size_t)(BK * 2);
    const size_t hstep = (size_t)HALF * K * 2;
    const size_t tstep = 2 * hstep;
    const unsigned ldsw = (unsigned)wid * 1024u;
    const int aoff = lds_byte(wr * 64 + fr, fq * 8), boff = lds_byte(wc * 32 + fr, fq * 8);
#define PG8_SA(b, h) (((b) * 2 + (h)) * HTB)
#define PG8_SB(b, h) ((4 + (b) * 2 + (h)) * HTB)
#define PG8_STAGE(bufoff, gbase, voff) do { _Pragma("unroll") for (int _i = 0; _i < 2; ++_i) \
        __builtin_amdgcn_global_load_lds((const unsigned*)((const char*)(gbase) + (voff)[_i]), (PG8_LAS unsigned*)(lds + (bufoff) + ldsw + _i * 8192), 16, 0, 0); } while (0)
#define PG8_LDA(dst, b, h) do { _Pragma("unroll") for (int m = 0; m < 4; ++m) _Pragma("unroll") for (int k = 0; k < 2; ++k) dst[m][k] = *(const PG8_LAS bf16x8*)(lds + PG8_SA(b, h) + aoff + m * 2048 + k * 1024); } while (0)
#define PG8_LDB(dst, b, h) do { _Pragma("unroll") for (int n = 0; n < 2; ++n) _Pragma("unroll") for (int k = 0; k < 2; ++k) dst[n][k] = *(const PG8_LAS bf16x8*)(lds + PG8_SB(b, h) + boff + n * 2048 + k * 1024); } while (0)
#define PG8_MMA(ai, bj, At, Bt) do { __builtin_amdgcn_s_setprio(1); _Pragma("unroll") for (int m = 0; m < 4; ++m) _Pragma("unroll") for (int n = 0; n < 2; ++n) _Pragma("unroll") for (int k = 0; k < 2; ++k) \
        acc[ai][bj][m][n] = __builtin_amdgcn_mfma_f32_16x16x32_bf16(Bt[n][k], At[m][k], acc[ai][bj][m][n], 0, 0, 0); __builtin_amdgcn_s_setprio(0); } while (0)
#define PG8_WAIT_V(n) asm volatile("s_waitcnt vmcnt(" #n ")" ::: "memory")
#define PG8_WAIT_L(n) asm volatile("s_waitcnt lgkmcnt(" #n ")" ::: "memory")
#define PG8_BAR __builtin_amdgcn_s_barrier()
#define PG8_SCHED __builtin_amdgcn_sched_barrier(0)
    Unit cur, nxt; int ui = 0;
    if (!S.next(0, cur)) return;
    f32x4 acc[2][2][4][2];
#pragma unroll
    for (int a = 0; a < 2; ++a)
#pragma unroll
        for (int b = 0; b < 2; ++b)
#pragma unroll
            for (int m = 0; m < 4; ++m)
#pragma unroll
                for (int n = 0; n < 2; ++n) acc[a][b][m][n] = (f32x4){0.f, 0.f, 0.f, 0.f};
    bf16x8 At[4][2], B0[2][2], B1[2][2];
    const char* cA = (const char*)g.A + (size_t)cur.pm * tstep; const char* cB = (const char*)g.Bt + (size_t)cur.pn * tstep;
    S.a_ready(cur);
    if constexpr (SP2) {
        PG8_STAGE(PG8_SB(0, 0), cB, voffB); PG8_STAGE(PG8_SB(0, 1), cB + hstep, voffB); PG8_STAGE(PG8_SA(0, 0), cA, voffA); PG8_STAGE(PG8_SA(0, 1), cA + hstep, voffA);
        if (wr == 1) PG8_BAR;
        PG8_WAIT_V(2); PG8_BAR;
        PG8_STAGE(PG8_SB(1, 0), cB + kstep, voffB); PG8_STAGE(PG8_SA(1, 0), cA + kstep, voffA); PG8_STAGE(PG8_SB(1, 1), cB + hstep + kstep, voffB);
        PG8_WAIT_V(6); PG8_BAR;
    } else {
        PG8_STAGE(PG8_SB(0, 0), cB, voffB); PG8_STAGE(PG8_SA(0, 0), cA, voffA); PG8_STAGE(PG8_SB(0, 1), cB + hstep, voffB); PG8_STAGE(PG8_SA(0, 1), cA + hstep, voffA);
        if (wr == 1) PG8_BAR;
        PG8_WAIT_V(4); PG8_BAR;
        PG8_STAGE(PG8_SB(1, 0), cB + kstep, voffB); PG8_STAGE(PG8_SA(1, 0), cA + kstep, voffA); PG8_STAGE(PG8_SB(1, 1), cB + hstep + kstep, voffB);
        PG8_WAIT_V(6); PG8_BAR;
    }
    for (;;) {
        const bool has_next = S.next(ui + 1, nxt);
        const char* nA = has_next ? (const char*)g.A + (size_t)nxt.pm * tstep : cA; const char* nB = has_next ? (const char*)g.Bt + (size_t)nxt.pn * tstep : cB;
        for (int t = 0; t < nt; t += 2) {
            const bool last = (t == nt - 2);
            const char* a1 = cA + (size_t)(t + 1) * kstep;
            const char* a2 = last ? nA : cA + (size_t)(t + 2) * kstep; const char* b2 = last ? nB : cB + (size_t)(t + 2) * kstep;
            const char* a3 = a2 + kstep; const char* b3 = b2 + kstep;
            if (last && has_next) S.a_ready(nxt);
            if constexpr (SP2) {
            PG8_LDB(B0, 0, 0); PG8_LDB(B1, 0, 1); PG8_SCHED; PG8_LDA(At, 0, 0); PG8_STAGE(PG8_SA(1, 1), a1 + hstep, voffA);
            PG8_WAIT_V(8); PG8_WAIT_L(0); PG8_BAR; PG8_MMA(0, 0, At, B0); PG8_MMA(0, 1, At, B1); PG8_BAR; PG8_SCHED;
            PG8_LDA(At, 0, 1); PG8_STAGE(PG8_SB(0, 0), b2, voffB); PG8_STAGE(PG8_SB(0, 1), b2 + hstep, voffB); PG8_STAGE(PG8_SA(0, 0), a2, voffA);
            PG8_WAIT_V(8); PG8_WAIT_L(0); PG8_BAR; PG8_MMA(1, 0, At, B0); PG8_MMA(1, 1, At, B1); PG8_BAR; PG8_SCHED;
            PG8_LDB(B0, 1, 0); PG8_LDB(B1, 1, 1); PG8_SCHED; PG8_LDA(At, 1, 0); PG8_STAGE(PG8_SA(0, 1), a2 + hstep, voffA);
            PG8_WAIT_V(8); PG8_WAIT_L(0); PG8_BAR; PG8_MMA(0, 0, At, B0); PG8_MMA(0, 1, At, B1); PG8_BAR; PG8_SCHED;
            PG8_LDA(At, 1, 1); PG8_STAGE(PG8_SB(1, 0), b3, voffB); PG8_STAGE(PG8_SB(1, 1), b3 + hstep, voffB); PG8_STAGE(PG8_SA(1, 0), a3, voffA);
            PG8_WAIT_V(8); PG8_WAIT_L(0); PG8_BAR; PG8_MMA(1, 0, At, B0); PG8_MMA(1, 1, At, B1); PG8_BAR; PG8_SCHED;
            } else {
            PG8_LDB(B0, 0, 0); PG8_SCHED; PG8_LDA(At, 0, 0); PG8_STAGE(PG8_SA(1, 1), a1 + hstep, voffA);
            PG8_WAIT_L(8); PG8_BAR; PG8_WAIT_L(0); PG8_MMA(0, 0, At, B0); PG8_BAR; PG8_SCHED;
            PG8_LDB(B1, 0, 1); PG8_STAGE(PG8_SB(0, 0), b2, voffB);
            PG8_BAR; PG8_WAIT_L(0); PG8_MMA(0, 1, At, B1); PG8_BAR;
            PG8_LDA(At, 0, 1); PG8_STAGE(PG8_SA(0, 0), a2, voffA);
            PG8_BAR; PG8_WAIT_L(0); PG8_MMA(1, 0, At, B0); PG8_BAR; PG8_SCHED;
            PG8_STAGE(PG8_SB(0, 1), b2 + hstep, voffB);
            PG8_WAIT_V(6); PG8_BAR; PG8_MMA(1, 1, At, B1); PG8_BAR;
            PG8_LDB(B0, 1, 0); PG8_SCHED; PG8_LDA(At, 1, 0); PG8_STAGE(PG8_SA(0, 1), a2 + hstep, voffA);
            PG8_WAIT_L(8); PG8_BAR; PG8_WAIT_L(0); PG8_MMA(0, 0, At, B0); PG8_BAR; PG8_SCHED;
            PG8_LDB(B1, 1, 1); PG8_STAGE(PG8_SB(1, 0), b3, voffB);
            PG8_BAR; PG8_WAIT_L(0); PG8_MMA(0, 1, At, B1); PG8_BAR;
            PG8_LDA(At, 1, 1); PG8_STAGE(PG8_SA(1, 0), a3, voffA);
            PG8_BAR; PG8_WAIT_L(0); PG8_MMA(1, 0, At, B0); PG8_BAR; PG8_SCHED;
            PG8_STAGE(PG8_SB(1, 1), b3 + hstep, voffB);
            PG8_WAIT_V(6); PG8_BAR; PG8_MMA(1, 1, At, B1); PG8_BAR;
            }
        }
        if constexpr (ALIGN_EPI) { if (wr == 0) PG8_BAR; }
        if constexpr (!Epi::AFTER_DRAIN) { E(acc, cur, wr, wc, fr, fq); S.done(cur); }
        if (!has_next) break;
        bool keep = false; if constexpr (Epi::CARRY) keep = E.carry(cur);
        if (!keep) {
#pragma unroll
        for (int a = 0; a < 2; ++a)
#pragma unroll
            for (int b = 0; b < 2; ++b)
#pragma unroll
                for (int m = 0; m < 4; ++m)
#pragma unroll
                    for (int n = 0; n < 2; ++n) acc[a][b][m][n] = (f32x4){0.f, 0.f, 0.f, 0.f};
        }
        cur = nxt; cA = nA; cB = nB; ++ui;
        if constexpr (ALIGN_EPI) { if (wr == 1) PG8_BAR; }
    }
    PG8_WAIT_V(0);
    if constexpr (!ALIGN_EPI) { if (wr == 0) PG8_BAR; }
    PG8_BAR;
#undef PG8_SA
#undef PG8_SB
#undef PG8_STAGE
#undef PG8_LDA
#undef PG8_LDB
#undef PG8_MMA
#undef PG8_WAIT_V
#undef PG8_WAIT_L
#undef PG8_BAR
#undef PG8_SCHED
}
}

template <class F> __device__ __forceinline__ void run_gemm8(PG8_LAS unsigned char* lds, const Ctx& cx, const bf16_t* A, const bf16_t* Bt, int M, int N, int K, const F& f) {
    pg8::Gemm g{A, Bt, M, N, K}; pg8::StaticOrder S; S.init(M, N, cx.nblk, cx.bid);
    pg8::Epi8<F> E{f};
    pg8::gemm_phase<pg8::Epi8<F>, pg8::StaticOrder, true, true>(lds, cx.tid, g, S, E);
}
template <class F> __device__ __forceinline__ void run_gemm4(PG8_LAS unsigned char* lds, const Ctx& cx, const bf16_t* A, const bf16_t* Bt, int M, int N, int K, const F& f) {
    pg8::Gemm g{A, Bt, M, N, K}; pg8::StaticOrder S; S.init(M, N, cx.nblk, cx.bid);
    pg8::Epi4L<F> E{f};
    pg8::gemm_phase<pg8::Epi4L<F>, pg8::StaticOrder, true, true>(lds, cx.tid, g, S, E);
}
__device__ __forceinline__ void run_gemm_branches(PG8_LAS unsigned char* lds, const Ctx& cx, const bf16_t* Y, const bf16_t* WBl, int mrows, const StMerge3& f, bf16_t*) {
    pg8::Gemm g{Y, WBl, 3 * MT, 3 * 1024, 512}; pg8::BranchOrder S; S.init(mrows, cx.nblk, cx.bid);
    pg8::EpiMergeCarry E{f.L, f.MRG};
    pg8::gemm_phase<pg8::EpiMergeCarry, pg8::BranchOrder, true, true>(lds, cx.tid, g, S, E);
}
__device__ __forceinline__ void run_gemm_logits(PG8_LAS unsigned char* lds, const Ctx& cx, const bf16_t* A, const bf16_t* Bt, int M, bf16_t* LT) {
    pg8::Gemm g{A, Bt, M, NMG, DM}; pg8::StaticOrder S; S.init(M, NMG, cx.nblk, cx.bid);
    pg8::Epi8T<pg8::SigTileStore> E{pg8::SigTileStore{LT}};
    pg8::gemm_phase<pg8::Epi8T<pg8::SigTileStore>, pg8::StaticOrder, true, true>(lds, cx.tid, g, S, E);
}
template <class F> __device__ __forceinline__ void run_gemm8L(PG8_LAS unsigned char* lds, const Ctx& cx, const bf16_t* A, const bf16_t* Bt, int M, int N, int K, const F& f) {
    pg8::Gemm g{A, Bt, M, N, K}; pg8::StaticOrder S; S.init(M, N, cx.nblk, cx.bid);
    pg8::Epi8L<F> E{f};
    pg8::gemm_phase<pg8::Epi8L<F>, pg8::StaticOrder, true, true>(lds, cx.tid, g, S, E);
}
#else
template <class F> void run_gemm8(unsigned char*, const Ctx&, const bf16_t* A, const bf16_t* Bt, int M, int N, int K, const F& f) {
#pragma omp parallel for schedule(dynamic, 8)
    for (int r = 0; r < M; ++r) for (int c0 = 0; c0 < N; c0 += 8) { float a[8];
        for (int e = 0; e < 8; ++e) { float s = 0.f; const bf16_t* ar = A + (size_t)r * K; const bf16_t* br = Bt + (size_t)(c0 + e) * K; for (int k = 0; k < K; ++k) s += bf2f(ar[k]) * bf2f(br[k]); a[e] = s; }
        f.st8(r, c0, a); }
}
inline void run_gemm_logits(unsigned char* l, const Ctx& c, const bf16_t* A, const bf16_t* Bt, int M, bf16_t* L) { run_gemm8(l, c, A, Bt, M, NMG, DM, StPlain{L, NMG}); }
inline void run_gemm_branches(unsigned char* l, const Ctx& c, const bf16_t* Y, const bf16_t* WBl, int mrows, const StMerge3& f, bf16_t*) {
    for (int br = 0; br < 3; ++br) run_gemm8(l, c, Y + (size_t)br * MT * 512, WBl + (size_t)br * DM * 512, mrows, DM, 512, StMerge{f.L, f.MRG, br}); }
template <class F> void run_gemm8L(unsigned char* l, const Ctx& c, const bf16_t* A, const bf16_t* Bt, int M, int N, int K, const F& f) { run_gemm8(l, c, A, Bt, M, N, K, f); }
template <class F> void run_gemm4(unsigned char*, const Ctx&, const bf16_t* A, const bf16_t* Bt, int M, int N, int K, const F& f) {
#pragma omp parallel for schedule(dynamic, 8)
    for (int r = 0; r < M; ++r) for (int c0 = 0; c0 < N; c0 += 4) { float a[4];
        for (int e = 0; e < 4; ++e) { float s = 0.f; const bf16_t* ar = A + (size_t)r * K; const bf16_t* br = Bt + (size_t)(c0 + e) * K; for (int k = 0; k < K; ++k) s += bf2f(ar[k]) * bf2f(br[k]); a[e] = s; }
        f.st4(r, c0, a); }
}
#endif

#ifndef PROBE_S
#define PROBE_S -1
#endif
constexpr int PPL = 11;
constexpr int NPHASE = 2 + PPL * NLAYER;
template <int PH> DEVI void run_phase_t(LQ unsigned char* lds, const Ctx& cx, const Params& p) {
    const Views v = make_views(p.ws, p.out);
    if constexpr (PH >= 100) { constexpr int layer = (PH - 100) / 10, kind = (PH - 100) % 10;
        if constexpr (kind == 0) phase_conv<0>(cx, p, layer); else if constexpr (kind == 1) phase_prep2(cx, p, layer); else phase_tmat(cx, p, lds, layer); }
    else if constexpr (PH == 0) { phase_prep(cx, p, lds); }
    else if constexpr (PH == NPHASE - 1) { phase_final(cx, p); }
    else {
        constexpr int layer = (PH - 1) / PPL, s = (PH - 1) % PPL;
        constexpr int mrows = layer == NLAYER - 1 ? ML : MT;
        if constexpr (s == 0) { phase_norm(cx, p, layer); if constexpr (layer > 0) { SYNC(); phase_prep_w(cx, p, lds, layer); } }
        else if constexpr (s == 1) run_gemm8(lds, cx, v.XN, v.W1, MT, N1, DM, StG1{v.AQKV, v.BQ, v.BKV, v.CQKV, v.HALO});
        else if constexpr (s == 2) phase_conv<0>(cx, p, layer);
        else if constexpr (s == 3) phase_prep2(cx, p, layer);
        else if constexpr (s == 4) { phase_tmat(cx, p, lds, layer); phase_attn<0>(cx, p, lds, layer); }
        else if constexpr (s == 5) phase_scan<0>(cx, p, lds, layer);
        else if constexpr (s == 6) run_gemm8(lds, cx, v.XN, v.WZ, mrows, NZ, DM, StPlain{v.Z, NZ});
        else if constexpr (s == 7) phase_y(cx, p, layer);
        else if constexpr (s == 8) run_gemm_logits(lds, cx, v.XN, v.WM, mrows, v.L);
        else if constexpr (s == 9) run_gemm_branches(lds, cx, v.Y, v.WB, mrows, StMerge3{v.L, v.MRG}, v.T);
        else run_gemm4(lds, cx, v.MRG, v.WO, mrows, DM, DM,
                       StResid{layer == 0 ? p.x : p.out, layer == 0 ? p.ctx : v.CTX1, p.out, v.CTX1, v.MOD + (size_t)layer * (NB + 1) * 3072});
    }
}
HD bool phase_is_gemm(int ph) { if (ph == 0 || ph == NPHASE - 1) return false; const int s = (ph - 1) % PPL; return s == 1 || s == 6 || s >= 8; }
#define MK_PHASE_LIST(X) X(0) X(1) X(2) X(3) X(4) X(5) X(6) X(7) X(8) X(9) X(10) X(11) X(12) X(13) X(14) X(15) X(16) X(17) X(18) X(19) X(20) X(21) X(22) X(23)
static_assert(NPHASE == 24, "phase list");
#ifdef CPU_EMU
inline void run_phase(unsigned char* lds, const Ctx& cx, const Params& p, int ph) {
    switch (ph) {
#define X(k) case k: run_phase_t<k>(lds, cx, p); break;
        MK_PHASE_LIST(X)
#undef X
    }
}
#endif

#ifndef CPU_EMU
constexpr int LDS_BYTES = 147456;
constexpr int LDS_BARST = 147392;
#define XB_TMO      128
#define XB_XCNT(j)  (256  + 64 * (j))
#define XB_XSUB(j)  (1280 + 64 * (j))
#define XB_XGEN(j)  (2304 + 64 * (j))
#define XB_TOP      3328
#define XB_TOPGEN   3392
#define XCD_BAR_WORDS 3456
#define XB_SPIN_CAP (1u << 22)
__device__ __forceinline__ unsigned xb_ld(unsigned* p)              { return __hip_atomic_load(p, __ATOMIC_RELAXED, __HIP_MEMORY_SCOPE_AGENT); }
__device__ __forceinline__ unsigned xb_add(unsigned* p, unsigned v) { return __hip_atomic_fetch_add(p, v, __ATOMIC_RELAXED, __HIP_MEMORY_SCOPE_AGENT); }
__device__ __forceinline__ unsigned xb_xcc_id() { return (unsigned)__builtin_amdgcn_s_getreg((3 << 11) | 20) & 0xFu; }
#define XB_SPIN(cond, bar) do { unsigned _sp = 0; while (cond) { __builtin_amdgcn_s_sleep(1); \
    if ((++_sp & 255u) == 0u) { if (xb_ld(&(bar)[XB_TMO])) break; if (_sp > XB_SPIN_CAP) { atomicAdd(&(bar)[XB_TMO], 1u); break; } } } } while (0)
struct XcdBarrier { unsigned* bar; unsigned x; volatile PG8_LAS unsigned* st; };
__device__ __forceinline__ void xcd_barrier_complete(unsigned* bar, unsigned x, unsigned G, unsigned& nloc, unsigned& nx) {
    unsigned sum, cnt, mine, sp = 0u;
    for (;;) {
        sum = 0u; cnt = 0u; mine = 0u;
#pragma unroll
        for (unsigned j = 0; j < 16; ++j) { const unsigned c = xb_ld(&bar[XB_XCNT(j)]); sum += c; cnt += (c > 0u) ? 1u : 0u; mine = (j == x) ? c : mine; }
        if (sum == G) break;
        __builtin_amdgcn_s_sleep(1);
        if ((++sp & 255u) == 0u) { if (xb_ld(&bar[XB_TMO])) break; if (sp > XB_SPIN_CAP) { atomicAdd(&bar[XB_TMO], 1u); break; } }
    }
    nloc = mine > 0u ? mine : 1u; nx = cnt > 0u ? cnt : 1u;
}
__device__ __forceinline__ void xcd_barrier(const XcdBarrier& b, int tid, unsigned G) {
    asm volatile("s_waitcnt vmcnt(0)" ::: "memory");
    __syncthreads();
    if (tid == 0) {
        unsigned* bar = b.bar;
        __builtin_amdgcn_s_waitcnt(0);
        unsigned nloc = b.st[0], nx = b.st[1];
        if (nloc == 0u) { xcd_barrier_complete(bar, b.x, G, nloc, nx); b.st[0] = nloc; b.st[1] = nx; }
        const unsigned old = xb_add(&bar[XB_XSUB(b.x)], 1u);
        const unsigned gen = old / nloc;
        if (old + 1u == (gen + 1u) * nloc) {
            __builtin_amdgcn_fence(__ATOMIC_RELEASE, "agent");
            asm volatile("s_waitcnt vmcnt(0)" ::: "memory");
            const unsigned og = xb_add(&bar[XB_TOP], 1u);
            const unsigned tg = og / nx;
            if (og + 1u == (tg + 1u) * nx) xb_add(&bar[XB_TOPGEN], 1u);
            else XB_SPIN(xb_ld(&bar[XB_TOPGEN]) == tg, bar);
            __builtin_amdgcn_fence(__ATOMIC_ACQUIRE, "agent");
            xb_add(&bar[XB_XGEN(b.x)], 1u);
            asm volatile("s_waitcnt vmcnt(0)" ::: "memory");
        } else {
            XB_SPIN(xb_ld(&bar[XB_XGEN(b.x)]) == gen, bar);
            __builtin_amdgcn_fence(__ATOMIC_ACQUIRE, "agent");
            asm volatile("s_waitcnt vmcnt(0)" ::: "memory");
        }
    }
    __syncthreads();
}

__device__ __forceinline__ void load_args(Params& pl, const Params& p) {
#if defined(__HIP_DEVICE_COMPILE__)
    const __attribute__((address_space(4))) unsigned long long* q4 = (const __attribute__((address_space(4))) unsigned long long*)__builtin_amdgcn_kernarg_segment_ptr();
    asm volatile("" : "+s"(q4) :: "memory");
    unsigned long long w[sizeof(Params) / 8];
#pragma unroll
    for (int i = 0; i < (int)(sizeof(Params) / 8); ++i) w[i] = q4[i];
    __builtin_memcpy(&pl, w, sizeof(Params));
#else
    pl = p;
#endif
}
__global__ void __launch_bounds__(512, 2) mk_fwd(Params p) {
    extern __shared__ __attribute__((aligned(16))) unsigned char lds_raw[];
    PG8_LAS unsigned char* lds = (PG8_LAS unsigned char*)lds_raw;
    cg::grid_group grid = cg::this_grid();
    const int ph_lo = p.ph_lo, ph_hi = p.ph_hi;
    const int wave_s = __builtin_amdgcn_readfirstlane((int)threadIdx.x >> 6);
    volatile PG8_LAS unsigned* bst = (volatile PG8_LAS unsigned*)(lds + LDS_BARST);
    if (threadIdx.x < 2) bst[threadIdx.x] = 0u;
    __syncthreads();
    XcdBarrier bar; bar.bar = (unsigned*)p.ws; bar.x = xb_xcc_id(); bar.st = bst;
    if (threadIdx.x == 0) (void)xb_add(&bar.bar[XB_XCNT(bar.x)], 1u);
#define X(k) if (k >= 100 || (ph_lo <= k && k < ph_hi)) { \
        Params pl; load_args(pl, p); \
        unsigned zl = 0u; asm volatile("" : "+v"(zl)); Ctx cx; cx.tid = wave_s * 64 + (int)__builtin_amdgcn_mbcnt_hi(~0u, __builtin_amdgcn_mbcnt_lo(~0u, zl)); cx.bid = (int)blockIdx.x; cx.nblk = (int)gridDim.x; \
        asm volatile("" : "+v"(cx.tid)); asm volatile("" : "+s"(cx.bid), "+s"(cx.nblk)); \
        run_phase_t<k>(lds, cx, pl); \
        if (k >= 100 || k + 1 < ph_hi) { if (k == 0) grid.sync(); else { unsigned z0 = 0u; asm volatile("" : "+v"(z0)); const int t2 = wave_s * 64 + (int)__builtin_amdgcn_mbcnt_hi(~0u, __builtin_amdgcn_mbcnt_lo(~0u, z0)); xcd_barrier(bar, t2, gridDim.x); } } }
    MK_PHASE_LIST(X)
#undef X
}

#ifndef MK_SINGLE
#define MK_SINGLE 1
#endif
extern "C" void kernel_launch(void* const* d_in, const int* in_sizes, int n_in, void* d_out, int out_size, void* d_ws, size_t ws_size, hipStream_t stream) {
    static int grid = 0;
    if (grid == 0) {
        if (n_in != 18 || in_sizes[0] != ML * DM || out_size != ML * DM || ws_size < (size_t)512 * MiB) { fprintf(stderr, "kernel_launch: unexpected shapes (n_in %d, in0 %d, out %d, ws %zu < %zu)\n", n_in, n_in > 0 ? in_sizes[0] : -1, out_size, ws_size, (size_t)WS_END); grid = -1; return; }
        int dev = 0, cus = 0, per_cu = 0;
        if (hipGetDevice(&dev) != hipSuccess || hipDeviceGetAttribute(&cus, hipDeviceAttributeMultiprocessorCount, dev) != hipSuccess) { grid = -1; return; }
        if (hipFuncSetAttribute((const void*)mk_fwd, hipFuncAttributeMaxDynamicSharedMemorySize, LDS_BYTES) != hipSuccess) { fprintf(stderr, "kernel_launch: hipFuncSetAttribute failed\n"); grid = -1; return; }
        if (hipOccupancyMaxActiveBlocksPerMultiprocessor(&per_cu, (const void*)mk_fwd, 512, LDS_BYTES) != hipSuccess || per_cu < 1) { fprintf(stderr, "kernel_launch: occupancy query says %d\n", per_cu); (void)hipGetLastError(); grid = -1; return; }
        grid = cus;
    }
    if (grid < 0) return;
    if (hipMemsetAsync(d_ws, 0, 16384, stream) != hipSuccess) { fprintf(stderr, "kernel_launch: memset failed\n"); return; }
    Params p{};
    const float** pp = (const float**)&p;
    for (int i = 0; i < 18; ++i) pp[i] = (const float*)d_in[i];
    p.out = (float*)d_out; p.ws = (unsigned char*)d_ws;
#if MK_SINGLE
    p.ph_lo = 0; p.ph_hi = NPHASE;
    { void* args[] = {&p}; hipError_t e = hipLaunchCooperativeKernel((const void*)mk_fwd, dim3(grid), dim3(512), args, LDS_BYTES, stream);
      if (e != hipSuccess) fprintf(stderr, "cooperative launch failed: %s\n", hipGetErrorString(e)); }
#else
    for (int ph = 0; ph < NPHASE; ++ph) {
        p.ph_lo = ph; p.ph_hi = ph + 1;
        void* args[] = {&p}; hipError_t e = hipLaunchCooperativeKernel((const void*)mk_fwd, dim3(grid), dim3(512), args, LDS_BYTES, stream);
        if (e != hipSuccess) { fprintf(stderr, "cooperative launch %d failed: %s\n", ph, hipGetErrorString(e)); break; }
    }
#endif
}
#endif
```

```cpp
#ifndef CPU_EMU
#include <hip/hip_runtime.h>
#include <hip/hip_cooperative_groups.h>
#include <cstdio>
#include <cstdint>
namespace cg = cooperative_groups;
#define DEVI __device__ __forceinline__
#define HD __host__ __device__ __forceinline__
#define CFENCE() asm volatile("" ::: "memory")
#define LAUNDER(x) asm volatile("" : "+v"(x))
#define SCHEDB() __builtin_amdgcn_sched_barrier(0)
#else
#define CFENCE() do {} while (0)
#define LAUNDER(x) do {} while (0)
#define SCHEDB() do {} while (0)
#include <cstring>
#include <cmath>
#include <cstdio>
#include <cstdint>
#include <cstddef>
#define DEVI inline
#define HD inline
#endif

#ifndef CPU_EMU
#define LQ __attribute__((address_space(3)))
typedef short bf16x8 __attribute__((ext_vector_type(8)));
typedef float f32x4 __attribute__((ext_vector_type(4)));
typedef short s16x4 __attribute__((ext_vector_type(4)));
typedef long long i64x2 __attribute__((ext_vector_type(2)));
typedef unsigned u32x4 __attribute__((ext_vector_type(4)));
#define MFMA16(a, b, c) __builtin_amdgcn_mfma_f32_16x16x32_bf16(a, b, c, 0, 0, 0)
#define SYNC() __syncthreads()
#define LSYNC() do { asm volatile("s_waitcnt lgkmcnt(0)" ::: "memory"); __builtin_amdgcn_s_barrier(); asm volatile("" ::: "memory"); } while (0)
#define WSYNC() __builtin_amdgcn_wave_barrier()
__device__ __forceinline__ s16x4 trread(LQ const unsigned char* p) { return __builtin_bit_cast(s16x4, __builtin_amdgcn_ds_read_tr16_b64_v4i16((LQ s16x4*)p)); }
__device__ __forceinline__ float shfl_f(float v, int src) { return __shfl(v, src, 64); }
#define RFL(x) __builtin_amdgcn_readfirstlane(x)
#define SPIN_YIELD() __builtin_amdgcn_s_sleep(1)
#define LDSWAIT() asm volatile("s_waitcnt lgkmcnt(0)" ::: "memory")
__device__ __forceinline__ void lds_inc(LQ unsigned* p) { (void)__hip_atomic_fetch_add(p, 1u, __ATOMIC_RELAXED, __HIP_MEMORY_SCOPE_WORKGROUP); }
__device__ __forceinline__ unsigned lds_peek(LQ unsigned* p) { return __hip_atomic_load(p, __ATOMIC_RELAXED, __HIP_MEMORY_SCOPE_WORKGROUP); }
#define FEXP(x) __expf(x)
#else
#define LQ
using simt::bf16x8; using simt::f32x4; using simt::s16x4;
typedef long long i64x2 __attribute__((vector_size(16)));
typedef unsigned u32x4 __attribute__((vector_size(16)));
#define MFMA16(a, b, c) simt::mfma16(a, b, c)
#define SYNC() simt::syncthreads()
#define LSYNC() simt::syncthreads()
#define WSYNC() ((void)simt::shfl(0.f, 0))
inline s16x4 trread(const unsigned char* p) { return simt::tr16_b64(p); }
inline float shfl_f(float v, int src) { return simt::shfl(v, src); }
#define RFL(x) (x)
#define SPIN_YIELD() simt::yield_()
#define LDSWAIT() do {} while (0)
inline void lds_inc(unsigned* p) { *(volatile unsigned*)p += 1u; }
inline unsigned lds_peek(unsigned* p) { return *(volatile unsigned*)p; }
#define FEXP(x) expf(x)
#endif

#ifndef NB
#define NB 8
#endif
#ifndef SEQ
#define SEQ 4096
#endif
#ifndef CTXL
#define CTXL 256
#endif
constexpr int DM = 1024, INW = 8464, GRIDW = 64;
constexpr int ML = NB * SEQ, MC = NB * CTXL, MT = ML + MC;
constexpr int N1 = 3840;
constexpr int NZ = 1536;
constexpr int NMG = 3072;
constexpr float EPSF = 1e-6f;
constexpr int NLAYER = 2;
static_assert(MT % 256 == 0 && ML % 256 == 0, "row tiles");
constexpr int NCH_C = CTXL / 64, NCH_L = SEQ / 64, NSTEP = NCH_C + NCH_L;

typedef unsigned short bf16_t;
struct alignas(16) U4 { unsigned x, y, z, w; };
DEVI void st16l(LQ unsigned char* p, const U4& w) { u32x4 t; t[0] = w.x; t[1] = w.y; t[2] = w.z; t[3] = w.w; *(LQ u32x4*)p = t; }
DEVI U4 ld16l(LQ const unsigned char* p) { const u32x4 t = *(LQ const u32x4*)p; U4 w; w.x = t[0]; w.y = t[1]; w.z = t[2]; w.w = t[3]; return w; }

constexpr size_t MiB = 1u << 20;
constexpr size_t al1(size_t x) { return (x + MiB - 1) & ~(MiB - 1); }
constexpr size_t WS_CTL = 0;
constexpr size_t WS_MOD = 256 * 1024;
constexpr size_t WS_WAB = 512 * 1024;
constexpr size_t WS_TAX = 640 * 1024;
constexpr size_t WS_W1 = 1 * MiB;
constexpr size_t WS_WZ = WS_W1 + al1((size_t)N1 * DM * 2);
constexpr size_t WS_WM = WS_WZ + al1((size_t)NZ * DM * 2);
constexpr size_t WS_WB = WS_WM + al1((size_t)NMG * DM * 2);
constexpr size_t WS_WO = WS_WB + al1((size_t)3 * DM * 512 * 2);
constexpr size_t WS_G = WS_WO + al1((size_t)DM * DM * 2);
constexpr size_t WS_BETA = WS_G + al1((size_t)MT * 8 * 4);
constexpr size_t WS_CTX1 = WS_BETA + al1((size_t)MT * 8 * 4);
constexpr size_t WS_XN = WS_CTX1 + al1((size_t)MC * DM * 4);
constexpr size_t WS_AQKV = WS_XN + al1((size_t)MT * DM * 2);
constexpr size_t WS_CQKV = WS_AQKV + al1((size_t)MT * 1536 * 2);
constexpr size_t WS_BQ = WS_CQKV + al1((size_t)MT * 1536 * 2);
constexpr size_t WS_PA = WS_BQ + al1((size_t)MT * 512 * 2);
constexpr size_t WS_PC = WS_PA + al1((size_t)MT * 512 * 2);
constexpr size_t WS_T = WS_PC + al1((size_t)MT * 512 * 2);
constexpr size_t WS_GC = WS_T + al1((size_t)(MT / 64) * 8 * 8192);
constexpr size_t WS_TRET = WS_GC + al1((size_t)MT * 8 * 4);
constexpr size_t WS_BKV = WS_TRET + al1((size_t)2 * SEQ * 64 * 4);
constexpr size_t WS_HALO = WS_BKV + al1((size_t)MT * 256 * 2);
constexpr size_t WS_END = WS_HALO + al1((size_t)(MT / 64) * 4 * 1536 * 2);
constexpr size_t WS_PB1 = WS_BKV;
static_assert(WS_PB1 + (size_t)2 * ML * 512 * 2 <= (size_t)512 * MiB, "layer-1 backward parks");
static_assert((size_t)2 * MT * 512 * 2 <= (size_t)ML * DM * 4, "layer-0 backward parks in d_out");
static_assert(WS_CQKV + (size_t)MT * NMG * 2 <= WS_T, "gate tile overlay");

static_assert(WS_END <= (size_t)512 * MiB, "workspace");

struct Params {
    const float *x, *c, *ctx, *c_ctx, *w_ada, *b_ada, *norm_w, *w_in, *a_conv_w, *a_log, *a_dt_bias, *a_norm_w, *b_sink, *c_decay, *c_norm_w, *w_branch, *w_out, *final_norm_w;
    float* out; unsigned char* ws;
    int ph_lo, ph_hi;
};

#ifdef CPU_EMU
inline float u2f(unsigned u) { float f; memcpy(&f, &u, 4); return f; }
inline unsigned f2u(float f) { unsigned u; memcpy(&u, &f, 4); return u; }
#else
DEVI float u2f(unsigned u) { return __uint_as_float(u); }
DEVI unsigned f2u(float f) { return __float_as_uint(f); }
#endif
DEVI float bf2f(bf16_t h) { return u2f((unsigned)h << 16); }
DEVI bf16_t f2bf(float f) { unsigned u = f2u(f); return (bf16_t)((u + 0x7fffu + ((u >> 16) & 1u)) >> 16); }
#ifndef CPU_EMU
typedef float f32x2_t __attribute__((ext_vector_type(2))); typedef __bf16 bf16x2_t __attribute__((ext_vector_type(2)));
__device__ __forceinline__ unsigned pk2(float lo, float hi) { const f32x2_t v = {lo, hi}; const bf16x2_t b = __builtin_convertvector(v, bf16x2_t); return __builtin_bit_cast(unsigned, b); }
#else
DEVI unsigned pk2(float lo, float hi) { return (unsigned)f2bf(lo) | ((unsigned)f2bf(hi) << 16); }
#endif
DEVI float lo16(unsigned w) { return u2f(w << 16); }
DEVI float hi16(unsigned w) { return u2f(w & 0xffff0000u); }
DEVI float sigmoidf_(float x) { return 1.0f / (1.0f + expf(-x)); }
DEVI float siluf_(float x) { return x / (1.0f + expf(-x)); }
DEVI float softplusf_(float x) { return x > 20.f ? x : log1pf(expf(x)); }
DEVI void unpack8(const U4& w, float* v) { v[0] = lo16(w.x); v[1] = hi16(w.x); v[2] = lo16(w.y); v[3] = hi16(w.y); v[4] = lo16(w.z); v[5] = hi16(w.z); v[6] = lo16(w.w); v[7] = hi16(w.w); }
DEVI U4 pack8(const float* v) { U4 w; w.x = pk2(v[0], v[1]); w.y = pk2(v[2], v[3]); w.z = pk2(v[4], v[5]); w.w = pk2(v[6], v[7]); return w; }

struct Ctx { int tid, bid, nblk; };
struct TI { long id, n; };
DEVI TI thread_info(const Ctx& c) {
    const int wave = c.tid >> 6, lane = c.tid & 63;
    return TI{((long)wave * c.nblk + c.bid) * 64 + lane, (long)c.nblk * 512};
}

struct Views {
    float *MOD, *WAB, *TAX, *TRET, *GC; bf16_t *W1, *WZ, *WM, *WB, *WO; float *G, *BETA, *CTX1; bf16_t *XN, *AQKV, *CQKV, *BQ, *BKV, *PA, *PC, *Y, *Z, *L, *MRG, *T, *HALO;
    bf16_t *PAb[2], *PCb[2];
};
DEVI Views make_views(unsigned char* ws, float* outbuf = nullptr) {
    Views v;
    v.MOD = (float*)(ws + WS_MOD); v.WAB = (float*)(ws + WS_WAB); v.TAX = (float*)(ws + WS_TAX); v.TRET = (float*)(ws + WS_TRET); v.GC = (float*)(ws + WS_GC); v.W1 = (bf16_t*)(ws + WS_W1); v.WZ = (bf16_t*)(ws + WS_WZ); v.WM = (bf16_t*)(ws + WS_WM); v.WB = (bf16_t*)(ws + WS_WB); v.WO = (bf16_t*)(ws + WS_WO);
    v.G = (float*)(ws + WS_G); v.BETA = (float*)(ws + WS_BETA); v.CTX1 = (float*)(ws + WS_CTX1);
    v.XN = (bf16_t*)(ws + WS_XN); v.AQKV = (bf16_t*)(ws + WS_AQKV); v.CQKV = (bf16_t*)(ws + WS_CQKV); v.BQ = (bf16_t*)(ws + WS_BQ); v.BKV = (bf16_t*)(ws + WS_BKV);
    v.PA = (bf16_t*)(ws + WS_PA); v.PC = (bf16_t*)(ws + WS_PC); v.Y = v.AQKV; v.Z = v.CQKV; v.L = v.CQKV; v.MRG = v.XN; v.T = (bf16_t*)(ws + WS_T); v.HALO = (bf16_t*)(ws + WS_HALO);
    v.PAb[0] = (bf16_t*)outbuf; v.PCb[0] = (bf16_t*)outbuf + (size_t)MT * 512; v.PAb[1] = (bf16_t*)(ws + WS_PB1); v.PCb[1] = (bf16_t*)(ws + WS_PB1) + (size_t)ML * 512;
    return v;
}

HD int map_g1(int n) { return n < 1536 ? n : (n < 2048 ? 2064 + (n - 1536) : (n < 2304 ? 2576 + (n - 2048) : 3344 + (n - 2304))); }
HD int map_z(int n) { return n < 512 ? 1536 + n : (n < 1024 ? 2832 + (n - 512) : 4880 + (n - 1024)); }

DEVI float wave_sum(float v, int lane) {
#pragma unroll
    for (int o = 32; o >= 1; o >>= 1) v += shfl_f(v, lane ^ o);
    return v;
}
template <int W> DEVI float grp_sum(float v, int lane) {
#pragma unroll
    for (int o = W / 2; o >= 1; o >>= 1) v += shfl_f(v, lane ^ o);
    return v;
}
DEVI f32x4 ldg4(const float* p) { f32x4 v; __builtin_memcpy(&v, p, 16); return v; }
DEVI void stg4(float* p, const f32x4& v) { __builtin_memcpy(p, &v, 16); }

DEVI void prep_tile(const Ctx& cx, LQ unsigned char* lds, const float* src, int ld, int srccol0, int k0, bf16_t* dst, int K, int n0) {
    const int wave = RFL(cx.tid >> 6), lane = cx.tid & 63;
    LQ float* tl = (LQ float*)(lds + wave * 16640);
    { const int r = lane >> 4, c4 = (lane & 15) * 4; f32x4 w[16];
#pragma unroll
      for (int i = 0; i < 16; ++i) w[i] = ldg4(src + (size_t)(k0 + r + 4 * i) * ld + srccol0 + c4);
#pragma unroll
      for (int i = 0; i < 16; ++i)
#pragma unroll
          for (int e = 0; e < 4; ++e) tl[(r + 4 * i) * 65 + c4 + e] = w[i][e]; }
    WSYNC();
    { const int kc = (lane & 7) * 8;
#pragma unroll
      for (int i = 0; i < 8; ++i) { const int n = (lane >> 3) + 8 * i; float a[8];
#pragma unroll
          for (int e = 0; e < 8; ++e) a[e] = tl[(kc + e) * 65 + n];
          *(U4*)(dst + (size_t)(n0 + n) * K + k0 + kc) = pack8(a); } }
    WSYNC();
}
DEVI void phase_prep_w(const Ctx& cx, const Params& p, LQ unsigned char* lds, int l) {
    const Views v = make_views(p.ws);
    constexpr int T1 = (N1 / 64) * 16, TZ = (NZ / 64) * 16, TM = (NMG / 64) * 16, TB = 3 * 16 * 8, TO = 16 * 16, TL = T1 + TZ + TM + TB + TO;
    for (int t = RFL(cx.tid >> 6) * cx.nblk + cx.bid; t < TL; t += 8 * cx.nblk) {
        int r = t;
        const float* win = p.w_in + (size_t)l * DM * INW;
        if (r < T1) { const int nt = r / 16, kt = r % 16; prep_tile(cx, lds, win, INW, map_g1(nt * 64), kt * 64, v.W1, DM, nt * 64); continue; } r -= T1;
        if (r < TZ) { const int nt = r / 16, kt = r % 16; prep_tile(cx, lds, win, INW, map_z(nt * 64), kt * 64, v.WZ, DM, nt * 64); continue; } r -= TZ;
        if (r < TM) { const int nt = r / 16, kt = r % 16; prep_tile(cx, lds, win, INW, 5392 + nt * 64, kt * 64, v.WM, DM, nt * 64); continue; } r -= TM;
        if (r < TB) { const int br = r / 128, r2 = r % 128, nt = r2 / 8, kt = r2 % 8; prep_tile(cx, lds, p.w_branch + ((size_t)l * 3 + br) * 512 * DM, DM, nt * 64, kt * 64, v.WB + (size_t)br * DM * 512, 512, nt * 64); continue; } r -= TB;
        { const int nt = r / 16, kt = r % 16; prep_tile(cx, lds, p.w_out + (size_t)l * DM * DM, DM, nt * 64, kt * 64, v.WO, DM, nt * 64); }
    }
}
DEVI void phase_prep(const Ctx& cx, const Params& p, LQ unsigned char* lds) {
    const Views v = make_views(p.ws); const TI ti = thread_info(cx);
    phase_prep_w(cx, p, lds, 0);
    long tb = ti.id; LAUNDER(tb);
    for (long i = tb; i < (long)NLAYER * 16 * DM; i += ti.n) { const int l = (int)(i / (16 * DM)), j = (int)((i / DM) % 16), k = (int)(i % DM); v.WAB[i] = p.w_in[((size_t)l * DM + k) * INW + 2048 + j]; }
    LAUNDER(tb);
    for (long i = tb; i < 64 * 16; i += ti.n) { const int pos = (int)(i >> 4), f = (int)(i & 15); const float ang = (float)pos * powf(10000.0f, -(float)f / 16.0f); v.TAX[i] = cosf(ang); v.TAX[1024 + i] = sinf(ang); }
    LAUNDER(tb);
    for (long i = tb; i < (long)SEQ * 64; i += ti.n) { const int pos = (int)(i >> 6), f = (int)(i & 63); const float ang = (float)pos * powf(10000.0f, -(float)f / 64.0f); v.TRET[i] = cosf(ang); v.TRET[(size_t)SEQ * 64 + i] = sinf(ang); }
    {
        const int wave = RFL(cx.tid >> 6), lane = cx.tid & 63, nl = lane & 7, ks = lane >> 3;
        for (int it = wave * cx.nblk + cx.bid; it < NLAYER * (NB + 1) * 384; it += 8 * cx.nblk) {
            const int l = it / ((NB + 1) * 384), rem = it % ((NB + 1) * 384), b = rem / 384, n = (rem % 384) * 8 + nl;
            const float* cv = (b < NB ? p.c + (size_t)b * DM : p.c_ctx) + ks * 128;
            const float* w = p.w_ada + (size_t)l * DM * 3072 + (size_t)ks * 128 * 3072 + n;
            float acc = 0.f;
#pragma unroll 8
            for (int k = 0; k < 128; ++k) { const float cvk = cv[k]; acc += (cvk / (1.0f + FEXP(-cvk))) * w[(size_t)k * 3072]; }
            acc += shfl_f(acc, lane ^ 8); acc += shfl_f(acc, lane ^ 16); acc += shfl_f(acc, lane ^ 32);
            if (ks == 0) v.MOD[((size_t)l * (NB + 1) + b) * 3072 + n] = acc + p.b_ada[l * 3072 + n];
        }
    }
}

DEVI const float* xrow_in(const Params& p, const Views& v, int layer, int m) {
    if (layer == 0) return m < ML ? p.x + (size_t)m * DM : p.ctx + (size_t)(m - ML) * DM;
    return m < ML ? p.out + (size_t)m * DM : v.CTX1 + (size_t)(m - ML) * DM;
}
DEVI void phase_norm(const Ctx& cx, const Params& p, LQ unsigned char* lds, int layer) {
    const Views v = make_views(p.ws);
    const int tid = cx.tid, wave = RFL(tid >> 6), lane = tid & 63;
    const float* nw = p.norm_w + layer * DM; const float* wab = v.WAB + (size_t)layer * 16 * DM;
    LQ float* WL = (LQ float*)lds; LQ float* AMl = WL + 16 * DM; LQ float* SHl = AMl + DM;
    for (int i = tid; i < 4 * DM; i += 512) *(LQ f32x4*)(WL + 4 * i) = ldg4(wab + 4 * i);
    const int nq = MT / 4, qlo = (int)((long)cx.bid * nq / cx.nblk), qhi = (int)((long)(cx.bid + 1) * nq / cx.nblk);
    int q0 = qlo;
    while (q0 < qhi) {
        const int m0 = 4 * q0, b = m0 < ML ? m0 / SEQ : NB, mend = m0 < ML ? (b + 1) * SEQ : MT; const int q1 = mend / 4 < qhi ? mend / 4 : qhi;
        const float* mod = v.MOD + ((size_t)layer * (NB + 1) + b) * 3072;
        SYNC();
        for (int k = tid; k < DM; k += 512) { AMl[k] = nw[k] * (1.0f + mod[1024 + k]); SHl[k] = mod[k]; }
        SYNC();
        for (int qd = q0 + wave; qd < q1; qd += 8) {
            f32x4 xv[4][4];
#pragma unroll
            for (int r = 0; r < 4; ++r) { const int m = 4 * qd + r; const float* xr = xrow_in(p, v, layer, m); float ss = 0.f;
#pragma unroll
                for (int j = 0; j < 4; ++j) { xv[r][j] = ldg4(xr + 256 * j + 4 * lane); ss += xv[r][j][0] * xv[r][j][0] + xv[r][j][1] * xv[r][j][1] + xv[r][j][2] * xv[r][j][2] + xv[r][j][3] * xv[r][j][3]; }
                ss = wave_sum(ss, lane);
                const float rr = 1.0f / sqrtf(ss * (1.0f / DM) + EPSF);
#pragma unroll
                for (int j = 0; j < 4; ++j) { const int k0 = 256 * j + 4 * lane; const f32x4 a4 = *(LQ const f32x4*)(AMl + k0), h4 = *(LQ const f32x4*)(SHl + k0);
                    xv[r][j] = xv[r][j] * rr * a4 + h4;
                    unsigned long long w = (unsigned long long)pk2(xv[r][j][0], xv[r][j][1]) | ((unsigned long long)pk2(xv[r][j][2], xv[r][j][3]) << 32);
                    *(unsigned long long*)(v.XN + (size_t)m * DM + k0) = w; } }
            float mine[4] = {0.f, 0.f, 0.f, 0.f};
#pragma unroll 2
            for (int jj = 0; jj < 16; ++jj) { float a[4] = {0.f, 0.f, 0.f, 0.f};
#pragma unroll
                for (int j = 0; j < 4; ++j) { const f32x4 w4 = *(LQ const f32x4*)(WL + jj * DM + 256 * j + 4 * lane);
#pragma unroll
                    for (int r = 0; r < 4; ++r) a[r] += xv[r][j][0] * w4[0] + xv[r][j][1] * w4[1] + xv[r][j][2] * w4[2] + xv[r][j][3] * w4[3]; }
#pragma unroll
                for (int r = 0; r < 4; ++r) { a[r] = wave_sum(a[r], lane); if (lane == jj) mine[r] = a[r]; } }
#pragma unroll
            for (int r = 0; r < 4; ++r) { const size_t m = (size_t)4 * qd + r;
                if (lane < 8) v.BETA[m * 8 + lane] = sigmoidf_(mine[r]);
                else if (lane < 16) v.G[m * 8 + lane - 8] = -expf(p.a_log[layer * 8 + lane - 8]) * softplusf_(mine[r] + p.a_dt_bias[layer * 8 + lane - 8]); }
        }
        q0 = q1;
    }
}

template <int PRB = 0> DEVI void phase_conv(const Ctx& cx, const Params& p, int layer) {
    const Views v = make_views(p.ws); const TI ti = thread_info(cx);
    const float* cw = p.a_conv_w + (size_t)layer * 5 * 1536;
    for (long it = ti.id; it < (long)(MT / 64) * 768; it += ti.n) {
        const int gch = (int)(it / 768), c = 2 * (int)(it % 768);
        const bool lat = gch < ML / 64; const int ci = lat ? gch % NCH_L : (gch - ML / 64) % NCH_C; const bool first = ci == 0, last = ci == (lat ? NCH_L : NCH_C) - 1;
        bf16_t* col = v.AQKV + (size_t)gch * 64 * 1536 + c;
        float wa[5], wb[5];
#pragma unroll
        for (int j = 0; j < 5; ++j) { wa[j] = cw[j * 1536 + c]; wb[j] = cw[j * 1536 + c + 1]; }
        unsigned xw[68];
        xw[0] = first ? 0u : *(const unsigned*)(v.HALO + ((size_t)(gch - 1) * 4 + 2) * 1536 + c); xw[1] = first ? 0u : *(const unsigned*)(v.HALO + ((size_t)(gch - 1) * 4 + 3) * 1536 + c);
        xw[66] = last ? 0u : *(const unsigned*)(v.HALO + ((size_t)(gch + 1) * 4 + 0) * 1536 + c); xw[67] = last ? 0u : *(const unsigned*)(v.HALO + ((size_t)(gch + 1) * 4 + 1) * 1536 + c);
#pragma unroll
        for (int t = 0; t < 64; ++t) xw[2 + t] = *(const unsigned*)(col + (size_t)t * 1536);
#pragma unroll
        for (int t = 0; t < 64; ++t) {
            float ya = 0.f, yb = 0.f;
#pragma unroll
            for (int j = 0; j < 5; ++j) { ya += wa[j] * lo16(xw[t + j]); yb += wb[j] * hi16(xw[t + j]); }
            *(unsigned*)(col + (size_t)t * 1536) = pk2(ya / (1.0f + FEXP(-ya)), yb / (1.0f + FEXP(-yb))); }
    }
}

DEVI void phase_prep2(const Ctx& cx, const Params& p, int layer) {
    const Views v = make_views(p.ws);
    const int wave = RFL(cx.tid >> 6), lane = cx.tid & 63;
    for (int m = wave * cx.nblk + cx.bid; m < MT; m += 8 * cx.nblk) {
        {
            bf16_t* ptr = v.AQKV + (size_t)m * 1536 + 16 * lane; float f[16]; unpack8(*(const U4*)ptr, f); unpack8(*(const U4*)(ptr + 8), f + 8);
            float ss = 0.f;
#pragma unroll
            for (int e = 0; e < 16; ++e) ss += f[e] * f[e];
            ss = grp_sum<8>(ss, lane);
            const float sc = (1.0f / sqrtf(ss + EPSF)) * (lane < 32 ? 0.08838834764831845f : 1.0f);
#pragma unroll
            for (int e = 0; e < 16; ++e) f[e] *= sc;
            *(U4*)ptr = pack8(f); *(U4*)(ptr + 8) = pack8(f + 8);
        }
        if (m < ML && lane < 40) {
            const int t = m % SEQ, hh = lane >> 2, pu = lane & 3, half = pu >> 1, ch = pu & 1; const int pos = half == 0 ? t / GRIDW : t % GRIDW;
            bf16_t* ptr = (hh < 8 ? v.BQ + (size_t)m * 512 + hh * 64 : v.BKV + (size_t)m * 256 + (hh - 8) * 64) + half * 32 + ch * 8;
            float x1[8], x2[8]; unpack8(*(const U4*)ptr, x1); unpack8(*(const U4*)(ptr + 16), x2);
            const float* cs = v.TAX + pos * 16 + ch * 8; const float* sn = cs + 1024;
#pragma unroll
            for (int e = 0; e < 8; ++e) { const float a = x1[e], bb = x2[e]; x1[e] = a * cs[e] - bb * sn[e]; x2[e] = a * sn[e] + bb * cs[e]; }
            *(U4*)ptr = pack8(x1); *(U4*)(ptr + 16) = pack8(x2);
        }
        {
            const int which = lane >> 5, h = (lane >> 3) & 3, pu = lane & 7;
            bf16_t* ptr = v.CQKV + (size_t)m * 1536 + which * 512 + h * 128 + pu * 8;
            const float sc = which == 1 ? 0.08838834764831845f : 1.0f;
            if (m < ML) {
                float x1[8], x2[8]; unpack8(*(const U4*)ptr, x1); unpack8(*(const U4*)(ptr + 64), x2);
                const float* cs = v.TRET + (size_t)(m % SEQ) * 64 + pu * 8; const float* sn = cs + (size_t)SEQ * 64;
#pragma unroll
                for (int e = 0; e < 8; ++e) { const float a = x1[e] * sc, bb = x2[e] * sc; x1[e] = a * cs[e] - bb * sn[e]; x2[e] = a * sn[e] + bb * cs[e]; }
                *(U4*)ptr = pack8(x1); *(U4*)(ptr + 64) = pack8(x2);
            } else if (which == 1) {
                float x1[8], x2[8]; unpack8(*(const U4*)ptr, x1); unpack8(*(const U4*)(ptr + 64), x2);
#pragma unroll
                for (int e = 0; e < 8; ++e) { x1[e] *= sc; x2[e] *= sc; }
                *(U4*)ptr = pack8(x1); *(U4*)(ptr + 64) = pack8(x2);
            }
        }
    }
}

DEVI void phase_y(const Ctx& cx, const Params& p, int layer) {
    const Views v = make_views(p.ws, p.out);
    const int wave = RFL(cx.tid >> 6), lane = cx.tid & 63;
    const int mrows = layer == 0 ? MT : ML;
    for (int m = wave * cx.nblk + cx.bid; m < mrows; m += 8 * cx.nblk) {
        const int c0 = 8 * lane; float o[8], z[8], y[8];
        {   unpack8(*(const U4*)(v.PA + (size_t)m * 512 + c0), o); unpack8(*(const U4*)(v.PAb[layer] + (size_t)m * 512 + c0), z);
#pragma unroll
            for (int e = 0; e < 8; ++e) o[e] += z[e];
            unpack8(*(const U4*)(v.Z + (size_t)m * 1536 + c0), z);
            float ss = 0.f;
#pragma unroll
            for (int e = 0; e < 8; ++e) ss += o[e] * o[e];
            ss = grp_sum<16>(ss, lane); const float rs = 1.0f / sqrtf(ss * (1.0f / 128.0f) + EPSF);
            const float* w = p.a_norm_w + layer * 128 + (c0 & 127);
#pragma unroll
            for (int e = 0; e < 8; ++e) y[e] = o[e] * rs * w[e] * (z[e] / (1.0f + FEXP(-z[e])));
            *(U4*)(v.Y + (size_t)m * 512 + c0) = pack8(y); }
        {   unpack8(*(const U4*)(v.BQ + (size_t)m * 512 + c0), o); unpack8(*(const U4*)(v.Z + (size_t)m * 1536 + 512 + c0), z);
#pragma unroll
            for (int e = 0; e < 8; ++e) y[e] = o[e] * (z[e] / (1.0f + FEXP(-z[e])));
            *(U4*)(v.Y + ((size_t)MT + m) * 512 + c0) = pack8(y); }
        {   unpack8(*(const U4*)(v.PC + (size_t)m * 512 + c0), o); unpack8(*(const U4*)(v.PCb[layer] + (size_t)m * 512 + c0), z);
#pragma unroll
            for (int e = 0; e < 8; ++e) o[e] += z[e];
            unpack8(*(const U4*)(v.Z + (size_t)m * 1536 + 1024 + c0), z);
            float sm = 0.f;
#pragma unroll
            for (int e = 0; e < 8; ++e) sm += o[e];
            const float mu = grp_sum<16>(sm, lane) * (1.0f / 128.0f); float qv = 0.f;
#pragma unroll
            for (int e = 0; e < 8; ++e) { o[e] -= mu; qv += o[e] * o[e]; }
            const float rs = 1.0f / sqrtf(grp_sum<16>(qv, lane) * (1.0f / 128.0f) + EPSF);
            const float* w = p.c_norm_w + layer * 512 + c0;
#pragma unroll
            for (int e = 0; e < 8; ++e) y[e] = o[e] * rs * w[e] * (z[e] / (1.0f + FEXP(-z[e])));
            *(U4*)(v.Y + ((size_t)2 * MT + m) * 512 + c0) = pack8(y); }
    }
}

DEVI void phase_final(const Ctx& cx, const Params& p) {
    const int wave = RFL(cx.tid >> 6), lane = cx.tid & 63;
    for (int m = wave * cx.nblk + cx.bid; m < ML; m += 8 * cx.nblk) {
        float* xr = p.out + (size_t)m * DM; f32x4 xv[4]; float ss = 0.f;
#pragma unroll
        for (int j = 0; j < 4; ++j) { xv[j] = ldg4(xr + 256 * j + 4 * lane); ss += xv[j][0] * xv[j][0] + xv[j][1] * xv[j][1] + xv[j][2] * xv[j][2] + xv[j][3] * xv[j][3]; }
        ss = wave_sum(ss, lane);
        const float r = 1.0f / sqrtf(ss * (1.0f / DM) + EPSF);
#pragma unroll
        for (int j = 0; j < 4; ++j) { const f32x4 w4 = ldg4(p.final_norm_w + 256 * j + 4 * lane); f32x4 o4;
#pragma unroll
            for (int e = 0; e < 4; ++e) o4[e] = xv[j][e] * r * w4[e];
            stg4(xr + 256 * j + 4 * lane, o4); }
    }
}

DEVI bf16x8 ld8g(const bf16_t* p) { bf16x8 v; __builtin_memcpy(&v, p, 16); return v; }
DEVI bf16x8 ld8l(LQ const unsigned char* p) { return *(LQ const bf16x8*)p; }
DEVI bf16x8 ld44l(LQ const unsigned char* p) { i64x2 t; t[0] = *(LQ const long long*)p; t[1] = *(LQ const long long*)(p + 32); return __builtin_bit_cast(bf16x8, t); }
DEVI f32x4 ld4fl(LQ const unsigned char* p) { return *(LQ const f32x4*)p; }
DEVI bf16x8 packb(const f32x4& x0, const f32x4& x1) { u32x4 t; t[0] = pk2(x0[0], x0[1]); t[1] = pk2(x0[2], x0[3]); t[2] = pk2(x1[0], x1[1]); t[3] = pk2(x1[2], x1[3]); return __builtin_bit_cast(bf16x8, t); }
DEVI float wave_incl_scan(float v, int lane) {
#pragma unroll
    for (int d = 1; d < 64; d <<= 1) { const float t = shfl_f(v, lane - d < 0 ? 0 : lane - d); if (lane >= d) v += t; }
    return v;
}
DEVI int chain_row0(int b, int dir, int n) {
    if (n < NCH_C) { const int c = dir ? NCH_C - 1 - n : n; return ML + b * CTXL + 64 * c; }
    int c = n - NCH_C; if (dir) c = NCH_L - 1 - c; return b * SEQ + 64 * c;
}

constexpr int TM_WAVE_BYTES = 16384 + 512;
DEVI void phase_tmat(const Ctx& cx, const Params& p, LQ unsigned char* lds, int layer) {
    const Views v = make_views(p.ws);
    const int wave = RFL(cx.tid >> 6), lane = cx.tid & 63, q = lane >> 4, c = lane & 15;
    LQ unsigned char* wl = lds + wave * TM_WAVE_BYTES;
    LQ float* Am = (LQ float*)wl; LQ float* tab = (LQ float*)(wl + 16384);
    const int nitem = (MT / 64) * 8;
    for (int item = wave * cx.nblk + cx.bid; item < nitem; item += 8 * cx.nblk) {
        const int gchunk = item >> 3, h = (item >> 1) & 3, dir = item & 1; const size_t m0 = (size_t)gchunk * 64;
        { const size_t m = m0 + (dir ? 63 - lane : lane); const float g = v.G[m * 8 + dir * 4 + h], be = v.BETA[m * 8 + dir * 4 + h];
          const float gc = wave_incl_scan(g, lane); tab[lane] = gc; tab[64 + lane] = be; v.GC[m * 8 + dir * 4 + h] = gc; }
        bf16x8 fr[4][4];
#pragma unroll
        for (int t = 0; t < 4; ++t) { const int row = 16 * t + c; const size_t m = m0 + (dir ? 63 - row : row);
#pragma unroll
            for (int s2 = 0; s2 < 4; ++s2) fr[t][s2] = ld8g(v.AQKV + m * 1536 + 512 + h * 128 + 32 * s2 + 8 * q); }
        WSYNC();
#pragma unroll
        for (int it = 0; it < 4; ++it)
#pragma unroll
            for (int jt = 0; jt <= it; ++jt) {
                f32x4 acc = {0.f, 0.f, 0.f, 0.f};
#pragma unroll
                for (int s2 = 0; s2 < 4; ++s2) acc = MFMA16(fr[it][s2], fr[jt][s2], acc);
                const int col = 16 * jt + c; const float gcol = tab[col];
#pragma unroll
                for (int r = 0; r < 4; ++r) { const int row = 16 * it + 4 * q + r;
                    Am[row * 64 + col] = row > col ? tab[64 + row] * acc[r] * FEXP(tab[row] - gcol) : 0.f; }
            }
        WSYNC();
        float x[64];
#pragma unroll
        for (int i = 0; i < 64; ++i) {
            float sa[4] = {(i == lane) ? 1.f : 0.f, 0.f, 0.f, 0.f};
#pragma unroll
            for (int j4 = 0; j4 < (i + 3) / 4; ++j4) { const f32x4 a4 = ld4fl((LQ const unsigned char*)(Am + i * 64 + j4 * 4));
#pragma unroll
                for (int e = 0; e < 4; ++e) if (4 * j4 + e < i) sa[e] -= a4[e] * x[4 * j4 + e]; }
            x[i] = (sa[0] + sa[1]) + (sa[2] + sa[3]);
        }
        WSYNC();
        LQ bf16_t* Ti = (LQ bf16_t*)wl;
#pragma unroll
        for (int i = 0; i < 64; ++i) Ti[i * 64 + lane] = f2bf(x[i]);
        WSYNC();
        bf16_t* Tg = v.T + (size_t)item * 4096;
#pragma unroll
        for (int j = 0; j < 8; ++j) { const int piece = lane + 64 * j; *(U4*)(Tg + piece * 8) = ld16l(wl + piece * 16); }
        WSYNC();
    }
}

constexpr int SC_KB = 0, SC_QB = 17408, SC_TB = 34816, SC_PB = 44032, SC_VB = 53248, SC_SC = 62464, SC_BUF = 63744;
template <int MIX, int PF = 0> DEVI void scan_chain(const Ctx& cx, const Params& p, const Views& v, LQ unsigned char* lds, int layer, const int DIR, int b, int h, int half) {
    const int tid = cx.tid, wave = RFL(tid >> 6), lane = tid & 63, q = lane >> 4, c = lane & 15;
    const bool helper = wave >= 4; const int ht = tid - 256;
    const bf16_t* QKV = MIX == 0 ? v.AQKV : v.CQKV; bf16_t* PARK = DIR == 0 ? (MIX == 0 ? v.PA : v.PC) : (MIX == 0 ? v.PAb[layer] : v.PCb[layer]);
    const int rx = DIR ? 63 : 0;
    const float lgam = MIX == 1 ? -softplusf_(-p.c_decay[layer * 8 + DIR * 4 + h]) : 0.f;
    U4 kreg[4], qreg[4], treg[2], vreg[2]; float breg = 1.f, greg = 0.f, bsc = 1.f;
    auto hload = [&](int n) {
        const size_t m0 = (size_t)chain_row0(b, DIR, n);
        const bf16_t* base = QKV + m0 * 1536 + h * 128;
#pragma unroll
        for (int j = 0; j < 4; ++j) { const int piece = ht + 256 * j, row = piece >> 4, c16 = piece & 15; const int off = (row ^ rx) * 1536 + c16 * 8;
            kreg[j] = *(const U4*)(base + 512 + off); qreg[j] = *(const U4*)(base + off); }
        if (MIX == 0) { const bf16_t* Tg = v.T + ((size_t)(m0 / 64) * 8 + h * 2 + DIR) * 4096;
#pragma unroll
            for (int j = 0; j < 2; ++j) treg[j] = *(const U4*)(Tg + (ht + 256 * j) * 8); }
#pragma unroll
        for (int j = 0; j < 2; ++j) { const int piece = ht + 256 * j, row = piece >> 3, c8 = piece & 7; vreg[j] = *(const U4*)(base + 1024 + 64 * half + (row ^ rx) * 1536 + c8 * 8); }
        if (MIX == 0 && wave == 4) { const size_t m = m0 + (ht ^ rx); greg = v.GC[m * 8 + DIR * 4 + h]; breg = v.BETA[m * 8 + DIR * 4 + h]; bsc = v.GC[(m0 + (63 ^ rx)) * 8 + DIR * 4 + h]; }
    };
    auto hwrite = [&](int bufi) {
        LQ unsigned char* B = lds + bufi * SC_BUF;
#pragma unroll
        for (int j = 0; j < 4; ++j) { const int piece = ht + 256 * j, row = piece >> 4, c16 = piece & 15;
            st16l(B + SC_KB + row * 272 + c16 * 16, kreg[j]); st16l(B + SC_QB + row * 272 + c16 * 16, qreg[j]); }
#pragma unroll
        for (int j = 0; j < 2; ++j) { const int piece = ht + 256 * j, row = piece >> 3, c8 = piece & 7;
            if (MIX == 0) st16l(B + SC_TB + row * 144 + c8 * 16, treg[j]);
            st16l(B + SC_VB + row * 144 + c8 * 16, vreg[j]); }
        if (wave == 4) { LQ float* sc = (LQ float*)(B + SC_SC);
            float Gc, g63;
            if (MIX == 0) { Gc = greg; g63 = bsc; } else { Gc = (float)(ht + 1) * lgam; g63 = 64.f * lgam; }
            const float Gam = FEXP(Gc);
            sc[ht] = -breg * Gam; sc[64 + ht] = Gam; sc[128 + ht] = FEXP(g63 - Gc); sc[192 + ht] = Gc; sc[256 + ht] = breg; }
    };
    auto ptile = [&](LQ unsigned char* B, int it, int jt, bool zr) {
        LQ const float* sc = (LQ const float*)(B + SC_SC);
        f32x4 acc = {0.f, 0.f, 0.f, 0.f};
#pragma unroll
        for (int s2 = 0; s2 < 4; ++s2) acc = MFMA16(ld8l(B + SC_QB + (16 * it + c) * 272 + (32 * s2 + 8 * q) * 2), ld8l(B + SC_KB + (16 * jt + c) * 272 + (32 * s2 + 8 * q) * 2), acc);
        const int col = 16 * jt + c; const float gcol = sc[192 + col];
        const f32x4 grow = ld4fl(B + SC_SC + (192 + 16 * it + 4 * q) * 4);
#pragma unroll
        for (int r = 0; r < 4; ++r) { const int row = 16 * it + 4 * q + r;
            *(LQ bf16_t*)(B + SC_PB + row * 144 + col * 2) = f2bf(row >= col ? acc[r] * FEXP(grow[r] - gcol) : 0.f);
            if (zr) *(LQ bf16_t*)(B + SC_PB + row * 144 + (col + 16) * 2) = 0; }
    };
    auto hscore = [&](int bufi) {
        LQ unsigned char* B = lds + bufi * SC_BUF;
        if (wave == 4) { ptile(B, 0, 0, true); ptile(B, 1, 1, false); }
        else if (wave == 5) { ptile(B, 1, 0, false); ptile(B, 2, 2, true); ptile(B, 3, 3, false); }
        else if (wave == 6) { ptile(B, 2, 0, false); ptile(B, 2, 1, false); ptile(B, 3, 2, false); }
        else { ptile(B, 3, 0, false); ptile(B, 3, 1, false); }
    };
    LQ unsigned* hcnt = (LQ unsigned*)(lds + 2 * SC_BUF);
    if (tid == 256) *hcnt = 0u;
    LSYNC();
    if (helper) {
        unsigned htarget = 0u;
        auto hmeet = [&]() { LDSWAIT(); WSYNC(); htarget += 4u; if (lane == 0) lds_inc(hcnt); while (lds_peek(hcnt) < htarget) SPIN_YIELD(); CFENCE(); };
        hload(0); hwrite(0); hmeet(); hscore(0); if (NSTEP > 1) hload(1);
        LSYNC();
        for (int n = 0; n < NSTEP; ++n) {
            if (n + 1 < NSTEP) { hwrite((n + 1) & 1); hmeet(); hscore((n + 1) & 1); }
            if (n + 2 < NSTEP && !(PF & 1)) hload(n + 2);
            LSYNC();
        }
    } else {
        f32x4 St[8];
#pragma unroll
        for (int t = 0; t < 8; ++t) St[t] = (f32x4){0.f, 0.f, 0.f, 0.f};
        const int arow = 8 * (c >> 2) + (c & 3);
        LSYNC();
        for (int n = 0; n < NSTEP; ++n) {
            LQ unsigned char* B = lds + (n & 1) * SC_BUF; LQ const float* sc = (LQ const float*)(B + SC_SC);
            f32x4 o[4], vn[4];
            if (PF & 8) { LSYNC(); continue; }
            {
                bf16x8 Sb[4];
#pragma unroll
                for (int s2 = 0; s2 < 4; ++s2) Sb[s2] = packb(St[2 * s2], St[2 * s2 + 1]);
                f32x4 R[4];
                bf16x8 fq[2][4], fk[2][4];
#pragma unroll
                for (int s2 = 0; s2 < 4; ++s2) { const int off = arow * 272 + (32 * s2 + 8 * q) * 2; fq[0][s2] = ld8l(B + SC_QB + off); if (MIX == 0) fk[0][s2] = ld8l(B + SC_KB + off); }
#pragma unroll
                for (int i = 0; i < 4; ++i) {
                    if (i < 3) {
#pragma unroll
                        for (int s2 = 0; s2 < 4; ++s2) { const int off = (32 * ((i + 1) >> 1) + 4 * ((i + 1) & 1) + arow) * 272 + (32 * s2 + 8 * q) * 2; fq[(i + 1) & 1][s2] = ld8l(B + SC_QB + off); if (MIX == 0) fk[(i + 1) & 1][s2] = ld8l(B + SC_KB + off); } }
                    const int r0 = 32 * (i >> 1) + 8 * q + 4 * (i & 1);
                    const f32x4 Gm = ld4fl(B + SC_SC + (64 + r0) * 4);
                    const s16x4 vraw = trread(B + SC_VB + (r0 + (c >> 2)) * 144 + (16 * wave + 4 * (c & 3)) * 2);
                    f32x4 Vt; Vt[0] = bf2f((bf16_t)vraw[0]); Vt[1] = bf2f((bf16_t)vraw[1]); Vt[2] = bf2f((bf16_t)vraw[2]); Vt[3] = bf2f((bf16_t)vraw[3]);
                    f32x4 a4 = {0.f, 0.f, 0.f, 0.f}; if (MIX == 0) { a4 = ld4fl(B + SC_SC + r0 * 4); Vt = Vt * ld4fl(B + SC_SC + (256 + r0) * 4); }
                    f32x4 aK = {0.f, 0.f, 0.f, 0.f}, aQ = {0.f, 0.f, 0.f, 0.f};
                    SCHEDB();
#pragma unroll
                    for (int s2 = 0; s2 < 4; ++s2) { aQ = MFMA16(fq[i & 1][s2], Sb[s2], aQ); if (MIX == 0) aK = MFMA16(fk[i & 1][s2], Sb[s2], aK); }
                    SCHEDB();
                    o[i] = Gm * aQ;
                    if (MIX == 0) R[i] = Vt + a4 * aK; else vn[i] = Vt;
                }
                if (MIX == 0) {
                    bf16x8 Rb[2]; Rb[0] = packb(R[0], R[1]); Rb[1] = packb(R[2], R[3]);
                    bf16x8 tf[6];
                    tf[0] = ld8l(B + SC_TB + arow * 144 + (8 * q) * 2); tf[1] = ld8l(B + SC_TB + (4 + arow) * 144 + (8 * q) * 2);
                    tf[2] = ld8l(B + SC_TB + (32 + arow) * 144 + (8 * q) * 2); tf[3] = ld8l(B + SC_TB + (32 + arow) * 144 + (32 + 8 * q) * 2);
                    tf[4] = ld8l(B + SC_TB + (36 + arow) * 144 + (8 * q) * 2); tf[5] = ld8l(B + SC_TB + (36 + arow) * 144 + (32 + 8 * q) * 2);
                    const f32x4 z4 = {0.f, 0.f, 0.f, 0.f};
                    SCHEDB();
                    vn[0] = MFMA16(tf[0], Rb[0], z4); vn[1] = MFMA16(tf[1], Rb[0], z4);
                    vn[2] = MFMA16(tf[3], Rb[1], MFMA16(tf[2], Rb[0], z4)); vn[3] = MFMA16(tf[5], Rb[1], MFMA16(tf[4], Rb[0], z4));
                }
            }
            {
                bf16x8 vnb[2], veb[2];
                vnb[0] = packb(vn[0], vn[1]); vnb[1] = packb(vn[2], vn[3]);
                { f32x4 ve[4];
#pragma unroll
                  for (int i = 0; i < 4; ++i) ve[i] = ld4fl(B + SC_SC + (128 + 32 * (i >> 1) + 8 * q + 4 * (i & 1)) * 4) * vn[i];
                  veb[0] = packb(ve[0], ve[1]); veb[1] = packb(ve[2], ve[3]); }
                { bf16x8 pf[6];
                  pf[0] = ld8l(B + SC_PB + arow * 144 + (8 * q) * 2); pf[1] = ld8l(B + SC_PB + (4 + arow) * 144 + (8 * q) * 2);
                  pf[2] = ld8l(B + SC_PB + (32 + arow) * 144 + (8 * q) * 2); pf[3] = ld8l(B + SC_PB + (32 + arow) * 144 + (32 + 8 * q) * 2);
                  pf[4] = ld8l(B + SC_PB + (36 + arow) * 144 + (8 * q) * 2); pf[5] = ld8l(B + SC_PB + (36 + arow) * 144 + (32 + 8 * q) * 2);
                  SCHEDB();
                  o[0] = MFMA16(pf[0], vnb[0], o[0]); o[1] = MFMA16(pf[1], vnb[0], o[1]);
                  o[2] = MFMA16(pf[3], vnb[1], MFMA16(pf[2], vnb[0], o[2])); o[3] = MFMA16(pf[5], vnb[1], MFMA16(pf[4], vnb[0], o[3])); }
                const float g63 = sc[64 + 63];
#pragma unroll
                for (int tp = 0; tp < 8; tp += 4) {
                    s16x4 lo[4][2], hi[4][2];
#pragma unroll
                    for (int t = 0; t < 4; ++t)
#pragma unroll
                        for (int s2 = 0; s2 < 2; ++s2) { const int colb = (32 * ((tp + t) >> 1) + 8 * (c & 3) + 4 * ((tp + t) & 1)) * 2;
                            lo[t][s2] = trread(B + SC_KB + (32 * s2 + 8 * q + (c >> 2)) * 272 + colb);
                            hi[t][s2] = trread(B + SC_KB + (32 * s2 + 8 * q + 4 + (c >> 2)) * 272 + colb); }
                    SCHEDB();
#pragma unroll
                    for (int t = 0; t < 4; ++t) { f32x4 acc = St[tp + t] * g63;
#pragma unroll
                        for (int s2 = 0; s2 < 2; ++s2) { bf16x8 kt; kt[0] = lo[t][s2][0]; kt[1] = lo[t][s2][1]; kt[2] = lo[t][s2][2]; kt[3] = lo[t][s2][3]; kt[4] = hi[t][s2][0]; kt[5] = hi[t][s2][1]; kt[6] = hi[t][s2][2]; kt[7] = hi[t][s2][3];
                            acc = MFMA16(kt, veb[s2], acc); }
                        St[tp + t] = acc; }
                }
                const size_t m0 = (size_t)chain_row0(b, DIR, n);
                if (!(DIR == 1 && layer == NLAYER - 1 && n < NCH_C))
#pragma unroll
                for (int i = 0; i < 4; ++i)
#pragma unroll
                    for (int r = 0; r < 4; ++r) { const int row = 32 * (i >> 1) + 8 * q + 4 * (i & 1) + r; const size_t m = m0 + (row ^ rx);
                        bf16_t* pp = PARK + m * 512 + h * 128 + 64 * half + 16 * wave + c;
                        if (!(PF & 2)) *pp = f2bf(o[i][r]); else if (o[i][r] == 12345.678f) *pp = 0; }
            }
            LSYNC();
        }
    }
}
template <int PF = 0> DEVI void phase_scan(const Ctx& cx, const Params& p, LQ unsigned char* lds, int layer) {
    const Views v = make_views(p.ws, p.out);
    const int nitem = 2 * NB * 4 * 2;
    for (int item = cx.bid; item < nitem; item += cx.nblk) scan_chain<0, PF>(cx, p, v, lds, layer, item / (8 * NB), (item >> 3) % NB, (item >> 1) & 3, item & 1);
    CFENCE();
    for (int item = (cx.bid + cx.nblk - (nitem % cx.nblk)) % cx.nblk; item < nitem; item += cx.nblk) scan_chain<1, PF>(cx, p, v, lds, layer, item / (8 * NB), (item >> 3) % NB, (item >> 1) & 3, item & 1);
}

constexpr int AT_V = 9216, AT_BUF = 18432;
template <bool CTXQ, int PRB = 0> DEVI void attn_unit(const Ctx& cx, const Params& p, const Views& v, LQ unsigned char* lds, int layer, int b, int hkv, int blk) {
    const int tid = cx.tid, wave = RFL(tid >> 6), lane = tid & 63, q = lane >> 4, c = lane & 15;
    const int g = wave >> 1, rh = wave & 1, hq = 4 * hkv + g;
    const size_t mq0 = (CTXQ ? (size_t)ML + (size_t)b * CTXL : (size_t)b * SEQ) + 64 * blk + 32 * rh;
    bf16x8 qf[2][2];
#pragma unroll
    for (int i = 0; i < 2; ++i)
#pragma unroll
        for (int s2 = 0; s2 < 2; ++s2) qf[i][s2] = ld8g(v.BQ + (mq0 + 16 * i + c) * 512 + hq * 64 + 32 * s2 + 8 * q);
    const int wlo = CTXQ ? 0 : (2 - blk > 0 ? 2 - blk : 0), whi = CTXQ ? 0 : (NCH_L + 2 - blk < 5 ? NCH_L + 2 - blk : 5);
    const int ntile = NCH_C + (whi - wlo);
    const int lrow = tid >> 3, lpc = tid & 7;
    auto tile_row0 = [&](int j, int& tstart) -> size_t { if (j < NCH_C) { tstart = -100000; return (size_t)ML + (size_t)b * CTXL + 64 * j; } tstart = 64 * (blk - 2 + wlo + (j - NCH_C)); return (size_t)b * SEQ + tstart; };
    U4 kr0, vr0, kr1, vr1;
    auto tload = [&](int j, U4& kr, U4& vr) { int ts; const size_t r0 = tile_row0(j, ts); const bf16_t* src = v.BKV + (r0 + lrow) * 256 + hkv * 64 + lpc * 8; kr = *(const U4*)src; vr = *(const U4*)(src + 128); };
    auto twrite = [&](int bufi, const U4& kr, const U4& vr) { LQ unsigned char* B = lds + bufi * AT_BUF; st16l(B + lrow * 144 + lpc * 16, kr); st16l(B + AT_V + lrow * 144 + lpc * 16, vr); };
    float mrun[2], lrun[2]; f32x4 ot[4][2];
    mrun[0] = mrun[1] = p.b_sink[layer * 8 + hq]; lrun[0] = lrun[1] = 1.0f;
#pragma unroll
    for (int dt = 0; dt < 4; ++dt) { ot[dt][0] = (f32x4){0.f, 0.f, 0.f, 0.f}; ot[dt][1] = (f32x4){0.f, 0.f, 0.f, 0.f}; }
    SYNC();
    tload(0, kr0, vr0); twrite(0, kr0, vr0); if (ntile > 1) tload(1, kr1, vr1);
    SYNC();
    auto tile_step = [&](int j, U4& kl, U4& vl, const U4& kw, const U4& vw) {
        LQ unsigned char* B = lds + (j & 1) * AT_BUF;
        if (j + 2 < ntile) tload(j + 2, kl, vl);
        int tstart; (void)tile_row0(j, tstart);
        f32x4 st[4][2];
#pragma unroll
        for (int kt = 0; kt < 4; ++kt) {
            const bf16x8 k0 = ld8l(B + (16 * kt + c) * 144 + (8 * q) * 2), k1 = ld8l(B + (16 * kt + c) * 144 + (32 + 8 * q) * 2);
#pragma unroll
            for (int i = 0; i < 2; ++i) { f32x4 acc = {0.f, 0.f, 0.f, 0.f}; acc = MFMA16(k0, qf[i][0], acc); acc = MFMA16(k1, qf[i][1], acc); st[kt][i] = acc * 0.125f; }
        }
        if (j >= NCH_C) {
#pragma unroll
            for (int i = 0; i < 2; ++i) { const int tq = 64 * blk + 32 * rh + 16 * i + c;
#pragma unroll
                for (int kt = 0; kt < 4; ++kt)
#pragma unroll
                    for (int r = 0; r < 4; ++r) { const int d = tstart + 16 * kt + 4 * q + r - tq; if (d > 128 || d < -128) st[kt][i][r] = -INFINITY; } }
        }
        bf16x8 pb[2][2];
#pragma unroll
        for (int i = 0; i < 2; ++i) {
            float mx = st[0][i][0];
#pragma unroll
            for (int kt = 0; kt < 4; ++kt)
#pragma unroll
                for (int r = 0; r < 4; ++r) mx = fmaxf(mx, st[kt][i][r]);
            mx = fmaxf(mx, shfl_f(mx, lane ^ 16)); mx = fmaxf(mx, shfl_f(mx, lane ^ 32));
            const float mnew = fmaxf(mrun[i], mx), alpha = FEXP(mrun[i] - mnew);
            float ls = 0.f;
#pragma unroll
            for (int kt = 0; kt < 4; ++kt)
#pragma unroll
                for (int r = 0; r < 4; ++r) { const float e = FEXP(st[kt][i][r] - mnew); st[kt][i][r] = e; ls += e; }
            ls += shfl_f(ls, lane ^ 16); ls += shfl_f(ls, lane ^ 32);
            lrun[i] = lrun[i] * alpha + ls; mrun[i] = mnew;
#pragma unroll
            for (int dt = 0; dt < 4; ++dt) ot[dt][i] = ot[dt][i] * alpha;
            pb[i][0] = packb(st[0][i], st[1][i]); pb[i][1] = packb(st[2][i], st[3][i]);
        }
#pragma unroll
        for (int dt = 0; dt < 4; ++dt)
#pragma unroll
            for (int ks = 0; ks < 2; ++ks) {
                const s16x4 lo = trread(B + AT_V + (32 * ks + 4 * q + (c >> 2)) * 144 + (16 * dt + 4 * (c & 3)) * 2);
                const s16x4 hi = trread(B + AT_V + (32 * ks + 16 + 4 * q + (c >> 2)) * 144 + (16 * dt + 4 * (c & 3)) * 2);
                bf16x8 vt; vt[0] = lo[0]; vt[1] = lo[1]; vt[2] = lo[2]; vt[3] = lo[3]; vt[4] = hi[0]; vt[5] = hi[1]; vt[6] = hi[2]; vt[7] = hi[3];
                ot[dt][0] = MFMA16(vt, pb[0][ks], ot[dt][0]); ot[dt][1] = MFMA16(vt, pb[1][ks], ot[dt][1]);
            }
        if (j + 1 < ntile) twrite((j + 1) & 1, kw, vw);
        SYNC();
    };
    for (int j = 0; j < ntile; j += 2) { tile_step(j, kr0, vr0, kr1, vr1); if (j + 1 < ntile) tile_step(j + 1, kr1, vr1, kr0, vr0); }
#pragma unroll
    for (int i = 0; i < 2; ++i) { const float il = 1.0f / lrun[i];
#pragma unroll
        for (int dt = 0; dt < 4; ++dt) { const f32x4 o4 = ot[dt][i] * il;
            unsigned long long w = (unsigned long long)pk2(o4[0], o4[1]) | ((unsigned long long)pk2(o4[2], o4[3]) << 32);
            *(unsigned long long*)((PRB ? v.PA : v.BQ) + (mq0 + 16 * i + c) * 512 + hq * 64 + 16 * dt + 4 * q) = w; } }
}
template <int PRB = 0> DEVI void phase_attn(const Ctx& cx, const Params& p, LQ unsigned char* lds, int layer) {
    const Views v = make_views(p.ws);
    const int nlat = NB * 2 * NCH_L, nctx = layer == 0 ? NB * 2 * NCH_C : 0;
    for (int item = cx.bid; item < nlat + nctx; item += cx.nblk) {
        if (item < nlat) attn_unit<false, PRB>(cx, p, v, lds, layer, item / (2 * NCH_L), (item / NCH_L) & 1, item % NCH_L);
        else { const int it = item - nlat; attn_unit<true, PRB>(cx, p, v, lds, layer, it / (2 * NCH_C), (it / NCH_C) & 1, it % NCH_C); }
    }
}

struct StG1 { bf16_t *AQKV, *BQ, *BKV, *CQKV, *HALO;
    DEVI void st8(int row, int col, const float* a) const {
        bf16_t* dst = col < 1536 ? AQKV + (size_t)row * 1536 + col : (col < 2048 ? BQ + (size_t)row * 512 + (col - 1536) : (col < 2304 ? BKV + (size_t)row * 256 + (col - 2048) : CQKV + (size_t)row * 1536 + (col - 2304)));
        const U4 w = pack8(a); *(U4*)dst = w;
        const int r64 = row & 63;
        if (col < 1536 && (r64 < 2 || r64 >= 62)) *(U4*)(HALO + ((size_t)(row >> 6) * 4 + (r64 < 2 ? r64 : r64 - 60)) * 1536 + col) = w; } };
struct StPlain { bf16_t* O; int ld;
    DEVI void st8(int row, int col, const float* a) const { *(U4*)(O + (size_t)row * ld + col) = pack8(a); } };
struct StMerge { const bf16_t* L; bf16_t* MRG; int br;
    DEVI void st8(int row, int col, const float* a) const {
        float lg[8], o[8]; unpack8(*(const U4*)(L + (size_t)row * NMG + br * 1024 + col), lg);
        if (br) unpack8(*(const U4*)(MRG + (size_t)row * DM + col), o); else { for (int e = 0; e < 8; ++e) o[e] = 0.f; }
        for (int e = 0; e < 8; ++e) o[e] += sigmoidf_(lg[e]) * a[e];
        *(U4*)(MRG + (size_t)row * DM + col) = pack8(o); }
    static constexpr bool HAS_LD = true;
    DEVI void ld8(int row, int col, U4& x0, U4& x1) const { x0 = *(const U4*)(L + (size_t)row * NMG + br * 1024 + col); if (br) x1 = *(const U4*)(MRG + (size_t)row * DM + col); else x1 = U4{0u, 0u, 0u, 0u}; }
    DEVI void fin8(int row, int col, const float* a, const U4& x0, const U4& x1) const {
        float lg[8], o[8]; unpack8(x0, lg); unpack8(x1, o);
        for (int e = 0; e < 8; ++e) o[e] += a[e] / (1.0f + FEXP(-lg[e]));
        *(U4*)(MRG + (size_t)row * DM + col) = pack8(o); } };
struct StMerge3 { const bf16_t* L; bf16_t* MRG;
    DEVI void st8(int row, int col, const float* a) const { const int br = col >> 10; StMerge{L, MRG, br}.st8(row - br * MT, col & 1023, a); }
    DEVI void ld8(int row, int col, U4& x0, U4& x1) const { const int br = col >> 10, r = row - br * MT, c = col & 1023; x0 = *(const U4*)(L + (size_t)r * NMG + br * 1024 + c); if (br) x1 = *(const U4*)(MRG + (size_t)r * DM + c); else x1 = U4{0u, 0u, 0u, 0u}; }
    DEVI void fin8(int row, int col, const float* a, const U4& x0, const U4& x1) const { const int br = col >> 10; StMerge{L, MRG, br}.fin8(row - br * MT, col & 1023, a, x0, x1); } };
struct StResid { const float *xlat, *xctx; float *olat, *octx; const float* mod;
    DEVI void st4(int row, int col, const float* a) const {
        const float* xi = row < ML ? xlat + (size_t)row * DM + col : xctx + (size_t)(row - ML) * DM + col;
        float* xo = row < ML ? olat + (size_t)row * DM + col : octx + (size_t)(row - ML) * DM + col;
        const int b = row < ML ? row / SEQ : NB; const float* g = mod + (size_t)b * 3072 + 2048 + col;
        for (int e = 0; e < 4; ++e) xo[e] = xi[e] + g[e] * a[e]; }
    DEVI f32x4 ldx(int row, int col) const { return ldg4(row < ML ? xlat + (size_t)row * DM + col : xctx + (size_t)(row - ML) * DM + col); }
    DEVI f32x4 ldgate(int row, int col) const { const int b = row < ML ? row / SEQ : NB; return ldg4(mod + (size_t)b * 3072 + 2048 + col); }
    DEVI void fin4(int row, int col, const f32x4& acc, const f32x4& x, const f32x4& g) const { stg4(row < ML ? olat + (size_t)row * DM + col : octx + (size_t)(row - ML) * DM + col, x + g * acc); } };

#ifndef CPU_EMU
namespace pg8 {
#define PG8_LAS __attribute__((address_space(3)))
typedef short bf16x8 __attribute__((ext_vector_type(8)));
typedef float f32x4 __attribute__((ext_vector_type(4)));
constexpr int BM = 256, BK = 64, HALF = 128, HTB = HALF * BK * 2, STAGE_BYTES = 8 * HTB, NXCD = 8, WGM = 8;
__host__ __device__ __forceinline__ int lds_byte(int r, int c) { const int st = (r >> 4) * 2 + (c >> 5), rr = r & 15, cc = c & 31, ob = rr * 64 + cc * 2; return st * 1024 + (ob ^ (((ob >> 9) & 1) << 5)); }
__host__ __device__ __forceinline__ void stage_rc(int b, int& R, int& C) { const int st = b / 1024, sb = b % 1024, swz = sb ^ (((sb >> 9) & 1) << 5); R = (st >> 1) * 16 + swz / 64; C = (st & 1) * 32 + (swz % 64) / 2; }
__host__ __device__ __forceinline__ int perm32(int rho) { const int n = rho >> 4, i = rho & 15; return 8 * (i >> 2) + 4 * n + (i & 3); }
struct Unit { int pm, pn; };
struct Gemm { const bf16_t* A; const bf16_t* Bt; int M, N, K; };
struct StaticOrder {
    int nM, nN, nwg, G, c;
    __host__ __device__ void init(int M, int N, int G_, int c_) { nM = M / BM; nN = N / BM; nwg = nM * nN; G = G_; c = c_; }
    __host__ __device__ bool next(int i, Unit& u) const {
        const long L = (long)i * G + c; if (L >= nwg) return false;
        int wgid = (int)L; { const int q = nwg / NXCD, r = nwg % NXCD, xcd = wgid % NXCD, off = wgid / NXCD; wgid = (xcd < r ? xcd * (q + 1) : r * (q + 1) + (xcd - r) * q) + off; }
        const int nig = WGM * nN, gid = wgid / nig, fm = gid * WGM, gsz = (nM - fm) < WGM ? (nM - fm) : WGM;
        u.pm = fm + ((wgid % nig) % gsz); u.pn = (wgid % nig) / gsz; return true;
    }
    __device__ __forceinline__ void a_ready(const Unit&) const {}
    __device__ __forceinline__ void done(const Unit&) const {}
};
struct BranchOrder {
    StaticOrder so;
    __host__ __device__ void init(int M, int G_, int c_) { so.init(M, 1024, G_, c_); }
    __host__ __device__ bool next(int i, Unit& u) const { Unit t; if (!so.next(i / 3, t)) return false; const int br = i % 3; u.pm = br * (MT / 256) + t.pm; u.pn = br * 4 + t.pn; return true; }
    __device__ __forceinline__ void a_ready(const Unit&) const {}
    __device__ __forceinline__ void done(const Unit&) const {}
};
template <class F> struct Epi8 {
    static constexpr bool PERM = true, AFTER_DRAIN = false, CARRY = false; F f;
    __device__ __forceinline__ void operator()(const f32x4 (&acc)[2][2][4][2], const Unit& u, int wr, int wc, int fr, int fq) const {
        const int row0 = u.pm * BM + wr * 64 + fr, col0 = u.pn * BM + wc * 32 + 8 * fq;
#pragma unroll
        for (int ai = 0; ai < 2; ++ai)
#pragma unroll
            for (int m = 0; m < 4; ++m)
#pragma unroll
                for (int bj = 0; bj < 2; ++bj) { const f32x4 v0 = acc[ai][bj][m][0], v1 = acc[ai][bj][m][1];
                    const float a[8] = {v0[0], v0[1], v0[2], v0[3], v1[0], v1[1], v1[2], v1[3]};
                    f.st8(row0 + ai * HALF + m * 16, col0 + bj * HALF, a); }
    }
};
template <class F> struct Epi8L {
    static constexpr bool PERM = true, AFTER_DRAIN = false, CARRY = false; F f;
    __device__ __forceinline__ void operator()(const f32x4 (&acc)[2][2][4][2], const Unit& u, int wr, int wc, int fr, int fq) const {
        const int row0 = u.pm * BM + wr * 64 + fr, col0 = u.pn * BM + wc * 32 + 8 * fq;
#pragma unroll
        for (int ai = 0; ai < 2; ++ai) {
            U4 x0[4][2], x1[4][2];
#pragma unroll
            for (int m = 0; m < 4; ++m)
#pragma unroll
                for (int bj = 0; bj < 2; ++bj) f.ld8(row0 + ai * HALF + m * 16, col0 + bj * HALF, x0[m][bj], x1[m][bj]);
#pragma unroll
            for (int m = 0; m < 4; ++m)
#pragma unroll
                for (int bj = 0; bj < 2; ++bj) { const f32x4 v0 = acc[ai][bj][m][0], v1 = acc[ai][bj][m][1];
                    const float a[8] = {v0[0], v0[1], v0[2], v0[3], v1[0], v1[1], v1[2], v1[3]};
                    f.fin8(row0 + ai * HALF + m * 16, col0 + bj * HALF, a, x0[m][bj], x1[m][bj]); }
        }
    }
};
struct SigTileStore { bf16_t* LT;
    __device__ __forceinline__ void st(const Unit& u, int slot, const float* a) const {
        float o[8];
#pragma unroll
        for (int e = 0; e < 8; ++e) o[e] = 1.0f / (1.0f + __expf(-a[e]));
        *(U4*)(LT + (((size_t)(u.pm * 12 + u.pn) * 8192 + slot) << 3)) = pack8(o); } };
template <class F> struct Epi8T {
    static constexpr bool PERM = true, AFTER_DRAIN = false, CARRY = false; F f;
    __device__ __forceinline__ void operator()(const f32x4 (&acc)[2][2][4][2], const Unit& u, int wr, int wc, int fr, int fq) const {
        int wl = (wr * 4 + wc) * 64 + fq * 16 + fr; asm volatile("" : "+v"(wl));
#pragma unroll
        for (int ai = 0; ai < 2; ++ai)
#pragma unroll
            for (int m = 0; m < 4; ++m)
#pragma unroll
                for (int bj = 0; bj < 2; ++bj) { const f32x4 v0 = acc[ai][bj][m][0], v1 = acc[ai][bj][m][1];
                    const float a[8] = {v0[0], v0[1], v0[2], v0[3], v1[0], v1[1], v1[2], v1[3]};
                    f.st(u, ((ai * 4 + m) * 2 + bj) * 512 + wl, a); }
    }
};
struct MergeTile { const bf16_t* LT; bf16_t* SCR; bf16_t* MRG; };
struct Epi8M {
    static constexpr bool PERM = true, AFTER_DRAIN = false, CARRY = false; MergeTile f;
    __device__ __forceinline__ void operator()(const f32x4 (&acc)[2][2][4][2], const Unit& u, int wr, int wc, int fr, int fq) const {
        const int br = u.pn >> 2, pm = u.pm - br * (MT / 256), pn = u.pn & 3;
        int wl = (wr * 4 + wc) * 64 + fq * 16 + fr; asm volatile("" : "+v"(wl));
        int row0 = pm * BM + wr * 64 + fr, col0 = pn * BM + wc * 32 + 8 * fq; asm volatile("" : "+v"(row0), "+v"(col0));
        const bf16_t* lt = f.LT + (((size_t)(pm * 12 + u.pn) * 8192) << 3);
#pragma unroll
        for (int ai = 0; ai < 2; ++ai) {
            U4 x0[4][2], x1[4][2];
#pragma unroll
            for (int m = 0; m < 4; ++m)
#pragma unroll
                for (int bj = 0; bj < 2; ++bj) { const int slot = ((ai * 4 + m) * 2 + bj) * 512 + wl;
                    x0[m][bj] = *(const U4*)(lt + ((size_t)slot << 3));
                    if (br) x1[m][bj] = *(const U4*)(f.SCR + ((size_t)slot << 3)); else x1[m][bj] = U4{0u, 0u, 0u, 0u}; }
#pragma unroll
            for (int m = 0; m < 4; ++m)
#pragma unroll
                for (int bj = 0; bj < 2; ++bj) { const f32x4 v0 = acc[ai][bj][m][0], v1 = acc[ai][bj][m][1];
                    const float a[8] = {v0[0], v0[1], v0[2], v0[3], v1[0], v1[1], v1[2], v1[3]};
                    float g[8], o[8]; unpack8(x0[m][bj], g); unpack8(x1[m][bj], o);
#pragma unroll
                    for (int e = 0; e < 8; ++e) o[e] += g[e] * a[e];
                    const int slot = ((ai * 4 + m) * 2 + bj) * 512 + wl;
                    if (br < 2) *(U4*)(f.SCR + ((size_t)slot << 3)) = pack8(o);
                    else *(U4*)(f.MRG + (size_t)(row0 + ai * HALF + m * 16) * DM + col0 + bj * HALF) = pack8(o); }
        }
    }
};
__device__ __forceinline__ void gate_scale(f32x4 (&acc)[2][2][4][2], const bf16_t* lt, int wl, bool recip) {
#pragma unroll
    for (int ai = 0; ai < 2; ++ai) {
        U4 g[4][2];
#pragma unroll
        for (int m = 0; m < 4; ++m)
#pragma unroll
            for (int bj = 0; bj < 2; ++bj) g[m][bj] = *(const U4*)(lt + ((size_t)(((ai * 4 + m) * 2 + bj) * 512 + wl) << 3));
#pragma unroll
        for (int m = 0; m < 4; ++m)
#pragma unroll
            for (int bj = 0; bj < 2; ++bj) { float f[8]; unpack8(g[m][bj], f);
                if (recip) {
#pragma unroll
                    for (int e = 0; e < 8; ++e) f[e] = __builtin_amdgcn_rcpf(fmaxf(f[e], 1e-12f)); }
                acc[ai][bj][m][0] = acc[ai][bj][m][0] * (f32x4){f[0], f[1], f[2], f[3]}; acc[ai][bj][m][1] = acc[ai][bj][m][1] * (f32x4){f[4], f[5], f[6], f[7]}; }
    }
}
struct EpiMergeCarry {
    static constexpr bool PERM = true, AFTER_DRAIN = false, CARRY = true; const bf16_t* LT; bf16_t* MRG;
    __device__ __forceinline__ bool carry(const Unit& u) const { return (u.pn >> 2) < 2; }
    __device__ __forceinline__ void operator()(f32x4 (&acc)[2][2][4][2], const Unit& u, int wr, int wc, int fr, int fq) const {
        const int br = u.pn >> 2, pm = u.pm - br * (MT / 256), pn = u.pn & 3;
        int wl = (wr * 4 + wc) * 64 + fq * 16 + fr; asm volatile("" : "+v"(wl));
        const bf16_t* lt = LT + (((size_t)(pm * 12 + u.pn) * 8192) << 3);
        if (br < 2) { gate_scale(acc, lt, wl, false); gate_scale(acc, lt + ((size_t)4 * 8192 << 3), wl, true); return; }
        int row0 = pm * BM + wr * 64 + fr, col0 = pn * BM + wc * 32 + 8 * fq; asm volatile("" : "+v"(row0), "+v"(col0));
#pragma unroll
        for (int ai = 0; ai < 2; ++ai) {
            U4 g[4][2];
#pragma unroll
            for (int m = 0; m < 4; ++m)
#pragma unroll
                for (int bj = 0; bj < 2; ++bj) g[m][bj] = *(const U4*)(lt + ((size_t)(((ai * 4 + m) * 2 + bj) * 512 + wl) << 3));
#pragma unroll
            for (int m = 0; m < 4; ++m)
#pragma unroll
                for (int bj = 0; bj < 2; ++bj) { float f[8], o[8]; unpack8(g[m][bj], f); const f32x4 v0 = acc[ai][bj][m][0], v1 = acc[ai][bj][m][1];
                    o[0] = v0[0] * f[0]; o[1] = v0[1] * f[1]; o[2] = v0[2] * f[2]; o[3] = v0[3] * f[3]; o[4] = v1[0] * f[4]; o[5] = v1[1] * f[5]; o[6] = v1[2] * f[6]; o[7] = v1[3] * f[7];
                    *(U4*)(MRG + (size_t)(row0 + ai * HALF + m * 16) * DM + col0 + bj * HALF) = pack8(o); }
        }
    }
};
template <class F> struct Epi4L {
    static constexpr bool PERM = false, AFTER_DRAIN = false, CARRY = false; F f;
    __device__ __forceinline__ void operator()(const f32x4 (&acc)[2][2][4][2], const Unit& u, int wr, int wc, int fr, int fq) const {
        const int row0 = u.pm * BM + wr * 64 + fr, col0 = u.pn * BM + wc * 32 + 4 * fq;
        f32x4 g[2][2];
#pragma unroll
        for (int bj = 0; bj < 2; ++bj)
#pragma unroll
            for (int n = 0; n < 2; ++n) g[bj][n] = f.ldgate(u.pm * BM, col0 + bj * HALF + n * 16);
#pragma unroll
        for (int ai = 0; ai < 2; ++ai) {
            f32x4 xr[4][2][2];
#pragma unroll
            for (int m = 0; m < 4; ++m)
#pragma unroll
                for (int bj = 0; bj < 2; ++bj)
#pragma unroll
                    for (int n = 0; n < 2; ++n) xr[m][bj][n] = f.ldx(row0 + ai * HALF + m * 16, col0 + bj * HALF + n * 16);
#pragma unroll
            for (int m = 0; m < 4; ++m)
#pragma unroll
                for (int bj = 0; bj < 2; ++bj)
#pragma unroll
                    for (int n = 0; n < 2; ++n) f.fin4(row0 + ai * HALF + m * 16, col0 + bj * HALF + n * 16, acc[ai][bj][m][n], xr[m][bj][n], g[bj][n]);
        }
    }
};
template <class F> struct Epi4 {
    static constexpr bool PERM = false, AFTER_DRAIN = false, CARRY = false; F f;
    __device__ __forceinline__ void operator()(const f32x4 (&acc)[2][2][4][2], const Unit& u, int wr, int wc, int fr, int fq) const {
        const int row0 = u.pm * BM + wr * 64 + fr, col0 = u.pn * BM + wc * 32 + 4 * fq;
#pragma unroll
        for (int ai = 0; ai < 2; ++ai)
#pragma unroll
            for (int m = 0; m < 4; ++m)
#pragma unroll
                for (int bj = 0; bj < 2; ++bj)
#pragma unroll
                    for (int n = 0; n < 2; ++n) { const f32x4 v0 = acc[ai][bj][m][n]; const float a[4] = {v0[0], v0[1], v0[2], v0[3]};
                        f.st4(row0 + ai * HALF + m * 16, col0 + bj * HALF + n * 16, a); }
    }
};

template <class Epi, class Sched, bool ALIGN_EPI = false, bool SP2 = false>
__device__ __forceinline__ void gemm_phase(PG8_LAS unsigned char* lds, const int tid, const Gemm g, const Sched& S, const Epi& E) {
    const int wid = __builtin_amdgcn_readfirstlane(tid >> 6), lane = tid & 63, wr = wid >> 2, wc = wid & 3, fr = lane & 15, fq = lane >> 4;
    const int K = g.K, nt = K / BK;
    unsigned voffA[2], voffB[2];
#pragma unroll
    for (int i = 0; i < 2; ++i) { int R, C; stage_rc(tid * 16 + i * 8192, R, C); const int Rb = Epi::PERM ? ((R & ~31) + perm32(R & 31)) : R;
        voffA[i] = (unsigned)(R * K + C) * 2u; voffB[i] = (unsigned)(Rb * K + C) * 2u; }
    const size_t kstep = (size_t)(BK * 2);
    const size_t hstep = (size_t)HALF * K * 2;
    const size_t tstep = 2 * hstep;
    const unsigned ldsw = (unsigned)wid * 1024u;
    const int aoff = lds_byte(wr * 64 + fr, fq * 8), boff = lds_byte(wc * 32 + fr, fq * 8);
#define PG8_SA(b, h) (((b) * 2 + (h)) * HTB)
#define PG8_SB(b, h) ((4 + (b) * 2 + (h)) * HTB)
#define PG8_STAGE(bufoff, gbase, voff) do { _Pragma("unroll") for (int _i = 0; _i < 2; ++_i) \
        __builtin_amdgcn_global_load_lds((const unsigned*)((const char*)(gbase) + (voff)[_i]), (PG8_LAS unsigned*)(lds + (bufoff) + ldsw + _i * 8192), 16, 0, 0); } while (0)
#define PG8_LDA(dst, b, h) do { _Pragma("unroll") for (int m = 0; m < 4; ++m) _Pragma("unroll") for (int k = 0; k < 2; ++k) dst[m][k] = *(const PG8_LAS bf16x8*)(lds + PG8_SA(b, h) + aoff + m * 2048 + k * 1024); } while (0)
#define PG8_LDB(dst, b, h) do { _Pragma("unroll") for (int n = 0; n < 2; ++n) _Pragma("unroll") for (int k = 0; k < 2; ++k) dst[n][k] = *(const PG8_LAS bf16x8*)(lds + PG8_SB(b, h) + boff + n * 2048 + k * 1024); } while (0)
#define PG8_MMA(ai, bj, At, Bt) do { __builtin_amdgcn_s_setprio(1); _Pragma("unroll") for (int m = 0; m < 4; ++m) _Pragma("unroll") for (int n = 0; n < 2; ++n) _Pragma("unroll") for (int k = 0; k < 2; ++k) \
        acc[ai][bj][m][n] = __builtin_amdgcn_mfma_f32_16x16x32_bf16(Bt[n][k], At[m][k], acc[ai][bj][m][n], 0, 0, 0); __builtin_amdgcn_s_setprio(0); } while (0)
#define PG8_WAIT_V(n) asm volatile("s_waitcnt vmcnt(" #n ")" ::: "memory")
#define PG8_WAIT_L(n) asm volatile("s_waitcnt lgkmcnt(" #n ")" ::: "memory")
#define PG8_BAR __builtin_amdgcn_s_barrier()
#define PG8_SCHED __builtin_amdgcn_sched_barrier(0)
    Unit cur, nxt; int ui = 0;
    if (!S.next(0, cur)) return;
    f32x4 acc[2][2][4][2];
#pragma unroll
    for (int a = 0; a < 2; ++a)
#pragma unroll
        for (int b = 0; b < 2; ++b)
#pragma unroll
            for (int m = 0; m < 4; ++m)
#pragma unroll
                for (int n = 0; n < 2; ++n) acc[a][b][m][n] = (f32x4){0.f, 0.f, 0.f, 0.f};
    bf16x8 At[4][2], B0[2][2], B1[2][2];
    const char* cA = (const char*)g.A + (size_t)cur.pm * tstep; const char* cB = (const char*)g.Bt + (size_t)cur.pn * tstep;
    S.a_ready(cur);
    if constexpr (SP2) {
        PG8_STAGE(PG8_SB(0, 0), cB, voffB); PG8_STAGE(PG8_SB(0, 1), cB + hstep, voffB); PG8_STAGE(PG8_SA(0, 0), cA, voffA); PG8_STAGE(PG8_SA(0, 1), cA + hstep, voffA);
        if (wr == 1) PG8_BAR;
        PG8_WAIT_V(2); PG8_BAR;
        PG8_STAGE(PG8_SB(1, 0), cB + kstep, voffB); PG8_STAGE(PG8_SA(1, 0), cA + kstep, voffA); PG8_STAGE(PG8_SB(1, 1), cB + hstep + kstep, voffB);
        PG8_WAIT_V(6); PG8_BAR;
    } else {
        PG8_STAGE(PG8_SB(0, 0), cB, voffB); PG8_STAGE(PG8_SA(0, 0), cA, voffA); PG8_STAGE(PG8_SB(0, 1), cB + hstep, voffB); PG8_STAGE(PG8_SA(0, 1), cA + hstep, voffA);
        if (wr == 1) PG8_BAR;
        PG8_WAIT_V(4); PG8_BAR;
        PG8_STAGE(PG8_SB(1, 0), cB + kstep, voffB); PG8_STAGE(PG8_SA(1, 0), cA + kstep, voffA); PG8_STAGE(PG8_SB(1, 1), cB + hstep + kstep, voffB);
        PG8_WAIT_V(6); PG8_BAR;
    }
    for (;;) {
        const bool has_next = S.next(ui + 1, nxt);
        const char* nA = has_next ? (const char*)g.A + (size_t)nxt.pm * tstep : cA; const char* nB = has_next ? (const char*)g.Bt + (size_t)nxt.pn * tstep : cB;
        for (int t = 0; t < nt; t += 2) {
            const bool last = (t == nt - 2);
            const char* a1 = cA + (size_t)(t + 1) * kstep;
            const char* a2 = last ? nA : cA + (size_t)(t + 2) * kstep; const char* b2 = last ? nB : cB + (size_t)(t + 2) * kstep;
            const char* a3 = a2 + kstep; const char* b3 = b2 + kstep;
            if (last && has_next) S.a_ready(nxt);
            if constexpr (SP2) {
            PG8_LDB(B0, 0, 0); PG8_LDB(B1, 0, 1); PG8_SCHED; PG8_LDA(At, 0, 0); PG8_STAGE(PG8_SA(1, 1), a1 + hstep, voffA);
            PG8_WAIT_V(8); PG8_WAIT_L(0); PG8_BAR; PG8_MMA(0, 0, At, B0); PG8_MMA(0, 1, At, B1); PG8_BAR; PG8_SCHED;
            PG8_LDA(At, 0, 1); PG8_STAGE(PG8_SB(0, 0), b2, voffB); PG8_STAGE(PG8_SB(0, 1), b2 + hstep, voffB); PG8_STAGE(PG8_SA(0, 0), a2, voffA);
            PG8_WAIT_V(8); PG8_WAIT_L(0); PG8_BAR; PG8_MMA(1, 0, At, B0); PG8_MMA(1, 1, At, B1); PG8_BAR; PG8_SCHED;
            PG8_LDB(B0, 1, 0); PG8_LDB(B1, 1, 1); PG8_SCHED; PG8_LDA(At, 1, 0); PG8_STAGE(PG8_SA(0, 1), a2 + hstep, voffA);
            PG8_WAIT_V(8); PG8_WAIT_L(0); PG8_BAR; PG8_MMA(0, 0, At, B0); PG8_MMA(0, 1, At, B1); PG8_BAR; PG8_SCHED;
            PG8_LDA(At, 1, 1); PG8_STAGE(PG8_SB(1, 0), b3, voffB); PG8_STAGE(PG8_SB(1, 1), b3 + hstep, voffB); PG8_STAGE(PG8_SA(1, 0), a3, voffA);
            PG8_WAIT_V(8); PG8_WAIT_L(0); PG8_BAR; PG8_MMA(1, 0, At, B0); PG8_MMA(1, 1, At, B1); PG8_BAR; PG8_SCHED;
            } else {
            PG8_LDB(B0, 0, 0); PG8_SCHED; PG8_LDA(At, 0, 0); PG8_STAGE(PG8_SA(1, 1), a1 + hstep, voffA);
            PG8_WAIT_L(8); PG8_BAR; PG8_WAIT_L(0); PG8_MMA(0, 0, At, B0); PG8_BAR; PG8_SCHED;
            PG8_LDB(B1, 0, 1); PG8_STAGE(PG8_SB(0, 0), b2, voffB);
            PG8_BAR; PG8_WAIT_L(0); PG8_MMA(0, 1, At, B1); PG8_BAR;
            PG8_LDA(At, 0, 1); PG8_STAGE(PG8_SA(0, 0), a2, voffA);
            PG8_BAR; PG8_WAIT_L(0); PG8_MMA(1, 0, At, B0); PG8_BAR; PG8_SCHED;
            PG8_STAGE(PG8_SB(0, 1), b2 + hstep, voffB);
            PG8_WAIT_V(6); PG8_BAR; PG8_MMA(1, 1, At, B1); PG8_BAR;
            PG8_LDB(B0, 1, 0); PG8_SCHED; PG8_LDA(At, 1, 0); PG8_STAGE(PG8_SA(0, 1), a2 + hstep, voffA);
            PG8_WAIT_L(8); PG8_BAR; PG8_WAIT_L(0); PG8_MMA(0, 0, At, B0); PG8_BAR; PG8_SCHED;
            PG8_LDB(B1, 1, 1); PG8_STAGE(PG8_SB(1, 0), b3, voffB);
            PG8_BAR; PG8_WAIT_L(0); PG8_MMA(0, 1, At, B1); PG8_BAR;
            PG8_LDA(At, 1, 1); PG8_STAGE(PG8_SA(1, 0), a3, voffA);
            PG8_BAR; PG8_WAIT_L(0); PG8_MMA(1, 0, At, B0); PG8_BAR; PG8_SCHED;
            PG8_STAGE(PG8_SB(1, 1), b3 + hstep, voffB);
            PG8_WAIT_V(6); PG8_BAR; PG8_MMA(1, 1, At, B1); PG8_BAR;
            }
        }
        if constexpr (ALIGN_EPI) { if (wr == 0) PG8_BAR; }
        if constexpr (!Epi::AFTER_DRAIN) { E(acc, cur, wr, wc, fr, fq); S.done(cur); }
        if (!has_next) break;
        bool keep = false; if constexpr (Epi::CARRY) keep = E.carry(cur);
        if (!keep) {
#pragma unroll
        for (int a = 0; a < 2; ++a)
#pragma unroll
            for (int b = 0; b < 2; ++b)
#pragma unroll
                for (int m = 0; m < 4; ++m)
#pragma unroll
                    for (int n = 0; n < 2; ++n) acc[a][b][m][n] = (f32x4){0.f, 0.f, 0.f, 0.f};
        }
        cur = nxt; cA = nA; cB = nB; ++ui;
        if constexpr (ALIGN_EPI) { if (wr == 1) PG8_BAR; }
    }
    PG8_WAIT_V(0);
    if constexpr (!ALIGN_EPI) { if (wr == 0) PG8_BAR; }
    PG8_BAR;
#undef PG8_SA
#undef PG8_SB
#undef PG8_STAGE
#undef PG8_LDA
#undef PG8_LDB
#undef PG8_MMA
#undef PG8_WAIT_V
#undef PG8_WAIT_L
#undef PG8_BAR
#undef PG8_SCHED
}
}

template <class F> __device__ __forceinline__ void run_gemm8(PG8_LAS unsigned char* lds, const Ctx& cx, const bf16_t* A, const bf16_t* Bt, int M, int N, int K, const F& f) {
    pg8::Gemm g{A, Bt, M, N, K}; pg8::StaticOrder S; S.init(M, N, cx.nblk, cx.bid);
    pg8::Epi8<F> E{f};
    pg8::gemm_phase<pg8::Epi8<F>, pg8::StaticOrder, true, true>(lds, cx.tid, g, S, E);
}
template <class F> __device__ __forceinline__ void run_gemm4(PG8_LAS unsigned char* lds, const Ctx& cx, const bf16_t* A, const bf16_t* Bt, int M, int N, int K, const F& f) {
    pg8::Gemm g{A, Bt, M, N, K}; pg8::StaticOrder S; S.init(M, N, cx.nblk, cx.bid);
    pg8::Epi4L<F> E{f};
    pg8::gemm_phase<pg8::Epi4L<F>, pg8::StaticOrder, true, true>(lds, cx.tid, g, S, E);
}
__device__ __forceinline__ void run_gemm_branches(PG8_LAS unsigned char* lds, const Ctx& cx, const bf16_t* Y, const bf16_t* WBl, int mrows, const StMerge3& f, bf16_t*) {
    pg8::Gemm g{Y, WBl, 3 * MT, 3 * 1024, 512}; pg8::BranchOrder S; S.init(mrows, cx.nblk, cx.bid);
    pg8::EpiMergeCarry E{f.L, f.MRG};
    pg8::gemm_phase<pg8::EpiMergeCarry, pg8::BranchOrder, true, true>(lds, cx.tid, g, S, E);
}
__device__ __forceinline__ void run_gemm_logits(PG8_LAS unsigned char* lds, const Ctx& cx, const bf16_t* A, const bf16_t* Bt, int M, bf16_t* LT) {
    pg8::Gemm g{A, Bt, M, NMG, DM}; pg8::StaticOrder S; S.init(M, NMG, cx.nblk, cx.bid);
    pg8::Epi8T<pg8::SigTileStore> E{pg8::SigTileStore{LT}};
    pg8::gemm_phase<pg8::Epi8T<pg8::SigTileStore>, pg8::StaticOrder, true, true>(lds, cx.tid, g, S, E);
}
template <class F> __device__ __forceinline__ void run_gemm8L(PG8_LAS unsigned char* lds, const Ctx& cx, const bf16_t* A, const bf16_t* Bt, int M, int N, int K, const F& f) {
    pg8::Gemm g{A, Bt, M, N, K}; pg8::StaticOrder S; S.init(M, N, cx.nblk, cx.bid);
    pg8::Epi8L<F> E{f};
    pg8::gemm_phase<pg8::Epi8L<F>, pg8::StaticOrder, true, true>(lds, cx.tid, g, S, E);
}
#else
template <class F> void run_gemm8(unsigned char*, const Ctx&, const bf16_t* A, const bf16_t* Bt, int M, int N, int K, const F& f) {
#pragma omp parallel for schedule(dynamic, 8)
    for (int r = 0; r < M; ++r) for (int c0 = 0; c0 < N; c0 += 8) { float a[8];
        for (int e = 0; e < 8; ++e) { float s = 0.f; const bf16_t* ar = A + (size_t)r * K; const bf16_t* br = Bt + (size_t)(c0 + e) * K; for (int k = 0; k < K; ++k) s += bf2f(ar[k]) * bf2f(br[k]); a[e] = s; }
        f.st8(r, c0, a); }
}
inline void run_gemm_logits(unsigned char* l, const Ctx& c, const bf16_t* A, const bf16_t* Bt, int M, bf16_t* L) { run_gemm8(l, c, A, Bt, M, NMG, DM, StPlain{L, NMG}); }
inline void run_gemm_branches(unsigned char* l, const Ctx& c, const bf16_t* Y, const bf16_t* WBl, int mrows, const StMerge3& f, bf16_t*) {
    for (int br = 0; br < 3; ++br) run_gemm8(l, c, Y + (size_t)br * MT * 512, WBl + (size_t)br * DM * 512, mrows, DM, 512, StMerge{f.L, f.MRG, br}); }
template <class F> void run_gemm8L(unsigned char* l, const Ctx& c, const bf16_t* A, const bf16_t* Bt, int M, int N, int K, const F& f) { run_gemm8(l, c, A, Bt, M, N, K, f); }
template <class F> void run_gemm4(unsigned char*, const Ctx&, const bf16_t* A, const bf16_t* Bt, int M, int N, int K, const F& f) {
#pragma omp parallel for schedule(dynamic, 8)
    for (int r = 0; r < M; ++r) for (int c0 = 0; c0 < N; c0 += 4) { float a[4];
        for (int e = 0; e < 4; ++e) { float s = 0.f; const bf16_t* ar = A + (size_t)r * K; const bf16_t* br = Bt + (size_t)(c0 + e) * K; for (int k = 0; k < K; ++k) s += bf2f(ar[k]) * bf2f(br[k]); a[e] = s; }
        f.st4(r, c0, a); }
}
#endif

#ifndef PROBE_S
#define PROBE_S -1
#endif
constexpr int PPL = 11;
constexpr int NPHASE = 2 + PPL * NLAYER;
template <int PH> DEVI void run_phase_t(LQ unsigned char* lds, const Ctx& cx, const Params& p) {
    const Views v = make_views(p.ws, p.out);
    if constexpr (PH >= 100) { constexpr int layer = (PH - 100) / 10, kind = (PH - 100) % 10;
        if constexpr (kind == 0) phase_conv<0>(cx, p, layer); else if constexpr (kind == 1) phase_prep2(cx, p, layer); else phase_tmat(cx, p, lds, layer); }
    else if constexpr (PH == 0) { phase_prep(cx, p, lds); }
    else if constexpr (PH == NPHASE - 1) { phase_final(cx, p); }
    else {
        constexpr int layer = (PH - 1) / PPL, s = (PH - 1) % PPL;
        constexpr int mrows = layer == NLAYER - 1 ? ML : MT;
        if constexpr (s == 0) { phase_norm(cx, p, lds, layer); if constexpr (layer > 0) { SYNC(); phase_prep_w(cx, p, lds, layer); } }
        else if constexpr (s == 1) run_gemm8(lds, cx, v.XN, v.W1, MT, N1, DM, StG1{v.AQKV, v.BQ, v.BKV, v.CQKV, v.HALO});
        else if constexpr (s == 2) phase_conv<0>(cx, p, layer);
        else if constexpr (s == 3) phase_prep2(cx, p, layer);
        else if constexpr (s == 4) { phase_tmat(cx, p, lds, layer); phase_attn<0>(cx, p, lds, layer); }
        else if constexpr (s == 5) phase_scan<0>(cx, p, lds, layer);
        else if constexpr (s == 6) run_gemm8(lds, cx, v.XN, v.WZ, mrows, NZ, DM, StPlain{v.Z, NZ});
        else if constexpr (s == 7) phase_y(cx, p, layer);
        else if constexpr (s == 8) run_gemm_logits(lds, cx, v.XN, v.WM, mrows, v.L);
        else if constexpr (s == 9) run_gemm_branches(lds, cx, v.Y, v.WB, mrows, StMerge3{v.L, v.MRG}, v.T);
        else run_gemm4(lds, cx, v.MRG, v.WO, mrows, DM, DM,
                       StResid{layer == 0 ? p.x : p.out, layer == 0 ? p.ctx : v.CTX1, p.out, v.CTX1, v.MOD + (size_t)layer * (NB + 1) * 3072});
    }
}
HD bool phase_is_gemm(int ph) { if (ph == 0 || ph == NPHASE - 1) return false; const int s = (ph - 1) % PPL; return s == 1 || s == 6 || s >= 8; }
#define MK_PHASE_LIST(X) X(0) X(1) X(2) X(3) X(4) X(5) X(6) X(7) X(8) X(9) X(10) X(11) X(12) X(13) X(14) X(15) X(16) X(17) X(18) X(19) X(20) X(21) X(22) X(23)
static_assert(NPHASE == 24, "phase list");
#ifdef CPU_EMU
inline void run_phase(unsigned char* lds, const Ctx& cx, const Params& p, int ph) {
    switch (ph) {
#define X(k) case k: run_phase_t<k>(lds, cx, p); break;
        MK_PHASE_LIST(X)
#undef X
    }
}
#endif

#ifndef CPU_EMU
constexpr int LDS_BYTES = 147456;
constexpr int LDS_BARST = 147392;
#define XB_TMO      128
#define XB_XCNT(j)  (256  + 64 * (j))
#define XB_XSUB(j)  (1280 + 64 * (j))
#define XB_XGEN(j)  (2304 + 64 * (j))
#define XB_TOP      3328
#define XB_TOPGEN   3392
#define XCD_BAR_WORDS 3456
#define XB_SPIN_CAP (1u << 22)
__device__ __forceinline__ unsigned xb_ld(unsigned* p)              { return __hip_atomic_load(p, __ATOMIC_RELAXED, __HIP_MEMORY_SCOPE_AGENT); }
__device__ __forceinline__ unsigned xb_add(unsigned* p, unsigned v) { return __hip_atomic_fetch_add(p, v, __ATOMIC_RELAXED, __HIP_MEMORY_SCOPE_AGENT); }
__device__ __forceinline__ unsigned xb_xcc_id() { return (unsigned)__builtin_amdgcn_s_getreg((3 << 11) | 20) & 0xFu; }
#define XB_SPIN(cond, bar) do { unsigned _sp = 0; while (cond) { __builtin_amdgcn_s_sleep(1); \
    if ((++_sp & 255u) == 0u) { if (xb_ld(&(bar)[XB_TMO])) break; if (_sp > XB_SPIN_CAP) { atomicAdd(&(bar)[XB_TMO], 1u); break; } } } } while (0)
struct XcdBarrier { unsigned* bar; unsigned x; volatile PG8_LAS unsigned* st; };
__device__ __forceinline__ void xcd_barrier_complete(unsigned* bar, unsigned x, unsigned G, unsigned& nloc, unsigned& nx) {
    unsigned sum, cnt, mine, sp = 0u;
    for (;;) {
        sum = 0u; cnt = 0u; mine = 0u;
#pragma unroll
        for (unsigned j = 0; j < 16; ++j) { const unsigned c = xb_ld(&bar[XB_XCNT(j)]); sum += c; cnt += (c > 0u) ? 1u : 0u; mine = (j == x) ? c : mine; }
        if (sum == G) break;
        __builtin_amdgcn_s_sleep(1);
        if ((++sp & 255u) == 0u) { if (xb_ld(&bar[XB_TMO])) break; if (sp > XB_SPIN_CAP) { atomicAdd(&bar[XB_TMO], 1u); break; } }
    }
    nloc = mine > 0u ? mine : 1u; nx = cnt > 0u ? cnt : 1u;
}
__device__ __forceinline__ void xcd_barrier(const XcdBarrier& b, int tid, unsigned G) {
    asm volatile("s_waitcnt vmcnt(0)" ::: "memory");
    __syncthreads();
    if (tid == 0) {
        unsigned* bar = b.bar;
        __builtin_amdgcn_s_waitcnt(0);
        unsigned nloc = b.st[0], nx = b.st[1];
        if (nloc == 0u) { xcd_barrier_complete(bar, b.x, G, nloc, nx); b.st[0] = nloc; b.st[1] = nx; }
        const unsigned old = xb_add(&bar[XB_XSUB(b.x)], 1u);
        const unsigned gen = old / nloc;
        if (old + 1u == (gen + 1u) * nloc) {
            __builtin_amdgcn_fence(__ATOMIC_RELEASE, "agent");
            asm volatile("s_waitcnt vmcnt(0)" ::: "memory");
            const unsigned og = xb_add(&bar[XB_TOP], 1u);
            const unsigned tg = og / nx;
            if (og + 1u == (tg + 1u) * nx) xb_add(&bar[XB_TOPGEN], 1u);
            else XB_SPIN(xb_ld(&bar[XB_TOPGEN]) == tg, bar);
            __builtin_amdgcn_fence(__ATOMIC_ACQUIRE, "agent");
            xb_add(&bar[XB_XGEN(b.x)], 1u);
            asm volatile("s_waitcnt vmcnt(0)" ::: "memory");
        } else {
            XB_SPIN(xb_ld(&bar[XB_XGEN(b.x)]) == gen, bar);
            __builtin_amdgcn_fence(__ATOMIC_ACQUIRE, "agent");
            asm volatile("s_waitcnt vmcnt(0)" ::: "memory");
        }
    }
    __syncthreads();
}

__device__ __forceinline__ void load_args(Params& pl, const Params& p) {
#if defined(__HIP_DEVICE_COMPILE__)
    const __attribute__((address_space(4))) unsigned long long* q4 = (const __attribute__((address_space(4))) unsigned long long*)__builtin_amdgcn_kernarg_segment_ptr();
    asm volatile("" : "+s"(q4) :: "memory");
    unsigned long long w[sizeof(Params) / 8];
#pragma unroll
    for (int i = 0; i < (int)(sizeof(Params) / 8); ++i) w[i] = q4[i];
    __builtin_memcpy(&pl, w, sizeof(Params));
#else
    pl = p;
#endif
}
#ifndef MK_USE_CG_SYNC
#define MK_USE_CG_SYNC 0
#endif
__global__ void __launch_bounds__(512, 2) mk_fwd(Params p) {
    extern __shared__ __attribute__((aligned(16))) unsigned char lds_raw[];
    PG8_LAS unsigned char* lds = (PG8_LAS unsigned char*)lds_raw;
    cg::grid_group grid = cg::this_grid();
    const int ph_lo = p.ph_lo, ph_hi = p.ph_hi;
    const int wave_s = __builtin_amdgcn_readfirstlane((int)threadIdx.x >> 6);
    volatile PG8_LAS unsigned* bst = (volatile PG8_LAS unsigned*)(lds + LDS_BARST);
    if (threadIdx.x < 2) bst[threadIdx.x] = 0u;
    __syncthreads();
    XcdBarrier bar; bar.bar = (unsigned*)p.ws; bar.x = xb_xcc_id(); bar.st = bst;
    if (threadIdx.x == 0) (void)xb_add(&bar.bar[XB_XCNT(bar.x)], 1u);
#define X(k) if (k >= 100 || (ph_lo <= k && k < ph_hi)) { \
        Params pl; load_args(pl, p); \
        unsigned zl = 0u; asm volatile("" : "+v"(zl)); Ctx cx; cx.tid = wave_s * 64 + (int)__builtin_amdgcn_mbcnt_hi(~0u, __builtin_amdgcn_mbcnt_lo(~0u, zl)); cx.bid = (int)blockIdx.x; cx.nblk = (int)gridDim.x; \
        asm volatile("" : "+v"(cx.tid)); asm volatile("" : "+s"(cx.bid), "+s"(cx.nblk)); \
        run_phase_t<k>(lds, cx, pl); \
        if (k >= 100 || k + 1 < ph_hi) { if (k == 0 && MK_USE_CG_SYNC) grid.sync(); else { unsigned z0 = 0u; asm volatile("" : "+v"(z0)); const int t2 = wave_s * 64 + (int)__builtin_amdgcn_mbcnt_hi(~0u, __builtin_amdgcn_mbcnt_lo(~0u, z0)); xcd_barrier(bar, t2, gridDim.x); } } }
    MK_PHASE_LIST(X)
#undef X
}

#ifndef MK_SINGLE
#define MK_SINGLE 1
#endif
extern "C" void kernel_launch(void* const* d_in, const int* in_sizes, int n_in, void* d_out, int out_size, void* d_ws, size_t ws_size, hipStream_t stream) {
    static int grid = 0;
    if (grid == 0) {
        if (n_in != 18 || in_sizes[0] != ML * DM || out_size != ML * DM || ws_size < (size_t)512 * MiB) { fprintf(stderr, "kernel_launch: unexpected shapes (n_in %d, in0 %d, out %d, ws %zu < %zu)\n", n_in, n_in > 0 ? in_sizes[0] : -1, out_size, ws_size, (size_t)WS_END); grid = -1; return; }
        int dev = 0, cus = 0, per_cu = 0;
        if (hipGetDevice(&dev) != hipSuccess || hipDeviceGetAttribute(&cus, hipDeviceAttributeMultiprocessorCount, dev) != hipSuccess) { grid = -1; return; }
        if (hipFuncSetAttribute((const void*)mk_fwd, hipFuncAttributeMaxDynamicSharedMemorySize, LDS_BYTES) != hipSuccess) { fprintf(stderr, "kernel_launch: hipFuncSetAttribute failed\n"); grid = -1; return; }
        if (hipOccupancyMaxActiveBlocksPerMultiprocessor(&per_cu, (const void*)mk_fwd, 512, LDS_BYTES) != hipSuccess || per_cu < 1) { fprintf(stderr, "kernel_launch: occupancy query says %d\n", per_cu); (void)hipGetLastError(); grid = -1; return; }
        grid = cus;
    }
    if (grid < 0) return;
    if (hipMemsetAsync(d_ws, 0, 16384, stream) != hipSuccess) { fprintf(stderr, "kernel_launch: memset failed\n"); return; }
    Params p{};
    const float** pp = (const float**)&p;
    for (int i = 0; i < 18; ++i) pp[i] = (const float*)d_in[i];
    p.out = (float*)d_out; p.ws = (unsigned char*)d_ws;
#if MK_SINGLE
    p.ph_lo = 0; p.ph_hi = NPHASE;
    { void* args[] = {&p}; hipError_t e = hipLaunchCooperativeKernel((const void*)mk_fwd, dim3(grid), dim3(512), args, LDS_BYTES, stream);
      if (e != hipSuccess) fprintf(stderr, "cooperative launch failed: %s\n", hipGetErrorString(e)); }
#else
    for (int ph = 0; ph < NPHASE; ++ph) {
        p.ph_lo = ph; p.ph_hi = ph + 1;
        void* args[] = {&p}; hipError_t e = hipLaunchCooperativeKernel((const void*)mk_fwd, dim3(grid), dim3(512), args, LDS_BYTES, stream);
        if (e != hipSuccess) { fprintf(stderr, "cooperative launch %d failed: %s\n", ph, hipGetErrorString(e)); break; }
    }
#endif
}
#endif
```
